# Optimizing an MI355X kernel written in HIP

```python
import math
import jax, jax.numpy as jnp
from jax import lax
import numpy as np

D_MODEL = 1024
BATCH = 16
SEQ = 2048
DEPTH = 4

N_MIXERS = 2
N_ATTN_LAYERS = (DEPTH + 1) // 2
N_RET_LAYERS = DEPTH // 2
NORM_EPS = 1e-6
N_NORMS = 6

D_FF = 2816

DILATED_GROUPS = ((128, 1), (512, 4), (2048, 16))
N_GROUPS = len(DILATED_GROUPS)
H_A = 16
DH_A = 64
D_A = H_A * DH_A
ATTN_IN_COLS = N_GROUPS * 3 * D_A
BLK = 64
NEG_INF = -1e30

NUM_BUCKETS = 32
REL_MAX_DISTANCE = 1024

H_R = 4
DK_R = D_MODEL // H_R
DV_R = 2 * D_MODEL // H_R
D_V = H_R * DV_R
RET_IN_COLS = 2 * H_R * DK_R + 3 * D_V
RET_CHUNK = 128
ROPE_BASE = 10000.0

kernel_name = "hybrid_dilated_attn_retention_macaron"


def rms_norm(x, g):
    xf = x.astype(jnp.float32)
    y = xf * lax.rsqrt(jnp.mean(xf * xf, axis=-1, keepdims=True) + NORM_EPS)
    return (y * g.astype(jnp.float32)).astype(x.dtype)


def swiglu(h, w_gate, w_up, w_down):
    return (jax.nn.silu(h @ w_gate) * (h @ w_up)) @ w_down


def t5_buckets(rel):
    half = NUM_BUCKETS // 2
    max_exact = half // 2
    n = np.abs(rel)
    large = max_exact + (np.log(np.maximum(n, 1) / max_exact)
                         / np.log(REL_MAX_DISTANCE / max_exact) * (half - max_exact)).astype(np.int64)
    large = np.minimum(large, half - 1)
    return ((rel > 0) * half + np.where(n < max_exact, n, large)).astype(np.int32)


def banded_attention(q, k, v, bias, radius):
    N, L, H, dh = q.shape
    nb = -(-L // BLK)
    Lp = nb * BLK
    qb = jnp.pad(q, ((0, 0), (0, Lp - L), (0, 0), (0, 0))).reshape(N, nb, BLK, H, dh)

    def windows(t):
        tp = jnp.pad(t, ((0, 0), (BLK, Lp - L + BLK), (0, 0), (0, 0))).reshape(N, nb + 2, BLK, H, dh)
        return jnp.concatenate([tp[:, :-2], tp[:, 1:-1], tp[:, 2:]], axis=2)

    kw, vw = windows(k), windows(v)
    a = np.arange(BLK)[:, None]
    c = np.arange(3 * BLK)[None, :]
    off = c - BLK - a
    key_pos = np.arange(nb)[:, None, None] * BLK - BLK + c[None]
    valid = (np.abs(off) <= radius)[None] & (key_pos >= 0) & (key_pos < L)
    bias_blk = bias[:, np.clip(off + radius, 0, 2 * radius)].astype(jnp.float32)

    s = jnp.einsum('nbqhd,nbkhd->nbhqk', qb, kw).astype(jnp.float32) * (dh ** -0.5) + bias_blk
    s = jnp.where(valid[None, :, None], s, NEG_INF)
    smax = jnp.max(s, axis=-1, keepdims=True)
    p = jnp.exp(s - smax)
    denom = jnp.sum(p, axis=-1, keepdims=True)
    o = jnp.einsum('nbhqk,nbkhd->nbqhd', (p / denom).astype(v.dtype), vw)
    lse = (smax + jnp.log(denom))[..., 0]
    o = o.reshape(N, Lp, H, dh)[:, :L]
    lse = lse.transpose(0, 1, 3, 2).reshape(N, Lp, H)[:, :L]
    return o, lse


def dilated_group(q, k, v, bias, dilation, radius):
    B, S, H, dh = q.shape
    Ls = S // dilation

    def split(t):
        return t.reshape(B, Ls, dilation, H, dh).transpose(0, 2, 1, 3, 4).reshape(B * dilation, Ls, H, dh)

    o, lse = banded_attention(split(q), split(k), split(v), bias, radius)
    o = o.reshape(B, dilation, Ls, H, dh).transpose(0, 2, 1, 3, 4).reshape(B, S, H, dh)
    lse = lse.reshape(B, dilation, Ls, H).transpose(0, 2, 1, 3).reshape(B, S, H)
    return o, lse


def dilated_attention(h, w_in, w_out, rel_bias):
    B, S, _ = h.shape
    proj = (h @ w_in).reshape(B, S, N_GROUPS, 3, H_A, DH_A)
    outs, lses = [], []
    for g, (window, dilation) in enumerate(DILATED_GROUPS):
        radius = window // (2 * dilation)
        buckets = t5_buckets(np.arange(-radius, radius + 1) * dilation)
        bias_g = rel_bias[g * H_A:(g + 1) * H_A][:, buckets]
        o, lse = dilated_group(proj[:, :, g, 0], proj[:, :, g, 1], proj[:, :, g, 2],
                               bias_g, dilation, radius)
        outs.append(o)
        lses.append(lse)
    wts = jax.nn.softmax(jnp.stack(lses, axis=0), axis=0)
    o = jnp.einsum('gbsh,gbshd->bshd', wts.astype(h.dtype), jnp.stack(outs, axis=0))
    return o.reshape(B, S, D_A) @ w_out


def rotary(t, pos):
    half = t.shape[-1] // 2
    inv_freq = 1.0 / (ROPE_BASE ** jnp.linspace(0.0, 1.0, half, dtype=jnp.float32))
    ang = pos[:, None] * inv_freq[None, :]
    cos = jnp.cos(ang)[None, :, None, :]
    sin = jnp.sin(ang)[None, :, None, :]
    t1, t2 = t[..., :half], t[..., half:]
    return jnp.concatenate([t1 * cos - t2 * sin, t1 * sin + t2 * cos], axis=-1)


def chunk_retention(q, k, v, log_gamma):
    B, S, H, dk = q.shape
    dv = v.shape[-1]
    C = RET_CHUNK
    n = S // C

    def to_chunks(t):
        return t.reshape(B, n, C, H, t.shape[-1]).transpose(1, 0, 3, 2, 4)

    qc, kc, vc = to_chunks(q), to_chunks(k), to_chunks(v)
    i = jnp.arange(C, dtype=jnp.float32)
    rel = i[:, None] - i[None, :]
    dmat = jnp.where(rel >= 0, jnp.exp(log_gamma[:, None, None] * jnp.maximum(rel, 0.0)), 0.0)
    inner = jnp.einsum('nbhid,nbhjd->nbhij', qc, kc) * dmat
    inner = jnp.einsum('nbhij,nbhje->nbhie', inner, vc)
    q_decay = jnp.exp(log_gamma[:, None] * (i + 1.0))[None, :, :, None]
    k_decay = jnp.exp(log_gamma[:, None] * (C - 1.0 - i))[None, :, :, None]
    chunk_decay = jnp.exp(log_gamma * C)[None, :, None, None]

    def step(state, xs):
        qi, ki, vi = xs
        cross = jnp.einsum('bhid,bhde->bhie', qi, state) * q_decay
        state = state * chunk_decay + jnp.einsum('bhjd,bhje->bhde', ki * k_decay, vi)
        return state, cross

    _, cross = lax.scan(step, jnp.zeros((B, H, dk, dv), jnp.float32), (qc, kc, vc))
    y = inner + cross
    return y.transpose(1, 0, 3, 2, 4).reshape(B, S, H, dv)


def head_group_norm(y):
    mu = jnp.mean(y, axis=-1, keepdims=True)
    var = jnp.mean(jnp.square(y - mu), axis=-1, keepdims=True)
    return (y - mu) * lax.rsqrt(var + NORM_EPS)


def retention(h, w_in, w_out, decay_logit):
    B, S, _ = h.shape
    proj = (h @ w_in).astype(jnp.float32)
    dq = H_R * DK_R
    q = proj[..., :dq].reshape(B, S, H_R, DK_R)
    k = proj[..., dq:2 * dq].reshape(B, S, H_R, DK_R)
    v = proj[..., 2 * dq:2 * dq + D_V].reshape(B, S, H_R, DV_R)
    g_f = proj[..., 2 * dq + D_V:2 * dq + 2 * D_V].reshape(B, S, H_R, DV_R)
    g_b = proj[..., 2 * dq + 2 * D_V:].reshape(B, S, H_R, DV_R)
    pos = jnp.arange(S, dtype=jnp.float32)
    q = rotary(q, pos)
    k = rotary(k, pos) * (DK_R ** -0.5)
    log_gamma = jnp.log1p(-jnp.exp(decay_logit.astype(jnp.float32)))
    y_f = chunk_retention(q, k, v, log_gamma[0])
    y_b = jnp.flip(chunk_retention(jnp.flip(q, 1), jnp.flip(k, 1), jnp.flip(v, 1), log_gamma[1]), 1)
    y = jax.nn.silu(g_f) * head_group_norm(y_f) + jax.nn.silu(g_b) * head_group_norm(y_b)
    return y.reshape(B, S, D_V).astype(h.dtype) @ w_out


def setup_inputs(seed: int = 0) -> dict:
    key = jax.random.key(seed)
    ks = jax.random.split(key, 12)
    f32 = jnp.float32
    x = jax.random.normal(ks[0], (BATCH, SEQ, D_MODEL), f32)
    norm_gains = 1.0 + 0.05 * jax.random.normal(ks[1], (DEPTH, N_NORMS, D_MODEL), f32)
    ffn_w_gate = jax.random.normal(ks[2], (DEPTH, 2, D_MODEL, D_FF), f32) * D_MODEL ** -0.5
    ffn_w_up = jax.random.normal(ks[3], (DEPTH, 2, D_MODEL, D_FF), f32) * D_MODEL ** -0.5
    ffn_w_down = jax.random.normal(ks[4], (DEPTH, 2, D_FF, D_MODEL), f32) * D_FF ** -0.5
    attn_w_in = jax.random.normal(ks[5], (N_ATTN_LAYERS, D_MODEL, ATTN_IN_COLS), f32) * D_MODEL ** -0.5
    attn_w_out = jax.random.normal(ks[6], (N_ATTN_LAYERS, D_A, D_MODEL), f32) * D_A ** -0.5
    rel_bias = 0.5 * jax.random.normal(ks[7], (N_GROUPS * H_A, NUM_BUCKETS), f32)
    ret_w_in = jax.random.normal(ks[8], (N_RET_LAYERS, D_MODEL, RET_IN_COLS), f32) * D_MODEL ** -0.5
    ret_w_out = jax.random.normal(ks[9], (N_RET_LAYERS, D_V, D_MODEL), f32) * D_V ** -0.5
    base = -(5.0 + jnp.arange(H_R, dtype=f32)) * math.log(2.0)
    ret_decay_logit = base[None, None, :] + 0.1 * jax.random.normal(ks[10], (N_RET_LAYERS, 2, H_R), f32)
    return {"x": x, "norm_gains": norm_gains, "ffn_w_gate": ffn_w_gate, "ffn_w_up": ffn_w_up,
            "ffn_w_down": ffn_w_down, "attn_w_in": attn_w_in, "attn_w_out": attn_w_out,
            "rel_bias": rel_bias, "ret_w_in": ret_w_in, "ret_w_out": ret_w_out,
            "ret_decay_logit": ret_decay_logit}


def reference(x, norm_gains, ffn_w_gate, ffn_w_up, ffn_w_down, attn_w_in, attn_w_out,
              rel_bias, ret_w_in, ret_w_out, ret_decay_logit):
    for i in range(DEPTH):
        g = norm_gains[i]
        h = swiglu(rms_norm(x, g[0]), ffn_w_gate[i, 0], ffn_w_up[i, 0], ffn_w_down[i, 0])
        x = x + 0.5 * rms_norm(h, g[1])
        hm = rms_norm(x, g[2])
        if i % N_MIXERS == 0:
            j = i // N_MIXERS
            m = dilated_attention(hm, attn_w_in[j], attn_w_out[j], rel_bias)
        else:
            j = i // N_MIXERS
            m = retention(hm, ret_w_in[j], ret_w_out[j], ret_decay_logit[j])
        x = x + rms_norm(m, g[3])
        h = swiglu(rms_norm(x, g[4]), ffn_w_gate[i, 1], ffn_w_up[i, 1], ffn_w_down[i, 1])
        x = x + 0.5 * rms_norm(h, g[5])
    return x
```

```cpp
#include <hip/hip_runtime.h>
#include <cstdio>
#include <cstdint>
#ifndef MK_ONE_LAUNCH
#define MK_ONE_LAUNCH 0
#endif
namespace pg8 {
#define PG8_LAS __attribute__((address_space(3)))
typedef unsigned short bf16_t;
typedef short bf16x8 __attribute__((ext_vector_type(8)));
typedef float f32x4 __attribute__((ext_vector_type(4)));
typedef unsigned u32x4 __attribute__((ext_vector_type(4)));
constexpr int BM = 256, BK = 64, HALF = 128, HTB = HALF * BK * 2  , STAGE_BYTES = 8 * HTB, NXCD = 8, WGM = 8;

__host__ __device__ __forceinline__ int lds_byte(int r, int c) { const int st = (r >> 4) * 2 + (c >> 5), rr = r & 15, cc = c & 31, ob = rr * 64 + cc * 2; return st * 1024 + (ob ^ (((ob >> 9) & 1) << 5)); }
__host__ __device__ __forceinline__ void stage_rc(int b, int& R, int& C) { const int st = b / 1024, sb = b % 1024, swz = sb ^ (((sb >> 9) & 1) << 5); R = (st >> 1) * 16 + swz / 64; C = (st & 1) * 32 + (swz % 64) / 2; }
__host__ __device__ __forceinline__ int perm32(int rho) { const int n = rho >> 4, i = rho & 15; return 8 * (i >> 2) + 4 * n + (i & 3); }

struct Unit { int pm, pn; };
struct Gemm { const bf16_t* A; const bf16_t* Bt; int M, N, K; };

struct StaticOrder {
    int nM, nN, nwg, G, c;
    __host__ __device__ void init(int M, int N, int G_, int c_) { nM = M / BM; nN = N / BM; nwg = nM * nN; G = G_; c = c_; }
    __host__ __device__ bool next(int i, Unit& u) const {
        const long L = (long)i * G + c; if (L >= nwg) return false;
        int wgid = (int)L; { const int q = nwg / NXCD, r = nwg % NXCD, xcd = wgid % NXCD, off = wgid / NXCD; wgid = (xcd < r ? xcd * (q + 1) : r * (q + 1) + (xcd - r) * q) + off; }
        const int nig = WGM * nN, gid = wgid / nig, fm = gid * WGM, gsz = (nM - fm) < WGM ? (nM - fm) : WGM;
        u.pm = fm + ((wgid % nig) % gsz); u.pn = (wgid % nig) / gsz; return true;
    }
    __device__ __forceinline__ void a_ready(const Unit&) const {}
    __device__ __forceinline__ void done(const Unit&) const {}
};

__device__ __forceinline__ unsigned cvt_pk_bf16(float lo, float hi) { unsigned r; asm volatile("v_cvt_pk_bf16_f32 %0, %1, %2" : "=v"(r) : "v"(lo), "v"(hi)); return r; }
typedef float f32x2 __attribute__((ext_vector_type(2)));

__device__ __forceinline__ float fast_sigmoid(float g) { return __builtin_amdgcn_rcpf(1.0f + __builtin_amdgcn_exp2f(-1.4426950409f * g)); }
struct EpiPlain {
    static constexpr bool PERM = true, AFTER_DRAIN = false;
    bf16_t* O; int ldc;
    __device__ __forceinline__ void operator()(const f32x4 (&acc)[2][2][4][2], const Unit& u, int wr, int wc, int fr, int fq) const {
        const int row0 = u.pm * BM + wr * 64 + fr, col0 = u.pn * BM + wc * 32 + 8 * fq;
#pragma unroll
        for (int ai = 0; ai < 2; ++ai)
#pragma unroll
            for (int m = 0; m < 4; ++m) { bf16_t* rowp = O + (size_t)(row0 + ai * HALF + m * 16) * ldc + col0;
#pragma unroll
                for (int bj = 0; bj < 2; ++bj) { const f32x4 v0 = acc[ai][bj][m][0], v1 = acc[ai][bj][m][1];
                    u32x4 w; w.x = cvt_pk_bf16(v0[0], v0[1]); w.y = cvt_pk_bf16(v0[2], v0[3]); w.z = cvt_pk_bf16(v1[0], v1[1]); w.w = cvt_pk_bf16(v1[2], v1[3]);
                    *(u32x4*)(rowp + bj * HALF) = w; } }
    }
};
struct EpiSwiGLU {
    static constexpr bool PERM = true, AFTER_DRAIN = false;
    bf16_t* O; int ldc;
    __device__ __forceinline__ void operator()(const f32x4 (&acc)[2][2][4][2], const Unit& u, int wr, int wc, int fr, int fq) const {
        const int row0 = u.pm * BM + wr * 64 + fr, col0 = u.pn * HALF + wc * 32 + 8 * fq;
#pragma unroll
        for (int ai = 0; ai < 2; ++ai)
#pragma unroll
            for (int m = 0; m < 4; ++m) { bf16_t* rowp = O + (size_t)(row0 + ai * HALF + m * 16) * ldc + col0;
                float r[8];
#pragma unroll
                for (int n = 0; n < 2; ++n)
#pragma unroll
                    for (int e = 0; e < 4; ++e) { const float g = acc[ai][0][m][n][e], up = acc[ai][1][m][n][e]; r[n * 4 + e] = g * fast_sigmoid(g) * up; }
                u32x4 w; w.x = cvt_pk_bf16(r[0], r[1]); w.y = cvt_pk_bf16(r[2], r[3]); w.z = cvt_pk_bf16(r[4], r[5]); w.w = cvt_pk_bf16(r[6], r[7]);
                *(u32x4*)rowp = w; }
    }
};
struct EpiRet {
    static constexpr bool PERM = true, AFTER_DRAIN = false;
    bf16_t* O; int ldc;
    __device__ __forceinline__ void operator()(const f32x4 (&acc)[2][2][4][2], const Unit& u, int wr, int wc, int fr, int fq) const {
        const int row0 = u.pm * BM + wr * 64 + fr, col0 = u.pn * BM + wc * 32 + 8 * fq;
        if (u.pn < 8) {
            const float osc = (u.pn >= 4) ? 0.0625f : 1.0f;
            float invf[8];
#pragma unroll
            for (int q = 0; q < 8; ++q) { const int j = wc * 32 + 8 * fq + q; invf[q] = exp2f(-(float)j * (13.287712379549449f / 127.0f)) * 0.15915494309189535f; }
#pragma unroll
            for (int ai = 0; ai < 2; ++ai)
#pragma unroll
                for (int m = 0; m < 4; ++m) { const int row = row0 + ai * HALF + m * 16; const float pos = (float)(row & 2047);
                    bf16_t* rowp = O + (size_t)row * ldc + col0;
                    float o1[8], o2[8];
#pragma unroll
                    for (int n = 0; n < 2; ++n)
#pragma unroll
                        for (int e = 0; e < 4; ++e) { const int q = n * 4 + e; float t = pos * invf[q]; t = t - floorf(t);
                            const float sn = __builtin_amdgcn_sinf(t), cs = __builtin_amdgcn_cosf(t);
                            const float a = acc[ai][0][m][n][e], b = acc[ai][1][m][n][e];
                            o1[q] = (a * cs - b * sn) * osc; o2[q] = (a * sn + b * cs) * osc; }
                    u32x4 w; w.x = cvt_pk_bf16(o1[0], o1[1]); w.y = cvt_pk_bf16(o1[2], o1[3]); w.z = cvt_pk_bf16(o1[4], o1[5]); w.w = cvt_pk_bf16(o1[6], o1[7]);
                    *(u32x4*)rowp = w;
                    w.x = cvt_pk_bf16(o2[0], o2[1]); w.y = cvt_pk_bf16(o2[2], o2[3]); w.z = cvt_pk_bf16(o2[4], o2[5]); w.w = cvt_pk_bf16(o2[6], o2[7]);
                    *(u32x4*)(rowp + HALF) = w; }
        } else {
#pragma unroll
            for (int ai = 0; ai < 2; ++ai)
#pragma unroll
                for (int m = 0; m < 4; ++m) { bf16_t* rowp = O + (size_t)(row0 + ai * HALF + m * 16) * ldc + col0;
#pragma unroll
                    for (int bj = 0; bj < 2; ++bj) { const f32x4 v0 = acc[ai][bj][m][0], v1 = acc[ai][bj][m][1];
                        u32x4 w; w.x = cvt_pk_bf16(v0[0], v0[1]); w.y = cvt_pk_bf16(v0[2], v0[3]); w.z = cvt_pk_bf16(v1[0], v1[1]); w.w = cvt_pk_bf16(v1[2], v1[3]);
                        *(u32x4*)(rowp + bj * HALF) = w; } }
        }
    }
};

template <class Epi, class Sched, bool ALIGN_EPI = false, bool SP2 = false>
__device__ __forceinline__ void gemm_phase(PG8_LAS unsigned char* lds, const Gemm g, const Sched& S, const Epi& E, const int tid) {
    const int wid = __builtin_amdgcn_readfirstlane(tid >> 6), lane = tid & 63, wr = wid >> 2, wc = wid & 3, fr = lane & 15, fq = lane >> 4;
    const int K = g.K, nt = K / BK;
    unsigned voffA[2], voffB[2];
#pragma unroll
    for (int i = 0; i < 2; ++i) { int R, C; stage_rc(tid * 16 + i * 8192, R, C); const int Rb = Epi::PERM ? ((R & ~31) + perm32(R & 31)) : R;
        voffA[i] = (unsigned)(R * K + C) * 2u; voffB[i] = (unsigned)(Rb * K + C) * 2u; }
    const size_t kstep = (size_t)(BK * 2);
    const size_t hstep = (size_t)HALF * K * 2;
    const size_t tstep = 2 * hstep;
    const unsigned ldsw = (unsigned)wid * 1024u;
    const int aoff = lds_byte(wr * 64 + fr, fq * 8), boff = lds_byte(wc * 32 + fr, fq * 8);
#define PG8_SA(b, h) (((b) * 2 + (h)) * HTB)
#define PG8_SB(b, h) ((4 + (b) * 2 + (h)) * HTB)
#define PG8_STAGE(bufoff, gbase, voff) do { _Pragma("unroll") for (int _i = 0; _i < 2; ++_i) \
        __builtin_amdgcn_global_load_lds((const unsigned*)((const char*)(gbase) + (voff)[_i]), (PG8_LAS unsigned*)(lds + (bufoff) + ldsw + _i * 8192), 16, 0, 0); } while (0)
#define PG8_LDA(dst, b, h) do { _Pragma("unroll") for (int m = 0; m < 4; ++m) _Pragma("unroll") for (int k = 0; k < 2; ++k) dst[m][k] = *(const PG8_LAS bf16x8*)(lds + PG8_SA(b, h) + aoff + m * 2048 + k * 1024); } while (0)
#define PG8_LDB(dst, b, h) do { _Pragma("unroll") for (int n = 0; n < 2; ++n) _Pragma("unroll") for (int k = 0; k < 2; ++k) dst[n][k] = *(const PG8_LAS bf16x8*)(lds + PG8_SB(b, h) + boff + n * 2048 + k * 1024); } while (0)
#define PG8_MMA(ai, bj, At, Bt) do { __builtin_amdgcn_s_setprio(1); _Pragma("unroll") for (int m = 0; m < 4; ++m) _Pragma("unroll") for (int n = 0; n < 2; ++n) _Pragma("unroll") for (int k = 0; k < 2; ++k) \
        acc[ai][bj][m][n] = __builtin_amdgcn_mfma_f32_16x16x32_bf16(Bt[n][k], At[m][k], acc[ai][bj][m][n], 0, 0, 0); __builtin_amdgcn_s_setprio(0); } while (0)
#define PG8_WAIT_V(n) asm volatile("s_waitcnt vmcnt(" #n ")" ::: "memory")
#define PG8_WAIT_L(n) asm volatile("s_waitcnt lgkmcnt(" #n ")" ::: "memory")
#define PG8_BAR __builtin_amdgcn_s_barrier()
#define PG8_SCHED __builtin_amdgcn_sched_barrier(0)
    Unit cur, nxt; int ui = 0;
    if (!S.next(0, cur)) return;
    f32x4 acc[2][2][4][2];
#pragma unroll
    for (int a = 0; a < 2; ++a)
#pragma unroll
        for (int b = 0; b < 2; ++b)
#pragma unroll
            for (int m = 0; m < 4; ++m)
#pragma unroll
                for (int n = 0; n < 2; ++n) acc[a][b][m][n] = (f32x4){0.f, 0.f, 0.f, 0.f};
    bf16x8 At[4][2], B0[2][2], B1[2][2];
    const char* cA = (const char*)g.A + (size_t)cur.pm * tstep; const char* cB = (const char*)g.Bt + (size_t)cur.pn * tstep;
    S.a_ready(cur);
    if constexpr (SP2) {
        PG8_STAGE(PG8_SB(0, 0), cB, voffB); PG8_STAGE(PG8_SB(0, 1), cB + hstep, voffB); PG8_STAGE(PG8_SA(0, 0), cA, voffA); PG8_STAGE(PG8_SA(0, 1), cA + hstep, voffA);
        if (wr == 1) PG8_BAR;
        PG8_WAIT_V(2); PG8_BAR;
        PG8_STAGE(PG8_SB(1, 0), cB + kstep, voffB); PG8_STAGE(PG8_SA(1, 0), cA + kstep, voffA); PG8_STAGE(PG8_SB(1, 1), cB + hstep + kstep, voffB);
        PG8_WAIT_V(6); PG8_BAR;
    } else {
        PG8_STAGE(PG8_SB(0, 0), cB, voffB); PG8_STAGE(PG8_SA(0, 0), cA, voffA); PG8_STAGE(PG8_SB(0, 1), cB + hstep, voffB); PG8_STAGE(PG8_SA(0, 1), cA + hstep, voffA);
        if (wr == 1) PG8_BAR;
        PG8_WAIT_V(4); PG8_BAR;
        PG8_STAGE(PG8_SB(1, 0), cB + kstep, voffB); PG8_STAGE(PG8_SA(1, 0), cA + kstep, voffA); PG8_STAGE(PG8_SB(1, 1), cB + hstep + kstep, voffB);
        PG8_WAIT_V(6); PG8_BAR;
    }
    for (;;) {
        const bool has_next = S.next(ui + 1, nxt);
        const char* nA = has_next ? (const char*)g.A + (size_t)nxt.pm * tstep : cA; const char* nB = has_next ? (const char*)g.Bt + (size_t)nxt.pn * tstep : cB;
        for (int t = 0; t < nt; t += 2) {
            const bool last = (t == nt - 2);
            const char* a1 = cA + (size_t)(t + 1) * kstep;
            const char* a2 = last ? nA : cA + (size_t)(t + 2) * kstep; const char* b2 = last ? nB : cB + (size_t)(t + 2) * kstep;
            const char* a3 = a2 + kstep; const char* b3 = b2 + kstep;
            if (last && has_next) S.a_ready(nxt);
            if constexpr (SP2) {
            PG8_LDB(B0, 0, 0); PG8_LDB(B1, 0, 1); PG8_SCHED; PG8_LDA(At, 0, 0); PG8_STAGE(PG8_SA(1, 1), a1 + hstep, voffA);
            PG8_WAIT_V(8); PG8_WAIT_L(0); PG8_BAR; PG8_MMA(0, 0, At, B0); PG8_MMA(0, 1, At, B1); PG8_BAR; PG8_SCHED;
            PG8_LDA(At, 0, 1); PG8_STAGE(PG8_SB(0, 0), b2, voffB); PG8_STAGE(PG8_SB(0, 1), b2 + hstep, voffB); PG8_STAGE(PG8_SA(0, 0), a2, voffA);
            PG8_WAIT_V(8); PG8_WAIT_L(0); PG8_BAR; PG8_MMA(1, 0, At, B0); PG8_MMA(1, 1, At, B1); PG8_BAR; PG8_SCHED;
            PG8_LDB(B0, 1, 0); PG8_LDB(B1, 1, 1); PG8_SCHED; PG8_LDA(At, 1, 0); PG8_STAGE(PG8_SA(0, 1), a2 + hstep, voffA);
            PG8_WAIT_V(8); PG8_WAIT_L(0); PG8_BAR; PG8_MMA(0, 0, At, B0); PG8_MMA(0, 1, At, B1); PG8_BAR; PG8_SCHED;
            PG8_LDA(At, 1, 1); PG8_STAGE(PG8_SB(1, 0), b3, voffB); PG8_STAGE(PG8_SB(1, 1), b3 + hstep, voffB); PG8_STAGE(PG8_SA(1, 0), a3, voffA);
            PG8_WAIT_V(8); PG8_WAIT_L(0); PG8_BAR; PG8_MMA(1, 0, At, B0); PG8_MMA(1, 1, At, B1); PG8_BAR; PG8_SCHED;
            } else {
            PG8_LDB(B0, 0, 0); PG8_SCHED; PG8_LDA(At, 0, 0); PG8_STAGE(PG8_SA(1, 1), a1 + hstep, voffA);
            PG8_WAIT_L(8); PG8_BAR; PG8_WAIT_L(0); PG8_MMA(0, 0, At, B0); PG8_BAR; PG8_SCHED;
            PG8_LDB(B1, 0, 1); PG8_STAGE(PG8_SB(0, 0), b2, voffB);
            PG8_BAR; PG8_WAIT_L(0); PG8_MMA(0, 1, At, B1); PG8_BAR;
            PG8_LDA(At, 0, 1); PG8_STAGE(PG8_SA(0, 0), a2, voffA);
            PG8_BAR; PG8_WAIT_L(0); PG8_MMA(1, 0, At, B0); PG8_BAR; PG8_SCHED;
            PG8_STAGE(PG8_SB(0, 1), b2 + hstep, voffB);
            PG8_WAIT_V(6); PG8_BAR; PG8_MMA(1, 1, At, B1); PG8_BAR;
            PG8_LDB(B0, 1, 0); PG8_SCHED; PG8_LDA(At, 1, 0); PG8_STAGE(PG8_SA(0, 1), a2 + hstep, voffA);
            PG8_WAIT_L(8); PG8_BAR; PG8_WAIT_L(0); PG8_MMA(0, 0, At, B0); PG8_BAR; PG8_SCHED;
            PG8_LDB(B1, 1, 1); PG8_STAGE(PG8_SB(1, 0), b3, voffB);
            PG8_BAR; PG8_WAIT_L(0); PG8_MMA(0, 1, At, B1); PG8_BAR;
            PG8_LDA(At, 1, 1); PG8_STAGE(PG8_SA(1, 0), a3, voffA);
            PG8_BAR; PG8_WAIT_L(0); PG8_MMA(1, 0, At, B0); PG8_BAR; PG8_SCHED;
            PG8_STAGE(PG8_SB(1, 1), b3 + hstep, voffB);
            PG8_WAIT_V(6); PG8_BAR; PG8_MMA(1, 1, At, B1); PG8_BAR;
            }
        }
        if constexpr (ALIGN_EPI) { if (wr == 0) PG8_BAR; }
        if constexpr (!Epi::AFTER_DRAIN) { E(acc, cur, wr, wc, fr, fq); S.done(cur); }
        if (!has_next) break;
#pragma unroll
        for (int a = 0; a < 2; ++a)
#pragma unroll
            for (int b = 0; b < 2; ++b)
#pragma unroll
                for (int m = 0; m < 4; ++m)
#pragma unroll
                    for (int n = 0; n < 2; ++n) acc[a][b][m][n] = (f32x4){0.f, 0.f, 0.f, 0.f};
        cur = nxt; cA = nA; cB = nB; ++ui;
        if constexpr (ALIGN_EPI) { if (wr == 1) PG8_BAR; }
    }
    PG8_WAIT_V(0);
    if constexpr (!ALIGN_EPI) { if (wr == 0) PG8_BAR; }
    PG8_BAR;
    if constexpr (Epi::AFTER_DRAIN) { E.fused(acc, cur, wr, wc, fr, fq, lds, wid, lane); S.done(cur); }
#undef PG8_SA
#undef PG8_SB
#undef PG8_STAGE
#undef PG8_LDA
#undef PG8_LDB
#undef PG8_MMA
#undef PG8_WAIT_V
#undef PG8_WAIT_L
#undef PG8_BAR
#undef PG8_SCHED
}
}

constexpr int BATCH = 16, SEQ = 2048, D = 1024, M = BATCH * SEQ, DEPTH = 4, DFF = 2816;
constexpr int NGRP = 3, HA = 16, DHA = 64, ATT_COLS = 3 * D;
constexpr int HR = 4, DKR = 256, DVR = 512, DV = HR * DVR, RET_COLS = 2 * D + 3 * DV;
constexpr int MH = M / 2;
constexpr float NORM_EPS = 1e-6f;
constexpr int NWAVES = 8, NTHREADS = NWAVES * 64;
constexpr int NPHASES = 1 + DEPTH * 14;

__device__ const unsigned char T5_BUCKET[3][129] = {
{11,11,11,11,11,11,11,11,11,11,11,11,11,11,11,10,10,10,10,10,10,10,10,10,10,10,10,10,10,10,10,10,10,10,10,10,10,10,9,9,9,9,9,9,9,9,9,9,9,9,8,8,8,8,8,8,8,7,6,5,4,3,2,1,0,17,18,19,20,21,22,23,24,24,24,24,24,24,24,25,25,25,25,25,25,25,25,25,25,25,25,26,26,26,26,26,26,26,26,26,26,26,26,26,26,26,26,26,26,26,26,26,26,26,27,27,27,27,27,27,27,27,27,27,27,27,27,27,27},
{13,13,13,13,13,13,13,13,13,13,13,13,13,13,13,13,13,13,13,13,13,13,13,12,12,12,12,12,12,12,12,12,12,12,12,12,12,12,12,12,12,12,11,11,11,11,11,11,11,11,11,11,10,10,10,10,10,10,9,9,9,8,8,4,0,20,24,24,25,25,25,26,26,26,26,26,26,27,27,27,27,27,27,27,27,27,27,28,28,28,28,28,28,28,28,28,28,28,28,28,28,28,28,28,28,28,29,29,29,29,29,29,29,29,29,29,29,29,29,29,29,29,29,29,29,29,29,29,29},
{15,15,15,15,15,15,15,15,15,15,15,15,15,15,15,15,15,15,15,15,15,15,15,15,15,15,15,15,15,15,14,14,14,14,14,14,14,14,14,14,14,14,14,14,14,13,13,13,13,13,13,13,13,13,12,12,12,12,12,11,11,10,10,9,0,25,26,26,27,27,28,28,28,28,28,29,29,29,29,29,29,29,29,29,30,30,30,30,30,30,30,30,30,30,30,30,30,30,30,31,31,31,31,31,31,31,31,31,31,31,31,31,31,31,31,31,31,31,31,31,31,31,31,31,31,31,31,31,31}};

constexpr size_t MiB = 1u << 20;
constexpr size_t WS_CTL = 0, CTL_ZERO_BYTES = 1 * MiB;
constexpr size_t WS_BIAS = 1 * MiB;
constexpr size_t WS_W = 2 * MiB;
constexpr size_t WS_W2_FFN = WS_W + (size_t)2 * DFF * D * 2;
constexpr size_t WS_W2_ATT = WS_W + (size_t)NGRP * ATT_COLS * D * 2;
constexpr size_t WS_W2_RET = WS_W + (size_t)RET_COLS * D * 2;
constexpr size_t WS_YC = 26 * MiB;
constexpr size_t WS_XH = WS_YC + 64 * MiB;
constexpr size_t WS_BIG = 154 * MiB;
constexpr size_t WS_YFB = 410 * MiB;
constexpr size_t WS_F = 410 * MiB;
constexpr size_t WS_OACC = 474 * MiB;
constexpr size_t WS_LSE = 538 * MiB;
constexpr size_t WS_END = 540 * MiB;
static_assert(WS_W2_FFN + (size_t)D * DFF * 2 <= WS_YC && WS_W2_ATT + (size_t)D * D * 2 <= WS_YC && WS_W2_RET + (size_t)D * DV * 2 <= WS_YC, "weight region");
static_assert(WS_XH + (size_t)M * D * 2 == WS_BIG && WS_BIG + (size_t)MH * RET_COLS * 2 == WS_YFB && WS_YFB + (size_t)2 * MH * DV * 2 == WS_LSE && WS_OACC + (size_t)M * D * 2 == WS_LSE, "d_ws map");
static_assert((size_t)M * DFF * 2 <= 256 * MiB && (size_t)M * ATT_COLS * 2 <= 256 * MiB && WS_LSE + (size_t)M * 16 * 4 <= WS_END, "d_ws map");
constexpr int CW_BAR = 4096;

constexpr int RING_OFF = 0, RING_BYTES = 131072;
constexpr int LDSCTL_OFF = RING_BYTES, MISC_OFF = LDSCTL_OFF + 320;
constexpr int LDS_BYTES = 147456;
static_assert(MISC_OFF + 128 <= LDS_BYTES, "LDS map");

#define LAS __attribute__((address_space(3)))
typedef unsigned short bf16;
typedef unsigned v4u __attribute__((ext_vector_type(4)));
typedef unsigned v2u __attribute__((ext_vector_type(2)));
typedef float f32x4 __attribute__((ext_vector_type(4)));
#define LDS_WAIT() asm volatile("s_waitcnt lgkmcnt(0)" ::: "memory")
__device__ __forceinline__ unsigned f2bf(float f) { unsigned u = __builtin_bit_cast(unsigned, f); return (u + 0x7fffu + ((u >> 16) & 1u)) >> 16; }
__device__ __forceinline__ unsigned pk2(float lo, float hi) { return f2bf(lo) | (f2bf(hi) << 16); }
__device__ __forceinline__ float bflo(unsigned w) { return __builtin_bit_cast(float, w << 16); }
__device__ __forceinline__ float bfhi(unsigned w) { return __builtin_bit_cast(float, w & 0xffff0000u); }
__device__ __forceinline__ float wave_sum(float v) {
#pragma unroll
    for (int o = 1; o < 64; o <<= 1) v += __shfl_xor(v, o);
    return v;
}

#define XB_TMO      128
#define XB_XCNT(j)  (256  + 64 * (j))
#define XB_XSUB(j)  (1280 + 64 * (j))
#define XB_XGEN(j)  (2304 + 64 * (j))
#define XB_TOP      3328
#define XB_TOPGEN   3392
#define XCD_BAR_WORDS 3456
#define XB_SPIN_CAP (1u << 18)

__device__ __forceinline__ unsigned xb_ld(unsigned* p)              { return __hip_atomic_load(p, __ATOMIC_RELAXED, __HIP_MEMORY_SCOPE_AGENT); }
__device__ __forceinline__ unsigned xb_add(unsigned* p, unsigned v) { return __hip_atomic_fetch_add(p, v, __ATOMIC_RELAXED, __HIP_MEMORY_SCOPE_AGENT); }
__device__ __forceinline__ unsigned xb_xcc_id() { return (unsigned)__builtin_amdgcn_s_getreg((3 << 11) | 20) & 0xFu; }
#define XB_SPIN(cond, bar) do { unsigned _sp = 0; while (cond) { __builtin_amdgcn_s_sleep(1); \
    if ((++_sp & 255u) == 0u) { if (xb_ld(&(bar)[XB_TMO])) break; if (_sp > XB_SPIN_CAP) { atomicAdd(&(bar)[XB_TMO], 1u); break; } } } } while (0)

struct XcdBarrier {
    unsigned* bar; unsigned x;
    volatile LAS unsigned* st;
};

__device__ __forceinline__ XcdBarrier xcd_barrier_post(unsigned* bar, volatile LAS unsigned* st) {
    XcdBarrier b; b.bar = bar; b.x = xb_xcc_id(); b.st = st;
    if (threadIdx.x == 0) (void)xb_add(&bar[XB_XCNT(b.x)], 1u);
    return b;
}
__device__ __forceinline__ void xcd_barrier_complete(unsigned* bar, unsigned x, unsigned& nloc, unsigned& nx) {
    const unsigned G = gridDim.x * gridDim.y * gridDim.z;
    unsigned sum, cnt, mine, sp = 0u;
    for (;;) {
        sum = 0u; cnt = 0u; mine = 0u;
#pragma unroll
        for (unsigned j = 0; j < 16; ++j) { const unsigned c = xb_ld(&bar[XB_XCNT(j)]); sum += c; cnt += (c > 0u) ? 1u : 0u; mine = (j == x) ? c : mine; }
        if (sum == G) break;
        __builtin_amdgcn_s_sleep(1);
        if ((++sp & 255u) == 0u) { if (xb_ld(&bar[XB_TMO])) break; if (sp > XB_SPIN_CAP) { atomicAdd(&bar[XB_TMO], 1u); break; } }
    }
    nloc = mine > 0u ? mine : 1u; nx = cnt > 0u ? cnt : 1u;
}

__device__ __forceinline__ void xcd_barrier(const XcdBarrier& b) {
    asm volatile("s_waitcnt vmcnt(0)" ::: "memory");
    __syncthreads();
    if (threadIdx.x == 0) {
        unsigned* bar = b.bar;
        __builtin_amdgcn_s_waitcnt(0);
        unsigned nloc = b.st[0], nx = b.st[1];
        if (nloc == 0u) { xcd_barrier_complete(bar, b.x, nloc, nx); b.st[0] = nloc; b.st[1] = nx; }
        const unsigned old = xb_add(&bar[XB_XSUB(b.x)], 1u);
        const unsigned gen = old / nloc;
        if (old + 1u == (gen + 1u) * nloc) {
            __builtin_amdgcn_fence(__ATOMIC_RELEASE, "agent");
            asm volatile("s_waitcnt vmcnt(0)" ::: "memory");
            const unsigned og = xb_add(&bar[XB_TOP], 1u);
            const unsigned tg = og / nx;
            if (og + 1u == (tg + 1u) * nx) xb_add(&bar[XB_TOPGEN], 1u);
            else XB_SPIN(xb_ld(&bar[XB_TOPGEN]) == tg, bar);
            __builtin_amdgcn_fence(__ATOMIC_ACQUIRE, "agent");
            xb_add(&bar[XB_XGEN(b.x)], 1u);
            asm volatile("s_waitcnt vmcnt(0)" ::: "memory");
        } else {
            XB_SPIN(xb_ld(&bar[XB_XGEN(b.x)]) == gen, bar);
            __builtin_amdgcn_fence(__ATOMIC_ACQUIRE, "agent");
            asm volatile("s_waitcnt vmcnt(0)" ::: "memory");
        }
    }
    __syncthreads();
}


__device__ __forceinline__ void conv_item(const float* W, int srcN, int k0, int n0, bf16* WT, int dstK, int drow0, LAS float* scr, int lane) {
#pragma unroll 8
    for (int i = 0; i < 32; ++i) { const int kk = 2 * i + (lane >> 5); scr[kk * 33 + (lane & 31)] = W[(size_t)(k0 + kk) * srcN + n0 + (lane & 31)]; }
    LDS_WAIT(); asm volatile("" ::: "memory");
    const int c = lane & 7;
#pragma unroll
    for (int j = 0; j < 4; ++j) { const int n = (lane >> 3) + 8 * j; const LAS float* s = scr + (8 * c) * 33 + n;
        v4u o; o.x = pk2(s[0 * 33], s[1 * 33]); o.y = pk2(s[2 * 33], s[3 * 33]); o.z = pk2(s[4 * 33], s[5 * 33]); o.w = pk2(s[6 * 33], s[7 * 33]);
        *(v4u*)(WT + (size_t)(drow0 + n) * dstK + k0 + 8 * c) = o; }
    LDS_WAIT(); asm volatile("" ::: "memory");
}
__device__ __forceinline__ void conv_plain(const float* W, int K, int N, bf16* WT, LAS float* scr, int gw, int NGW, int lane) {
    const int nblk = N / 32, nitems = (K / 64) * nblk;
    for (int it = gw; it < nitems; it += NGW) { const int kb = it / nblk, nb = it % nblk; conv_item(W, N, 64 * kb, 32 * nb, WT, K, 32 * nb, scr, lane); }
}
__device__ __forceinline__ void conv_gateup(const float* Wg, const float* Wu, bf16* WT, LAS float* scr, int gw, int NGW, int lane) {
    constexpr int nblk = 2 * DFF / 32, nitems = (D / 64) * nblk;
    for (int it = gw; it < nitems; it += NGW) { const int kb = it / nblk, nb = it % nblk, n0 = 32 * nb, pn = n0 >> 8, bj = (n0 >> 7) & 1, c0 = n0 & 127;
        conv_item(bj ? Wu : Wg, DFF, 64 * kb, 128 * pn + c0, WT, D, n0, scr, lane); }
}

__device__ __forceinline__ void thin_rows(const bf16* Fin, const float* xin, float* xout, const float* gpost, float cpost, const float* gpre, bf16* XH, int gw, int NGW, int lane) {
    f32x4 gp[4], gq[4];
#pragma unroll
    for (int j = 0; j < 4; ++j) { gp[j] = Fin ? *(const f32x4*)(gpost + 4 * lane + 256 * j) : (f32x4){0.f, 0.f, 0.f, 0.f}; gq[j] = gpre ? *(const f32x4*)(gpre + 4 * lane + 256 * j) : (f32x4){0.f, 0.f, 0.f, 0.f}; }
    for (int m = gw; m < M; m += NGW) {
        f32x4 v[4];
#pragma unroll
        for (int j = 0; j < 4; ++j) v[j] = *(const f32x4*)(xin + (size_t)m * D + 4 * lane + 256 * j);
        if (Fin) {
            f32x4 f[4]; float ss = 0.f;
#pragma unroll
            for (int j = 0; j < 4; ++j) { const v2u w = *(const v2u*)(Fin + (size_t)m * D + 4 * lane + 256 * j); f[j] = (f32x4){bflo(w.x), bfhi(w.x), bflo(w.y), bfhi(w.y)};
                ss += (f[j].x * f[j].x + f[j].y * f[j].y) + (f[j].z * f[j].z + f[j].w * f[j].w); }
            const float rF = cpost / sqrtf(wave_sum(ss) * (1.f / D) + NORM_EPS);
#pragma unroll
            for (int j = 0; j < 4; ++j) v[j] = v[j] + f[j] * gp[j] * rF;
        }
#pragma unroll
        for (int j = 0; j < 4; ++j) *(f32x4*)(xout + (size_t)m * D + 4 * lane + 256 * j) = v[j];
        if (gpre) {
            float ss = 0.f;
#pragma unroll
            for (int j = 0; j < 4; ++j) ss += (v[j].x * v[j].x + v[j].y * v[j].y) + (v[j].z * v[j].z + v[j].w * v[j].w);
            const float rx = 1.f / sqrtf(wave_sum(ss) * (1.f / D) + NORM_EPS);
#pragma unroll
            for (int j = 0; j < 4; ++j) { const f32x4 h = v[j] * gq[j] * rx; v2u w; w.x = pk2(h.x, h.y); w.y = pk2(h.z, h.w); *(v2u*)(XH + (size_t)m * D + 4 * lane + 256 * j) = w; }
        }
    }
}

__device__ __forceinline__ void attn_group_scalar(const bf16* P, const float* bias2, int dil, int first, bf16* OACC, float* LSE, int gw, int NGW, int lane) {
    const int Ls = SEQ / dil, tbn = Ls / 64;
    constexpr float SC = 0.125f * 1.4426950409f;
    for (int w = gw; w < BATCH * HA * 32; w += NGW) {
        const int tb = w % tbn, r = (w / tbn) % dil, h = (w >> 5) & 15, b = w >> 9;
        const int t = tb * 64 + lane; const size_t row = (size_t)b * SEQ + (size_t)t * dil + r;
        float q[64], acc[64];
        { const v4u* qp = (const v4u*)(P + row * ATT_COLS + h * 64);
#pragma unroll
          for (int c = 0; c < 8; ++c) { const v4u x = qp[c]; q[8 * c + 0] = bflo(x.x); q[8 * c + 1] = bfhi(x.x); q[8 * c + 2] = bflo(x.y); q[8 * c + 3] = bfhi(x.y); q[8 * c + 4] = bflo(x.z); q[8 * c + 5] = bfhi(x.z); q[8 * c + 6] = bflo(x.w); q[8 * c + 7] = bfhi(x.w); } }
#pragma unroll
        for (int c = 0; c < 64; ++c) acc[c] = 0.f;
        float mx = -INFINITY, l = 0.f;
        for (int kk = 0; kk < 129; ++kk) {
            const int tk = t - 64 + kk;
            if (tk >= 0 && tk < Ls) {
                const size_t krow = (size_t)b * SEQ + (size_t)tk * dil + r;
                const v4u* kp = (const v4u*)(P + krow * ATT_COLS + D + h * 64);
                float s = 0.f;
#pragma unroll
                for (int c = 0; c < 8; ++c) { const v4u x = kp[c];
                    s += q[8 * c + 0] * bflo(x.x) + q[8 * c + 1] * bfhi(x.x) + q[8 * c + 2] * bflo(x.y) + q[8 * c + 3] * bfhi(x.y) + q[8 * c + 4] * bflo(x.z) + q[8 * c + 5] * bfhi(x.z) + q[8 * c + 6] * bflo(x.w) + q[8 * c + 7] * bfhi(x.w); }
                s = s * SC + bias2[h * 129 + kk];
                const float mn = fmaxf(mx, s), a = exp2f(mx - mn), p = exp2f(s - mn);
                l = l * a + p; mx = mn;
                const v4u* vp = (const v4u*)(P + krow * ATT_COLS + 2 * D + h * 64);
#pragma unroll
                for (int c = 0; c < 8; ++c) { const v4u x = vp[c];
                    acc[8 * c + 0] = acc[8 * c + 0] * a + p * bflo(x.x); acc[8 * c + 1] = acc[8 * c + 1] * a + p * bfhi(x.x); acc[8 * c + 2] = acc[8 * c + 2] * a + p * bflo(x.y); acc[8 * c + 3] = acc[8 * c + 3] * a + p * bfhi(x.y);
                    acc[8 * c + 4] = acc[8 * c + 4] * a + p * bflo(x.z); acc[8 * c + 5] = acc[8 * c + 5] * a + p * bfhi(x.z); acc[8 * c + 6] = acc[8 * c + 6] * a + p * bflo(x.w); acc[8 * c + 7] = acc[8 * c + 7] * a + p * bfhi(x.w); }
            }
        }
        const float il = 1.f / l; float lse = mx + log2f(l);
        float wn = il, wo = 0.f;
        if (!first) { const float lo = LSE[row * 16 + h]; const float mm = fmaxf(lo, lse), eo = exp2f(lo - mm), en = exp2f(lse - mm), inv = 1.f / (eo + en); wn = en * inv * il; wo = eo * inv; lse = mm + log2f(eo + en); }
        LSE[row * 16 + h] = lse;
        v4u* op = (v4u*)(OACC + row * D + h * 64);
#pragma unroll
        for (int c = 0; c < 8; ++c) { v4u x = (v4u){0u, 0u, 0u, 0u}; if (!first) x = op[c];
            v4u y; y.x = pk2(wn * acc[8 * c + 0] + wo * bflo(x.x), wn * acc[8 * c + 1] + wo * bfhi(x.x)); y.y = pk2(wn * acc[8 * c + 2] + wo * bflo(x.y), wn * acc[8 * c + 3] + wo * bfhi(x.y));
            y.z = pk2(wn * acc[8 * c + 4] + wo * bflo(x.z), wn * acc[8 * c + 5] + wo * bfhi(x.z)); y.w = pk2(wn * acc[8 * c + 6] + wo * bflo(x.w), wn * acc[8 * c + 7] + wo * bfhi(x.w)); op[c] = y; }
    }
}

__device__ __forceinline__ void ret_core_scalar(const bf16* P, const float* decay_logit  , bf16* Y, int gw, int NGW, int lane) {
    const int el = lane & 15, dq = lane >> 4;
    for (int w = gw; w < 8 * HR * 2 * 32; w += NGW) {
        const int eb = w & 31, dir = (w >> 5) & 1, h = (w >> 6) & 3, bl = w >> 8;
        const int e = eb * 16 + el;
        const float gamma = 1.0f - expf(decay_logit[dir * HR + h]);
        float S[64];
#pragma unroll
        for (int c = 0; c < 64; ++c) S[c] = 0.f;
        for (int ti = 0; ti < SEQ; ++ti) {
            const int s = dir ? (SEQ - 1 - ti) : ti; const size_t row = (size_t)bl * SEQ + s;
            const bf16* pr = P + row * RET_COLS;
            const float v = __builtin_bit_cast(float, (unsigned)pr[2 * D + h * DVR + e] << 16);
            const v4u* qp = (const v4u*)(pr + h * DKR + dq * 64); const v4u* kp = (const v4u*)(pr + D + h * DKR + dq * 64);
            float y = 0.f;
#pragma unroll
            for (int c = 0; c < 8; ++c) { const v4u kx = kp[c], qx = qp[c];
                S[8 * c + 0] = S[8 * c + 0] * gamma + bflo(kx.x) * v; y += bflo(qx.x) * S[8 * c + 0];
                S[8 * c + 1] = S[8 * c + 1] * gamma + bfhi(kx.x) * v; y += bfhi(qx.x) * S[8 * c + 1];
                S[8 * c + 2] = S[8 * c + 2] * gamma + bflo(kx.y) * v; y += bflo(qx.y) * S[8 * c + 2];
                S[8 * c + 3] = S[8 * c + 3] * gamma + bfhi(kx.y) * v; y += bfhi(qx.y) * S[8 * c + 3];
                S[8 * c + 4] = S[8 * c + 4] * gamma + bflo(kx.z) * v; y += bflo(qx.z) * S[8 * c + 4];
                S[8 * c + 5] = S[8 * c + 5] * gamma + bfhi(kx.z) * v; y += bfhi(qx.z) * S[8 * c + 5];
                S[8 * c + 6] = S[8 * c + 6] * gamma + bflo(kx.w) * v; y += bflo(qx.w) * S[8 * c + 6];
                S[8 * c + 7] = S[8 * c + 7] * gamma + bfhi(kx.w) * v; y += bfhi(qx.w) * S[8 * c + 7]; }
            y += __shfl_xor(y, 16); y += __shfl_xor(y, 32);
            if (dq == 0) Y[((size_t)dir * MH + row) * DV + h * DVR + e] = (bf16)f2bf(y);
        }
    }
}

__device__ __forceinline__ void ret_combine(const bf16* P, const bf16* Y, bf16* YC  , int gw, int NGW, int lane) {
    for (int m = gw; m < MH; m += NGW) {
#pragma unroll
        for (int j = 0; j < 4; ++j) {
            const int idx = j * 512 + lane * 8;
            const v4u a = *(const v4u*)(Y + (size_t)m * DV + idx), bq = *(const v4u*)(Y + ((size_t)MH + m) * DV + idx);
            const v4u gfv = *(const v4u*)(P + (size_t)m * RET_COLS + 2 * D + DV + idx), gbv = *(const v4u*)(P + (size_t)m * RET_COLS + 2 * D + 2 * DV + idx);
            float yf[8] = {bflo(a.x), bfhi(a.x), bflo(a.y), bfhi(a.y), bflo(a.z), bfhi(a.z), bflo(a.w), bfhi(a.w)};
            float yb[8] = {bflo(bq.x), bfhi(bq.x), bflo(bq.y), bfhi(bq.y), bflo(bq.z), bfhi(bq.z), bflo(bq.w), bfhi(bq.w)};
            float gf[8] = {bflo(gfv.x), bfhi(gfv.x), bflo(gfv.y), bfhi(gfv.y), bflo(gfv.z), bfhi(gfv.z), bflo(gfv.w), bfhi(gfv.w)};
            float gb[8] = {bflo(gbv.x), bfhi(gbv.x), bflo(gbv.y), bfhi(gbv.y), bflo(gbv.z), bfhi(gbv.z), bflo(gbv.w), bfhi(gbv.w)};
            float sf = 0.f, sb = 0.f;
#pragma unroll
            for (int c = 0; c < 8; ++c) { sf += yf[c]; sb += yb[c]; }
            const float muf = wave_sum(sf) * (1.f / DVR), mub = wave_sum(sb) * (1.f / DVR);
            float qf = 0.f, qb = 0.f;
#pragma unroll
            for (int c = 0; c < 8; ++c) { yf[c] -= muf; yb[c] -= mub; qf += yf[c] * yf[c]; qb += yb[c] * yb[c]; }
            const float rf = 1.f / sqrtf(wave_sum(qf) * (1.f / DVR) + NORM_EPS), rb = 1.f / sqrtf(wave_sum(qb) * (1.f / DVR) + NORM_EPS);
            float o[8];
#pragma unroll
            for (int c = 0; c < 8; ++c) o[c] = gf[c] * pg8::fast_sigmoid(gf[c]) * yf[c] * rf + gb[c] * pg8::fast_sigmoid(gb[c]) * yb[c] * rb;
            v4u w; w.x = pk2(o[0], o[1]); w.y = pk2(o[2], o[3]); w.z = pk2(o[4], o[5]); w.w = pk2(o[6], o[7]);
            *(v4u*)(YC + (size_t)m * DV + idx) = w;
        }
    }
}


struct Args { const float* in[11]; float* out; unsigned char* ws; int ph_lo, ph_hi; };
__global__ void __launch_bounds__(NTHREADS, 2) mk_fwd(Args args) {
    extern __shared__ __attribute__((aligned(16))) unsigned char lds_raw[];
    LAS unsigned char* lds = (LAS unsigned char*)lds_raw;
    volatile LAS unsigned* MISC = (volatile LAS unsigned*)(lds + MISC_OFF);
    const int tid0 = threadIdx.x;
    for (int u = tid0; u < (LDS_BYTES - LDSCTL_OFF) / 4; u += NTHREADS) ((LAS unsigned*)(lds + LDSCTL_OFF))[u] = 0u;
    __syncthreads();
    XcdBarrier bar = xcd_barrier_post((unsigned*)(args.ws + WS_CTL) + CW_BAR, MISC + 8);
    const int lo = args.ph_lo, hi = args.ph_hi; int ph = 0;
#define PH_BEGIN if (ph >= lo && ph < hi) { int tid = tid0; asm volatile("" : "+v"(tid)); unsigned char* ws = args.ws; asm volatile("" : "+s"(ws)); \
        const int lane = tid & 63, wave = __builtin_amdgcn_readfirstlane(tid >> 6), G = gridDim.x, gw = blockIdx.x * NWAVES + wave, NGW = G * NWAVES; \
        LAS float* scr = (LAS float*)(lds + RING_OFF + wave * 16384); (void)lane; (void)gw; (void)NGW; (void)scr;
#define PH_END   if (ph + 1 < hi) xcd_barrier(bar); } ++ph;
#define P_BIAS ((float*)(ws + WS_BIAS))
#define P_WA   ((bf16*)(ws + WS_W))
#define P_XH   ((bf16*)(ws + WS_XH))
#define P_BIG  ((bf16*)(ws + WS_BIG))
#define P_F    ((bf16*)(ws + WS_F))
#define P_YC   ((bf16*)(ws + WS_YC))
#define P_YFB  ((bf16*)(ws + WS_YFB))
#define P_OACC ((bf16*)(ws + WS_OACC))
#define P_LSE  ((float*)(ws + WS_LSE))
    const float* x_in = args.in[0]; const float* gains = args.in[1]; const float* w_gate = args.in[2]; const float* w_up = args.in[3]; const float* w_down = args.in[4];
    const float* a_win = args.in[5]; const float* a_wout = args.in[6]; const float* rel_bias = args.in[7]; const float* r_win = args.in[8]; const float* r_wout = args.in[9]; const float* r_decay = args.in[10];
    float* out = args.out;

    PH_BEGIN
        if (blockIdx.x == 0) for (int i = tid; i < 3 * 16 * 129; i += NTHREADS) { const int g = i / (16 * 129), h = (i / 129) % 16, kk = i % 129; P_BIAS[i] = rel_bias[(g * 16 + h) * 32 + T5_BUCKET[g][kk]] * 1.4426950409f; }
        conv_gateup(w_gate, w_up, P_WA, scr, gw, NGW, lane);
        conv_plain(w_down, DFF, D, (bf16*)(ws + WS_W2_FFN), scr, gw, NGW, lane);
        thin_rows(nullptr, x_in, out, nullptr, 0.f, gains, P_XH, gw, NGW, lane);
    PH_END

    for (int sub = 0; sub < 3 * DEPTH; ++sub) {
        const int L = sub / 3, kind = sub % 3, jj = L >> 1; const bool is_att = (L & 1) == 0;
        size_t fA, fB; int fK;
        if (kind != 1) {
            PH_BEGIN
                pg8::Gemm g{P_XH, P_WA, M, 2 * DFF, D}; pg8::StaticOrder S; S.init(M, 2 * DFF, G, (int)blockIdx.x);
                pg8::EpiSwiGLU E{P_BIG, DFF};
                pg8::gemm_phase<pg8::EpiSwiGLU, pg8::StaticOrder, true, true>(lds + RING_OFF, g, S, E, tid);
            PH_END
            fA = WS_BIG; fB = WS_W2_FFN; fK = DFF;
        } else if (is_att) {
            for (int grp = 0; grp < NGRP; ++grp) {
                PH_BEGIN
                    pg8::Gemm g{P_XH, P_WA + (size_t)grp * ATT_COLS * D, M, ATT_COLS, D}; pg8::StaticOrder S; S.init(M, ATT_COLS, G, (int)blockIdx.x);
                    pg8::EpiPlain E{P_BIG, ATT_COLS};
                    pg8::gemm_phase<pg8::EpiPlain, pg8::StaticOrder, true, true>(lds + RING_OFF, g, S, E, tid);
                PH_END
                PH_BEGIN
                    attn_group_scalar(P_BIG, P_BIAS + grp * 16 * 129, grp == 0 ? 1 : (grp == 1 ? 4 : 16), grp == 0, P_OACC, P_LSE, gw, NGW, lane);
                PH_END
            }
            fA = WS_OACC; fB = WS_W2_ATT; fK = D;
        } else {
            for (int half = 0; half < 2; ++half) {
                PH_BEGIN
                    pg8::Gemm g{P_XH + (size_t)half * MH * D, P_WA, MH, RET_COLS, D}; pg8::StaticOrder S; S.init(MH, RET_COLS, G, (int)blockIdx.x);
                    pg8::EpiRet E{P_BIG, RET_COLS};
                    pg8::gemm_phase<pg8::EpiRet, pg8::StaticOrder, true, true>(lds + RING_OFF, g, S, E, tid);
                PH_END
                PH_BEGIN
                    ret_core_scalar(P_BIG, r_decay + jj * 2 * HR, P_YFB, gw, NGW, lane);
                PH_END
                PH_BEGIN
                    ret_combine(P_BIG, P_YFB, P_YC + (size_t)half * MH * DV, gw, NGW, lane);
                PH_END
            }
            fA = WS_YC; fB = WS_W2_RET; fK = DV;
        }
        PH_BEGIN
            pg8::Gemm g{(const bf16*)(ws + fA), (const bf16*)(ws + fB), M, D, fK}; pg8::StaticOrder S; S.init(M, D, G, (int)blockIdx.x);
            pg8::EpiPlain E{P_F, D};
            pg8::gemm_phase<pg8::EpiPlain, pg8::StaticOrder, true, true>(lds + RING_OFF, g, S, E, tid);
        PH_END
        PH_BEGIN
            if (sub + 1 < 3 * DEPTH) {
                const int nk = (sub + 1) % 3, nL = (sub + 1) / 3, nj = nL >> 1;
                if (nk != 1) { const size_t o = (size_t)(nL * 2 + (nk >> 1)) * D * DFF;
                    conv_gateup(w_gate + o, w_up + o, P_WA, scr, gw, NGW, lane); conv_plain(w_down + o, DFF, D, (bf16*)(ws + WS_W2_FFN), scr, gw, NGW, lane); }
                else if ((nL & 1) == 0) { conv_plain(a_win + (size_t)nj * D * NGRP * ATT_COLS, D, NGRP * ATT_COLS, P_WA, scr, gw, NGW, lane); conv_plain(a_wout + (size_t)nj * D * D, D, D, (bf16*)(ws + WS_W2_ATT), scr, gw, NGW, lane); }
                else { conv_plain(r_win + (size_t)nj * D * RET_COLS, D, RET_COLS, P_WA, scr, gw, NGW, lane); conv_plain(r_wout + (size_t)nj * DV * D, DV, D, (bf16*)(ws + WS_W2_RET), scr, gw, NGW, lane); }
            }
            const float* gl = gains + (size_t)L * 6 * D;
            const float* gpost = gl + (kind == 0 ? 1 : (kind == 1 ? 3 : 5)) * D;
            const float* gpre = kind == 0 ? gl + 2 * D : (kind == 1 ? gl + 4 * D : (L + 1 < DEPTH ? gl + 6 * D : nullptr));
            thin_rows(P_F, out, out, gpost, kind == 1 ? 1.0f : 0.5f, gpre, P_XH, gw, NGW, lane);
        PH_END
    }
#undef PH_BEGIN
#undef PH_END
}

extern "C" void kernel_launch(void* const* d_in, const int* in_sizes, int n_in, void* d_out, int out_size, void* d_ws, size_t ws_size, hipStream_t stream) {
    static int grid = 0;
    if (grid == 0) {
        if (n_in != 11 || in_sizes[0] != M * D || out_size != M * D || ws_size < WS_END) { fprintf(stderr, "kernel_launch: unexpected shapes / workspace (n_in %d, ws %zu, need %zu); nothing launched\n", n_in, ws_size, (size_t)WS_END); grid = -1; return; }
        int dev = 0, cus = 0, per_cu = 0;
        if (hipGetDevice(&dev) != hipSuccess || hipDeviceGetAttribute(&cus, hipDeviceAttributeMultiprocessorCount, dev) != hipSuccess) { grid = -1; return; }
        if (hipFuncSetAttribute((const void*)mk_fwd, hipFuncAttributeMaxDynamicSharedMemorySize, LDS_BYTES) != hipSuccess) { fprintf(stderr, "kernel_launch: hipFuncSetAttribute failed\n"); grid = -1; return; }
        if (hipOccupancyMaxActiveBlocksPerMultiprocessor(&per_cu, (const void*)mk_fwd, NTHREADS, LDS_BYTES) != hipSuccess || per_cu < 1) { fprintf(stderr, "kernel_launch: occupancy query reports %d workgroups per CU\n", per_cu); }
        (void)hipGetLastError();
        grid = cus;
    }
    if (grid < 0) return;
    if (hipMemsetAsync((char*)d_ws + WS_CTL, 0, CTL_ZERO_BYTES, stream) != hipSuccess) return;
    Args a{};
    for (int i = 0; i < 11; ++i) a.in[i] = (const float*)d_in[i];
    a.out = (float*)d_out; a.ws = (unsigned char*)d_ws;
#if MK_ONE_LAUNCH
    a.ph_lo = 0; a.ph_hi = NPHASES;
    hipLaunchKernelGGL(mk_fwd, dim3(grid), dim3(NTHREADS), LDS_BYTES, stream, a);
#else
    for (int p = 0; p < NPHASES; ++p) { a.ph_lo = p; a.ph_hi = p + 1; hipLaunchKernelGGL(mk_fwd, dim3(grid), dim3(NTHREADS), LDS_BYTES, stream, a); }
#endif
}
```

```cpp
#include <hip/hip_runtime.h>
#include <cstdio>
#include <cstdint>
#ifndef PROBE_REPEAT
#define PROBE_REPEAT 0
#endif
#ifndef PROBE_THIN2
#define PROBE_THIN2 0
#endif
#ifndef PROBE_ATT2
#define PROBE_ATT2 0
#endif
#ifndef PROBE_CONV2
#define PROBE_CONV2 0
#endif
#ifndef PROBE_FGM
#define PROBE_FGM 0
#endif
#ifndef PROBE_RC
#define PROBE_RC -1
#endif
#ifndef PROBE_G1V
#define PROBE_G1V -1
#endif
#ifndef PROBE_BAR2
#define PROBE_BAR2 0
#endif
#ifndef PROBE_MFMA
#define PROBE_MFMA 0
#endif
#ifndef MK_ONE_LAUNCH
#define MK_ONE_LAUNCH 1
#endif
namespace pg8 {
#define PG8_LAS __attribute__((address_space(3)))
typedef unsigned short bf16_t;
typedef short bf16x8 __attribute__((ext_vector_type(8)));
typedef float f32x4 __attribute__((ext_vector_type(4)));
typedef unsigned u32x4 __attribute__((ext_vector_type(4)));
constexpr int BM = 256, BK = 64, HALF = 128, HTB = HALF * BK * 2  , STAGE_BYTES = 8 * HTB, NXCD = 8, WGM = 8;

__host__ __device__ __forceinline__ int lds_byte(int r, int c) { const int st = (r >> 4) * 2 + (c >> 5), rr = r & 15, cc = c & 31, ob = rr * 64 + cc * 2; return st * 1024 + (ob ^ (((ob >> 9) & 1) << 5)); }
__host__ __device__ __forceinline__ void stage_rc(int b, int& R, int& C) { const int st = b / 1024, sb = b % 1024, swz = sb ^ (((sb >> 9) & 1) << 5); R = (st >> 1) * 16 + swz / 64; C = (st & 1) * 32 + (swz % 64) / 2; }
__host__ __device__ __forceinline__ int perm32(int rho) { const int n = rho >> 4, i = rho & 15; return 8 * (i >> 2) + 4 * n + (i & 3); }

struct Unit { int pm, pn, idx; };
struct Gemm { const bf16_t* A; const bf16_t* Bt; int M, N, K; int ldil; };

struct StaticOrder {
    int nM, nN, nwg, G, c;
    __host__ __device__ void init(int M, int N, int G_, int c_) { nM = M / BM; nN = N / BM; nwg = nM * nN; G = G_; c = c_; }
    __host__ __device__ bool next(int i, Unit& u) const {
        const long L = (long)i * G + c; if (L >= nwg) return false;
        int wgid = (int)L; { const int q = nwg / NXCD, r = nwg % NXCD, xcd = wgid % NXCD, off = wgid / NXCD; wgid = (xcd < r ? xcd * (q + 1) : r * (q + 1) + (xcd - r) * q) + off; }
        const int nig = WGM * nN, gid = wgid / nig, fm = gid * WGM, gsz = (nM - fm) < WGM ? (nM - fm) : WGM;
        u.pm = fm + ((wgid % nig) % gsz); u.pn = (wgid % nig) / gsz; u.idx = i; return true;
    }
    __device__ __forceinline__ void a_ready(const Unit&) const {}
    __device__ __forceinline__ void done(const Unit&) const {}
};

__device__ __forceinline__ unsigned cvt_pk_bf16(float lo, float hi) { unsigned r; asm volatile("v_cvt_pk_bf16_f32 %0, %1, %2" : "=v"(r) : "v"(lo), "v"(hi)); return r; }
typedef float f32x2 __attribute__((ext_vector_type(2)));

__device__ __forceinline__ float fast_sigmoid(float g) { return __builtin_amdgcn_rcpf(1.0f + __builtin_amdgcn_exp2f(-1.4426950409f * g)); }
constexpr int RS_TAB_OFF = 131072;
template <class Sched> __device__ __forceinline__ void stage_scales(PG8_LAS unsigned char* lds, const Sched& S, const float* rs, bool cols, int ldil, int tid) {
    PG8_LAS float* tab = (PG8_LAS float*)(lds + RS_TAB_OFF); Unit u;
    if (tid < 256) { const int lper = 8 - ldil, c = tid, tm = ((c & ((1 << lper) - 1)) << ldil) + (c >> lper);
        for (int i = 0; i < 16 && S.next(i, u); ++i) tab[i * 256 + tid] = rs[cols ? u.pn * BM + tm : u.pm * BM + tid]; }
    __syncthreads();
}
struct EpiPlain {
    static constexpr bool PERM = true, AFTER_DRAIN = false;
    bf16_t* O; int ldc; const PG8_LAS float* tab;
    __device__ __forceinline__ void operator()(const f32x4 (&acc)[2][2][4][2], const Unit& u, int wr, int wc, int fr, int fq) const {
        const int row0 = u.pm * BM + wr * 64 + fr, col0 = u.pn * BM + wc * 32 + 8 * fq;
#pragma unroll
        for (int ai = 0; ai < 2; ++ai)
#pragma unroll
            for (int m = 0; m < 4; ++m) { const int row = row0 + ai * HALF + m * 16; bf16_t* rowp = O + (size_t)row * ldc + col0; const float r = tab ? tab[u.idx * 256 + (row & 255)] : 1.0f;
#pragma unroll
                for (int bj = 0; bj < 2; ++bj) { const f32x4 v0 = acc[ai][bj][m][0] * r, v1 = acc[ai][bj][m][1] * r;
                    u32x4 w; w.x = cvt_pk_bf16(v0[0], v0[1]); w.y = cvt_pk_bf16(v0[2], v0[3]); w.z = cvt_pk_bf16(v1[0], v1[1]); w.w = cvt_pk_bf16(v1[2], v1[3]);
                    *(u32x4*)(rowp + bj * HALF) = w; } }
    }
};
template <int CHEAP = 0  > struct EpiSwiGLUT {
    static constexpr bool PERM = true, AFTER_DRAIN = false;
    bf16_t* O; int ldc; const PG8_LAS float* tab;
    __device__ __forceinline__ void operator()(const f32x4 (&acc)[2][2][4][2], const Unit& u, int wr, int wc, int fr, int fq) const {
        const int row0 = u.pm * BM + wr * 64 + fr, col0 = CHEAP ? ((u.pn * HALF + wc * 32 + 8 * fq) & 1023) : (u.pn * HALF + wc * 32 + 8 * fq);
#pragma unroll
        for (int ai = 0; ai < 2; ++ai)
#pragma unroll
            for (int m = 0; m < 4; ++m) { const int row = row0 + ai * HALF + m * 16; bf16_t* rowp = O + (size_t)row * ldc + col0; const float r = tab[u.idx * 256 + (row & 255)];
                float o[8];
#pragma unroll
                for (int n = 0; n < 2; ++n)
#pragma unroll
                    for (int e = 0; e < 4; ++e) { const float g = acc[ai][0][m][n][e] * r, up = acc[ai][1][m][n][e] * r; o[n * 4 + e] = CHEAP ? g * up : g * fast_sigmoid(g) * up; }
                u32x4 w; w.x = cvt_pk_bf16(o[0], o[1]); w.y = cvt_pk_bf16(o[2], o[3]); w.z = cvt_pk_bf16(o[4], o[5]); w.w = cvt_pk_bf16(o[6], o[7]);
                if (CHEAP == 2) { if (w.x == 0x12345678u && w.y == w.z) *(u32x4*)rowp = w; } else *(u32x4*)rowp = w; }
    }
};
typedef EpiSwiGLUT<0> EpiSwiGLU;
struct EpiRet {
    static constexpr bool PERM = true, AFTER_DRAIN = false;
    bf16_t* O; int ldc; const PG8_LAS float* tab;
    __device__ __forceinline__ void operator()(const f32x4 (&acc)[2][2][4][2], const Unit& u, int wr, int wc, int fr, int fq) const {
        const int row0 = u.pm * BM + wr * 64 + fr, col0 = u.pn * BM + wc * 32 + 8 * fq;
        if (u.pn < 4 || u.pn >= 20) {
            const float osc = (u.pn >= 4) ? 0.0625f : 1.0f;
            float invf[8];
#pragma unroll
            for (int q = 0; q < 8; ++q) { const int j = wc * 32 + 8 * fq + q; invf[q] = __builtin_amdgcn_exp2f(-(float)j * (13.287712379549449f / 127.0f)) * 0.15915494309189535f; }
#pragma unroll
            for (int ai = 0; ai < 2; ++ai)
#pragma unroll
                for (int m = 0; m < 4; ++m) { const int row = row0 + ai * HALF + m * 16; const float pos = (float)(row & 2047), r = tab[u.idx * 256 + (row & 255)] * osc;
                    bf16_t* rowp = O + (size_t)row * ldc + col0;
                    float o1[8], o2[8];
#pragma unroll
                    for (int n = 0; n < 2; ++n)
#pragma unroll
                        for (int e = 0; e < 4; ++e) { const int q = n * 4 + e; float t = pos * invf[q]; t = __builtin_amdgcn_fractf(t);
                            const float sn = __builtin_amdgcn_sinf(t), cs = __builtin_amdgcn_cosf(t);
                            const float a = acc[ai][0][m][n][e], b = acc[ai][1][m][n][e];
                            o1[q] = (a * cs - b * sn) * r; o2[q] = (a * sn + b * cs) * r; }
                    u32x4 w; w.x = cvt_pk_bf16(o1[0], o1[1]); w.y = cvt_pk_bf16(o1[2], o1[3]); w.z = cvt_pk_bf16(o1[4], o1[5]); w.w = cvt_pk_bf16(o1[6], o1[7]);
                    *(u32x4*)rowp = w;
                    w.x = cvt_pk_bf16(o2[0], o2[1]); w.y = cvt_pk_bf16(o2[2], o2[3]); w.z = cvt_pk_bf16(o2[4], o2[5]); w.w = cvt_pk_bf16(o2[6], o2[7]);
                    *(u32x4*)(rowp + HALF) = w; }
        } else {
#pragma unroll
            for (int ai = 0; ai < 2; ++ai)
#pragma unroll
                for (int m = 0; m < 4; ++m) { const int row = row0 + ai * HALF + m * 16; bf16_t* rowp = O + (size_t)row * ldc + col0; const float r = tab[u.idx * 256 + (row & 255)];
#pragma unroll
                    for (int bj = 0; bj < 2; ++bj) { const f32x4 v0 = acc[ai][bj][m][0] * r, v1 = acc[ai][bj][m][1] * r;
                        u32x4 w; w.x = cvt_pk_bf16(v0[0], v0[1]); w.y = cvt_pk_bf16(v0[2], v0[3]); w.z = cvt_pk_bf16(v1[0], v1[1]); w.w = cvt_pk_bf16(v1[2], v1[3]);
                        *(u32x4*)(rowp + bj * HALF) = w; } }
        }
    }
};

struct EpiVT {
    static constexpr bool PERM = true, AFTER_DRAIN = false;
    bf16_t* O; int ldc; int ldil; const PG8_LAS float* tab;
    __device__ __forceinline__ void operator()(const f32x4 (&acc)[2][2][4][2], const Unit& u, int wr, int wc, int fr, int fq) const {
        const int lper = 8 - ldil, per = 1 << lper, Ls = 2048 >> ldil, b = u.pn >> 3, pl = u.pn & 7;
        const int row0 = u.pm * BM + wr * 64 + fr;
        int colb[2]; float cs[2][8];
#pragma unroll
        for (int bj = 0; bj < 2; ++bj) { const int c0 = bj * HALF + wc * 32 + 8 * fq; colb[bj] = b * 2048 + (c0 >> lper) * Ls + pl * per + (c0 & (per - 1));
            const f32x4 a = *(const PG8_LAS f32x4*)(tab + u.idx * 256 + c0), b4 = *(const PG8_LAS f32x4*)(tab + u.idx * 256 + c0 + 4);
            cs[bj][0] = a[0]; cs[bj][1] = a[1]; cs[bj][2] = a[2]; cs[bj][3] = a[3]; cs[bj][4] = b4[0]; cs[bj][5] = b4[1]; cs[bj][6] = b4[2]; cs[bj][7] = b4[3]; }
#pragma unroll
        for (int ai = 0; ai < 2; ++ai)
#pragma unroll
            for (int m = 0; m < 4; ++m) { bf16_t* rowp = O + (size_t)(row0 + ai * HALF + m * 16) * ldc;
#pragma unroll
                for (int bj = 0; bj < 2; ++bj) { const f32x4 v0 = acc[ai][bj][m][0], v1 = acc[ai][bj][m][1];
                    u32x4 w; w.x = cvt_pk_bf16(v0[0] * cs[bj][0], v0[1] * cs[bj][1]); w.y = cvt_pk_bf16(v0[2] * cs[bj][2], v0[3] * cs[bj][3]); w.z = cvt_pk_bf16(v1[0] * cs[bj][4], v1[1] * cs[bj][5]); w.w = cvt_pk_bf16(v1[2] * cs[bj][6], v1[3] * cs[bj][7]);
                    *(u32x4*)(rowp + colb[bj]) = w; } }
    }
};

struct EpiKVT {
    static constexpr bool PERM = true, AFTER_DRAIN = false;
    bf16_t* OK; bf16_t* OV; int ldc; const PG8_LAS float* tab;
    __device__ __forceinline__ void operator()(const f32x4 (&acc)[2][2][4][2], const Unit& u, int wr, int wc, int fr, int fq) const {
        const int col0 = u.pn * BM + wc * 32 + 8 * fq;
        float cs[2][8];
#pragma unroll
        for (int bj = 0; bj < 2; ++bj) { const int cl = bj * HALF + wc * 32 + 8 * fq; const f32x4 a = *(const PG8_LAS f32x4*)(tab + u.idx * 256 + cl), b = *(const PG8_LAS f32x4*)(tab + u.idx * 256 + cl + 4);
            cs[bj][0] = a[0]; cs[bj][1] = a[1]; cs[bj][2] = a[2]; cs[bj][3] = a[3]; cs[bj][4] = b[0]; cs[bj][5] = b[1]; cs[bj][6] = b[2]; cs[bj][7] = b[3]; }
        if (u.pm < 4) {
#pragma unroll
            for (int m = 0; m < 4; ++m) { const int j = wr * 64 + m * 16 + fr;
                const float invf = __builtin_amdgcn_exp2f(-(float)j * (13.287712379549449f / 127.0f)) * 0.15915494309189535f;
                bf16_t* r1 = OK + (size_t)(u.pm * BM + j) * ldc + col0; bf16_t* r2 = r1 + (size_t)HALF * ldc;
#pragma unroll
                for (int bj = 0; bj < 2; ++bj) { float o1[8], o2[8];
#pragma unroll
                    for (int n = 0; n < 2; ++n)
#pragma unroll
                        for (int e = 0; e < 4; ++e) { const int q = n * 4 + e; const float pos = (float)((col0 + bj * HALF + q) & 2047); float t = pos * invf; t = __builtin_amdgcn_fractf(t);
                            const float sn = __builtin_amdgcn_sinf(t), cn = __builtin_amdgcn_cosf(t), sc = cs[bj][q] * 0.0625f;
                            const float a = acc[0][bj][m][n][e], b = acc[1][bj][m][n][e];
                            o1[q] = (a * cn - b * sn) * sc; o2[q] = (a * sn + b * cn) * sc; }
                    u32x4 w; w.x = cvt_pk_bf16(o1[0], o1[1]); w.y = cvt_pk_bf16(o1[2], o1[3]); w.z = cvt_pk_bf16(o1[4], o1[5]); w.w = cvt_pk_bf16(o1[6], o1[7]);
                    *(u32x4*)(r1 + bj * HALF) = w;
                    w.x = cvt_pk_bf16(o2[0], o2[1]); w.y = cvt_pk_bf16(o2[2], o2[3]); w.z = cvt_pk_bf16(o2[4], o2[5]); w.w = cvt_pk_bf16(o2[6], o2[7]);
                    *(u32x4*)(r2 + bj * HALF) = w; } }
        } else {
            const int row0 = (u.pm - 4) * BM + wr * 64 + fr;
#pragma unroll
            for (int ai = 0; ai < 2; ++ai)
#pragma unroll
                for (int m = 0; m < 4; ++m) { bf16_t* rowp = OV + (size_t)(row0 + ai * HALF + m * 16) * ldc + col0;
#pragma unroll
                    for (int bj = 0; bj < 2; ++bj) { const f32x4 v0 = acc[ai][bj][m][0], v1 = acc[ai][bj][m][1];
                        u32x4 w; w.x = cvt_pk_bf16(v0[0] * cs[bj][0], v0[1] * cs[bj][1]); w.y = cvt_pk_bf16(v0[2] * cs[bj][2], v0[3] * cs[bj][3]); w.z = cvt_pk_bf16(v1[0] * cs[bj][4], v1[1] * cs[bj][5]); w.w = cvt_pk_bf16(v1[2] * cs[bj][6], v1[3] * cs[bj][7]);
                        *(u32x4*)(rowp + bj * HALF) = w; } }
        }
    }
};

template <class Epi, class Sched, bool ALIGN_EPI = false, bool SP2 = false>
__device__ __forceinline__ void gemm_phase(PG8_LAS unsigned char* lds, const Gemm g, const Sched& S, const Epi& E, const int tid) {
    const int wid = __builtin_amdgcn_readfirstlane(tid >> 6), lane = tid & 63, wr = wid >> 2, wc = wid & 3, fr = lane & 15, fq = lane >> 4;
    const int K = g.K, nt = K / BK;
    unsigned voffA[2], voffB[2], voffB1[2];
#pragma unroll
    for (int i = 0; i < 2; ++i) { int R, C; stage_rc(tid * 16 + i * 8192, R, C); const int Rb = Epi::PERM ? ((R & ~31) + perm32(R & 31)) : R;
        voffA[i] = (unsigned)(R * K + C) * 2u; { const int ld = g.ldil, lper = 8 - ld, pm1 = (1 << lper) - 1; const int c0 = Rb, c1 = 128 + Rb; voffB[i] = (unsigned)((((c0 & pm1) << ld) + (c0 >> lper)) * K + C) * 2u; voffB1[i] = (unsigned)((((c1 & pm1) << ld) + (c1 >> lper)) * K + C) * 2u; } }
    const size_t kstep = (size_t)(BK * 2);
    const size_t hstep = (size_t)HALF * K * 2;
    const size_t tstep = 2 * hstep;
    const unsigned ldsw = (unsigned)wid * 1024u;
    const int aoff = lds_byte(wr * 64 + fr, fq * 8), boff = lds_byte(wc * 32 + fr, fq * 8);
#define PG8_SA(b, h) (((b) * 2 + (h)) * HTB)
#define PG8_SB(b, h) ((4 + (b) * 2 + (h)) * HTB)
#define PG8_STAGE(bufoff, gbase, voff) do { _Pragma("unroll") for (int _i = 0; _i < 2; ++_i) \
        __builtin_amdgcn_global_load_lds((const unsigned*)((const char*)(gbase) + (voff)[_i]), (PG8_LAS unsigned*)(lds + (bufoff) + ldsw + _i * 8192), 16, 0, 0); } while (0)
#define PG8_LDA(dst, b, h) do { _Pragma("unroll") for (int m = 0; m < 4; ++m) _Pragma("unroll") for (int k = 0; k < 2; ++k) dst[m][k] = *(const PG8_LAS bf16x8*)(lds + PG8_SA(b, h) + aoff + m * 2048 + k * 1024); } while (0)
#define PG8_LDB(dst, b, h) do { _Pragma("unroll") for (int n = 0; n < 2; ++n) _Pragma("unroll") for (int k = 0; k < 2; ++k) dst[n][k] = *(const PG8_LAS bf16x8*)(lds + PG8_SB(b, h) + boff + n * 2048 + k * 1024); } while (0)
#define PG8_MMA(ai, bj, At, Bt) do { __builtin_amdgcn_s_setprio(1); _Pragma("unroll") for (int m = 0; m < 4; ++m) _Pragma("unroll") for (int n = 0; n < 2; ++n) _Pragma("unroll") for (int k = 0; k < 2; ++k) \
        acc[ai][bj][m][n] = __builtin_amdgcn_mfma_f32_16x16x32_bf16(Bt[n][k], At[m][k], acc[ai][bj][m][n], 0, 0, 0); __builtin_amdgcn_s_setprio(0); } while (0)
#define PG8_WAIT_V(n) asm volatile("s_waitcnt vmcnt(" #n ")" ::: "memory")
#define PG8_WAIT_L(n) asm volatile("s_waitcnt lgkmcnt(" #n ")" ::: "memory")
#define PG8_BAR __builtin_amdgcn_s_barrier()
#define PG8_SCHED __builtin_amdgcn_sched_barrier(0)
    Unit cur, nxt; int ui = 0;
    if (!S.next(0, cur)) return;
    f32x4 acc[2][2][4][2];
#pragma unroll
    for (int a = 0; a < 2; ++a)
#pragma unroll
        for (int b = 0; b < 2; ++b)
#pragma unroll
            for (int m = 0; m < 4; ++m)
#pragma unroll
                for (int n = 0; n < 2; ++n) acc[a][b][m][n] = (f32x4){0.f, 0.f, 0.f, 0.f};
    bf16x8 At[4][2], B0[2][2], B1[2][2];
    const char* cA = (const char*)g.A + (size_t)cur.pm * tstep; const char* cB = (const char*)g.Bt + (size_t)cur.pn * tstep;
    S.a_ready(cur);
    if constexpr (SP2) {
        PG8_STAGE(PG8_SB(0, 0), cB, voffB); PG8_STAGE(PG8_SB(0, 1), cB, voffB1); PG8_STAGE(PG8_SA(0, 0), cA, voffA); PG8_STAGE(PG8_SA(0, 1), cA + hstep, voffA);
        if (wr == 1) PG8_BAR;
        PG8_WAIT_V(2); PG8_BAR;
        PG8_STAGE(PG8_SB(1, 0), cB + kstep, voffB); PG8_STAGE(PG8_SA(1, 0), cA + kstep, voffA); PG8_STAGE(PG8_SB(1, 1), cB + kstep, voffB1);
        PG8_WAIT_V(6); PG8_BAR;
    } else {
        PG8_STAGE(PG8_SB(0, 0), cB, voffB); PG8_STAGE(PG8_SA(0, 0), cA, voffA); PG8_STAGE(PG8_SB(0, 1), cB, voffB1); PG8_STAGE(PG8_SA(0, 1), cA + hstep, voffA);
        if (wr == 1) PG8_BAR;
        PG8_WAIT_V(4); PG8_BAR;
        PG8_STAGE(PG8_SB(1, 0), cB + kstep, voffB); PG8_STAGE(PG8_SA(1, 0), cA + kstep, voffA); PG8_STAGE(PG8_SB(1, 1), cB + kstep, voffB1);
        PG8_WAIT_V(6); PG8_BAR;
    }
    for (;;) {
        const bool has_next = S.next(ui + 1, nxt);
        const char* nA = has_next ? (const char*)g.A + (size_t)nxt.pm * tstep : cA; const char* nB = has_next ? (const char*)g.Bt + (size_t)nxt.pn * tstep : cB;
        for (int t = 0; t < nt; t += 2) {
            const bool last = (t == nt - 2);
            const char* a1 = cA + (size_t)(t + 1) * kstep;
            const char* a2 = last ? nA : cA + (size_t)(t + 2) * kstep; const char* b2 = last ? nB : cB + (size_t)(t + 2) * kstep;
            const char* a3 = a2 + kstep; const char* b3 = b2 + kstep;
            if (last && has_next) S.a_ready(nxt);
            if constexpr (SP2) {
            PG8_LDB(B0, 0, 0); PG8_LDB(B1, 0, 1); PG8_SCHED; PG8_LDA(At, 0, 0); PG8_STAGE(PG8_SA(1, 1), a1 + hstep, voffA);
            PG8_WAIT_V(8); PG8_WAIT_L(0); PG8_BAR; PG8_MMA(0, 0, At, B0); PG8_MMA(0, 1, At, B1); PG8_BAR; PG8_SCHED;
            PG8_LDA(At, 0, 1); PG8_STAGE(PG8_SB(0, 0), b2, voffB); PG8_STAGE(PG8_SB(0, 1), b2, voffB1); PG8_STAGE(PG8_SA(0, 0), a2, voffA);
            PG8_WAIT_V(8); PG8_WAIT_L(0); PG8_BAR; PG8_MMA(1, 0, At, B0); PG8_MMA(1, 1, At, B1); PG8_BAR; PG8_SCHED;
            PG8_LDB(B0, 1, 0); PG8_LDB(B1, 1, 1); PG8_SCHED; PG8_LDA(At, 1, 0); PG8_STAGE(PG8_SA(0, 1), a2 + hstep, voffA);
            PG8_WAIT_V(8); PG8_WAIT_L(0); PG8_BAR; PG8_MMA(0, 0, At, B0); PG8_MMA(0, 1, At, B1); PG8_BAR; PG8_SCHED;
            PG8_LDA(At, 1, 1); PG8_STAGE(PG8_SB(1, 0), b3, voffB); PG8_STAGE(PG8_SB(1, 1), b3, voffB1); PG8_STAGE(PG8_SA(1, 0), a3, voffA);
            PG8_WAIT_V(8); PG8_WAIT_L(0); PG8_BAR; PG8_MMA(1, 0, At, B0); PG8_MMA(1, 1, At, B1); PG8_BAR; PG8_SCHED;
            } else {
            PG8_LDB(B0, 0, 0); PG8_SCHED; PG8_LDA(At, 0, 0); PG8_STAGE(PG8_SA(1, 1), a1 + hstep, voffA);
            PG8_WAIT_L(8); PG8_BAR; PG8_WAIT_L(0); PG8_MMA(0, 0, At, B0); PG8_BAR; PG8_SCHED;
            PG8_LDB(B1, 0, 1); PG8_STAGE(PG8_SB(0, 0), b2, voffB);
            PG8_BAR; PG8_WAIT_L(0); PG8_MMA(0, 1, At, B1); PG8_BAR;
            PG8_LDA(At, 0, 1); PG8_STAGE(PG8_SA(0, 0), a2, voffA);
            PG8_BAR; PG8_WAIT_L(0); PG8_MMA(1, 0, At, B0); PG8_BAR; PG8_SCHED;
            PG8_STAGE(PG8_SB(0, 1), b2, voffB1);
            PG8_WAIT_V(6); PG8_BAR; PG8_MMA(1, 1, At, B1); PG8_BAR;
            PG8_LDB(B0, 1, 0); PG8_SCHED; PG8_LDA(At, 1, 0); PG8_STAGE(PG8_SA(0, 1), a2 + hstep, voffA);
            PG8_WAIT_L(8); PG8_BAR; PG8_WAIT_L(0); PG8_MMA(0, 0, At, B0); PG8_BAR; PG8_SCHED;
            PG8_LDB(B1, 1, 1); PG8_STAGE(PG8_SB(1, 0), b3, voffB);
            PG8_BAR; PG8_WAIT_L(0); PG8_MMA(0, 1, At, B1); PG8_BAR;
            PG8_LDA(At, 1, 1); PG8_STAGE(PG8_SA(1, 0), a3, voffA);
            PG8_BAR; PG8_WAIT_L(0); PG8_MMA(1, 0, At, B0); PG8_BAR; PG8_SCHED;
            PG8_STAGE(PG8_SB(1, 1), b3, voffB1);
            PG8_WAIT_V(6); PG8_BAR; PG8_MMA(1, 1, At, B1); PG8_BAR;
            }
        }
        if constexpr (ALIGN_EPI) { if (wr == 0) PG8_BAR; }
        if constexpr (!Epi::AFTER_DRAIN) { E(acc, cur, wr, wc, fr, fq); S.done(cur); }
        if (!has_next) break;
#pragma unroll
        for (int a = 0; a < 2; ++a)
#pragma unroll
            for (int b = 0; b < 2; ++b)
#pragma unroll
                for (int m = 0; m < 4; ++m)
#pragma unroll
                    for (int n = 0; n < 2; ++n) acc[a][b][m][n] = (f32x4){0.f, 0.f, 0.f, 0.f};
        cur = nxt; cA = nA; cB = nB; ++ui;
        if constexpr (ALIGN_EPI) { if (wr == 1) PG8_BAR; }
    }
    PG8_WAIT_V(0);
    if constexpr (!ALIGN_EPI) { if (wr == 0) PG8_BAR; }
    PG8_BAR;
    if constexpr (Epi::AFTER_DRAIN) { E.fused(acc, cur, wr, wc, fr, fq, lds, wid, lane); S.done(cur); }
#undef PG8_SA
#undef PG8_SB
#undef PG8_STAGE
#undef PG8_LDA
#undef PG8_LDB
#undef PG8_MMA
#undef PG8_WAIT_V
#undef PG8_WAIT_L
#undef PG8_BAR
#undef PG8_SCHED
}
}

constexpr int BATCH = 16, SEQ = 2048, D = 1024, M = BATCH * SEQ, DEPTH = 4, DFF = 2816;
constexpr int NGRP = 3, HA = 16, DHA = 64, ATT_COLS = 3 * D;
constexpr int HR = 4, DKR = 256, DVR = 512, DV = HR * DVR, RET_COLS = 2 * D + 3 * DV;
constexpr int MH = M / 2;
constexpr float NORM_EPS = 1e-6f;
constexpr int NWAVES = 8, NTHREADS = NWAVES * 64;
constexpr int NPHASES = 1 + DEPTH * 14;

__device__ const unsigned char T5_BUCKET[3][129] = {
{11,11,11,11,11,11,11,11,11,11,11,11,11,11,11,10,10,10,10,10,10,10,10,10,10,10,10,10,10,10,10,10,10,10,10,10,10,10,9,9,9,9,9,9,9,9,9,9,9,9,8,8,8,8,8,8,8,7,6,5,4,3,2,1,0,17,18,19,20,21,22,23,24,24,24,24,24,24,24,25,25,25,25,25,25,25,25,25,25,25,25,26,26,26,26,26,26,26,26,26,26,26,26,26,26,26,26,26,26,26,26,26,26,26,27,27,27,27,27,27,27,27,27,27,27,27,27,27,27},
{13,13,13,13,13,13,13,13,13,13,13,13,13,13,13,13,13,13,13,13,13,13,13,12,12,12,12,12,12,12,12,12,12,12,12,12,12,12,12,12,12,12,11,11,11,11,11,11,11,11,11,11,10,10,10,10,10,10,9,9,9,8,8,4,0,20,24,24,25,25,25,26,26,26,26,26,26,27,27,27,27,27,27,27,27,27,27,28,28,28,28,28,28,28,28,28,28,28,28,28,28,28,28,28,28,28,29,29,29,29,29,29,29,29,29,29,29,29,29,29,29,29,29,29,29,29,29,29,29},
{15,15,15,15,15,15,15,15,15,15,15,15,15,15,15,15,15,15,15,15,15,15,15,15,15,15,15,15,15,15,14,14,14,14,14,14,14,14,14,14,14,14,14,14,14,13,13,13,13,13,13,13,13,13,12,12,12,12,12,11,11,10,10,9,0,25,26,26,27,27,28,28,28,28,28,29,29,29,29,29,29,29,29,29,30,30,30,30,30,30,30,30,30,30,30,30,30,30,30,31,31,31,31,31,31,31,31,31,31,31,31,31,31,31,31,31,31,31,31,31,31,31,31,31,31,31,31,31,31}};

constexpr size_t MiB = 1u << 20;
constexpr size_t WS_CTL = 0, CTL_ZERO_BYTES = 1 * MiB;
constexpr size_t WS_BIAS = 1 * MiB;
constexpr size_t WS_RS = WS_BIAS + 256 * 1024;
constexpr size_t WS_W = 2 * MiB;
constexpr size_t WS_W2_FFN = WS_W + (size_t)2 * DFF * D * 2;
constexpr size_t WS_W2_ATT = WS_W + (size_t)NGRP * ATT_COLS * D * 2;
constexpr size_t WS_W2_RET = WS_W + (size_t)RET_COLS * D * 2;
constexpr size_t WS_XH = 26 * MiB;
constexpr size_t WS_YC = 90 * MiB;
constexpr size_t WS_BIG = 218 * MiB;
constexpr size_t WS_F = 410 * MiB;
constexpr size_t WS_RVT = 410 * MiB;
constexpr size_t WS_RKT = 474 * MiB;
constexpr size_t WS_OACC = 474 * MiB;
constexpr size_t WS_LSE = 538 * MiB;
constexpr size_t WS_END = 540 * MiB;
static_assert(WS_W2_FFN + (size_t)D * DFF * 2 <= WS_XH && WS_W2_ATT + (size_t)D * D * 2 <= WS_XH && WS_W2_RET + (size_t)D * DV * 2 <= WS_XH, "weight region");
constexpr int RP_COLS = 2 * D + 2 * DV;
static_assert(WS_XH + (size_t)M * D * 2 == WS_YC && WS_YC + (size_t)M * DV * 2 == WS_BIG && WS_BIG + (size_t)MH * RP_COLS * 2 == WS_F && WS_F + (size_t)M * D * 2 == WS_RKT && WS_RVT + (size_t)DV * MH * 2 == WS_RKT && WS_RKT + (size_t)D * MH * 2 <= WS_LSE && WS_OACC + (size_t)M * D * 2 == WS_LSE, "d_ws map");
static_assert((size_t)M * DFF * 2 <= 192 * MiB && (size_t)M * ATT_COLS * 2 <= 192 * MiB && WS_LSE + (size_t)M * 16 * 4 <= WS_END, "d_ws map");
constexpr int CW_BAR = 4096;

constexpr int RING_OFF = 0, RING_BYTES = 147456;
constexpr int LDSCTL_OFF = RING_BYTES, MISC_OFF = LDSCTL_OFF + 320;
constexpr int LDS_BYTES = RING_BYTES + 512;
static_assert(MISC_OFF + 128 <= LDS_BYTES, "LDS map");

#define LAS __attribute__((address_space(3)))
typedef unsigned short bf16;
typedef unsigned v4u __attribute__((ext_vector_type(4)));
typedef unsigned v2u __attribute__((ext_vector_type(2)));
typedef float f32x4 __attribute__((ext_vector_type(4)));
#define LDS_WAIT() asm volatile("s_waitcnt lgkmcnt(0)" ::: "memory")
__device__ __forceinline__ unsigned f2bf(float f) { unsigned u = __builtin_bit_cast(unsigned, f); return (u + 0x7fffu + ((u >> 16) & 1u)) >> 16; }
__device__ __forceinline__ unsigned pk2(float lo, float hi) { return f2bf(lo) | (f2bf(hi) << 16); }
__device__ __forceinline__ float bflo(unsigned w) { return __builtin_bit_cast(float, w << 16); }
__device__ __forceinline__ float bfhi(unsigned w) { return __builtin_bit_cast(float, w & 0xffff0000u); }
template <int O> __device__ __forceinline__ float swz_xor(float v) { return __builtin_bit_cast(float, __builtin_amdgcn_ds_swizzle(__builtin_bit_cast(int, v), (O << 10) | 0x1f)); }
__device__ __forceinline__ float wave_sum(float v) {
    v += swz_xor<1>(v); v += swz_xor<2>(v); v += swz_xor<4>(v); v += swz_xor<8>(v); v += swz_xor<16>(v);
    return __builtin_bit_cast(float, __builtin_amdgcn_readlane(__builtin_bit_cast(int, v), 0)) + __builtin_bit_cast(float, __builtin_amdgcn_readlane(__builtin_bit_cast(int, v), 32));
}
__device__ __forceinline__ float get_xor32(float v, int lane) { return __builtin_bit_cast(float, __builtin_amdgcn_ds_bpermute((lane ^ 32) << 2, __builtin_bit_cast(int, v))); }

#define XB_TMO      128
#define XB_XCNT(j)  (256  + 64 * (j))
#define XB_XSUB(j)  (1280 + 64 * (j))
#define XB_XGEN(j)  (2304 + 64 * (j))
#define XB_TOP      3328
#define XB_TOPGEN   3392
#define XCD_BAR_WORDS 3456
#define XB_SPIN_CAP (1u << 18)

__device__ __forceinline__ unsigned xb_ld(unsigned* p)              { return __hip_atomic_load(p, __ATOMIC_RELAXED, __HIP_MEMORY_SCOPE_AGENT); }
__device__ __forceinline__ unsigned xb_add(unsigned* p, unsigned v) { return __hip_atomic_fetch_add(p, v, __ATOMIC_RELAXED, __HIP_MEMORY_SCOPE_AGENT); }
__device__ __forceinline__ unsigned xb_xcc_id() { return (unsigned)__builtin_amdgcn_s_getreg((3 << 11) | 20) & 0xFu; }
#define XB_SPIN(cond, bar) do { unsigned _sp = 0; while (cond) { __builtin_amdgcn_s_sleep(1); \
    if ((++_sp & 255u) == 0u) { if (xb_ld(&(bar)[XB_TMO])) break; if (_sp > XB_SPIN_CAP) { atomicAdd(&(bar)[XB_TMO], 1u); break; } } } } while (0)

struct XcdBarrier {
    unsigned* bar; unsigned x;
    volatile LAS unsigned* st;
};

__device__ __forceinline__ XcdBarrier xcd_barrier_post(unsigned* bar, volatile LAS unsigned* st) {
    XcdBarrier b; b.bar = bar; b.x = xb_xcc_id(); b.st = st;
    if (threadIdx.x == 0) (void)xb_add(&bar[XB_XCNT(b.x)], 1u);
    return b;
}
__device__ __forceinline__ void xcd_barrier_complete(unsigned* bar, unsigned x, unsigned& nloc, unsigned& nx) {
    const unsigned G = gridDim.x * gridDim.y * gridDim.z;
    unsigned sum, cnt, mine, sp = 0u;
    for (;;) {
        sum = 0u; cnt = 0u; mine = 0u;
#pragma unroll
        for (unsigned j = 0; j < 16; ++j) { const unsigned c = xb_ld(&bar[XB_XCNT(j)]); sum += c; cnt += (c > 0u) ? 1u : 0u; mine = (j == x) ? c : mine; }
        if (sum == G) break;
        __builtin_amdgcn_s_sleep(1);
        if ((++sp & 255u) == 0u) { if (xb_ld(&bar[XB_TMO])) break; if (sp > XB_SPIN_CAP) { atomicAdd(&bar[XB_TMO], 1u); break; } }
    }
    nloc = mine > 0u ? mine : 1u; nx = cnt > 0u ? cnt : 1u;
}

__device__ __forceinline__ void xcd_barrier(const XcdBarrier& b) {
    asm volatile("s_waitcnt vmcnt(0)" ::: "memory");
    __syncthreads();
    if (threadIdx.x == 0) {
        unsigned* bar = b.bar;
        __builtin_amdgcn_s_waitcnt(0);
        unsigned nloc = b.st[0], nx = b.st[1];
        if (nloc == 0u) { xcd_barrier_complete(bar, b.x, nloc, nx); b.st[0] = nloc; b.st[1] = nx; }
        const unsigned old = xb_add(&bar[XB_XSUB(b.x)], 1u);
        const unsigned gen = old / nloc;
        if (old + 1u == (gen + 1u) * nloc) {
            __builtin_amdgcn_fence(__ATOMIC_RELEASE, "agent");
            asm volatile("s_waitcnt vmcnt(0)" ::: "memory");
            const unsigned og = xb_add(&bar[XB_TOP], 1u);
            const unsigned tg = og / nx;
            if (og + 1u == (tg + 1u) * nx) xb_add(&bar[XB_TOPGEN], 1u);
            else XB_SPIN(xb_ld(&bar[XB_TOPGEN]) == tg, bar);
            __builtin_amdgcn_fence(__ATOMIC_ACQUIRE, "agent");
            xb_add(&bar[XB_XGEN(b.x)], 1u);
            asm volatile("s_waitcnt vmcnt(0)" ::: "memory");
        } else {
            XB_SPIN(xb_ld(&bar[XB_XGEN(b.x)]) == gen, bar);
            __builtin_amdgcn_fence(__ATOMIC_ACQUIRE, "agent");
            asm volatile("s_waitcnt vmcnt(0)" ::: "memory");
        }
    }
    __syncthreads();
}


constexpr int CV_SCR = 64 * 65 * 4;
__device__ __forceinline__ void conv_item(const float* W, int srcN, int k0, int n0, bf16* WT, int dstK, int drow0, const float* gain, LAS float* scr, int lane) {
    { const float* src = W + (size_t)(k0 + (lane >> 4)) * srcN + n0 + (lane & 15) * 4; LAS float* d = scr + (lane >> 4) * 65 + (lane & 15) * 4;
#pragma unroll
      for (int i = 0; i < 16; ++i) { const f32x4 v = *(const f32x4*)(src + (size_t)(4 * i) * srcN); d[4 * i * 65 + 0] = v.x; d[4 * i * 65 + 1] = v.y; d[4 * i * 65 + 2] = v.z; d[4 * i * 65 + 3] = v.w; } }
    LDS_WAIT(); asm volatile("" ::: "memory");
    const int c = lane & 7;
    float gk[8];
#pragma unroll
    for (int i = 0; i < 8; ++i) gk[i] = gain ? gain[k0 + 8 * c + i] : 1.0f;
#pragma unroll
    for (int j = 0; j < 8; ++j) { const int n = (lane >> 3) + 8 * j; const LAS float* s = scr + (8 * c) * 65 + n;
        v4u o; o.x = pk2(s[0 * 65] * gk[0], s[1 * 65] * gk[1]); o.y = pk2(s[2 * 65] * gk[2], s[3 * 65] * gk[3]); o.z = pk2(s[4 * 65] * gk[4], s[5 * 65] * gk[5]); o.w = pk2(s[6 * 65] * gk[6], s[7 * 65] * gk[7]);
        *(v4u*)(WT + (size_t)(drow0 + n) * dstK + k0 + 8 * c) = o; }
    LDS_WAIT(); asm volatile("" ::: "memory");
}
template <int K, int N, int NC> __device__ __forceinline__ void conv_cols(const float* W, int c0, bf16* WT, int r0, const float* gain, LAS float* scr, int gw, int NGW, int lane) {
    constexpr int nblk = NC / 64, nitems = (K / 64) * nblk;
    for (int it = gw; it < nitems; it += NGW) { const int kb = it / nblk, nb = it % nblk; conv_item(W, N, 64 * kb, c0 + 64 * nb, WT, K, r0 + 64 * nb, gain, scr, lane); }
}
template <int K, int N> __device__ __forceinline__ void conv_plain(const float* W, bf16* WT, const float* gain, LAS float* scr, int gw, int NGW, int lane) { conv_cols<K, N, N>(W, 0, WT, 0, gain, scr, gw, NGW, lane); }
__device__ __forceinline__ void conv_gateup(const float* Wg, const float* Wu, bf16* WT, const float* gain, LAS float* scr, int gw, int NGW, int lane) {
    constexpr int nblk = 2 * DFF / 64, nitems = (D / 64) * nblk;
    for (int it = gw; it < nitems; it += NGW) { const int kb = it / nblk, nb = it % nblk, n0 = 64 * nb, pn = n0 >> 8, bj = (n0 >> 7) & 1, c0 = n0 & 127;
        conv_item(bj ? Wu : Wg, DFF, 64 * kb, 128 * pn + c0, WT, D, n0, gain, scr, lane); }
}

__device__ __forceinline__ void unpack8(const v4u w, float (&f)[8]) { f[0] = bflo(w.x); f[1] = bfhi(w.x); f[2] = bflo(w.y); f[3] = bfhi(w.y); f[4] = bflo(w.z); f[5] = bfhi(w.z); f[6] = bflo(w.w); f[7] = bfhi(w.w); }
__device__ __forceinline__ void p0_rows(const float* xin, bf16* XB, float* RS, int gw, int NGW, int lane) {
    for (int m = gw; m < M; m += NGW) {
        float ss = 0.f;
#pragma unroll
        for (int j = 0; j < 2; ++j) { const float* p = xin + (size_t)m * D + 512 * j + 8 * lane; const f32x4 a = *(const f32x4*)p, b = *(const f32x4*)(p + 4);
            ss += (a.x * a.x + a.y * a.y) + (a.z * a.z + a.w * a.w) + (b.x * b.x + b.y * b.y) + (b.z * b.z + b.w * b.w);
            v4u w; w.x = pk2(a.x, a.y); w.y = pk2(a.z, a.w); w.z = pk2(b.x, b.y); w.w = pk2(b.z, b.w); *(v4u*)(XB + (size_t)m * D + 512 * j + 8 * lane) = w; }
        ss = wave_sum(ss);
        if (lane == 0) RS[m] = __builtin_amdgcn_rsqf(ss * (1.f / D) + NORM_EPS);
    }
}
__device__ __forceinline__ void thin_rows(const bf16* Fin, bf16* XB, const float* gpost, float cpost, float* RS, float* outf, int gw, int NGW, int lane) {
    float gp[2][8];
#pragma unroll
    for (int j = 0; j < 2; ++j) { const f32x4 a = *(const f32x4*)(gpost + 512 * j + 8 * lane), b = *(const f32x4*)(gpost + 512 * j + 8 * lane + 4);
        gp[j][0] = a.x; gp[j][1] = a.y; gp[j][2] = a.z; gp[j][3] = a.w; gp[j][4] = b.x; gp[j][5] = b.y; gp[j][6] = b.z; gp[j][7] = b.w; }
    for (int m = gw; m < M; m += NGW) {
        float x[2][8], f[2][8]; float ss = 0.f;
#pragma unroll
        for (int j = 0; j < 2; ++j) { unpack8(*(const v4u*)(XB + (size_t)m * D + 512 * j + 8 * lane), x[j]); unpack8(*(const v4u*)(Fin + (size_t)m * D + 512 * j + 8 * lane), f[j]);
#pragma unroll
            for (int q = 0; q < 8; ++q) ss += f[j][q] * f[j][q]; }
        const float rF = cpost * __builtin_amdgcn_rsqf(wave_sum(ss) * (1.f / D) + NORM_EPS);
        float s2 = 0.f;
#pragma unroll
        for (int j = 0; j < 2; ++j)
#pragma unroll
            for (int q = 0; q < 8; ++q) { x[j][q] += f[j][q] * gp[j][q] * rF; s2 += x[j][q] * x[j][q]; }
        if (outf) {
#pragma unroll
            for (int j = 0; j < 2; ++j) { float* p = outf + (size_t)m * D + 512 * j + 8 * lane; *(f32x4*)p = (f32x4){x[j][0], x[j][1], x[j][2], x[j][3]}; *(f32x4*)(p + 4) = (f32x4){x[j][4], x[j][5], x[j][6], x[j][7]}; }
        } else {
#pragma unroll
            for (int j = 0; j < 2; ++j) { v4u w; w.x = pk2(x[j][0], x[j][1]); w.y = pk2(x[j][2], x[j][3]); w.z = pk2(x[j][4], x[j][5]); w.w = pk2(x[j][6], x[j][7]); *(v4u*)(XB + (size_t)m * D + 512 * j + 8 * lane) = w; }
            s2 = wave_sum(s2);
            if (lane == 0) RS[m] = __builtin_amdgcn_rsqf(s2 * (1.f / D) + NORM_EPS);
        }
    }
}

__device__ __forceinline__ void attn_group_scalar(const bf16* P, const float* bias2, int dil, int first, bf16* OACC, float* LSE, int gw, int NGW, int lane) {
    const int Ls = SEQ / dil, tbn = Ls / 64;
    constexpr float SC = 0.125f * 1.4426950409f;
    for (int w = gw; w < BATCH * HA * 32; w += NGW) {
        const int tb = w % tbn, r = (w / tbn) % dil, h = (w >> 5) & 15, b = w >> 9;
        const int t = tb * 64 + lane; const size_t row = (size_t)b * SEQ + (size_t)t * dil + r;
        float q[64], acc[64];
        { const v4u* qp = (const v4u*)(P + row * ATT_COLS + h * 64);
#pragma unroll
          for (int c = 0; c < 8; ++c) { const v4u x = qp[c]; q[8 * c + 0] = bflo(x.x); q[8 * c + 1] = bfhi(x.x); q[8 * c + 2] = bflo(x.y); q[8 * c + 3] = bfhi(x.y); q[8 * c + 4] = bflo(x.z); q[8 * c + 5] = bfhi(x.z); q[8 * c + 6] = bflo(x.w); q[8 * c + 7] = bfhi(x.w); } }
#pragma unroll
        for (int c = 0; c < 64; ++c) acc[c] = 0.f;
        float mx = -INFINITY, l = 0.f;
        for (int kk = 0; kk < 129; ++kk) {
            const int tk = t - 64 + kk;
            if (tk >= 0 && tk < Ls) {
                const size_t krow = (size_t)b * SEQ + (size_t)tk * dil + r;
                const v4u* kp = (const v4u*)(P + krow * ATT_COLS + D + h * 64);
                float s = 0.f;
#pragma unroll
                for (int c = 0; c < 8; ++c) { const v4u x = kp[c];
                    s += q[8 * c + 0] * bflo(x.x) + q[8 * c + 1] * bfhi(x.x) + q[8 * c + 2] * bflo(x.y) + q[8 * c + 3] * bfhi(x.y) + q[8 * c + 4] * bflo(x.z) + q[8 * c + 5] * bfhi(x.z) + q[8 * c + 6] * bflo(x.w) + q[8 * c + 7] * bfhi(x.w); }
                s = s * SC + bias2[h * 129 + kk];
                const float mn = fmaxf(mx, s), a = exp2f(mx - mn), p = exp2f(s - mn);
                l = l * a + p; mx = mn;
                const v4u* vp = (const v4u*)(P + krow * ATT_COLS + 2 * D + h * 64);
#pragma unroll
                for (int c = 0; c < 8; ++c) { const v4u x = vp[c];
                    acc[8 * c + 0] = acc[8 * c + 0] * a + p * bflo(x.x); acc[8 * c + 1] = acc[8 * c + 1] * a + p * bfhi(x.x); acc[8 * c + 2] = acc[8 * c + 2] * a + p * bflo(x.y); acc[8 * c + 3] = acc[8 * c + 3] * a + p * bfhi(x.y);
                    acc[8 * c + 4] = acc[8 * c + 4] * a + p * bflo(x.z); acc[8 * c + 5] = acc[8 * c + 5] * a + p * bfhi(x.z); acc[8 * c + 6] = acc[8 * c + 6] * a + p * bflo(x.w); acc[8 * c + 7] = acc[8 * c + 7] * a + p * bfhi(x.w); }
            }
        }
        const float il = 1.f / l; float lse = mx + log2f(l);
        float wn = il, wo = 0.f;
        if (!first) { const float lo = LSE[row * 16 + h]; const float mm = fmaxf(lo, lse), eo = exp2f(lo - mm), en = exp2f(lse - mm), inv = 1.f / (eo + en); wn = en * inv * il; wo = eo * inv; lse = mm + log2f(eo + en); }
        LSE[row * 16 + h] = lse;
        v4u* op = (v4u*)(OACC + row * D + h * 64);
#pragma unroll
        for (int c = 0; c < 8; ++c) { v4u x = (v4u){0u, 0u, 0u, 0u}; if (!first) x = op[c];
            v4u y; y.x = pk2(wn * acc[8 * c + 0] + wo * bflo(x.x), wn * acc[8 * c + 1] + wo * bfhi(x.x)); y.y = pk2(wn * acc[8 * c + 2] + wo * bflo(x.y), wn * acc[8 * c + 3] + wo * bfhi(x.y));
            y.z = pk2(wn * acc[8 * c + 4] + wo * bflo(x.z), wn * acc[8 * c + 5] + wo * bfhi(x.z)); y.w = pk2(wn * acc[8 * c + 6] + wo * bflo(x.w), wn * acc[8 * c + 7] + wo * bfhi(x.w)); op[c] = y; }
    }
}

__device__ __forceinline__ void ret_core_scalar(const bf16* P, const bf16* KT, const bf16* VT, const float* decay_logit  , bf16* YF, bf16* YB, int useKT, int gw, int NGW, int lane) {
    const int el = lane & 15, dq = lane >> 4;
    for (int w = gw; w < 8 * HR * 2 * 32; w += NGW) {
        const int eb = w & 31, dir = (w >> 5) & 1, h = (w >> 6) & 3, bl = w >> 8;
        const int e = eb * 16 + el;
        const float gamma = 1.0f - expf(decay_logit[dir * HR + h]);
        bf16* Y = dir ? YB : YF;
        float S[64];
#pragma unroll
        for (int c = 0; c < 64; ++c) S[c] = 0.f;
        for (int ti = 0; ti < SEQ; ++ti) {
            const int s = dir ? (SEQ - 1 - ti) : ti; const size_t row = (size_t)bl * SEQ + s;
            const bf16* pr = P + row * RP_COLS;
            const float v = __builtin_bit_cast(float, (unsigned)VT[(size_t)(h * DVR + e) * MH + row] << 16);
            const v4u* qp = (const v4u*)(pr + h * DKR + dq * 64); const v4u* kp = (const v4u*)(pr + D + 2 * DV + h * DKR + dq * 64);
            float y = 0.f;
#pragma unroll
            for (int c = 0; c < 8; ++c) { v4u kx = kp[c]; const v4u qx = qp[c];
                if (useKT) { const bf16* kt = KT + (size_t)(h * DKR + dq * 64 + 8 * c) * MH + row;
                    kx.x = (unsigned)kt[0] | ((unsigned)kt[MH] << 16); kx.y = (unsigned)kt[2 * (size_t)MH] | ((unsigned)kt[3 * (size_t)MH] << 16);
                    kx.z = (unsigned)kt[4 * (size_t)MH] | ((unsigned)kt[5 * (size_t)MH] << 16); kx.w = (unsigned)kt[6 * (size_t)MH] | ((unsigned)kt[7 * (size_t)MH] << 16); }
                S[8 * c + 0] = S[8 * c + 0] * gamma + bflo(kx.x) * v; y += bflo(qx.x) * S[8 * c + 0];
                S[8 * c + 1] = S[8 * c + 1] * gamma + bfhi(kx.x) * v; y += bfhi(qx.x) * S[8 * c + 1];
                S[8 * c + 2] = S[8 * c + 2] * gamma + bflo(kx.y) * v; y += bflo(qx.y) * S[8 * c + 2];
                S[8 * c + 3] = S[8 * c + 3] * gamma + bfhi(kx.y) * v; y += bfhi(qx.y) * S[8 * c + 3];
                S[8 * c + 4] = S[8 * c + 4] * gamma + bflo(kx.z) * v; y += bflo(qx.z) * S[8 * c + 4];
                S[8 * c + 5] = S[8 * c + 5] * gamma + bfhi(kx.z) * v; y += bfhi(qx.z) * S[8 * c + 5];
                S[8 * c + 6] = S[8 * c + 6] * gamma + bflo(kx.w) * v; y += bflo(qx.w) * S[8 * c + 6];
                S[8 * c + 7] = S[8 * c + 7] * gamma + bfhi(kx.w) * v; y += bfhi(qx.w) * S[8 * c + 7]; }
            y += __shfl_xor(y, 16); y += __shfl_xor(y, 32);
            if (dq == 0) Y[row * DV + h * DVR + e] = (bf16)f2bf(y);
        }
    }
}

__device__ __forceinline__ void ret_combine(const bf16* P, bf16* YF  , const bf16* YB, int gw, int NGW, int lane) {
    for (int m = gw; m < MH; m += NGW) {
#pragma unroll
        for (int j = 0; j < 4; ++j) {
            const int idx = j * 512 + lane * 8;
            const v4u a = *(const v4u*)(YF + (size_t)m * DV + idx), bq = *(const v4u*)(YB + (size_t)m * DV + idx);
            const v4u gfv = *(const v4u*)(P + (size_t)m * RP_COLS + D + idx), gbv = *(const v4u*)(P + (size_t)m * RP_COLS + D + DV + idx);
            float yf[8] = {bflo(a.x), bfhi(a.x), bflo(a.y), bfhi(a.y), bflo(a.z), bfhi(a.z), bflo(a.w), bfhi(a.w)};
            float yb[8] = {bflo(bq.x), bfhi(bq.x), bflo(bq.y), bfhi(bq.y), bflo(bq.z), bfhi(bq.z), bflo(bq.w), bfhi(bq.w)};
            float gf[8] = {bflo(gfv.x), bfhi(gfv.x), bflo(gfv.y), bfhi(gfv.y), bflo(gfv.z), bfhi(gfv.z), bflo(gfv.w), bfhi(gfv.w)};
            float gb[8] = {bflo(gbv.x), bfhi(gbv.x), bflo(gbv.y), bfhi(gbv.y), bflo(gbv.z), bfhi(gbv.z), bflo(gbv.w), bfhi(gbv.w)};
            float sf = 0.f, sb = 0.f;
#pragma unroll
            for (int c = 0; c < 8; ++c) { sf += yf[c]; sb += yb[c]; }
            const float muf = wave_sum(sf) * (1.f / DVR), mub = wave_sum(sb) * (1.f / DVR);
            float qf = 0.f, qb = 0.f;
#pragma unroll
            for (int c = 0; c < 8; ++c) { yf[c] -= muf; yb[c] -= mub; qf += yf[c] * yf[c]; qb += yb[c] * yb[c]; }
            const float rf = __builtin_amdgcn_rsqf(wave_sum(qf) * (1.f / DVR) + NORM_EPS), rb = __builtin_amdgcn_rsqf(wave_sum(qb) * (1.f / DVR) + NORM_EPS);
            float o[8];
#pragma unroll
            for (int c = 0; c < 8; ++c) o[c] = gf[c] * pg8::fast_sigmoid(gf[c]) * yf[c] * rf + gb[c] * pg8::fast_sigmoid(gb[c]) * yb[c] * rb;
            v4u w; w.x = pk2(o[0], o[1]); w.y = pk2(o[2], o[3]); w.z = pk2(o[4], o[5]); w.w = pk2(o[6], o[7]);
            *(v4u*)(YF + (size_t)m * DV + idx) = w;
        }
    }
}

typedef float f32x16 __attribute__((ext_vector_type(16)));
typedef short bf16x8s __attribute__((ext_vector_type(8)));
typedef float f32x2_t __attribute__((ext_vector_type(2))); typedef __bf16 bf16x2_t __attribute__((ext_vector_type(2)));
__device__ __forceinline__ unsigned cvtpk(float lo, float hi) { f32x2_t v = {lo, hi}; bf16x2_t b = __builtin_convertvector(v, bf16x2_t); return __builtin_bit_cast(unsigned, b); }
__device__ __forceinline__ void attn_group_mfma(const bf16* QK, const bf16* VT, const float* bias2g, int dil, int first, bf16* OACC, float* LSE, LAS unsigned char* lds, int tid, int gw, int NGW) {
    LAS float* tab = (LAS float*)lds;
    for (int i = tid; i < 16 * 192; i += NTHREADS) { const int h = i / 192, o = i % 192 - 96; tab[i] = (o >= -64 && o <= 64) ? bias2g[h * 129 + o + 64] : -1e30f; }
    __syncthreads();
    const int lane = tid & 63, r = lane & 31, hh = lane >> 5;
    const int Ls = SEQ / dil, nqb = Ls / 32;
    constexpr float SC = 0.125f * 1.4426950409f;
    constexpr int NU = BATCH * HA * 64;
    const int upw = (NU + NGW - 1) / NGW;
    for (int u = gw * upw; u < (gw + 1) * upw && u < NU; ++u) {
        const int qb = u % nqb, rr = (u / nqb) % dil, h = (u >> 6) & 15, b = u >> 10, t0 = qb * 32;
        const size_t rowq = (size_t)b * SEQ + (size_t)(t0 + r) * dil + rr;
        bf16x8s qf[4];
#pragma unroll
        for (int ks = 0; ks < 4; ++ks) qf[ks] = *(const bf16x8s*)(QK + rowq * 2048 + h * 64 + 16 * ks + 8 * hh);
        f32x16 S[5];
#pragma unroll
        for (int kb = 0; kb < 5; ++kb) {
            int t = t0 - 64 + 32 * kb + r; t = t < 0 ? 0 : (t > Ls - 1 ? Ls - 1 : t);
            const bf16* kp = QK + ((size_t)b * SEQ + (size_t)t * dil + rr) * 2048 + 1024 + h * 64 + 8 * hh;
            bf16x8s kf[4];
#pragma unroll
            for (int ks = 0; ks < 4; ++ks) kf[ks] = *(const bf16x8s*)(kp + 16 * ks);
#pragma unroll
            for (int i = 0; i < 16; ++i) S[kb][i] = 0.f;
#pragma unroll
            for (int ks = 0; ks < 4; ++ks) S[kb] = __builtin_amdgcn_mfma_f32_32x32x16_bf16(kf[ks], qf[ks], S[kb], 0, 0, 0);
        }
        const LAS float* tb = tab + h * 192 + (32 + 4 * hh - r);
        float mx = -1e30f;
#pragma unroll
        for (int kb = 0; kb < 5; ++kb)
#pragma unroll
            for (int i = 0; i < 16; ++i) { const int krel = 32 * kb + (i & 3) + 8 * (i >> 2); const int kt = t0 - 64 + krel + 4 * hh;
                float s = S[kb][i] * SC + tb[krel]; s = (kt < 0 || kt >= Ls) ? -1e30f : s; S[kb][i] = s; mx = fmaxf(mx, s); }
        mx = fmaxf(mx, get_xor32(mx, lane));
        float l = 0.f;
#pragma unroll
        for (int kb = 0; kb < 5; ++kb)
#pragma unroll
            for (int i = 0; i < 16; ++i) { const float p = __builtin_amdgcn_exp2f(S[kb][i] - mx); S[kb][i] = p; l += p; }
        l += get_xor32(l, lane);
        f32x16 O[2];
#pragma unroll
        for (int db = 0; db < 2; ++db)
#pragma unroll
            for (int i = 0; i < 16; ++i) O[db][i] = 0.f;
        const bf16* vbase = VT + (size_t)(h * 64 + r) * M + (size_t)b * SEQ + (size_t)rr * Ls;
#pragma unroll
        for (int kb = 0; kb < 5; ++kb)
#pragma unroll
            for (int s2 = 0; s2 < 2; ++s2) {
                v4u pw; pw.x = cvtpk(S[kb][8 * s2 + 0], S[kb][8 * s2 + 1]); pw.y = cvtpk(S[kb][8 * s2 + 2], S[kb][8 * s2 + 3]); pw.z = cvtpk(S[kb][8 * s2 + 4], S[kb][8 * s2 + 5]); pw.w = cvtpk(S[kb][8 * s2 + 6], S[kb][8 * s2 + 7]);
                const bf16x8s pf = __builtin_bit_cast(bf16x8s, pw);
                int ta = t0 - 64 + 32 * kb + 16 * s2 + 4 * hh, tb2 = ta + 8;
                ta = (ta < 0 || ta >= Ls) ? 0 : ta; tb2 = (tb2 < 0 || tb2 >= Ls) ? 0 : tb2;
#pragma unroll
                for (int db = 0; db < 2; ++db) { const bf16* vp = vbase + (size_t)(32 * db) * M;
                    const v2u lo = *(const v2u*)(vp + ta), hi = *(const v2u*)(vp + tb2);
                    const v4u vw = (v4u){lo.x, lo.y, hi.x, hi.y};
                    O[db] = __builtin_amdgcn_mfma_f32_32x32x16_bf16(__builtin_bit_cast(bf16x8s, vw), pf, O[db], 0, 0, 0); }
            }
        const float il = 1.f / l; float lse = mx + log2f(l);
        const size_t row = rowq;
        float wn = il, wo = 0.f;
        if (!first) { const float lo = LSE[row * 16 + h]; const float mm = fmaxf(lo, lse), eo = exp2f(lo - mm), en = exp2f(lse - mm), inv = 1.f / (eo + en); wn = en * inv * il; wo = eo * inv; lse = mm + log2f(eo + en); }
        if (hh == 0) LSE[row * 16 + h] = lse;
#pragma unroll
        for (int db = 0; db < 2; ++db)
#pragma unroll
            for (int gq = 0; gq < 4; ++gq) { v2u* op = (v2u*)(OACC + row * D + h * 64 + 32 * db + 8 * gq + 4 * hh);
                v2u x = (v2u){0u, 0u}; if (!first) x = *op;
                v2u y; y.x = cvtpk(wn * O[db][4 * gq + 0] + wo * bflo(x.x), wn * O[db][4 * gq + 1] + wo * bfhi(x.x)); y.y = cvtpk(wn * O[db][4 * gq + 2] + wo * bflo(x.y), wn * O[db][4 * gq + 3] + wo * bfhi(x.y));
                *op = y; }
    }
}

constexpr int RC_ST = 0, RC_RG = 65536, RC_NSLOT = 5, RC_LDS = RC_RG + RC_NSLOT * 16384;
__device__ __forceinline__ int sl_swz(int ob) { return ob ^ (((ob >> 9) & 1) << 5); }
template <int VAR  >
__device__ __forceinline__ void ret_core_mfma(const bf16* P, const bf16* VT, const float* decay_logit  , bf16* YF, bf16* YB, LAS unsigned char* lds, const int tid, const int bid, const int G) {
    typedef short bf16x8v __attribute__((ext_vector_type(8)));
    const int w = __builtin_amdgcn_readfirstlane(tid >> 6), lane = tid & 63, fr = lane & 15, fq = lane >> 4, wr = w >> 2, wc = w & 3;
#define RC_DMA(gptr, ldsoff) __builtin_amdgcn_global_load_lds((const unsigned*)(gptr), (LAS unsigned*)(lds + (ldsoff)), 16, 0, 0)
#define RC_WAITV(n) asm volatile("s_waitcnt vmcnt(" #n ")" ::: "memory")
#define RC_WAITL() asm volatile("s_waitcnt lgkmcnt(0)" ::: "memory")
#define RC_BAR() do { asm volatile("" ::: "memory"); __builtin_amdgcn_s_barrier(); asm volatile("" ::: "memory"); } while (0)
#define RC_MFMA(b, a, c) __builtin_amdgcn_mfma_f32_16x16x32_bf16((b), (a), (c), 0, 0, 0)
#define RC_NEXT(sl) ((sl) == RC_NSLOT - 1 ? 0 : (sl) + 1)
#define RC_PREV(sl) ((sl) == 0 ? RC_NSLOT - 1 : (sl) - 1)
    const int dob = sl_swz(lane * 16), drow = 16 * w + (dob >> 6), dcc = (dob & 63) >> 1;
    const int aoff = 4 * wr * 1024 + sl_swz(fr * 64 + fq * 16), boff = 2 * wc * 1024 + sl_swz(fr * 64 + fq * 16);
    for (int u = bid; u < 256; u += G) {
        const int xcd = u & 7, idx = u >> 3, es = idx & 3, cmb = (idx >> 2) * 8 + xcd, dir = cmb & 1, h = (cmb >> 1) & 3, bl = cmb >> 3;
        const float lg = __builtin_amdgcn_logf(1.0f - __builtin_amdgcn_exp2f(decay_logit[dir * HR + h] * 1.4426950409f));
        const float cdec = __builtin_amdgcn_exp2f(lg * 128.f);
        bf16* Y = dir ? YB : YF;
        const size_t rowbase = (size_t)bl * SEQ;
        const bf16* qsrc = P + (rowbase + drow) * RP_COLS + h * DKR + dcc;
        const bf16* ksrc = qsrc + (D + 2 * DV);
        const bf16* vsrc = VT + (size_t)(h * DVR + es * 128 + drow) * MH + rowbase + dcc;
        const bf16* vown = VT + (size_t)(h * DVR + es * 128 + 16 * w + fr) * MH + rowbase + 8 * fq;
        { const v4u z = (v4u){0u, 0u, 0u, 0u};
#pragma unroll
          for (int i = 0; i < 8; ++i) *(LAS v4u*)(lds + RC_ST + (i * NTHREADS + tid) * 16) = z; }
        f32x4 acc4[16];
#pragma unroll
        for (int n = 0; n < 16; ++n) acc4[n] = (f32x4){0.f, 0.f, 0.f, 0.f};
#define RC_ISSUE(st, tk, sl) do { if ((st) < 8) { const size_t to_ = (size_t)(tk) * RP_COLS + 32 * (st); RC_DMA(qsrc + to_, RC_RG + (sl) * 16384 + w * 1024); RC_DMA(ksrc + to_, RC_RG + (sl) * 16384 + 8192 + w * 1024); } \
                                  else RC_DMA(vsrc + (tk) + 32 * ((st) - 8), RC_RG + (sl) * 16384 + w * 1024); } while (0)
        v4u vnx[4];
        { const int tok0 = dir ? 128 * 15 : 0;
#pragma unroll
          for (int js = 0; js < 4; ++js) vnx[js] = *(const v4u*)(vown + tok0 + 32 * js);
          RC_ISSUE(0, tok0, 0); RC_ISSUE(1, tok0, 1); RC_ISSUE(2, tok0, 2); RC_ISSUE(3, tok0, 3); }
        RC_WAITL();
        int slot = 0;
        for (int c = 0; c < 16; ++c) {
            const int tok0 = 128 * (dir ? 15 - c : c), tokn = 128 * (dir ? (c < 15 ? 14 - c : 0) : (c < 15 ? c + 1 : 15));
            float lgc = lg; int zo = 0; asm volatile("" : "+v"(lgc), "+v"(zo));
            int lc = lane; asm volatile("" : "+v"(lc)); const int frc = lc & 15, fqc = lc >> 4;
            bf16x8v Avs[4];
#pragma unroll
            for (int js = 0; js < 4; ++js) { const v4u kw = vnx[js]; float kd[8];
#pragma unroll
                for (int q = 0; q < 8; ++q) { const int j = 32 * js + 8 * fqc + q; kd[q] = __builtin_amdgcn_exp2f(lgc * (dir ? (float)j : (float)(127 - j))); }
                v4u sw; sw.x = cvtpk(bflo(kw.x) * kd[0], bfhi(kw.x) * kd[1]); sw.y = cvtpk(bflo(kw.y) * kd[2], bfhi(kw.y) * kd[3]); sw.z = cvtpk(bflo(kw.z) * kd[4], bfhi(kw.z) * kd[5]); sw.w = cvtpk(bflo(kw.w) * kd[6], bfhi(kw.w) * kd[7]);
                Avs[js] = __builtin_bit_cast(bf16x8v, sw); }
#pragma unroll
            for (int n = 0; n < 16; ++n) acc4[n] = acc4[n] * cdec;
            const int jj = 8 * fqc + (frc >> 2);
            const unsigned trA = (unsigned)((jj >> 4) * 1024 + sl_swz((jj & 15) * 64 + 8 * (frc & 3))), trB = (unsigned)(((jj + 4) >> 4) * 1024 + sl_swz(((jj + 4) & 15) * 64 + 8 * (frc & 3)));
            f32x4 accA[4][2], accY[4][2];
#pragma unroll
            for (int m = 0; m < 4; ++m)
#pragma unroll
                for (int n = 0; n < 2; ++n) { accA[m][n] = (f32x4){0.f, 0.f, 0.f, 0.f}; accY[m][n] = (f32x4){0.f, 0.f, 0.f, 0.f}; }
#pragma unroll
            for (int ks = 0; ks < 8; ++ks) {
                if (ks < 4) { if (c == 0) RC_WAITV(6); else RC_WAITV(14); } else if (ks == 4) RC_WAITV(6); else if (ks == 5) RC_WAITV(5); else if (ks == 6) RC_WAITV(4); else RC_WAITV(3);
                RC_BAR();
                { const int s4 = RC_PREV(slot);
                  if (ks + 4 < 12) RC_ISSUE(ks + 4, tok0, s4); else RC_ISSUE(ks + 4 - 12, tokn, s4); }
                bf16x8v At[4], Bk[2], Bs[2];
                const LAS unsigned char* sq = lds + RC_RG + slot * 16384;
#pragma unroll
                for (int m = 0; m < 4; ++m) At[m] = *(const LAS bf16x8v*)(sq + aoff + m * 1024);
#pragma unroll
                for (int n = 0; n < 2; ++n) { Bk[n] = *(const LAS bf16x8v*)(sq + 8192 + boff + n * 1024); Bs[n] = *(const LAS bf16x8v*)(lds + RC_ST + ks * 8192 + boff + n * 1024); }
                RC_WAITL();
#pragma unroll
                for (int m = 0; m < 4; ++m)
#pragma unroll
                    for (int n = 0; n < 2; ++n) { accA[m][n] = RC_MFMA(Bk[n], At[m], accA[m][n]); accY[m][n] = RC_MFMA(Bs[n], At[m], accY[m][n]); }
                { const unsigned kb = (unsigned)(size_t)(sq + 8192);
#pragma unroll
                  for (int nl = 0; nl < 2; ++nl) { const unsigned a0 = kb + (trA ^ (nl << 5)), a1 = kb + (trB ^ (nl << 5));
                      v2u l0, h0, l1, h1, l2, h2, l3, h3;
                      asm volatile("ds_read_b64_tr_b16 %0, %8\n\tds_read_b64_tr_b16 %1, %9\n\tds_read_b64_tr_b16 %2, %8 offset:2048\n\tds_read_b64_tr_b16 %3, %9 offset:2048\n\t"
                                   "ds_read_b64_tr_b16 %4, %8 offset:4096\n\tds_read_b64_tr_b16 %5, %9 offset:4096\n\tds_read_b64_tr_b16 %6, %8 offset:6144\n\tds_read_b64_tr_b16 %7, %9 offset:6144\n\ts_waitcnt lgkmcnt(0)"
                                   : "=&v"(l0), "=&v"(h0), "=&v"(l1), "=&v"(h1), "=&v"(l2), "=&v"(h2), "=&v"(l3), "=&v"(h3) : "v"(a0), "v"(a1) : "memory");
                      acc4[2 * ks + nl] = RC_MFMA(__builtin_bit_cast(bf16x8v, ((v4u){l0.x, l0.y, h0.x, h0.y})), Avs[0], acc4[2 * ks + nl]);
                      acc4[2 * ks + nl] = RC_MFMA(__builtin_bit_cast(bf16x8v, ((v4u){l1.x, l1.y, h1.x, h1.y})), Avs[1], acc4[2 * ks + nl]);
                      acc4[2 * ks + nl] = RC_MFMA(__builtin_bit_cast(bf16x8v, ((v4u){l2.x, l2.y, h2.x, h2.y})), Avs[2], acc4[2 * ks + nl]);
                      acc4[2 * ks + nl] = RC_MFMA(__builtin_bit_cast(bf16x8v, ((v4u){l3.x, l3.y, h3.x, h3.y})), Avs[3], acc4[2 * ks + nl]); } }
                slot = RC_NEXT(slot);
            }
#pragma unroll
            for (int m = 0; m < 4; ++m)
#pragma unroll
                for (int n = 0; n < 2; ++n) { accY[m][n] = accY[m][n] * __builtin_amdgcn_exp2f(lgc * (dir ? (float)(128 - (64 * wr + 16 * m + frc)) : (float)(64 * wr + 16 * m + frc + 1)));
                    const int i = 64 * wr + 16 * m + frc;
#pragma unroll
                    for (int ii = 0; ii < 4; ++ii) { const int j = 32 * wc + 16 * n + 4 * fqc + ii; const int dd = dir ? j - i : i - j;
                        accA[m][n][ii] = dd >= 0 ? accA[m][n][ii] * __builtin_amdgcn_exp2f(lgc * (float)dd) : 0.f; } }
            RC_BAR();
#pragma unroll
            for (int m = 0; m < 4; ++m)
#pragma unroll
                for (int n = 0; n < 2; ++n) { v2u pw; pw.x = cvtpk(accA[m][n][0], accA[m][n][1]); pw.y = cvtpk(accA[m][n][2], accA[m][n][3]);
                    *(LAS v2u*)(lds + RC_ST + wc * 8192 + (4 * wr + m) * 1024 + sl_swz(frc * 64 + (16 * n + 4 * fqc) * 2)) = pw; }
#pragma unroll
            for (int js = 0; js < 4; ++js) vnx[js] = *(const v4u*)(vown + tokn + 32 * js + zo);
            RC_WAITL();
#pragma unroll
            for (int js = 0; js < 4; ++js) {
                if (js == 0) RC_WAITV(7); else if (js == 1) RC_WAITV(8); else if (js == 2) RC_WAITV(9); else RC_WAITV(10);
                RC_BAR();
                { const int s4 = RC_PREV(slot); RC_ISSUE(js, tokn, s4); }
                bf16x8v At[4], Bv[2];
                const LAS unsigned char* sv = lds + RC_RG + slot * 16384;
#pragma unroll
                for (int m = 0; m < 4; ++m) At[m] = *(const LAS bf16x8v*)(lds + RC_ST + js * 8192 + aoff + m * 1024);
#pragma unroll
                for (int n = 0; n < 2; ++n) Bv[n] = *(const LAS bf16x8v*)(sv + boff + n * 1024);
                RC_WAITL();
#pragma unroll
                for (int m = 0; m < 4; ++m)
#pragma unroll
                    for (int n = 0; n < 2; ++n) accY[m][n] = RC_MFMA(Bv[n], At[m], accY[m][n]);
                slot = RC_NEXT(slot);
            }
#pragma unroll
            for (int m = 0; m < 4; ++m)
#pragma unroll
                for (int n = 0; n < 2; ++n) { v2u pw; pw.x = cvtpk(accY[m][n][0], accY[m][n][1]); pw.y = cvtpk(accY[m][n][2], accY[m][n][3]);
                    *(v2u*)(Y + (rowbase + tok0 + 64 * wr + 16 * m + frc + zo) * DV + h * DVR + es * 128 + 32 * wc + 16 * n + 4 * fqc) = pw; }
            RC_BAR();
#pragma unroll
            for (int n = 0; n < 16; ++n) { v2u pw; pw.x = cvtpk(acc4[n][0], acc4[n][1]); pw.y = cvtpk(acc4[n][2], acc4[n][3]);
                *(LAS v2u*)(lds + RC_ST + (n >> 1) * 8192 + w * 1024 + sl_swz(frc * 64 + (16 * (n & 1) + 4 * fqc) * 2)) = pw; }
            RC_WAITL();
        }
        RC_WAITV(0); RC_BAR();
    }
#undef RC_DMA
#undef RC_WAITV
#undef RC_WAITL
#undef RC_BAR
#undef RC_MFMA
#undef RC_NEXT
#undef RC_PREV
#undef RC_ISSUE
}

constexpr int AT_KROW = 144, AT_VROW = 520, AT_KB = 256 * AT_KROW, AT_VB = 64 * AT_VROW, AT_HALF = AT_KB + AT_VB + 768;
static_assert(2 * AT_HALF <= RING_BYTES, "attention tiles");
__device__ __forceinline__ void attn_group_mfma2(const bf16* QK, const bf16* VT, const float* bias2g, int ldil, int first, bf16* OACC, float* LSE, LAS unsigned char* lds, const int tid, const int bid, const int G) {
    const int wave = __builtin_amdgcn_readfirstlane(tid >> 6), lane = tid & 63, r = lane & 31, hh = lane >> 5, hw = wave >> 2, wq = wave & 3, tih0 = tid & 255;
    LAS unsigned char* Kl = lds + hw * AT_HALF; LAS unsigned char* Vl = Kl + AT_KB; LAS float* tab = (LAS float*)(Vl + AT_VB);
    const int Ls = SEQ >> ldil, lq4 = 4 - ldil, nq4m = (1 << lq4) - 1, dilm = (1 << ldil) - 1;
    constexpr float SC = 0.125f * 1.4426950409f;
    constexpr int NP = BATCH * HA * 16 / 2;
    const int npp = (NP + G - 1) / G;
    v4u kreg[8], vreg[8];
#define AT_FETCH_K(su_) do { int tih = tih0; asm volatile("" : "+v"(tih)); const int su__ = (su_); const int q4_ = su__ & nq4m, rr_ = (su__ >> lq4) & dilm, h_ = (su__ >> 4) & 15, b_ = su__ >> 8, ks_ = q4_ * 128 - 64; \
        _Pragma("unroll") for (int j = 0; j < 8; ++j) { const int pi = j * 256 + tih, row = pi >> 3, ch = pi & 7; int kt = ks_ + row; kt = kt < 0 ? 0 : (kt > Ls - 1 ? Ls - 1 : kt); \
            kreg[j] = *(const v4u*)(QK + ((size_t)b_ * SEQ + ((size_t)kt << ldil) + rr_) * 2048 + 1024 + h_ * 64 + ch * 8); } } while (0)
#define AT_FETCH_V(su_) do { int tih = tih0; asm volatile("" : "+v"(tih)); const int su__ = (su_); const int q4_ = su__ & nq4m, rr_ = (su__ >> lq4) & dilm, h_ = (su__ >> 4) & 15, b_ = su__ >> 8, ks_ = q4_ * 128 - 64; \
        _Pragma("unroll") for (int j = 0; j < 8; ++j) { const int pi = j * 256 + tih, row = pi >> 5, ch = pi & 31; int kt = ks_ + 8 * ch; kt = (kt < 0 || kt >= Ls) ? 0 : kt; \
            vreg[j] = *(const v4u*)(VT + (size_t)(h_ * 64 + row) * M + (size_t)b_ * SEQ + (size_t)rr_ * Ls + kt); } } while (0)
    if (bid * npp < NP) { AT_FETCH_K(2 * (bid * npp) + hw); AT_FETCH_V(2 * (bid * npp) + hw); }
    for (int it = 0; it < npp; ++it) {
        const int p = bid * npp + it; if (p >= NP) break;
        const int su = 2 * p + hw, q4 = su & nq4m, rr = (su >> lq4) & dilm, h = (su >> 4) & 15, b = su >> 8, t0 = q4 * 128 + 32 * wq;
        asm volatile("" ::: "memory"); __builtin_amdgcn_s_barrier(); asm volatile("" ::: "memory");
        int tih = tih0; asm volatile("" : "+v"(tih));
#pragma unroll
        for (int j = 0; j < 8; ++j) { const int pi = j * 256 + tih; *(LAS v4u*)(Kl + (pi >> 3) * AT_KROW + (pi & 7) * 16) = kreg[j]; }
#pragma unroll
        for (int j = 0; j < 8; ++j) { const int pi = j * 256 + tih; LAS v2u* d = (LAS v2u*)(Vl + (pi >> 5) * AT_VROW + (pi & 31) * 16); d[0] = (v2u){vreg[j].x, vreg[j].y}; d[1] = (v2u){vreg[j].z, vreg[j].w}; }
        if (tih < 192) { const int o = tih - 96; tab[tih] = (o >= -64 && o <= 64) ? bias2g[h * 129 + o + 64] : -1e30f; }
        const size_t rowq = (size_t)b * SEQ + ((size_t)(t0 + r) << ldil) + rr;
        bf16x8s qf[4];
#pragma unroll
        for (int ks = 0; ks < 4; ++ks) qf[ks] = *(const bf16x8s*)(QK + rowq * 2048 + h * 64 + 16 * ks + 8 * hh);
        asm volatile("s_waitcnt lgkmcnt(0)" ::: "memory"); __builtin_amdgcn_s_barrier(); asm volatile("" ::: "memory");
        f32x16 S[5];
#pragma unroll
        for (int kb = 0; kb < 5; ++kb) {
            const LAS unsigned char* kp = Kl + (32 * wq + 32 * kb + r) * AT_KROW + 16 * hh;
#pragma unroll
            for (int i = 0; i < 16; ++i) S[kb][i] = 0.f;
#pragma unroll
            for (int ks = 0; ks < 4; ++ks) S[kb] = __builtin_amdgcn_mfma_f32_32x32x16_bf16(*(const LAS bf16x8s*)(kp + 32 * ks), qf[ks], S[kb], 0, 0, 0);
        }
        const bool more = it + 1 < npp && p + 1 < NP;
        __builtin_amdgcn_sched_barrier(0);
        if (more) AT_FETCH_K(2 * (p + 1) + hw);
        __builtin_amdgcn_sched_barrier(0);
        const LAS float* tb = tab + (32 + 4 * hh - r);
        float mx = -1e30f;
#pragma unroll
        for (int kb = 0; kb < 5; ++kb)
#pragma unroll
            for (int i = 0; i < 16; ++i) { const int krel = 32 * kb + (i & 3) + 8 * (i >> 2); const int kt = t0 - 64 + krel + 4 * hh;
                float s = S[kb][i] * SC + tb[krel]; s = (kt < 0 || kt >= Ls) ? -1e30f : s; S[kb][i] = s; mx = fmaxf(mx, s); }
        mx = fmaxf(mx, get_xor32(mx, lane));
        float l = 0.f;
#pragma unroll
        for (int kb = 0; kb < 5; ++kb)
#pragma unroll
            for (int i = 0; i < 16; ++i) { const float pv = __builtin_amdgcn_exp2f(S[kb][i] - mx); S[kb][i] = pv; l += pv; }
        l += get_xor32(l, lane);
        f32x16 O[2];
#pragma unroll
        for (int db = 0; db < 2; ++db)
#pragma unroll
            for (int i = 0; i < 16; ++i) O[db][i] = 0.f;
#pragma unroll
        for (int kb = 0; kb < 5; ++kb) {
            if (kb == 3) { __builtin_amdgcn_sched_barrier(0); if (more) AT_FETCH_V(2 * (p + 1) + hw); __builtin_amdgcn_sched_barrier(0); }
#pragma unroll
            for (int s2 = 0; s2 < 2; ++s2) {
                v4u pw; pw.x = cvtpk(S[kb][8 * s2 + 0], S[kb][8 * s2 + 1]); pw.y = cvtpk(S[kb][8 * s2 + 2], S[kb][8 * s2 + 3]); pw.z = cvtpk(S[kb][8 * s2 + 4], S[kb][8 * s2 + 5]); pw.w = cvtpk(S[kb][8 * s2 + 6], S[kb][8 * s2 + 7]);
                const bf16x8s pf = __builtin_bit_cast(bf16x8s, pw);
                const int ko = 32 * wq + 32 * kb + 16 * s2 + 4 * hh;
#pragma unroll
                for (int db = 0; db < 2; ++db) { const LAS unsigned char* vp = Vl + (32 * db + r) * AT_VROW + ko * 2;
                    const v2u lo = *(const LAS v2u*)vp, hi = *(const LAS v2u*)(vp + 16);
                    const v4u vw = (v4u){lo.x, lo.y, hi.x, hi.y};
                    O[db] = __builtin_amdgcn_mfma_f32_32x32x16_bf16(__builtin_bit_cast(bf16x8s, vw), pf, O[db], 0, 0, 0); }
            }
        }
        const float il = __builtin_amdgcn_rcpf(l); float lse = mx + __builtin_amdgcn_logf(l);
        const size_t row = rowq;
        float wn = il, wo = 0.f;
        if (!first) { const float lo = LSE[row * 16 + h]; const float mm = fmaxf(lo, lse), eo = __builtin_amdgcn_exp2f(lo - mm), en = __builtin_amdgcn_exp2f(lse - mm), inv = __builtin_amdgcn_rcpf(eo + en); wn = en * inv * il; wo = eo * inv; lse = mm + __builtin_amdgcn_logf(eo + en); }
        if (hh == 0) LSE[row * 16 + h] = lse;
#pragma unroll
        for (int db = 0; db < 2; ++db)
#pragma unroll
            for (int gq = 0; gq < 4; ++gq) { v2u* op = (v2u*)(OACC + row * D + h * 64 + 32 * db + 8 * gq + 4 * hh);
                v2u x = (v2u){0u, 0u}; if (!first) x = *op;
                v2u y; y.x = cvtpk(wn * O[db][4 * gq + 0] + wo * bflo(x.x), wn * O[db][4 * gq + 1] + wo * bfhi(x.x)); y.y = cvtpk(wn * O[db][4 * gq + 2] + wo * bflo(x.y), wn * O[db][4 * gq + 3] + wo * bfhi(x.y));
                *op = y; }
    }
#undef AT_FETCH_K
#undef AT_FETCH_V
    __syncthreads();
}


struct Args { const float* in[11]; float* out; unsigned char* ws; int ph_lo, ph_hi; };
__global__ void __launch_bounds__(NTHREADS, 2) mk_fwd(Args args) {
    extern __shared__ __attribute__((aligned(16))) unsigned char lds_raw[];
    LAS unsigned char* lds = (LAS unsigned char*)lds_raw;
    volatile LAS unsigned* MISC = (volatile LAS unsigned*)(lds + MISC_OFF);
    const int wave0 = __builtin_amdgcn_readfirstlane(threadIdx.x >> 6);
    for (int u = threadIdx.x; u < (LDS_BYTES - LDSCTL_OFF) / 4; u += NTHREADS) ((LAS unsigned*)(lds + LDSCTL_OFF))[u] = 0u;
    __syncthreads();
    (void)xcd_barrier_post((unsigned*)(args.ws + WS_CTL) + CW_BAR, MISC + 8);
    bool again = false;
    for (int ph = args.ph_lo; ph < args.ph_hi; ++ph) {
        unsigned char* ws = args.ws; asm volatile("" : "+s"(ws));
        int bid = blockIdx.x, G = gridDim.x; asm volatile("" : "+s"(bid), "+s"(G));
        const int gw = bid * NWAVES + wave0, NGW = G * NWAVES;
#define GET_TID() int tid; asm volatile("v_mbcnt_lo_u32_b32 %0, -1, 0\n\tv_mbcnt_hi_u32_b32 %0, -1, %0" : "=v"(tid)); const int lane = tid; tid += wave0 * 64; (void)lane;
        LAS float* scr = (LAS float*)(lds + RING_OFF + wave0 * CV_SCR);
        const float* gains = args.in[1]; float* out = args.out;
        float* RS = (float*)(ws + WS_RS);
        enum { T_P0, T_G1, T_FG, T_THIN, T_APROJ, T_ATT, T_RPROJ, T_RCORE, T_RCOMB };
        int type, L = 0, kind = 0, aux = 0;
        if (ph == 0) type = T_P0;
        else { const int p = ph - 1, q = p % 14; L = p / 14;
            if (q < 3) { kind = 0; type = q == 0 ? T_G1 : (q == 1 ? T_FG : T_THIN); }
            else if (q >= 11) { kind = 2; type = q == 11 ? T_G1 : (q == 12 ? T_FG : T_THIN); }
            else { kind = 1; const int r = q - 3;
                if (r == 6) type = T_FG; else if (r == 7) type = T_THIN;
                else if ((L & 1) == 0) { aux = r >> 1; type = (r & 1) ? T_ATT : T_APROJ; }
                else { aux = r / 3; const int st = r % 3; type = st == 0 ? T_RPROJ : (st == 1 ? T_RCORE : T_RCOMB); } } }
        const bool is_att = (L & 1) == 0; const int jj = L >> 1;
#define P_BIAS ((float*)(ws + WS_BIAS))
#define P_WA   ((bf16*)(ws + WS_W))
#define P_XH   ((bf16*)(ws + WS_XH))
#define P_BIG  ((bf16*)(ws + WS_BIG))
#define P_F    ((bf16*)(ws + WS_F))
#define P_YC   ((bf16*)(ws + WS_YC))
#define P_OACC ((bf16*)(ws + WS_OACC))
#define P_LSE  ((float*)(ws + WS_LSE))
        if (type == T_P0) {
            GET_TID()
            const float* rel_bias = args.in[7];
            if (bid == 0) for (int i = tid; i < 3 * 16 * 129; i += NTHREADS) { const int g = i / (16 * 129), h = (i / 129) % 16, kk = i % 129; P_BIAS[i] = rel_bias[(g * 16 + h) * 32 + T5_BUCKET[g][kk]] * 1.4426950409f; }
            conv_gateup(args.in[2], args.in[3], P_WA, gains, scr, gw, NGW, lane);
            conv_plain<DFF, D>(args.in[4], (bf16*)(ws + WS_W2_FFN), nullptr, scr, gw, NGW, lane);
            p0_rows(args.in[0], P_XH, RS, gw, NGW, lane);
#if PROBE_MFMA
            {
                typedef short bx8 __attribute__((ext_vector_type(8)));
                bx8 a = {1, 2, 3, 4, 5, 6, 7, (short)lane}, b = {3, 1, 4, 1, 5, 9, 2, (short)(lane + 1)};
                f32x4 c0 = {0, 0, 0, 0}, c1 = c0, c2 = c0, c3 = c0, c4 = c0, c5 = c0, c6 = c0, c7 = c0;
                for (int it = 0; it < PROBE_MFMA; ++it) {
#pragma unroll
                    for (int r = 0; r < 4; ++r) {
                        c0 = __builtin_amdgcn_mfma_f32_16x16x32_bf16(a, b, c0, 0, 0, 0); c1 = __builtin_amdgcn_mfma_f32_16x16x32_bf16(a, b, c1, 0, 0, 0); c2 = __builtin_amdgcn_mfma_f32_16x16x32_bf16(a, b, c2, 0, 0, 0); c3 = __builtin_amdgcn_mfma_f32_16x16x32_bf16(a, b, c3, 0, 0, 0);
                        c4 = __builtin_amdgcn_mfma_f32_16x16x32_bf16(a, b, c4, 0, 0, 0); c5 = __builtin_amdgcn_mfma_f32_16x16x32_bf16(a, b, c5, 0, 0, 0); c6 = __builtin_amdgcn_mfma_f32_16x16x32_bf16(a, b, c6, 0, 0, 0); c7 = __builtin_amdgcn_mfma_f32_16x16x32_bf16(a, b, c7, 0, 0, 0); }
                    asm volatile("" : "+v"(a), "+v"(b)); }
                const f32x4 t = c0 + c1 + c2 + c3 + c4 + c5 + c6 + c7;
                if (t.x + t.y + t.z + t.w == 12345.678f) P_BIAS[60000 + tid] = t.x;
            }
#endif
        } else if (type == T_G1) {
            GET_TID()
            pg8::Gemm g{P_XH, P_WA, M, 2 * DFF, D, 0}; pg8::StaticOrder S; S.init(M, 2 * DFF, G, bid);
            pg8::stage_scales(lds + RING_OFF, S, RS, false, 0, tid);
            pg8::EpiSwiGLU E{P_BIG, DFF, (const LAS float*)(lds + RING_OFF + pg8::RS_TAB_OFF)};
            pg8::gemm_phase<pg8::EpiSwiGLU, pg8::StaticOrder, true, true>(lds + RING_OFF, g, S, E, tid);
#if PROBE_G1V >= 0
            { GET_TID() pg8::Gemm g2{P_XH, P_WA, M, 2 * DFF, D, 0}; pg8::StaticOrder S2; S2.init(M, 2 * DFF, G, bid);
              pg8::EpiSwiGLUT<PROBE_G1V> E2{PROBE_G1V ? P_F : P_BIG, PROBE_G1V ? D : DFF, (const LAS float*)(lds + RING_OFF + pg8::RS_TAB_OFF)};
              pg8::gemm_phase<pg8::EpiSwiGLUT<PROBE_G1V>, pg8::StaticOrder, true, true>(lds + RING_OFF, g2, S2, E2, tid); }
#endif
        } else if (type == T_FG) {
            GET_TID()
            const size_t fA = kind != 1 ? WS_BIG : (is_att ? WS_OACC : WS_YC), fB = kind != 1 ? WS_W2_FFN : (is_att ? WS_W2_ATT : WS_W2_RET); const int fK = kind != 1 ? DFF : (is_att ? D : DV);
            pg8::Gemm g{(const bf16*)(ws + fA), (const bf16*)(ws + fB), M, D, fK, 0}; pg8::StaticOrder S; S.init(M, D, G, bid);
            pg8::EpiPlain E{P_F, D, (const LAS float*)nullptr};
            pg8::gemm_phase<pg8::EpiPlain, pg8::StaticOrder, true, true>(lds + RING_OFF, g, S, E, tid);
#if PROBE_FGM
            if (kind != 1) { GET_TID()
                pg8::Gemm g2{(const bf16*)(ws + fA), (const bf16*)(ws + fB), PROBE_FGM, D, fK, 0}; pg8::StaticOrder S2; S2.init(PROBE_FGM, D, G, bid);
                pg8::EpiPlain E2{P_XH, D, (const LAS float*)nullptr};
                pg8::gemm_phase<pg8::EpiPlain, pg8::StaticOrder, true, true>(lds + RING_OFF, g2, S2, E2, tid); }
#endif
        } else if (type == T_THIN) {
            GET_TID()
            const int sub = L * 3 + kind;
            for (int crep = 0; crep < 1 + PROBE_CONV2; ++crep)
            if (sub + 1 < 3 * DEPTH) {
                const int nk = (sub + 1) % 3, nL = (sub + 1) / 3, nj = nL >> 1;
                const float* gn = gains + ((size_t)nL * 6 + (nk == 0 ? 0 : (nk == 1 ? 2 : 4))) * D;
                if (nk != 1) { const size_t o = (size_t)(nL * 2 + (nk >> 1)) * D * DFF;
                    conv_gateup(args.in[2] + o, args.in[3] + o, P_WA, gn, scr, gw, NGW, lane); conv_plain<DFF, D>(args.in[4] + o, (bf16*)(ws + WS_W2_FFN), nullptr, scr, gw, NGW, lane); }
                else if ((nL & 1) == 0) { conv_plain<D, NGRP * ATT_COLS>(args.in[5] + (size_t)nj * D * NGRP * ATT_COLS, P_WA, gn, scr, gw, NGW, lane); conv_plain<D, D>(args.in[6] + (size_t)nj * D * D, (bf16*)(ws + WS_W2_ATT), nullptr, scr, gw, NGW, lane); }
                else { const float* rw = args.in[8] + (size_t)nj * D * RET_COLS;
                    conv_cols<D, RET_COLS, D>(rw, 0, P_WA, 0, gn, scr, gw, NGW, lane); conv_cols<D, RET_COLS, 2 * DV>(rw, 2 * D + DV, P_WA, D, gn, scr, gw, NGW, lane);
                    conv_cols<D, RET_COLS, D>(rw, D, P_WA, D + 2 * DV, gn, scr, gw, NGW, lane); conv_cols<D, RET_COLS, DV>(rw, 2 * D, P_WA, 2 * D + 2 * DV, gn, scr, gw, NGW, lane);
                    conv_plain<DV, D>(args.in[9] + (size_t)nj * DV * D, (bf16*)(ws + WS_W2_RET), nullptr, scr, gw, NGW, lane); }
            }
            asm volatile("" ::: "memory");
            const float* gpost = gains + ((size_t)L * 6 + (kind == 0 ? 1 : (kind == 1 ? 3 : 5))) * D;
            thin_rows(P_F, P_XH, gpost, kind == 1 ? 1.0f : 0.5f, RS, sub + 1 < 3 * DEPTH ? nullptr : out, gw, NGW, lane);
        } else if (type == T_APROJ) {
            GET_TID()
            const int ldil = 2 * aux;
            { pg8::Gemm g{P_XH, P_WA + (size_t)aux * ATT_COLS * D, M, 2 * D, D, 0}; pg8::StaticOrder S; S.init(M, 2 * D, G, bid);
              pg8::stage_scales(lds + RING_OFF, S, RS, false, 0, tid);
              pg8::EpiPlain E{P_BIG, 2 * D, (const LAS float*)(lds + RING_OFF + pg8::RS_TAB_OFF)};
              pg8::gemm_phase<pg8::EpiPlain, pg8::StaticOrder, true, true>(lds + RING_OFF, g, S, E, tid); }
            { GET_TID()
              pg8::Gemm g{P_WA + ((size_t)aux * ATT_COLS + 2 * D) * D, P_XH, D, M, D, ldil}; pg8::StaticOrder S; S.init(D, M, G, bid);
              pg8::stage_scales(lds + RING_OFF, S, RS, true, ldil, tid);
              pg8::EpiVT E{P_BIG + (size_t)M * 2 * D, M, ldil, (const LAS float*)(lds + RING_OFF + pg8::RS_TAB_OFF)};
              pg8::gemm_phase<pg8::EpiVT, pg8::StaticOrder, true, true>(lds + RING_OFF, g, S, E, tid); }
        } else if (type == T_ATT) {
            GET_TID()
            const int ldil = 2 * aux;
            attn_group_mfma2(P_BIG, P_BIG + (size_t)M * 2 * D, P_BIAS + aux * 16 * 129, ldil, aux == 0, P_OACC, P_LSE, lds + RING_OFF, tid, bid, G);
#if PROBE_ATT2
            __syncthreads();
            attn_group_mfma(P_BIG, P_BIG + (size_t)M * 2 * D, P_BIAS + aux * 16 * 129, ldil, 1, P_YC, (float*)P_F, lds + RING_OFF, tid, bid, G);
#endif
        } else if (type == T_RPROJ) {
            GET_TID()
            { pg8::Gemm g{P_XH + (size_t)aux * MH * D, P_WA, MH, RP_COLS, D, 0}; pg8::StaticOrder S; S.init(MH, RP_COLS, G, bid);
              pg8::stage_scales(lds + RING_OFF, S, RS + (size_t)aux * MH, false, 0, tid);
              pg8::EpiRet E{P_BIG, RP_COLS, (const LAS float*)(lds + RING_OFF + pg8::RS_TAB_OFF)};
              pg8::gemm_phase<pg8::EpiRet, pg8::StaticOrder, true, true>(lds + RING_OFF, g, S, E, tid); }
            { GET_TID()
              pg8::Gemm g{P_WA + (size_t)RP_COLS * D, P_XH + (size_t)aux * MH * D, DV, MH, D, 0}; pg8::StaticOrder S; S.init(DV, MH, G, bid);
              pg8::stage_scales(lds + RING_OFF, S, RS + (size_t)aux * MH, true, 0, tid);
              pg8::EpiVT E{(bf16*)(ws + WS_RVT), MH, 0, (const LAS float*)(lds + RING_OFF + pg8::RS_TAB_OFF)};
              pg8::gemm_phase<pg8::EpiVT, pg8::StaticOrder, true, true>(lds + RING_OFF, g, S, E, tid); }
        } else if (type == T_RCORE) {
            GET_TID()
            static_assert(RC_LDS <= RING_BYTES, "retention core LDS tiles");
            ret_core_mfma<0>(P_BIG, (const bf16*)(ws + WS_RVT), args.in[10] + jj * 2 * HR, P_YC + (size_t)aux * MH * DV, (bf16*)out, lds + RING_OFF, tid, bid, G);
#if PROBE_RC >= 0
            { GET_TID() ret_core_mfma<PROBE_RC>(P_BIG, (const bf16*)(ws + WS_RVT), args.in[10] + jj * 2 * HR, (bf16*)out + (size_t)MH * DV, (bf16*)out + (size_t)MH * DV, lds + RING_OFF, tid, bid, G); }
#endif
        } else {
            GET_TID()
            ret_combine(P_BIG, P_YC + (size_t)aux * MH * DV, (const bf16*)out, gw, NGW, lane);
        }
        if (ph + 1 < args.ph_hi) { XcdBarrier b_; b_.bar = (unsigned*)(ws + WS_CTL) + CW_BAR; b_.x = xb_xcc_id(); b_.st = MISC + 8; xcd_barrier(b_);
#if PROBE_BAR2
            xcd_barrier(b_);
#endif
        }
        if (PROBE_REPEAT) {
            if (!again && ((PROBE_REPEAT >> type) & 1) && (type != T_ATT || aux == 0) && ph + 1 < args.ph_hi) { again = true; --ph; } else again = false; }
    }
}

extern "C" void kernel_launch(void* const* d_in, const int* in_sizes, int n_in, void* d_out, int out_size, void* d_ws, size_t ws_size, hipStream_t stream) {
    static int grid = 0;
    if (grid == 0) {
        if (n_in != 11 || in_sizes[0] != M * D || out_size != M * D || ws_size < WS_END) { fprintf(stderr, "kernel_launch: unexpected shapes / workspace (n_in %d, ws %zu, need %zu); nothing launched\n", n_in, ws_size, (size_t)WS_END); grid = -1; return; }
        int dev = 0, cus = 0, per_cu = 0;
        if (hipGetDevice(&dev) != hipSuccess || hipDeviceGetAttribute(&cus, hipDeviceAttributeMultiprocessorCount, dev) != hipSuccess) { grid = -1; return; }
        if (hipFuncSetAttribute((const void*)mk_fwd, hipFuncAttributeMaxDynamicSharedMemorySize, LDS_BYTES) != hipSuccess) { fprintf(stderr, "kernel_launch: hipFuncSetAttribute failed\n"); grid = -1; return; }
        if (hipOccupancyMaxActiveBlocksPerMultiprocessor(&per_cu, (const void*)mk_fwd, NTHREADS, LDS_BYTES) != hipSuccess || per_cu < 1) { fprintf(stderr, "kernel_launch: occupancy query reports %d workgroups per CU\n", per_cu); }
        (void)hipGetLastError();
        grid = cus;
    }
    if (grid < 0) return;
    if (hipMemsetAsync((char*)d_ws + WS_CTL, 0, CTL_ZERO_BYTES, stream) != hipSuccess) return;
    Args a{};
    for (int i = 0; i < 11; ++i) a.in[i] = (const float*)d_in[i];
    a.out = (float*)d_out; a.ws = (unsigned char*)d_ws;
#if MK_ONE_LAUNCH
    a.ph_lo = 0; a.ph_hi = NPHASES;
    hipLaunchKernelGGL(mk_fwd, dim3(grid), dim3(NTHREADS), LDS_BYTES, stream, a);
#else
    for (int p = 0; p < NPHASES; ++p) { a.ph_lo = p; a.ph_hi = p + 1; hipLaunchKernelGGL(mk_fwd, dim3(grid), dim3(NTHREADS), LDS_BYTES, stream, a); }
#endif
}
```

```cpp
#include <hip/hip_runtime.h>
#include <cstdio>
#include <cstdint>
#ifndef PROBE_REPEAT
#define PROBE_REPEAT 0
#endif
#ifndef PROBE_THIN2
#define PROBE_THIN2 0
#endif
#ifndef PROBE_ATT2
#define PROBE_ATT2 0
#endif
#ifndef PROBE_CONV2
#define PROBE_CONV2 0
#endif
#ifndef PROBE_FGM
#define PROBE_FGM 0
#endif
#ifndef PROBE_RC
#define PROBE_RC -1
#endif
#ifndef PROBE_G1V
#define PROBE_G1V -1
#endif
#ifndef PROBE_BAR2
#define PROBE_BAR2 0
#endif
#ifndef PROBE_MFMA
#define PROBE_MFMA 0
#endif
#ifndef MK_ONE_LAUNCH
#define MK_ONE_LAUNCH 1
#endif
namespace pg8 {
#define PG8_LAS __attribute__((address_space(3)))
typedef unsigned short bf16_t;
typedef short bf16x8 __attribute__((ext_vector_type(8)));
typedef float f32x4 __attribute__((ext_vector_type(4)));
typedef unsigned u32x4 __attribute__((ext_vector_type(4)));
constexpr int BM = 256, BK = 64, HALF = 128, HTB = HALF * BK * 2  , STAGE_BYTES = 8 * HTB, NXCD = 8, WGM = 8;

__host__ __device__ __forceinline__ int lds_byte(int r, int c) { const int st = (r >> 4) * 2 + (c >> 5), rr = r & 15, cc = c & 31, ob = rr * 64 + cc * 2; return st * 1024 + (ob ^ (((ob >> 9) & 1) << 5)); }
__host__ __device__ __forceinline__ void stage_rc(int b, int& R, int& C) { const int st = b / 1024, sb = b % 1024, swz = sb ^ (((sb >> 9) & 1) << 5); R = (st >> 1) * 16 + swz / 64; C = (st & 1) * 32 + (swz % 64) / 2; }
__host__ __device__ __forceinline__ int perm32(int rho) { const int n = rho >> 4, i = rho & 15; return 8 * (i >> 2) + 4 * n + (i & 3); }

struct Unit { int pm, pn, idx; };
struct Gemm { const bf16_t* A; const bf16_t* Bt; int M, N, K; int ldil; };

struct StaticOrder {
    int nM, nN, nwg, G, c;
    __host__ __device__ void init(int M, int N, int G_, int c_) { nM = M / BM; nN = N / BM; nwg = nM * nN; G = G_; c = c_; }
    __host__ __device__ bool next(int i, Unit& u) const {
        const long L = (long)i * G + c; if (L >= nwg) return false;
        int wgid = (int)L; { const int q = nwg / NXCD, r = nwg % NXCD, xcd = wgid % NXCD, off = wgid / NXCD; wgid = (xcd < r ? xcd * (q + 1) : r * (q + 1) + (xcd - r) * q) + off; }
        const int nig = WGM * nN, gid = wgid / nig, fm = gid * WGM, gsz = (nM - fm) < WGM ? (nM - fm) : WGM;
        u.pm = fm + ((wgid % nig) % gsz); u.pn = (wgid % nig) / gsz; u.idx = i; return true;
    }
    __device__ __forceinline__ void a_ready(const Unit&) const {}
    __device__ __forceinline__ void done(const Unit&) const {}
};

__device__ __forceinline__ unsigned cvt_pk_bf16(float lo, float hi) { unsigned r; asm volatile("v_cvt_pk_bf16_f32 %0, %1, %2" : "=v"(r) : "v"(lo), "v"(hi)); return r; }
typedef float f32x2 __attribute__((ext_vector_type(2)));

__device__ __forceinline__ float fast_sigmoid(float g) { return __builtin_amdgcn_rcpf(1.0f + __builtin_amdgcn_exp2f(-1.4426950409f * g)); }
constexpr int RS_TAB_OFF = 131072;
template <class Sched> __device__ __forceinline__ void stage_scales(PG8_LAS unsigned char* lds, const Sched& S, const float* rs, bool cols, int ldil, int tid) {
    PG8_LAS float* tab = (PG8_LAS float*)(lds + RS_TAB_OFF); Unit u;
    if (tid < 256) { const int lper = 8 - ldil, c = tid, tm = ((c & ((1 << lper) - 1)) << ldil) + (c >> lper);
        for (int i = 0; i < 16 && S.next(i, u); ++i) tab[i * 256 + tid] = rs[cols ? u.pn * BM + tm : u.pm * BM + tid]; }
    __syncthreads();
}
struct EpiPlain {
    static constexpr bool PERM = true, AFTER_DRAIN = false;
    bf16_t* O; int ldc; const PG8_LAS float* tab;
    __device__ __forceinline__ void operator()(const f32x4 (&acc)[2][2][4][2], const Unit& u, int wr, int wc, int fr, int fq) const {
        const int row0 = u.pm * BM + wr * 64 + fr, col0 = u.pn * BM + wc * 32 + 8 * fq;
#pragma unroll
        for (int ai = 0; ai < 2; ++ai)
#pragma unroll
            for (int m = 0; m < 4; ++m) { const int row = row0 + ai * HALF + m * 16; bf16_t* rowp = O + (size_t)row * ldc + col0; const float r = tab ? tab[u.idx * 256 + (row & 255)] : 1.0f;
#pragma unroll
                for (int bj = 0; bj < 2; ++bj) { const f32x4 v0 = acc[ai][bj][m][0] * r, v1 = acc[ai][bj][m][1] * r;
                    u32x4 w; w.x = cvt_pk_bf16(v0[0], v0[1]); w.y = cvt_pk_bf16(v0[2], v0[3]); w.z = cvt_pk_bf16(v1[0], v1[1]); w.w = cvt_pk_bf16(v1[2], v1[3]);
                    *(u32x4*)(rowp + bj * HALF) = w; } }
    }
};
template <int CHEAP = 0  > struct EpiSwiGLUT {
    static constexpr bool PERM = true, AFTER_DRAIN = false;
    bf16_t* O; int ldc; const PG8_LAS float* tab;
    __device__ __forceinline__ void operator()(const f32x4 (&acc)[2][2][4][2], const Unit& u, int wr, int wc, int fr, int fq) const {
        const int row0 = u.pm * BM + wr * 64 + fr, col0 = CHEAP ? ((u.pn * HALF + wc * 32 + 8 * fq) & 1023) : (u.pn * HALF + wc * 32 + 8 * fq);
#pragma unroll
        for (int ai = 0; ai < 2; ++ai)
#pragma unroll
            for (int m = 0; m < 4; ++m) { const int row = row0 + ai * HALF + m * 16; bf16_t* rowp = O + (size_t)row * ldc + col0; const float r = tab[u.idx * 256 + (row & 255)];
                float o[8];
#pragma unroll
                for (int n = 0; n < 2; ++n)
#pragma unroll
                    for (int e = 0; e < 4; ++e) { const float g = acc[ai][0][m][n][e] * r, up = acc[ai][1][m][n][e] * r; o[n * 4 + e] = CHEAP ? g * up : g * fast_sigmoid(g) * up; }
                u32x4 w; w.x = cvt_pk_bf16(o[0], o[1]); w.y = cvt_pk_bf16(o[2], o[3]); w.z = cvt_pk_bf16(o[4], o[5]); w.w = cvt_pk_bf16(o[6], o[7]);
                if (CHEAP == 2) { if (w.x == 0x12345678u && w.y == w.z) *(u32x4*)rowp = w; } else *(u32x4*)rowp = w; }
    }
};
typedef EpiSwiGLUT<0> EpiSwiGLU;
struct EpiRet {
    static constexpr bool PERM = true, AFTER_DRAIN = false;
    bf16_t* O; int ldc; const PG8_LAS float* tab;
    __device__ __forceinline__ void operator()(const f32x4 (&acc)[2][2][4][2], const Unit& u, int wr, int wc, int fr, int fq) const {
        const int row0 = u.pm * BM + wr * 64 + fr, col0 = u.pn * BM + wc * 32 + 8 * fq;
        if (u.pn < 4 || u.pn >= 20) {
            const float osc = (u.pn >= 4) ? 0.0625f : 1.0f;
            float invf[8];
#pragma unroll
            for (int q = 0; q < 8; ++q) { const int j = wc * 32 + 8 * fq + q; invf[q] = __builtin_amdgcn_exp2f(-(float)j * (13.287712379549449f / 127.0f)) * 0.15915494309189535f; }
#pragma unroll
            for (int ai = 0; ai < 2; ++ai)
#pragma unroll
                for (int m = 0; m < 4; ++m) { const int row = row0 + ai * HALF + m * 16; const float pos = (float)(row & 2047), r = tab[u.idx * 256 + (row & 255)] * osc;
                    bf16_t* rowp = O + (size_t)row * ldc + col0;
                    float o1[8], o2[8];
#pragma unroll
                    for (int n = 0; n < 2; ++n)
#pragma unroll
                        for (int e = 0; e < 4; ++e) { const int q = n * 4 + e; float t = pos * invf[q]; t = __builtin_amdgcn_fractf(t);
                            const float sn = __builtin_amdgcn_sinf(t), cs = __builtin_amdgcn_cosf(t);
                            const float a = acc[ai][0][m][n][e], b = acc[ai][1][m][n][e];
                            o1[q] = (a * cs - b * sn) * r; o2[q] = (a * sn + b * cs) * r; }
                    u32x4 w; w.x = cvt_pk_bf16(o1[0], o1[1]); w.y = cvt_pk_bf16(o1[2], o1[3]); w.z = cvt_pk_bf16(o1[4], o1[5]); w.w = cvt_pk_bf16(o1[6], o1[7]);
                    *(u32x4*)rowp = w;
                    w.x = cvt_pk_bf16(o2[0], o2[1]); w.y = cvt_pk_bf16(o2[2], o2[3]); w.z = cvt_pk_bf16(o2[4], o2[5]); w.w = cvt_pk_bf16(o2[6], o2[7]);
                    *(u32x4*)(rowp + HALF) = w; }
        } else {
#pragma unroll
            for (int ai = 0; ai < 2; ++ai)
#pragma unroll
                for (int m = 0; m < 4; ++m) { const int row = row0 + ai * HALF + m * 16; bf16_t* rowp = O + (size_t)row * ldc + col0; const float r = tab[u.idx * 256 + (row & 255)];
#pragma unroll
                    for (int bj = 0; bj < 2; ++bj) { const f32x4 v0 = acc[ai][bj][m][0] * r, v1 = acc[ai][bj][m][1] * r;
                        u32x4 w; w.x = cvt_pk_bf16(v0[0], v0[1]); w.y = cvt_pk_bf16(v0[2], v0[3]); w.z = cvt_pk_bf16(v1[0], v1[1]); w.w = cvt_pk_bf16(v1[2], v1[3]);
                        *(u32x4*)(rowp + bj * HALF) = w; } }
        }
    }
};

struct EpiVT {
    static constexpr bool PERM = true, AFTER_DRAIN = false;
    bf16_t* O; int ldc; int ldil; const PG8_LAS float* tab;
    __device__ __forceinline__ void operator()(const f32x4 (&acc)[2][2][4][2], const Unit& u, int wr, int wc, int fr, int fq) const {
        const int lper = 8 - ldil, per = 1 << lper, Ls = 2048 >> ldil, b = u.pn >> 3, pl = u.pn & 7;
        const int row0 = u.pm * BM + wr * 64 + fr;
        int colb[2]; float cs[2][8];
#pragma unroll
        for (int bj = 0; bj < 2; ++bj) { const int c0 = bj * HALF + wc * 32 + 8 * fq; colb[bj] = b * 2048 + (c0 >> lper) * Ls + pl * per + (c0 & (per - 1));
            const f32x4 a = *(const PG8_LAS f32x4*)(tab + u.idx * 256 + c0), b4 = *(const PG8_LAS f32x4*)(tab + u.idx * 256 + c0 + 4);
            cs[bj][0] = a[0]; cs[bj][1] = a[1]; cs[bj][2] = a[2]; cs[bj][3] = a[3]; cs[bj][4] = b4[0]; cs[bj][5] = b4[1]; cs[bj][6] = b4[2]; cs[bj][7] = b4[3]; }
#pragma unroll
        for (int ai = 0; ai < 2; ++ai)
#pragma unroll
            for (int m = 0; m < 4; ++m) { bf16_t* rowp = O + (size_t)(row0 + ai * HALF + m * 16) * ldc;
#pragma unroll
                for (int bj = 0; bj < 2; ++bj) { const f32x4 v0 = acc[ai][bj][m][0], v1 = acc[ai][bj][m][1];
                    u32x4 w; w.x = cvt_pk_bf16(v0[0] * cs[bj][0], v0[1] * cs[bj][1]); w.y = cvt_pk_bf16(v0[2] * cs[bj][2], v0[3] * cs[bj][3]); w.z = cvt_pk_bf16(v1[0] * cs[bj][4], v1[1] * cs[bj][5]); w.w = cvt_pk_bf16(v1[2] * cs[bj][6], v1[3] * cs[bj][7]);
                    *(u32x4*)(rowp + colb[bj]) = w; } }
    }
};

struct EpiKVT {
    static constexpr bool PERM = true, AFTER_DRAIN = false;
    bf16_t* OK; bf16_t* OV; int ldc; const PG8_LAS float* tab;
    __device__ __forceinline__ void operator()(const f32x4 (&acc)[2][2][4][2], const Unit& u, int wr, int wc, int fr, int fq) const {
        const int col0 = u.pn * BM + wc * 32 + 8 * fq;
        float cs[2][8];
#pragma unroll
        for (int bj = 0; bj < 2; ++bj) { const int cl = bj * HALF + wc * 32 + 8 * fq; const f32x4 a = *(const PG8_LAS f32x4*)(tab + u.idx * 256 + cl), b = *(const PG8_LAS f32x4*)(tab + u.idx * 256 + cl + 4);
            cs[bj][0] = a[0]; cs[bj][1] = a[1]; cs[bj][2] = a[2]; cs[bj][3] = a[3]; cs[bj][4] = b[0]; cs[bj][5] = b[1]; cs[bj][6] = b[2]; cs[bj][7] = b[3]; }
        if (u.pm < 4) {
#pragma unroll
            for (int m = 0; m < 4; ++m) { const int j = wr * 64 + m * 16 + fr;
                const float invf = __builtin_amdgcn_exp2f(-(float)j * (13.287712379549449f / 127.0f)) * 0.15915494309189535f;
                bf16_t* r1 = OK + (size_t)(u.pm * BM + j) * ldc + col0; bf16_t* r2 = r1 + (size_t)HALF * ldc;
#pragma unroll
                for (int bj = 0; bj < 2; ++bj) { float o1[8], o2[8];
#pragma unroll
                    for (int n = 0; n < 2; ++n)
#pragma unroll
                        for (int e = 0; e < 4; ++e) { const int q = n * 4 + e; const float pos = (float)((col0 + bj * HALF + q) & 2047); float t = pos * invf; t = __builtin_amdgcn_fractf(t);
                            const float sn = __builtin_amdgcn_sinf(t), cn = __builtin_amdgcn_cosf(t), sc = cs[bj][q] * 0.0625f;
                            const float a = acc[0][bj][m][n][e], b = acc[1][bj][m][n][e];
                            o1[q] = (a * cn - b * sn) * sc; o2[q] = (a * sn + b * cn) * sc; }
                    u32x4 w; w.x = cvt_pk_bf16(o1[0], o1[1]); w.y = cvt_pk_bf16(o1[2], o1[3]); w.z = cvt_pk_bf16(o1[4], o1[5]); w.w = cvt_pk_bf16(o1[6], o1[7]);
                    *(u32x4*)(r1 + bj * HALF) = w;
                    w.x = cvt_pk_bf16(o2[0], o2[1]); w.y = cvt_pk_bf16(o2[2], o2[3]); w.z = cvt_pk_bf16(o2[4], o2[5]); w.w = cvt_pk_bf16(o2[6], o2[7]);
                    *(u32x4*)(r2 + bj * HALF) = w; } }
        } else {
            const int row0 = (u.pm - 4) * BM + wr * 64 + fr;
#pragma unroll
            for (int ai = 0; ai < 2; ++ai)
#pragma unroll
                for (int m = 0; m < 4; ++m) { bf16_t* rowp = OV + (size_t)(row0 + ai * HALF + m * 16) * ldc + col0;
#pragma unroll
                    for (int bj = 0; bj < 2; ++bj) { const f32x4 v0 = acc[ai][bj][m][0], v1 = acc[ai][bj][m][1];
                        u32x4 w; w.x = cvt_pk_bf16(v0[0] * cs[bj][0], v0[1] * cs[bj][1]); w.y = cvt_pk_bf16(v0[2] * cs[bj][2], v0[3] * cs[bj][3]); w.z = cvt_pk_bf16(v1[0] * cs[bj][4], v1[1] * cs[bj][5]); w.w = cvt_pk_bf16(v1[2] * cs[bj][6], v1[3] * cs[bj][7]);
                        *(u32x4*)(rowp + bj * HALF) = w; } }
        }
    }
};

template <class Epi, class Sched, bool ALIGN_EPI = false, bool SP2 = false>
__device__ __forceinline__ void gemm_phase(PG8_LAS unsigned char* lds, const Gemm g, const Sched& S, const Epi& E, const int tid) {
    const int wid = __builtin_amdgcn_readfirstlane(tid >> 6), lane = tid & 63, wr = wid >> 2, wc = wid & 3, fr = lane & 15, fq = lane >> 4;
    const int K = g.K, nt = K / BK;
    unsigned voffA[2], voffB[2], voffB1[2];
#pragma unroll
    for (int i = 0; i < 2; ++i) { int R, C; stage_rc(tid * 16 + i * 8192, R, C); const int Rb = Epi::PERM ? ((R & ~31) + perm32(R & 31)) : R;
        voffA[i] = (unsigned)(R * K + C) * 2u; { const int ld = g.ldil, lper = 8 - ld, pm1 = (1 << lper) - 1; const int c0 = Rb, c1 = 128 + Rb; voffB[i] = (unsigned)((((c0 & pm1) << ld) + (c0 >> lper)) * K + C) * 2u; voffB1[i] = (unsigned)((((c1 & pm1) << ld) + (c1 >> lper)) * K + C) * 2u; } }
    const size_t kstep = (size_t)(BK * 2);
    const size_t hstep = (size_t)HALF * K * 2;
    const size_t tstep = 2 * hstep;
    const unsigned ldsw = (unsigned)wid * 1024u;
    const int aoff = lds_byte(wr * 64 + fr, fq * 8), boff = lds_byte(wc * 32 + fr, fq * 8);
#define PG8_SA(b, h) (((b) * 2 + (h)) * HTB)
#define PG8_SB(b, h) ((4 + (b) * 2 + (h)) * HTB)
#define PG8_STAGE(bufoff, gbase, voff) do { _Pragma("unroll") for (int _i = 0; _i < 2; ++_i) \
        __builtin_amdgcn_global_load_lds((const unsigned*)((const char*)(gbase) + (voff)[_i]), (PG8_LAS unsigned*)(lds + (bufoff) + ldsw + _i * 8192), 16, 0, 0); } while (0)
#define PG8_LDA(dst, b, h) do { _Pragma("unroll") for (int m = 0; m < 4; ++m) _Pragma("unroll") for (int k = 0; k < 2; ++k) dst[m][k] = *(const PG8_LAS bf16x8*)(lds + PG8_SA(b, h) + aoff + m * 2048 + k * 1024); } while (0)
#define PG8_LDB(dst, b, h) do { _Pragma("unroll") for (int n = 0; n < 2; ++n) _Pragma("unroll") for (int k = 0; k < 2; ++k) dst[n][k] = *(const PG8_LAS bf16x8*)(lds + PG8_SB(b, h) + boff + n * 2048 + k * 1024); } while (0)
#define PG8_MMA(ai, bj, At, Bt) do { __builtin_amdgcn_s_setprio(1); _Pragma("unroll") for (int m = 0; m < 4; ++m) _Pragma("unroll") for (int n = 0; n < 2; ++n) _Pragma("unroll") for (int k = 0; k < 2; ++k) \
        acc[ai][bj][m][n] = __builtin_amdgcn_mfma_f32_16x16x32_bf16(Bt[n][k], At[m][k], acc[ai][bj][m][n], 0, 0, 0); __builtin_amdgcn_s_setprio(0); } while (0)
#define PG8_WAIT_V(n) asm volatile("s_waitcnt vmcnt(" #n ")" ::: "memory")
#define PG8_WAIT_L(n) asm volatile("s_waitcnt lgkmcnt(" #n ")" ::: "memory")
#define PG8_BAR __builtin_amdgcn_s_barrier()
#define PG8_SCHED __builtin_amdgcn_sched_barrier(0)
    Unit cur, nxt; int ui = 0;
    if (!S.next(0, cur)) return;
    f32x4 acc[2][2][4][2];
#pragma unroll
    for (int a = 0; a < 2; ++a)
#pragma unroll
        for (int b = 0; b < 2; ++b)
#pragma unroll
            for (int m = 0; m < 4; ++m)
#pragma unroll
                for (int n = 0; n < 2; ++n) acc[a][b][m][n] = (f32x4){0.f, 0.f, 0.f, 0.f};
    bf16x8 At[4][2], B0[2][2], B1[2][2];
    const char* cA = (const char*)g.A + (size_t)cur.pm * tstep; const char* cB = (const char*)g.Bt + (size_t)cur.pn * tstep;
    S.a_ready(cur);
    if constexpr (SP2) {
        PG8_STAGE(PG8_SB(0, 0), cB, voffB); PG8_STAGE(PG8_SB(0, 1), cB, voffB1); PG8_STAGE(PG8_SA(0, 0), cA, voffA); PG8_STAGE(PG8_SA(0, 1), cA + hstep, voffA);
        if (wr == 1) PG8_BAR;
        PG8_WAIT_V(2); PG8_BAR;
        PG8_STAGE(PG8_SB(1, 0), cB + kstep, voffB); PG8_STAGE(PG8_SA(1, 0), cA + kstep, voffA); PG8_STAGE(PG8_SB(1, 1), cB + kstep, voffB1);
        PG8_WAIT_V(6); PG8_BAR;
    } else {
        PG8_STAGE(PG8_SB(0, 0), cB, voffB); PG8_STAGE(PG8_SA(0, 0), cA, voffA); PG8_STAGE(PG8_SB(0, 1), cB, voffB1); PG8_STAGE(PG8_SA(0, 1), cA + hstep, voffA);
        if (wr == 1) PG8_BAR;
        PG8_WAIT_V(4); PG8_BAR;
        PG8_STAGE(PG8_SB(1, 0), cB + kstep, voffB); PG8_STAGE(PG8_SA(1, 0), cA + kstep, voffA); PG8_STAGE(PG8_SB(1, 1), cB + kstep, voffB1);
        PG8_WAIT_V(6); PG8_BAR;
    }
    for (;;) {
        const bool has_next = S.next(ui + 1, nxt);
        const char* nA = has_next ? (const char*)g.A + (size_t)nxt.pm * tstep : cA; const char* nB = has_next ? (const char*)g.Bt + (size_t)nxt.pn * tstep : cB;
        for (int t = 0; t < nt; t += 2) {
            const bool last = (t == nt - 2);
            const char* a1 = cA + (size_t)(t + 1) * kstep;
            const char* a2 = last ? nA : cA + (size_t)(t + 2) * kstep; const char* b2 = last ? nB : cB + (size_t)(t + 2) * kstep;
            const char* a3 = a2 + kstep; const char* b3 = b2 + kstep;
            if (last && has_next) S.a_ready(nxt);
            if constexpr (SP2) {
            PG8_LDB(B0, 0, 0); PG8_LDB(B1, 0, 1); PG8_SCHED; PG8_LDA(At, 0, 0); PG8_STAGE(PG8_SA(1, 1), a1 + hstep, voffA);
            PG8_WAIT_V(8); PG8_WAIT_L(0); PG8_BAR; PG8_MMA(0, 0, At, B0); PG8_MMA(0, 1, At, B1); PG8_BAR; PG8_SCHED;
            PG8_LDA(At, 0, 1); PG8_STAGE(PG8_SB(0, 0), b2, voffB); PG8_STAGE(PG8_SB(0, 1), b2, voffB1); PG8_STAGE(PG8_SA(0, 0), a2, voffA);
            PG8_WAIT_V(8); PG8_WAIT_L(0); PG8_BAR; PG8_MMA(1, 0, At, B0); PG8_MMA(1, 1, At, B1); PG8_BAR; PG8_SCHED;
            PG8_LDB(B0, 1, 0); PG8_LDB(B1, 1, 1); PG8_SCHED; PG8_LDA(At, 1, 0); PG8_STAGE(PG8_SA(0, 1), a2 + hstep, voffA);
            PG8_WAIT_V(8); PG8_WAIT_L(0); PG8_BAR; PG8_MMA(0, 0, At, B0); PG8_MMA(0, 1, At, B1); PG8_BAR; PG8_SCHED;
            PG8_LDA(At, 1, 1); PG8_STAGE(PG8_SB(1, 0), b3, voffB); PG8_STAGE(PG8_SB(1, 1), b3, voffB1); PG8_STAGE(PG8_SA(1, 0), a3, voffA);
            PG8_WAIT_V(8); PG8_WAIT_L(0); PG8_BAR; PG8_MMA(1, 0, At, B0); PG8_MMA(1, 1, At, B1); PG8_BAR; PG8_SCHED;
            } else {
            PG8_LDB(B0, 0, 0); PG8_SCHED; PG8_LDA(At, 0, 0); PG8_STAGE(PG8_SA(1, 1), a1 + hstep, voffA);
            PG8_WAIT_L(8); PG8_BAR; PG8_WAIT_L(0); PG8_MMA(0, 0, At, B0); PG8_BAR; PG8_SCHED;
            PG8_LDB(B1, 0, 1); PG8_STAGE(PG8_SB(0, 0), b2, voffB);
            PG8_BAR; PG8_WAIT_L(0); PG8_MMA(0, 1, At, B1); PG8_BAR;
            PG8_LDA(At, 0, 1); PG8_STAGE(PG8_SA(0, 0), a2, voffA);
            PG8_BAR; PG8_WAIT_L(0); PG8_MMA(1, 0, At, B0); PG8_BAR; PG8_SCHED;
            PG8_STAGE(PG8_SB(0, 1), b2, voffB1);
            PG8_WAIT_V(6); PG8_BAR; PG8_MMA(1, 1, At, B1); PG8_BAR;
            PG8_LDB(B0, 1, 0); PG8_SCHED; PG8_LDA(At, 1, 0); PG8_STAGE(PG8_SA(0, 1), a2 + hstep, voffA);
            PG8_WAIT_L(8); PG8_BAR; PG8_WAIT_L(0); PG8_MMA(0, 0, At, B0); PG8_BAR; PG8_SCHED;
            PG8_LDB(B1, 1, 1); PG8_STAGE(PG8_SB(1, 0), b3, voffB);
            PG8_BAR; PG8_WAIT_L(0); PG8_MMA(0, 1, At, B1); PG8_BAR;
            PG8_LDA(At, 1, 1); PG8_STAGE(PG8_SA(1, 0), a3, voffA);
            PG8_BAR; PG8_WAIT_L(0); PG8_MMA(1, 0, At, B0); PG8_BAR; PG8_SCHED;
            PG8_STAGE(PG8_SB(1, 1), b3, voffB1);
            PG8_WAIT_V(6); PG8_BAR; PG8_MMA(1, 1, At, B1); PG8_BAR;
            }
        }
        if constexpr (ALIGN_EPI) { if (wr == 0) PG8_BAR; }
        if constexpr (!Epi::AFTER_DRAIN) { E(acc, cur, wr, wc, fr, fq); S.done(cur); }
        if (!has_next) break;
#pragma unroll
        for (int a = 0; a < 2; ++a)
#pragma unroll
            for (int b = 0; b < 2; ++b)
#pragma unroll
                for (int m = 0; m < 4; ++m)
#pragma unroll
                    for (int n = 0; n < 2; ++n) acc[a][b][m][n] = (f32x4){0.f, 0.f, 0.f, 0.f};
        cur = nxt; cA = nA; cB = nB; ++ui;
        if constexpr (ALIGN_EPI) { if (wr == 1) PG8_BAR; }
    }
    PG8_WAIT_V(0);
    if constexpr (!ALIGN_EPI) { if (wr == 0) PG8_BAR; }
    PG8_BAR;
    if constexpr (Epi::AFTER_DRAIN) { E.fused(acc, cur, wr, wc, fr, fq, lds, wid, lane); S.done(cur); }
#undef PG8_SA
#undef PG8_SB
#undef PG8_STAGE
#undef PG8_LDA
#undef PG8_LDB
#undef PG8_MMA
#undef PG8_WAIT_V
#undef PG8_WAIT_L
#undef PG8_BAR
#undef PG8_SCHED
}
}

constexpr int BATCH = 16, SEQ = 2048, D = 1024, M = BATCH * SEQ, DEPTH = 4, DFF = 2816;
constexpr int NGRP = 3, HA = 16, DHA = 64, ATT_COLS = 3 * D;
constexpr int HR = 4, DKR = 256, DVR = 512, DV = HR * DVR, RET_COLS = 2 * D + 3 * DV;
constexpr int MH = M / 2;
constexpr float NORM_EPS = 1e-6f;
constexpr int NWAVES = 8, NTHREADS = NWAVES * 64;
constexpr int NPHASES = 1 + DEPTH * 14;

__device__ const unsigned char T5_BUCKET[3][129] = {
{11,11,11,11,11,11,11,11,11,11,11,11,11,11,11,10,10,10,10,10,10,10,10,10,10,10,10,10,10,10,10,10,10,10,10,10,10,10,9,9,9,9,9,9,9,9,9,9,9,9,8,8,8,8,8,8,8,7,6,5,4,3,2,1,0,17,18,19,20,21,22,23,24,24,24,24,24,24,24,25,25,25,25,25,25,25,25,25,25,25,25,26,26,26,26,26,26,26,26,26,26,26,26,26,26,26,26,26,26,26,26,26,26,26,27,27,27,27,27,27,27,27,27,27,27,27,27,27,27},
{13,13,13,13,13,13,13,13,13,13,13,13,13,13,13,13,13,13,13,13,13,13,13,12,12,12,12,12,12,12,12,12,12,12,12,12,12,12,12,12,12,12,11,11,11,11,11,11,11,11,11,11,10,10,10,10,10,10,9,9,9,8,8,4,0,20,24,24,25,25,25,26,26,26,26,26,26,27,27,27,27,27,27,27,27,27,27,28,28,28,28,28,28,28,28,28,28,28,28,28,28,28,28,28,28,28,29,29,29,29,29,29,29,29,29,29,29,29,29,29,29,29,29,29,29,29,29,29,29},
{15,15,15,15,15,15,15,15,15,15,15,15,15,15,15,15,15,15,15,15,15,15,15,15,15,15,15,15,15,15,14,14,14,14,14,14,14,14,14,14,14,14,14,14,14,13,13,13,13,13,13,13,13,13,12,12,12,12,12,11,11,10,10,9,0,25,26,26,27,27,28,28,28,28,28,29,29,29,29,29,29,29,29,29,30,30,30,30,30,30,30,30,30,30,30,30,30,30,30,31,31,31,31,31,31,31,31,31,31,31,31,31,31,31,31,31,31,31,31,31,31,31,31,31,31,31,31,31,31}};

constexpr size_t MiB = 1u << 20;
constexpr size_t WS_CTL = 0, CTL_ZERO_BYTES = 1 * MiB;
constexpr size_t WS_BIAS = 1 * MiB;
constexpr size_t WS_RS = WS_BIAS + 256 * 1024;
constexpr size_t WS_W = 2 * MiB;
constexpr size_t WS_W2_FFN = WS_W + (size_t)2 * DFF * D * 2;
constexpr size_t WS_W2_ATT = WS_W + (size_t)NGRP * ATT_COLS * D * 2;
constexpr size_t WS_W2_RET = WS_W + (size_t)RET_COLS * D * 2;
constexpr size_t WS_XH = 26 * MiB;
constexpr size_t WS_YC = 90 * MiB;
constexpr size_t WS_BIG = 218 * MiB;
constexpr size_t WS_F = 410 * MiB;
constexpr size_t WS_RVT = 410 * MiB;
constexpr size_t WS_RKT = 474 * MiB;
constexpr size_t WS_OACC = 474 * MiB;
constexpr size_t WS_LSE = 538 * MiB;
constexpr size_t WS_END = 540 * MiB;
static_assert(WS_W2_FFN + (size_t)D * DFF * 2 <= WS_XH && WS_W2_ATT + (size_t)D * D * 2 <= WS_XH && WS_W2_RET + (size_t)D * DV * 2 <= WS_XH, "weight region");
constexpr int RP_COLS = 2 * D + 2 * DV;
static_assert(WS_XH + (size_t)M * D * 2 == WS_YC && WS_YC + (size_t)M * DV * 2 == WS_BIG && WS_BIG + (size_t)MH * RP_COLS * 2 == WS_F && WS_F + (size_t)M * D * 2 == WS_RKT && WS_RVT + (size_t)DV * MH * 2 == WS_RKT && WS_RKT + (size_t)D * MH * 2 <= WS_LSE && WS_OACC + (size_t)M * D * 2 == WS_LSE, "d_ws map");
static_assert((size_t)M * DFF * 2 <= 192 * MiB && (size_t)M * ATT_COLS * 2 <= 192 * MiB && WS_LSE + (size_t)M * 16 * 4 <= WS_END, "d_ws map");
constexpr int CW_BAR = 4096;

constexpr int RING_OFF = 0, RING_BYTES = 149504;
constexpr int LDSCTL_OFF = RING_BYTES, MISC_OFF = LDSCTL_OFF + 320;
constexpr int LDS_BYTES = RING_BYTES + 512;
static_assert(MISC_OFF + 128 <= LDS_BYTES, "LDS map");

#define LAS __attribute__((address_space(3)))
typedef unsigned short bf16;
typedef unsigned v4u __attribute__((ext_vector_type(4)));
typedef unsigned v2u __attribute__((ext_vector_type(2)));
typedef float f32x4 __attribute__((ext_vector_type(4)));
#define LDS_WAIT() asm volatile("s_waitcnt lgkmcnt(0)" ::: "memory")
__device__ __forceinline__ unsigned f2bf(float f) { unsigned u = __builtin_bit_cast(unsigned, f); return (u + 0x7fffu + ((u >> 16) & 1u)) >> 16; }
__device__ __forceinline__ unsigned pk2(float lo, float hi) { return f2bf(lo) | (f2bf(hi) << 16); }
__device__ __forceinline__ float bflo(unsigned w) { return __builtin_bit_cast(float, w << 16); }
__device__ __forceinline__ float bfhi(unsigned w) { return __builtin_bit_cast(float, w & 0xffff0000u); }
template <int O> __device__ __forceinline__ float swz_xor(float v) { return __builtin_bit_cast(float, __builtin_amdgcn_ds_swizzle(__builtin_bit_cast(int, v), (O << 10) | 0x1f)); }
__device__ __forceinline__ float wave_sum(float v) {
    v += swz_xor<1>(v); v += swz_xor<2>(v); v += swz_xor<4>(v); v += swz_xor<8>(v); v += swz_xor<16>(v);
    return __builtin_bit_cast(float, __builtin_amdgcn_readlane(__builtin_bit_cast(int, v), 0)) + __builtin_bit_cast(float, __builtin_amdgcn_readlane(__builtin_bit_cast(int, v), 32));
}
__device__ __forceinline__ float get_xor32(float v, int lane) { return __builtin_bit_cast(float, __builtin_amdgcn_ds_bpermute((lane ^ 32) << 2, __builtin_bit_cast(int, v))); }

#define XB_TMO      128
#define XB_XCNT(j)  (256  + 64 * (j))
#define XB_XSUB(j)  (1280 + 64 * (j))
#define XB_XGEN(j)  (2304 + 64 * (j))
#define XB_TOP      3328
#define XB_TOPGEN   3392
#define XCD_BAR_WORDS 3456
#define XB_SPIN_CAP (1u << 18)

__device__ __forceinline__ unsigned xb_ld(unsigned* p)              { return __hip_atomic_load(p, __ATOMIC_RELAXED, __HIP_MEMORY_SCOPE_AGENT); }
__device__ __forceinline__ unsigned xb_add(unsigned* p, unsigned v) { return __hip_atomic_fetch_add(p, v, __ATOMIC_RELAXED, __HIP_MEMORY_SCOPE_AGENT); }
__device__ __forceinline__ unsigned xb_xcc_id() { return (unsigned)__builtin_amdgcn_s_getreg((3 << 11) | 20) & 0xFu; }
#define XB_SPIN(cond, bar) do { unsigned _sp = 0; while (cond) { __builtin_amdgcn_s_sleep(1); \
    if ((++_sp & 255u) == 0u) { if (xb_ld(&(bar)[XB_TMO])) break; if (_sp > XB_SPIN_CAP) { atomicAdd(&(bar)[XB_TMO], 1u); break; } } } } while (0)

struct XcdBarrier {
    unsigned* bar; unsigned x;
    volatile LAS unsigned* st;
};

__device__ __forceinline__ XcdBarrier xcd_barrier_post(unsigned* bar, volatile LAS unsigned* st) {
    XcdBarrier b; b.bar = bar; b.x = xb_xcc_id(); b.st = st;
    if (threadIdx.x == 0) (void)xb_add(&bar[XB_XCNT(b.x)], 1u);
    return b;
}
__device__ __forceinline__ void xcd_barrier_complete(unsigned* bar, unsigned x, unsigned& nloc, unsigned& nx) {
    const unsigned G = gridDim.x * gridDim.y * gridDim.z;
    unsigned sum, cnt, mine, sp = 0u;
    for (;;) {
        sum = 0u; cnt = 0u; mine = 0u;
#pragma unroll
        for (unsigned j = 0; j < 16; ++j) { const unsigned c = xb_ld(&bar[XB_XCNT(j)]); sum += c; cnt += (c > 0u) ? 1u : 0u; mine = (j == x) ? c : mine; }
        if (sum == G) break;
        __builtin_amdgcn_s_sleep(1);
        if ((++sp & 255u) == 0u) { if (xb_ld(&bar[XB_TMO])) break; if (sp > XB_SPIN_CAP) { atomicAdd(&bar[XB_TMO], 1u); break; } }
    }
    nloc = mine > 0u ? mine : 1u; nx = cnt > 0u ? cnt : 1u;
}

__device__ __forceinline__ void xcd_barrier(const XcdBarrier& b) {
    asm volatile("s_waitcnt vmcnt(0)" ::: "memory");
    __syncthreads();
    if (threadIdx.x == 0) {
        unsigned* bar = b.bar;
        __builtin_amdgcn_s_waitcnt(0);
        unsigned nloc = b.st[0], nx = b.st[1];
        if (nloc == 0u) { xcd_barrier_complete(bar, b.x, nloc, nx); b.st[0] = nloc; b.st[1] = nx; }
        const unsigned old = xb_add(&bar[XB_XSUB(b.x)], 1u);
        const unsigned gen = old / nloc;
        if (old + 1u == (gen + 1u) * nloc) {
            __builtin_amdgcn_fence(__ATOMIC_RELEASE, "agent");
            asm volatile("s_waitcnt vmcnt(0)" ::: "memory");
            const unsigned og = xb_add(&bar[XB_TOP], 1u);
            const unsigned tg = og / nx;
            if (og + 1u == (tg + 1u) * nx) xb_add(&bar[XB_TOPGEN], 1u);
            else XB_SPIN(xb_ld(&bar[XB_TOPGEN]) == tg, bar);
            __builtin_amdgcn_fence(__ATOMIC_ACQUIRE, "agent");
            xb_add(&bar[XB_XGEN(b.x)], 1u);
            asm volatile("s_waitcnt vmcnt(0)" ::: "memory");
        } else {
            XB_SPIN(xb_ld(&bar[XB_XGEN(b.x)]) == gen, bar);
            __builtin_amdgcn_fence(__ATOMIC_ACQUIRE, "agent");
            asm volatile("s_waitcnt vmcnt(0)" ::: "memory");
        }
    }
    __syncthreads();
}


constexpr int CV_SCR = 64 * 65 * 4;
__device__ __forceinline__ void conv_item(const float* W, int srcN, int k0, int n0, bf16* WT, int dstK, int drow0, const float* gain, LAS float* scr, int lane) {
    { const float* src = W + (size_t)(k0 + (lane >> 4)) * srcN + n0 + (lane & 15) * 4; LAS float* d = scr + (lane >> 4) * 65 + (lane & 15) * 4;
#pragma unroll
      for (int i = 0; i < 16; ++i) { const f32x4 v = *(const f32x4*)(src + (size_t)(4 * i) * srcN); d[4 * i * 65 + 0] = v.x; d[4 * i * 65 + 1] = v.y; d[4 * i * 65 + 2] = v.z; d[4 * i * 65 + 3] = v.w; } }
    LDS_WAIT(); asm volatile("" ::: "memory");
    const int c = lane & 7;
    float gk[8];
#pragma unroll
    for (int i = 0; i < 8; ++i) gk[i] = gain ? gain[k0 + 8 * c + i] : 1.0f;
#pragma unroll
    for (int j = 0; j < 8; ++j) { const int n = (lane >> 3) + 8 * j; const LAS float* s = scr + (8 * c) * 65 + n;
        v4u o; o.x = pk2(s[0 * 65] * gk[0], s[1 * 65] * gk[1]); o.y = pk2(s[2 * 65] * gk[2], s[3 * 65] * gk[3]); o.z = pk2(s[4 * 65] * gk[4], s[5 * 65] * gk[5]); o.w = pk2(s[6 * 65] * gk[6], s[7 * 65] * gk[7]);
        *(v4u*)(WT + (size_t)(drow0 + n) * dstK + k0 + 8 * c) = o; }
    LDS_WAIT(); asm volatile("" ::: "memory");
}
template <int K, int N, int NC> __device__ __forceinline__ void conv_cols(const float* W, int c0, bf16* WT, int r0, const float* gain, LAS float* scr, int gw, int NGW, int lane) {
    constexpr int nblk = NC / 64, nitems = (K / 64) * nblk;
    for (int it = gw; it < nitems; it += NGW) { const int kb = it / nblk, nb = it % nblk; conv_item(W, N, 64 * kb, c0 + 64 * nb, WT, K, r0 + 64 * nb, gain, scr, lane); }
}
template <int K, int N> __device__ __forceinline__ void conv_plain(const float* W, bf16* WT, const float* gain, LAS float* scr, int gw, int NGW, int lane) { conv_cols<K, N, N>(W, 0, WT, 0, gain, scr, gw, NGW, lane); }
__device__ __forceinline__ void conv_gateup(const float* Wg, const float* Wu, bf16* WT, const float* gain, LAS float* scr, int gw, int NGW, int lane) {
    constexpr int nblk = 2 * DFF / 64, nitems = (D / 64) * nblk;
    for (int it = gw; it < nitems; it += NGW) { const int kb = it / nblk, nb = it % nblk, n0 = 64 * nb, pn = n0 >> 8, bj = (n0 >> 7) & 1, c0 = n0 & 127;
        conv_item(bj ? Wu : Wg, DFF, 64 * kb, 128 * pn + c0, WT, D, n0, gain, scr, lane); }
}

__device__ __forceinline__ void unpack8(const v4u w, float (&f)[8]) { f[0] = bflo(w.x); f[1] = bfhi(w.x); f[2] = bflo(w.y); f[3] = bfhi(w.y); f[4] = bflo(w.z); f[5] = bfhi(w.z); f[6] = bflo(w.w); f[7] = bfhi(w.w); }
__device__ __forceinline__ void p0_rows(const float* xin, bf16* XB, float* RS, int gw, int NGW, int lane) {
    for (int m = gw; m < M; m += NGW) {
        float ss = 0.f;
#pragma unroll
        for (int j = 0; j < 2; ++j) { const float* p = xin + (size_t)m * D + 512 * j + 8 * lane; const f32x4 a = *(const f32x4*)p, b = *(const f32x4*)(p + 4);
            ss += (a.x * a.x + a.y * a.y) + (a.z * a.z + a.w * a.w) + (b.x * b.x + b.y * b.y) + (b.z * b.z + b.w * b.w);
            v4u w; w.x = pk2(a.x, a.y); w.y = pk2(a.z, a.w); w.z = pk2(b.x, b.y); w.w = pk2(b.z, b.w); *(v4u*)(XB + (size_t)m * D + 512 * j + 8 * lane) = w; }
        ss = wave_sum(ss);
        if (lane == 0) RS[m] = __builtin_amdgcn_rsqf(ss * (1.f / D) + NORM_EPS);
    }
}
__device__ __forceinline__ void thin_rows(const bf16* Fin, bf16* XB, const float* gpost, float cpost, float* RS, float* outf, int gw, int NGW, int lane) {
    float gp[2][8];
#pragma unroll
    for (int j = 0; j < 2; ++j) { const f32x4 a = *(const f32x4*)(gpost + 512 * j + 8 * lane), b = *(const f32x4*)(gpost + 512 * j + 8 * lane + 4);
        gp[j][0] = a.x; gp[j][1] = a.y; gp[j][2] = a.z; gp[j][3] = a.w; gp[j][4] = b.x; gp[j][5] = b.y; gp[j][6] = b.z; gp[j][7] = b.w; }
    for (int m = gw; m < M; m += NGW) {
        float x[2][8], f[2][8]; float ss = 0.f;
#pragma unroll
        for (int j = 0; j < 2; ++j) { unpack8(*(const v4u*)(XB + (size_t)m * D + 512 * j + 8 * lane), x[j]); unpack8(*(const v4u*)(Fin + (size_t)m * D + 512 * j + 8 * lane), f[j]);
#pragma unroll
            for (int q = 0; q < 8; ++q) ss += f[j][q] * f[j][q]; }
        const float rF = cpost * __builtin_amdgcn_rsqf(wave_sum(ss) * (1.f / D) + NORM_EPS);
        float s2 = 0.f;
#pragma unroll
        for (int j = 0; j < 2; ++j)
#pragma unroll
            for (int q = 0; q < 8; ++q) { x[j][q] += f[j][q] * gp[j][q] * rF; s2 += x[j][q] * x[j][q]; }
        if (outf) {
#pragma unroll
            for (int j = 0; j < 2; ++j) { float* p = outf + (size_t)m * D + 512 * j + 8 * lane; *(f32x4*)p = (f32x4){x[j][0], x[j][1], x[j][2], x[j][3]}; *(f32x4*)(p + 4) = (f32x4){x[j][4], x[j][5], x[j][6], x[j][7]}; }
        } else {
#pragma unroll
            for (int j = 0; j < 2; ++j) { v4u w; w.x = pk2(x[j][0], x[j][1]); w.y = pk2(x[j][2], x[j][3]); w.z = pk2(x[j][4], x[j][5]); w.w = pk2(x[j][6], x[j][7]); *(v4u*)(XB + (size_t)m * D + 512 * j + 8 * lane) = w; }
            s2 = wave_sum(s2);
            if (lane == 0) RS[m] = __builtin_amdgcn_rsqf(s2 * (1.f / D) + NORM_EPS);
        }
    }
}

__device__ __forceinline__ void attn_group_scalar(const bf16* P, const float* bias2, int dil, int first, bf16* OACC, float* LSE, int gw, int NGW, int lane) {
    const int Ls = SEQ / dil, tbn = Ls / 64;
    constexpr float SC = 0.125f * 1.4426950409f;
    for (int w = gw; w < BATCH * HA * 32; w += NGW) {
        const int tb = w % tbn, r = (w / tbn) % dil, h = (w >> 5) & 15, b = w >> 9;
        const int t = tb * 64 + lane; const size_t row = (size_t)b * SEQ + (size_t)t * dil + r;
        float q[64], acc[64];
        { const v4u* qp = (const v4u*)(P + row * ATT_COLS + h * 64);
#pragma unroll
          for (int c = 0; c < 8; ++c) { const v4u x = qp[c]; q[8 * c + 0] = bflo(x.x); q[8 * c + 1] = bfhi(x.x); q[8 * c + 2] = bflo(x.y); q[8 * c + 3] = bfhi(x.y); q[8 * c + 4] = bflo(x.z); q[8 * c + 5] = bfhi(x.z); q[8 * c + 6] = bflo(x.w); q[8 * c + 7] = bfhi(x.w); } }
#pragma unroll
        for (int c = 0; c < 64; ++c) acc[c] = 0.f;
        float mx = -INFINITY, l = 0.f;
        for (int kk = 0; kk < 129; ++kk) {
            const int tk = t - 64 + kk;
            if (tk >= 0 && tk < Ls) {
                const size_t krow = (size_t)b * SEQ + (size_t)tk * dil + r;
                const v4u* kp = (const v4u*)(P + krow * ATT_COLS + D + h * 64);
                float s = 0.f;
#pragma unroll
                for (int c = 0; c < 8; ++c) { const v4u x = kp[c];
                    s += q[8 * c + 0] * bflo(x.x) + q[8 * c + 1] * bfhi(x.x) + q[8 * c + 2] * bflo(x.y) + q[8 * c + 3] * bfhi(x.y) + q[8 * c + 4] * bflo(x.z) + q[8 * c + 5] * bfhi(x.z) + q[8 * c + 6] * bflo(x.w) + q[8 * c + 7] * bfhi(x.w); }
                s = s * SC + bias2[h * 129 + kk];
                const float mn = fmaxf(mx, s), a = exp2f(mx - mn), p = exp2f(s - mn);
                l = l * a + p; mx = mn;
                const v4u* vp = (const v4u*)(P + krow * ATT_COLS + 2 * D + h * 64);
#pragma unroll
                for (int c = 0; c < 8; ++c) { const v4u x = vp[c];
                    acc[8 * c + 0] = acc[8 * c + 0] * a + p * bflo(x.x); acc[8 * c + 1] = acc[8 * c + 1] * a + p * bfhi(x.x); acc[8 * c + 2] = acc[8 * c + 2] * a + p * bflo(x.y); acc[8 * c + 3] = acc[8 * c + 3] * a + p * bfhi(x.y);
                    acc[8 * c + 4] = acc[8 * c + 4] * a + p * bflo(x.z); acc[8 * c + 5] = acc[8 * c + 5] * a + p * bfhi(x.z); acc[8 * c + 6] = acc[8 * c + 6] * a + p * bflo(x.w); acc[8 * c + 7] = acc[8 * c + 7] * a + p * bfhi(x.w); }
            }
        }
        const float il = 1.f / l; float lse = mx + log2f(l);
        float wn = il, wo = 0.f;
        if (!first) { const float lo = LSE[row * 16 + h]; const float mm = fmaxf(lo, lse), eo = exp2f(lo - mm), en = exp2f(lse - mm), inv = 1.f / (eo + en); wn = en * inv * il; wo = eo * inv; lse = mm + log2f(eo + en); }
        LSE[row * 16 + h] = lse;
        v4u* op = (v4u*)(OACC + row * D + h * 64);
#pragma unroll
        for (int c = 0; c < 8; ++c) { v4u x = (v4u){0u, 0u, 0u, 0u}; if (!first) x = op[c];
            v4u y; y.x = pk2(wn * acc[8 * c + 0] + wo * bflo(x.x), wn * acc[8 * c + 1] + wo * bfhi(x.x)); y.y = pk2(wn * acc[8 * c + 2] + wo * bflo(x.y), wn * acc[8 * c + 3] + wo * bfhi(x.y));
            y.z = pk2(wn * acc[8 * c + 4] + wo * bflo(x.z), wn * acc[8 * c + 5] + wo * bfhi(x.z)); y.w = pk2(wn * acc[8 * c + 6] + wo * bflo(x.w), wn * acc[8 * c + 7] + wo * bfhi(x.w)); op[c] = y; }
    }
}

__device__ __forceinline__ void ret_core_scalar(const bf16* P, const bf16* KT, const bf16* VT, const float* decay_logit  , bf16* YF, bf16* YB, int useKT, int gw, int NGW, int lane) {
    const int el = lane & 15, dq = lane >> 4;
    for (int w = gw; w < 8 * HR * 2 * 32; w += NGW) {
        const int eb = w & 31, dir = (w >> 5) & 1, h = (w >> 6) & 3, bl = w >> 8;
        const int e = eb * 16 + el;
        const float gamma = 1.0f - expf(decay_logit[dir * HR + h]);
        bf16* Y = dir ? YB : YF;
        float S[64];
#pragma unroll
        for (int c = 0; c < 64; ++c) S[c] = 0.f;
        for (int ti = 0; ti < SEQ; ++ti) {
            const int s = dir ? (SEQ - 1 - ti) : ti; const size_t row = (size_t)bl * SEQ + s;
            const bf16* pr = P + row * RP_COLS;
            const float v = __builtin_bit_cast(float, (unsigned)VT[(size_t)(h * DVR + e) * MH + row] << 16);
            const v4u* qp = (const v4u*)(pr + h * DKR + dq * 64); const v4u* kp = (const v4u*)(pr + D + 2 * DV + h * DKR + dq * 64);
            float y = 0.f;
#pragma unroll
            for (int c = 0; c < 8; ++c) { v4u kx = kp[c]; const v4u qx = qp[c];
                if (useKT) { const bf16* kt = KT + (size_t)(h * DKR + dq * 64 + 8 * c) * MH + row;
                    kx.x = (unsigned)kt[0] | ((unsigned)kt[MH] << 16); kx.y = (unsigned)kt[2 * (size_t)MH] | ((unsigned)kt[3 * (size_t)MH] << 16);
                    kx.z = (unsigned)kt[4 * (size_t)MH] | ((unsigned)kt[5 * (size_t)MH] << 16); kx.w = (unsigned)kt[6 * (size_t)MH] | ((unsigned)kt[7 * (size_t)MH] << 16); }
                S[8 * c + 0] = S[8 * c + 0] * gamma + bflo(kx.x) * v; y += bflo(qx.x) * S[8 * c + 0];
                S[8 * c + 1] = S[8 * c + 1] * gamma + bfhi(kx.x) * v; y += bfhi(qx.x) * S[8 * c + 1];
                S[8 * c + 2] = S[8 * c + 2] * gamma + bflo(kx.y) * v; y += bflo(qx.y) * S[8 * c + 2];
                S[8 * c + 3] = S[8 * c + 3] * gamma + bfhi(kx.y) * v; y += bfhi(qx.y) * S[8 * c + 3];
                S[8 * c + 4] = S[8 * c + 4] * gamma + bflo(kx.z) * v; y += bflo(qx.z) * S[8 * c + 4];
                S[8 * c + 5] = S[8 * c + 5] * gamma + bfhi(kx.z) * v; y += bfhi(qx.z) * S[8 * c + 5];
                S[8 * c + 6] = S[8 * c + 6] * gamma + bflo(kx.w) * v; y += bflo(qx.w) * S[8 * c + 6];
                S[8 * c + 7] = S[8 * c + 7] * gamma + bfhi(kx.w) * v; y += bfhi(qx.w) * S[8 * c + 7]; }
            y += __shfl_xor(y, 16); y += __shfl_xor(y, 32);
            if (dq == 0) Y[row * DV + h * DVR + e] = (bf16)f2bf(y);
        }
    }
}

__device__ __forceinline__ void ret_combine(const bf16* P, bf16* YF  , const bf16* YB, int gw, int NGW, int lane) {
    for (int m = gw; m < MH; m += NGW) {
#pragma unroll
        for (int j = 0; j < 4; ++j) {
            const int idx = j * 512 + lane * 8;
            const v4u a = *(const v4u*)(YF + (size_t)m * DV + idx), bq = *(const v4u*)(YB + (size_t)m * DV + idx);
            const v4u gfv = *(const v4u*)(P + (size_t)m * RP_COLS + D + idx), gbv = *(const v4u*)(P + (size_t)m * RP_COLS + D + DV + idx);
            float yf[8] = {bflo(a.x), bfhi(a.x), bflo(a.y), bfhi(a.y), bflo(a.z), bfhi(a.z), bflo(a.w), bfhi(a.w)};
            float yb[8] = {bflo(bq.x), bfhi(bq.x), bflo(bq.y), bfhi(bq.y), bflo(bq.z), bfhi(bq.z), bflo(bq.w), bfhi(bq.w)};
            float gf[8] = {bflo(gfv.x), bfhi(gfv.x), bflo(gfv.y), bfhi(gfv.y), bflo(gfv.z), bfhi(gfv.z), bflo(gfv.w), bfhi(gfv.w)};
            float gb[8] = {bflo(gbv.x), bfhi(gbv.x), bflo(gbv.y), bfhi(gbv.y), bflo(gbv.z), bfhi(gbv.z), bflo(gbv.w), bfhi(gbv.w)};
            float sf = 0.f, sb = 0.f;
#pragma unroll
            for (int c = 0; c < 8; ++c) { sf += yf[c]; sb += yb[c]; }
            const float muf = wave_sum(sf) * (1.f / DVR), mub = wave_sum(sb) * (1.f / DVR);
            float qf = 0.f, qb = 0.f;
#pragma unroll
            for (int c = 0; c < 8; ++c) { yf[c] -= muf; yb[c] -= mub; qf += yf[c] * yf[c]; qb += yb[c] * yb[c]; }
            const float rf = __builtin_amdgcn_rsqf(wave_sum(qf) * (1.f / DVR) + NORM_EPS), rb = __builtin_amdgcn_rsqf(wave_sum(qb) * (1.f / DVR) + NORM_EPS);
            float o[8];
#pragma unroll
            for (int c = 0; c < 8; ++c) o[c] = gf[c] * pg8::fast_sigmoid(gf[c]) * yf[c] * rf + gb[c] * pg8::fast_sigmoid(gb[c]) * yb[c] * rb;
            v4u w; w.x = pk2(o[0], o[1]); w.y = pk2(o[2], o[3]); w.z = pk2(o[4], o[5]); w.w = pk2(o[6], o[7]);
            *(v4u*)(YF + (size_t)m * DV + idx) = w;
        }
    }
}

typedef float f32x16 __attribute__((ext_vector_type(16)));
typedef short bf16x8s __attribute__((ext_vector_type(8)));
typedef float f32x2_t __attribute__((ext_vector_type(2))); typedef __bf16 bf16x2_t __attribute__((ext_vector_type(2)));
__device__ __forceinline__ unsigned cvtpk(float lo, float hi) { f32x2_t v = {lo, hi}; bf16x2_t b = __builtin_convertvector(v, bf16x2_t); return __builtin_bit_cast(unsigned, b); }
__device__ __forceinline__ void attn_group_mfma(const bf16* QK, const bf16* VT, const float* bias2g, int dil, int first, bf16* OACC, float* LSE, LAS unsigned char* lds, int tid, int gw, int NGW) {
    LAS float* tab = (LAS float*)lds;
    for (int i = tid; i < 16 * 192; i += NTHREADS) { const int h = i / 192, o = i % 192 - 96; tab[i] = (o >= -64 && o <= 64) ? bias2g[h * 129 + o + 64] : -1e30f; }
    __syncthreads();
    const int lane = tid & 63, r = lane & 31, hh = lane >> 5;
    const int Ls = SEQ / dil, nqb = Ls / 32;
    constexpr float SC = 0.125f * 1.4426950409f;
    constexpr int NU = BATCH * HA * 64;
    const int upw = (NU + NGW - 1) / NGW;
    for (int u = gw * upw; u < (gw + 1) * upw && u < NU; ++u) {
        const int qb = u % nqb, rr = (u / nqb) % dil, h = (u >> 6) & 15, b = u >> 10, t0 = qb * 32;
        const size_t rowq = (size_t)b * SEQ + (size_t)(t0 + r) * dil + rr;
        bf16x8s qf[4];
#pragma unroll
        for (int ks = 0; ks < 4; ++ks) qf[ks] = *(const bf16x8s*)(QK + rowq * 2048 + h * 64 + 16 * ks + 8 * hh);
        f32x16 S[5];
#pragma unroll
        for (int kb = 0; kb < 5; ++kb) {
            int t = t0 - 64 + 32 * kb + r; t = t < 0 ? 0 : (t > Ls - 1 ? Ls - 1 : t);
            const bf16* kp = QK + ((size_t)b * SEQ + (size_t)t * dil + rr) * 2048 + 1024 + h * 64 + 8 * hh;
            bf16x8s kf[4];
#pragma unroll
            for (int ks = 0; ks < 4; ++ks) kf[ks] = *(const bf16x8s*)(kp + 16 * ks);
#pragma unroll
            for (int i = 0; i < 16; ++i) S[kb][i] = 0.f;
#pragma unroll
            for (int ks = 0; ks < 4; ++ks) S[kb] = __builtin_amdgcn_mfma_f32_32x32x16_bf16(kf[ks], qf[ks], S[kb], 0, 0, 0);
        }
        const LAS float* tb = tab + h * 192 + (32 + 4 * hh - r);
        float mx = -1e30f;
#pragma unroll
        for (int kb = 0; kb < 5; ++kb)
#pragma unroll
            for (int i = 0; i < 16; ++i) { const int krel = 32 * kb + (i & 3) + 8 * (i >> 2); const int kt = t0 - 64 + krel + 4 * hh;
                float s = S[kb][i] * SC + tb[krel]; s = (kt < 0 || kt >= Ls) ? -1e30f : s; S[kb][i] = s; mx = fmaxf(mx, s); }
        mx = fmaxf(mx, get_xor32(mx, lane));
        float l = 0.f;
#pragma unroll
        for (int kb = 0; kb < 5; ++kb)
#pragma unroll
            for (int i = 0; i < 16; ++i) { const float p = __builtin_amdgcn_exp2f(S[kb][i] - mx); S[kb][i] = p; l += p; }
        l += get_xor32(l, lane);
        f32x16 O[2];
#pragma unroll
        for (int db = 0; db < 2; ++db)
#pragma unroll
            for (int i = 0; i < 16; ++i) O[db][i] = 0.f;
        const bf16* vbase = VT + (size_t)(h * 64 + r) * M + (size_t)b * SEQ + (size_t)rr * Ls;
#pragma unroll
        for (int kb = 0; kb < 5; ++kb)
#pragma unroll
            for (int s2 = 0; s2 < 2; ++s2) {
                v4u pw; pw.x = cvtpk(S[kb][8 * s2 + 0], S[kb][8 * s2 + 1]); pw.y = cvtpk(S[kb][8 * s2 + 2], S[kb][8 * s2 + 3]); pw.z = cvtpk(S[kb][8 * s2 + 4], S[kb][8 * s2 + 5]); pw.w = cvtpk(S[kb][8 * s2 + 6], S[kb][8 * s2 + 7]);
                const bf16x8s pf = __builtin_bit_cast(bf16x8s, pw);
                int ta = t0 - 64 + 32 * kb + 16 * s2 + 4 * hh, tb2 = ta + 8;
                ta = (ta < 0 || ta >= Ls) ? 0 : ta; tb2 = (tb2 < 0 || tb2 >= Ls) ? 0 : tb2;
#pragma unroll
                for (int db = 0; db < 2; ++db) { const bf16* vp = vbase + (size_t)(32 * db) * M;
                    const v2u lo = *(const v2u*)(vp + ta), hi = *(const v2u*)(vp + tb2);
                    const v4u vw = (v4u){lo.x, lo.y, hi.x, hi.y};
                    O[db] = __builtin_amdgcn_mfma_f32_32x32x16_bf16(__builtin_bit_cast(bf16x8s, vw), pf, O[db], 0, 0, 0); }
            }
        const float il = 1.f / l; float lse = mx + log2f(l);
        const size_t row = rowq;
        float wn = il, wo = 0.f;
        if (!first) { const float lo = LSE[row * 16 + h]; const float mm = fmaxf(lo, lse), eo = exp2f(lo - mm), en = exp2f(lse - mm), inv = 1.f / (eo + en); wn = en * inv * il; wo = eo * inv; lse = mm + log2f(eo + en); }
        if (hh == 0) LSE[row * 16 + h] = lse;
#pragma unroll
        for (int db = 0; db < 2; ++db)
#pragma unroll
            for (int gq = 0; gq < 4; ++gq) { v2u* op = (v2u*)(OACC + row * D + h * 64 + 32 * db + 8 * gq + 4 * hh);
                v2u x = (v2u){0u, 0u}; if (!first) x = *op;
                v2u y; y.x = cvtpk(wn * O[db][4 * gq + 0] + wo * bflo(x.x), wn * O[db][4 * gq + 1] + wo * bfhi(x.x)); y.y = cvtpk(wn * O[db][4 * gq + 2] + wo * bflo(x.y), wn * O[db][4 * gq + 3] + wo * bfhi(x.y));
                *op = y; }
    }
}

constexpr int RC_ST = 0, RC_RG = 65536, RC_NSLOT = 5, RC_LDS = RC_RG + RC_NSLOT * 16384;
__device__ __forceinline__ int sl_swz(int ob) { return ob ^ (((ob >> 9) & 1) << 5); }
template <int VAR  >
__device__ __forceinline__ void ret_core_mfma(const bf16* P, const bf16* VT, const float* decay_logit  , bf16* YF, bf16* YB, LAS unsigned char* lds, const int tid, const int bid, const int G) {
    typedef short bf16x8v __attribute__((ext_vector_type(8)));
    const int w = __builtin_amdgcn_readfirstlane(tid >> 6), lane = tid & 63, fr = lane & 15, fq = lane >> 4, wr = w >> 2, wc = w & 3;
#define RC_DMA(gptr, ldsoff) __builtin_amdgcn_global_load_lds((const unsigned*)(gptr), (LAS unsigned*)(lds + (ldsoff)), 16, 0, 0)
#define RC_WAITV(n) asm volatile("s_waitcnt vmcnt(" #n ")" ::: "memory")
#define RC_WAITL() asm volatile("s_waitcnt lgkmcnt(0)" ::: "memory")
#define RC_BAR() do { asm volatile("" ::: "memory"); __builtin_amdgcn_s_barrier(); asm volatile("" ::: "memory"); } while (0)
#define RC_MFMA(b, a, c) __builtin_amdgcn_mfma_f32_16x16x32_bf16((b), (a), (c), 0, 0, 0)
#define RC_NEXT(sl) ((sl) == RC_NSLOT - 1 ? 0 : (sl) + 1)
#define RC_PREV(sl) ((sl) == 0 ? RC_NSLOT - 1 : (sl) - 1)
    const int dob = sl_swz(lane * 16), drow = 16 * w + (dob >> 6), dcc = (dob & 63) >> 1;
    const int aoff = 4 * wr * 1024 + sl_swz(fr * 64 + fq * 16), boff = 2 * wc * 1024 + sl_swz(fr * 64 + fq * 16);
    for (int u = bid; u < 256; u += G) {
        const int xcd = u & 7, idx = u >> 3, es = idx & 3, cmb = (idx >> 2) * 8 + xcd, dir = cmb & 1, h = (cmb >> 1) & 3, bl = cmb >> 3;
        const float lg = __builtin_amdgcn_logf(1.0f - __builtin_amdgcn_exp2f(decay_logit[dir * HR + h] * 1.4426950409f));
        const float cdec = __builtin_amdgcn_exp2f(lg * 128.f);
        bf16* Y = dir ? YB : YF;
        const size_t rowbase = (size_t)bl * SEQ;
        const bf16* qsrc = P + (rowbase + drow) * RP_COLS + h * DKR + dcc;
        const bf16* ksrc = qsrc + (D + 2 * DV);
        const bf16* vsrc = VT + (size_t)(h * DVR + es * 128 + drow) * MH + rowbase + dcc;
        const bf16* vown = VT + (size_t)(h * DVR + es * 128 + 16 * w + fr) * MH + rowbase + 8 * fq;
        { const v4u z = (v4u){0u, 0u, 0u, 0u};
#pragma unroll
          for (int i = 0; i < 8; ++i) *(LAS v4u*)(lds + RC_ST + (i * NTHREADS + tid) * 16) = z; }
        f32x4 acc4[16];
#pragma unroll
        for (int n = 0; n < 16; ++n) acc4[n] = (f32x4){0.f, 0.f, 0.f, 0.f};
#define RC_ISSUE(st, tk, sl) do { if ((st) < 8) { const size_t to_ = (size_t)(tk) * RP_COLS + 32 * (st); RC_DMA(qsrc + to_, RC_RG + (sl) * 16384 + w * 1024); RC_DMA(ksrc + to_, RC_RG + (sl) * 16384 + 8192 + w * 1024); } \
                                  else RC_DMA(vsrc + (tk) + 32 * ((st) - 8), RC_RG + (sl) * 16384 + w * 1024); } while (0)
        v4u vnx[4];
        { const int tok0 = dir ? 128 * 15 : 0;
#pragma unroll
          for (int js = 0; js < 4; ++js) vnx[js] = *(const v4u*)(vown + tok0 + 32 * js);
          RC_ISSUE(0, tok0, 0); RC_ISSUE(1, tok0, 1); RC_ISSUE(2, tok0, 2); RC_ISSUE(3, tok0, 3); }
        RC_WAITL();
        int slot = 0;
        for (int c = 0; c < 16; ++c) {
            const int tok0 = 128 * (dir ? 15 - c : c), tokn = 128 * (dir ? (c < 15 ? 14 - c : 0) : (c < 15 ? c + 1 : 15));
            float lgc = lg; int zo = 0; asm volatile("" : "+v"(lgc), "+v"(zo));
            int lc = lane; asm volatile("" : "+v"(lc)); const int frc = lc & 15, fqc = lc >> 4;
            bf16x8v Avs[4];
#pragma unroll
            for (int js = 0; js < 4; ++js) { const v4u kw = vnx[js]; float kd[8];
#pragma unroll
                for (int q = 0; q < 8; ++q) { const int j = 32 * js + 8 * fqc + q; kd[q] = __builtin_amdgcn_exp2f(lgc * (dir ? (float)j : (float)(127 - j))); }
                v4u sw; sw.x = cvtpk(bflo(kw.x) * kd[0], bfhi(kw.x) * kd[1]); sw.y = cvtpk(bflo(kw.y) * kd[2], bfhi(kw.y) * kd[3]); sw.z = cvtpk(bflo(kw.z) * kd[4], bfhi(kw.z) * kd[5]); sw.w = cvtpk(bflo(kw.w) * kd[6], bfhi(kw.w) * kd[7]);
                Avs[js] = __builtin_bit_cast(bf16x8v, sw); }
#pragma unroll
            for (int n = 0; n < 16; ++n) acc4[n] = acc4[n] * cdec;
            const int jj = 8 * fqc + (frc >> 2);
            const unsigned trA = (unsigned)((jj >> 4) * 1024 + sl_swz((jj & 15) * 64 + 8 * (frc & 3))), trB = (unsigned)(((jj + 4) >> 4) * 1024 + sl_swz(((jj + 4) & 15) * 64 + 8 * (frc & 3)));
            f32x4 accA[4][2], accY[4][2];
#pragma unroll
            for (int m = 0; m < 4; ++m)
#pragma unroll
                for (int n = 0; n < 2; ++n) { accA[m][n] = (f32x4){0.f, 0.f, 0.f, 0.f}; accY[m][n] = (f32x4){0.f, 0.f, 0.f, 0.f}; }
#pragma unroll
            for (int ks = 0; ks < 8; ++ks) {
                if (ks < 4) { if (c == 0) RC_WAITV(6); else RC_WAITV(14); } else if (ks == 4) RC_WAITV(6); else if (ks == 5) RC_WAITV(5); else if (ks == 6) RC_WAITV(4); else RC_WAITV(3);
                RC_BAR();
                { const int s4 = RC_PREV(slot);
                  if (ks + 4 < 12) RC_ISSUE(ks + 4, tok0, s4); else RC_ISSUE(ks + 4 - 12, tokn, s4); }
                bf16x8v At[4], Bk[2], Bs[2];
                const LAS unsigned char* sq = lds + RC_RG + slot * 16384;
#pragma unroll
                for (int m = 0; m < 4; ++m) At[m] = *(const LAS bf16x8v*)(sq + aoff + m * 1024);
#pragma unroll
                for (int n = 0; n < 2; ++n) { Bk[n] = *(const LAS bf16x8v*)(sq + 8192 + boff + n * 1024); Bs[n] = *(const LAS bf16x8v*)(lds + RC_ST + ks * 8192 + boff + n * 1024); }
                RC_WAITL();
#pragma unroll
                for (int m = 0; m < 4; ++m)
#pragma unroll
                    for (int n = 0; n < 2; ++n) { accA[m][n] = RC_MFMA(Bk[n], At[m], accA[m][n]); accY[m][n] = RC_MFMA(Bs[n], At[m], accY[m][n]); }
                { const unsigned kb = (unsigned)(size_t)(sq + 8192);
#pragma unroll
                  for (int nl = 0; nl < 2; ++nl) { const unsigned a0 = kb + (trA ^ (nl << 5)), a1 = kb + (trB ^ (nl << 5));
                      v2u l0, h0, l1, h1, l2, h2, l3, h3;
                      asm volatile("ds_read_b64_tr_b16 %0, %8\n\tds_read_b64_tr_b16 %1, %9\n\tds_read_b64_tr_b16 %2, %8 offset:2048\n\tds_read_b64_tr_b16 %3, %9 offset:2048\n\t"
                                   "ds_read_b64_tr_b16 %4, %8 offset:4096\n\tds_read_b64_tr_b16 %5, %9 offset:4096\n\tds_read_b64_tr_b16 %6, %8 offset:6144\n\tds_read_b64_tr_b16 %7, %9 offset:6144\n\ts_waitcnt lgkmcnt(0)"
                                   : "=&v"(l0), "=&v"(h0), "=&v"(l1), "=&v"(h1), "=&v"(l2), "=&v"(h2), "=&v"(l3), "=&v"(h3) : "v"(a0), "v"(a1) : "memory");
                      acc4[2 * ks + nl] = RC_MFMA(__builtin_bit_cast(bf16x8v, ((v4u){l0.x, l0.y, h0.x, h0.y})), Avs[0], acc4[2 * ks + nl]);
                      acc4[2 * ks + nl] = RC_MFMA(__builtin_bit_cast(bf16x8v, ((v4u){l1.x, l1.y, h1.x, h1.y})), Avs[1], acc4[2 * ks + nl]);
                      acc4[2 * ks + nl] = RC_MFMA(__builtin_bit_cast(bf16x8v, ((v4u){l2.x, l2.y, h2.x, h2.y})), Avs[2], acc4[2 * ks + nl]);
                      acc4[2 * ks + nl] = RC_MFMA(__builtin_bit_cast(bf16x8v, ((v4u){l3.x, l3.y, h3.x, h3.y})), Avs[3], acc4[2 * ks + nl]); } }
                slot = RC_NEXT(slot);
            }
#pragma unroll
            for (int m = 0; m < 4; ++m)
#pragma unroll
                for (int n = 0; n < 2; ++n) { accY[m][n] = accY[m][n] * __builtin_amdgcn_exp2f(lgc * (dir ? (float)(128 - (64 * wr + 16 * m + frc)) : (float)(64 * wr + 16 * m + frc + 1)));
                    const int i = 64 * wr + 16 * m + frc;
#pragma unroll
                    for (int ii = 0; ii < 4; ++ii) { const int j = 32 * wc + 16 * n + 4 * fqc + ii; const int dd = dir ? j - i : i - j;
                        accA[m][n][ii] = dd >= 0 ? accA[m][n][ii] * __builtin_amdgcn_exp2f(lgc * (float)dd) : 0.f; } }
            RC_BAR();
#pragma unroll
            for (int m = 0; m < 4; ++m)
#pragma unroll
                for (int n = 0; n < 2; ++n) { v2u pw; pw.x = cvtpk(accA[m][n][0], accA[m][n][1]); pw.y = cvtpk(accA[m][n][2], accA[m][n][3]);
                    *(LAS v2u*)(lds + RC_ST + wc * 8192 + (4 * wr + m) * 1024 + sl_swz(frc * 64 + (16 * n + 4 * fqc) * 2)) = pw; }
#pragma unroll
            for (int js = 0; js < 4; ++js) vnx[js] = *(const v4u*)(vown + tokn + 32 * js + zo);
            RC_WAITL();
#pragma unroll
            for (int js = 0; js < 4; ++js) {
                if (js == 0) RC_WAITV(7); else if (js == 1) RC_WAITV(8); else if (js == 2) RC_WAITV(9); else RC_WAITV(10);
                RC_BAR();
                { const int s4 = RC_PREV(slot); RC_ISSUE(js, tokn, s4); }
                bf16x8v At[4], Bv[2];
                const LAS unsigned char* sv = lds + RC_RG + slot * 16384;
#pragma unroll
                for (int m = 0; m < 4; ++m) At[m] = *(const LAS bf16x8v*)(lds + RC_ST + js * 8192 + aoff + m * 1024);
#pragma unroll
                for (int n = 0; n < 2; ++n) Bv[n] = *(const LAS bf16x8v*)(sv + boff + n * 1024);
                RC_WAITL();
#pragma unroll
                for (int m = 0; m < 4; ++m)
#pragma unroll
                    for (int n = 0; n < 2; ++n) accY[m][n] = RC_MFMA(Bv[n], At[m], accY[m][n]);
                slot = RC_NEXT(slot);
            }
#pragma unroll
            for (int m = 0; m < 4; ++m)
#pragma unroll
                for (int n = 0; n < 2; ++n) { v2u pw; pw.x = cvtpk(accY[m][n][0], accY[m][n][1]); pw.y = cvtpk(accY[m][n][2], accY[m][n][3]);
                    *(v2u*)(Y + (rowbase + tok0 + 64 * wr + 16 * m + frc + zo) * DV + h * DVR + es * 128 + 32 * wc + 16 * n + 4 * fqc) = pw; }
            RC_BAR();
#pragma unroll
            for (int n = 0; n < 16; ++n) { v2u pw; pw.x = cvtpk(acc4[n][0], acc4[n][1]); pw.y = cvtpk(acc4[n][2], acc4[n][3]);
                *(LAS v2u*)(lds + RC_ST + (n >> 1) * 8192 + w * 1024 + sl_swz(frc * 64 + (16 * (n & 1) + 4 * fqc) * 2)) = pw; }
            RC_WAITL();
        }
        RC_WAITV(0); RC_BAR();
    }
#undef RC_DMA
#undef RC_WAITV
#undef RC_WAITL
#undef RC_BAR
#undef RC_MFMA
#undef RC_NEXT
#undef RC_PREV
#undef RC_ISSUE
}

constexpr int AT_KROW = 144, AT_KB = 256 * AT_KROW, AT_VB = AT_KB, AT_HALF = AT_KB + AT_VB + 768, AT_LD = 3 * D;
static_assert(2 * AT_HALF <= RING_BYTES, "attention tiles");
__device__ __forceinline__ void attn_group_mfma2(const bf16* QK, const float* bias2g, int ldil, int first, bf16* OACC, float* LSE, LAS unsigned char* lds, const int tid, const int bid, const int G) {
    const int wave = __builtin_amdgcn_readfirstlane(tid >> 6), lane = tid & 63, r = lane & 31, hh = lane >> 5, hw = wave >> 2, wq = wave & 3, tih0 = tid & 255;
    LAS unsigned char* Kl = lds + hw * AT_HALF; LAS unsigned char* Vl = Kl + AT_KB; LAS float* tab = (LAS float*)(Vl + AT_VB);
    const int Ls = SEQ >> ldil, lq4 = 4 - ldil, nq4m = (1 << lq4) - 1, dilm = (1 << ldil) - 1;
    constexpr float SC = 0.125f * 1.4426950409f;
    constexpr int NP = BATCH * HA * 16 / 2;
    const int npp = (NP + G - 1) / G;
    v4u kreg[8], vreg[8];
#define AT_FETCH_K(su_) do { int tih = tih0; asm volatile("" : "+v"(tih)); const int su__ = (su_); const int q4_ = su__ & nq4m, rr_ = (su__ >> lq4) & dilm, h_ = (su__ >> 4) & 15, b_ = su__ >> 8, ks_ = q4_ * 128 - 64; \
        _Pragma("unroll") for (int j = 0; j < 8; ++j) { const int pi = j * 256 + tih, row = pi >> 3, ch = pi & 7; int kt = ks_ + row; kt = kt < 0 ? 0 : (kt > Ls - 1 ? Ls - 1 : kt); \
            kreg[j] = *(const v4u*)(QK + ((size_t)b_ * SEQ + ((size_t)kt << ldil) + rr_) * AT_LD + D + h_ * 64 + ch * 8); } } while (0)
#define AT_FETCH_V(su_) do { int tih = tih0; asm volatile("" : "+v"(tih)); const int su__ = (su_); const int q4_ = su__ & nq4m, rr_ = (su__ >> lq4) & dilm, h_ = (su__ >> 4) & 15, b_ = su__ >> 8, ks_ = q4_ * 128 - 64; \
        _Pragma("unroll") for (int j = 0; j < 8; ++j) { const int pi = j * 256 + tih, row = pi >> 3, ch = pi & 7; int kt = ks_ + row; kt = kt < 0 ? 0 : (kt > Ls - 1 ? Ls - 1 : kt); \
            vreg[j] = *(const v4u*)(QK + ((size_t)b_ * SEQ + ((size_t)kt << ldil) + rr_) * AT_LD + 2 * D + h_ * 64 + ch * 8); } } while (0)
    if (bid * npp < NP) { AT_FETCH_K(2 * (bid * npp) + hw); AT_FETCH_V(2 * (bid * npp) + hw); }
    for (int it = 0; it < npp; ++it) {
        const int p = bid * npp + it; if (p >= NP) break;
        const int su = 2 * p + hw, q4 = su & nq4m, rr = (su >> lq4) & dilm, h = (su >> 4) & 15, b = su >> 8, t0 = q4 * 128 + 32 * wq;
        asm volatile("" ::: "memory"); __builtin_amdgcn_s_barrier(); asm volatile("" ::: "memory");
        int tih = tih0; asm volatile("" : "+v"(tih));
#pragma unroll
        for (int j = 0; j < 8; ++j) { const int pi = j * 256 + tih; *(LAS v4u*)(Kl + (pi >> 3) * AT_KROW + (pi & 7) * 16) = kreg[j]; }
#pragma unroll
        for (int j = 0; j < 8; ++j) { const int pi = j * 256 + tih; *(LAS v4u*)(Vl + (pi >> 3) * AT_KROW + (pi & 7) * 16) = vreg[j]; }
        if (tih < 192) { const int o = tih - 96; tab[tih] = (o >= -64 && o <= 64) ? bias2g[h * 129 + o + 64] : -1e30f; }
        const size_t rowq = (size_t)b * SEQ + ((size_t)(t0 + r) << ldil) + rr;
        bf16x8s qf[4];
#pragma unroll
        for (int ks = 0; ks < 4; ++ks) qf[ks] = *(const bf16x8s*)(QK + rowq * AT_LD + h * 64 + 16 * ks + 8 * hh);
        asm volatile("s_waitcnt lgkmcnt(0)" ::: "memory"); __builtin_amdgcn_s_barrier(); asm volatile("" ::: "memory");
        f32x16 S[5];
#pragma unroll
        for (int kb = 0; kb < 5; ++kb) {
            const LAS unsigned char* kp = Kl + (32 * wq + 32 * kb + r) * AT_KROW + 16 * hh;
#pragma unroll
            for (int i = 0; i < 16; ++i) S[kb][i] = 0.f;
#pragma unroll
            for (int ks = 0; ks < 4; ++ks) S[kb] = __builtin_amdgcn_mfma_f32_32x32x16_bf16(*(const LAS bf16x8s*)(kp + 32 * ks), qf[ks], S[kb], 0, 0, 0);
        }
        const bool more = it + 1 < npp && p + 1 < NP;
        __builtin_amdgcn_sched_barrier(0);
        if (more) AT_FETCH_K(2 * (p + 1) + hw);
        __builtin_amdgcn_sched_barrier(0);
        const LAS float* tb = tab + (32 + 4 * hh - r);
        float mx = -1e30f;
#pragma unroll
        for (int kb = 0; kb < 5; ++kb)
#pragma unroll
            for (int i = 0; i < 16; ++i) { const int krel = 32 * kb + (i & 3) + 8 * (i >> 2); const int kt = t0 - 64 + krel + 4 * hh;
                float s = S[kb][i] * SC + tb[krel]; s = (kt < 0 || kt >= Ls) ? -1e30f : s; S[kb][i] = s; mx = fmaxf(mx, s); }
        mx = fmaxf(mx, get_xor32(mx, lane));
        float l = 0.f;
#pragma unroll
        for (int kb = 0; kb < 5; ++kb)
#pragma unroll
            for (int i = 0; i < 16; ++i) { const float pv = __builtin_amdgcn_exp2f(S[kb][i] - mx); S[kb][i] = pv; l += pv; }
        l += get_xor32(l, lane);
        f32x16 O[2];
#pragma unroll
        for (int db = 0; db < 2; ++db)
#pragma unroll
            for (int i = 0; i < 16; ++i) O[db][i] = 0.f;
#pragma unroll
        for (int kb = 0; kb < 5; ++kb) {
            if (kb == 3) { __builtin_amdgcn_sched_barrier(0); if (more) AT_FETCH_V(2 * (p + 1) + hw); __builtin_amdgcn_sched_barrier(0); }
#pragma unroll
            for (int s2 = 0; s2 < 2; ++s2) {
                v4u pw; pw.x = cvtpk(S[kb][8 * s2 + 0], S[kb][8 * s2 + 1]); pw.y = cvtpk(S[kb][8 * s2 + 2], S[kb][8 * s2 + 3]); pw.z = cvtpk(S[kb][8 * s2 + 4], S[kb][8 * s2 + 5]); pw.w = cvtpk(S[kb][8 * s2 + 6], S[kb][8 * s2 + 7]);
                const bf16x8s pf = __builtin_bit_cast(bf16x8s, pw);
                typedef short s16x4 __attribute__((ext_vector_type(4)));
                const LAS unsigned char* vb = Vl + (32 * wq + 32 * kb + 16 * s2 + 4 * hh + ((lane & 15) >> 2)) * AT_KROW + (16 * ((lane >> 4) & 1) + 4 * (lane & 3)) * 2;
#pragma unroll
                for (int db = 0; db < 2; ++db) {
                    const v2u lo = __builtin_bit_cast(v2u, __builtin_amdgcn_ds_read_tr16_b64_v4i16((LAS s16x4*)(vb + 64 * db))), hi = __builtin_bit_cast(v2u, __builtin_amdgcn_ds_read_tr16_b64_v4i16((LAS s16x4*)(vb + 64 * db + 8 * AT_KROW)));
                    const v4u vw = (v4u){lo.x, lo.y, hi.x, hi.y};
                    O[db] = __builtin_amdgcn_mfma_f32_32x32x16_bf16(__builtin_bit_cast(bf16x8s, vw), pf, O[db], 0, 0, 0); }
            }
        }
        const float il = __builtin_amdgcn_rcpf(l); float lse = mx + __builtin_amdgcn_logf(l);
        const size_t row = rowq;
        float wn = il, wo = 0.f;
        if (!first) { const float lo = LSE[row * 16 + h]; const float mm = fmaxf(lo, lse), eo = __builtin_amdgcn_exp2f(lo - mm), en = __builtin_amdgcn_exp2f(lse - mm), inv = __builtin_amdgcn_rcpf(eo + en); wn = en * inv * il; wo = eo * inv; lse = mm + __builtin_amdgcn_logf(eo + en); }
        if (hh == 0) LSE[row * 16 + h] = lse;
#pragma unroll
        for (int db = 0; db < 2; ++db)
#pragma unroll
            for (int gq = 0; gq < 4; ++gq) { v2u* op = (v2u*)(OACC + row * D + h * 64 + 32 * db + 8 * gq + 4 * hh);
                v2u x = (v2u){0u, 0u}; if (!first) x = *op;
                v2u y; y.x = cvtpk(wn * O[db][4 * gq + 0] + wo * bflo(x.x), wn * O[db][4 * gq + 1] + wo * bfhi(x.x)); y.y = cvtpk(wn * O[db][4 * gq + 2] + wo * bflo(x.y), wn * O[db][4 * gq + 3] + wo * bfhi(x.y));
                *op = y; }
    }
#undef AT_FETCH_K
#undef AT_FETCH_V
    __syncthreads();
}


struct Args { const float* in[11]; float* out; unsigned char* ws; int ph_lo, ph_hi; };
__global__ void __launch_bounds__(NTHREADS, 2) mk_fwd(Args args) {
    extern __shared__ __attribute__((aligned(16))) unsigned char lds_raw[];
    LAS unsigned char* lds = (LAS unsigned char*)lds_raw;
    volatile LAS unsigned* MISC = (volatile LAS unsigned*)(lds + MISC_OFF);
    const int wave0 = __builtin_amdgcn_readfirstlane(threadIdx.x >> 6);
    for (int u = threadIdx.x; u < (LDS_BYTES - LDSCTL_OFF) / 4; u += NTHREADS) ((LAS unsigned*)(lds + LDSCTL_OFF))[u] = 0u;
    __syncthreads();
    (void)xcd_barrier_post((unsigned*)(args.ws + WS_CTL) + CW_BAR, MISC + 8);
    bool again = false;
    for (int ph = args.ph_lo; ph < args.ph_hi; ++ph) {
        unsigned char* ws = args.ws; asm volatile("" : "+s"(ws));
        int bid = blockIdx.x, G = gridDim.x; asm volatile("" : "+s"(bid), "+s"(G));
        const int gw = bid * NWAVES + wave0, NGW = G * NWAVES;
#define GET_TID() int tid; asm volatile("v_mbcnt_lo_u32_b32 %0, -1, 0\n\tv_mbcnt_hi_u32_b32 %0, -1, %0" : "=v"(tid)); const int lane = tid; tid += wave0 * 64; (void)lane;
        LAS float* scr = (LAS float*)(lds + RING_OFF + wave0 * CV_SCR);
        const float* gains = args.in[1]; float* out = args.out;
        float* RS = (float*)(ws + WS_RS);
        enum { T_P0, T_G1, T_FG, T_THIN, T_APROJ, T_ATT, T_RPROJ, T_RCORE, T_RCOMB };
        int type, L = 0, kind = 0, aux = 0;
        if (ph == 0) type = T_P0;
        else { const int p = ph - 1, q = p % 14; L = p / 14;
            if (q < 3) { kind = 0; type = q == 0 ? T_G1 : (q == 1 ? T_FG : T_THIN); }
            else if (q >= 11) { kind = 2; type = q == 11 ? T_G1 : (q == 12 ? T_FG : T_THIN); }
            else { kind = 1; const int r = q - 3;
                if (r == 6) type = T_FG; else if (r == 7) type = T_THIN;
                else if ((L & 1) == 0) { aux = r >> 1; type = (r & 1) ? T_ATT : T_APROJ; }
                else { aux = r / 3; const int st = r % 3; type = st == 0 ? T_RPROJ : (st == 1 ? T_RCORE : T_RCOMB); } } }
        const bool is_att = (L & 1) == 0; const int jj = L >> 1;
#define P_BIAS ((float*)(ws + WS_BIAS))
#define P_WA   ((bf16*)(ws + WS_W))
#define P_XH   ((bf16*)(ws + WS_XH))
#define P_BIG  ((bf16*)(ws + WS_BIG))
#define P_F    ((bf16*)(ws + WS_F))
#define P_YC   ((bf16*)(ws + WS_YC))
#define P_OACC ((bf16*)(ws + WS_OACC))
#define P_LSE  ((float*)(ws + WS_LSE))
        if (type == T_P0) {
            GET_TID()
            const float* rel_bias = args.in[7];
            if (bid == 0) for (int i = tid; i < 3 * 16 * 129; i += NTHREADS) { const int g = i / (16 * 129), h = (i / 129) % 16, kk = i % 129; P_BIAS[i] = rel_bias[(g * 16 + h) * 32 + T5_BUCKET[g][kk]] * 1.4426950409f; }
            conv_gateup(args.in[2], args.in[3], P_WA, gains, scr, gw, NGW, lane);
            conv_plain<DFF, D>(args.in[4], (bf16*)(ws + WS_W2_FFN), nullptr, scr, gw, NGW, lane);
            p0_rows(args.in[0], P_XH, RS, gw, NGW, lane);
#if PROBE_MFMA
            {
                typedef short bx8 __attribute__((ext_vector_type(8)));
                bx8 a = {1, 2, 3, 4, 5, 6, 7, (short)lane}, b = {3, 1, 4, 1, 5, 9, 2, (short)(lane + 1)};
                f32x4 c0 = {0, 0, 0, 0}, c1 = c0, c2 = c0, c3 = c0, c4 = c0, c5 = c0, c6 = c0, c7 = c0;
                for (int it = 0; it < PROBE_MFMA; ++it) {
#pragma unroll
                    for (int r = 0; r < 4; ++r) {
                        c0 = __builtin_amdgcn_mfma_f32_16x16x32_bf16(a, b, c0, 0, 0, 0); c1 = __builtin_amdgcn_mfma_f32_16x16x32_bf16(a, b, c1, 0, 0, 0); c2 = __builtin_amdgcn_mfma_f32_16x16x32_bf16(a, b, c2, 0, 0, 0); c3 = __builtin_amdgcn_mfma_f32_16x16x32_bf16(a, b, c3, 0, 0, 0);
                        c4 = __builtin_amdgcn_mfma_f32_16x16x32_bf16(a, b, c4, 0, 0, 0); c5 = __builtin_amdgcn_mfma_f32_16x16x32_bf16(a, b, c5, 0, 0, 0); c6 = __builtin_amdgcn_mfma_f32_16x16x32_bf16(a, b, c6, 0, 0, 0); c7 = __builtin_amdgcn_mfma_f32_16x16x32_bf16(a, b, c7, 0, 0, 0); }
                    asm volatile("" : "+v"(a), "+v"(b)); }
                const f32x4 t = c0 + c1 + c2 + c3 + c4 + c5 + c6 + c7;
                if (t.x + t.y + t.z + t.w == 12345.678f) P_BIAS[60000 + tid] = t.x;
            }
#endif
        } else if (type == T_G1) {
            GET_TID()
            pg8::Gemm g{P_XH, P_WA, M, 2 * DFF, D, 0}; pg8::StaticOrder S; S.init(M, 2 * DFF, G, bid);
            pg8::stage_scales(lds + RING_OFF, S, RS, false, 0, tid);
            pg8::EpiSwiGLU E{P_BIG, DFF, (const LAS float*)(lds + RING_OFF + pg8::RS_TAB_OFF)};
            pg8::gemm_phase<pg8::EpiSwiGLU, pg8::StaticOrder, true, true>(lds + RING_OFF, g, S, E, tid);
#if PROBE_G1V >= 0
            { GET_TID() pg8::Gemm g2{P_XH, P_WA, M, 2 * DFF, D, 0}; pg8::StaticOrder S2; S2.init(M, 2 * DFF, G, bid);
              pg8::EpiSwiGLUT<PROBE_G1V> E2{PROBE_G1V ? P_F : P_BIG, PROBE_G1V ? D : DFF, (const LAS float*)(lds + RING_OFF + pg8::RS_TAB_OFF)};
              pg8::gemm_phase<pg8::EpiSwiGLUT<PROBE_G1V>, pg8::StaticOrder, true, true>(lds + RING_OFF, g2, S2, E2, tid); }
#endif
        } else if (type == T_FG) {
            GET_TID()
            const size_t fA = kind != 1 ? WS_BIG : (is_att ? WS_OACC : WS_YC), fB = kind != 1 ? WS_W2_FFN : (is_att ? WS_W2_ATT : WS_W2_RET); const int fK = kind != 1 ? DFF : (is_att ? D : DV);
            pg8::Gemm g{(const bf16*)(ws + fA), (const bf16*)(ws + fB), M, D, fK, 0}; pg8::StaticOrder S; S.init(M, D, G, bid);
            pg8::EpiPlain E{P_F, D, (const LAS float*)nullptr};
            pg8::gemm_phase<pg8::EpiPlain, pg8::StaticOrder, true, true>(lds + RING_OFF, g, S, E, tid);
#if PROBE_FGM
            if (kind != 1) { GET_TID()
                pg8::Gemm g2{(const bf16*)(ws + fA), (const bf16*)(ws + fB), PROBE_FGM, D, fK, 0}; pg8::StaticOrder S2; S2.init(PROBE_FGM, D, G, bid);
                pg8::EpiPlain E2{P_XH, D, (const LAS float*)nullptr};
                pg8::gemm_phase<pg8::EpiPlain, pg8::StaticOrder, true, true>(lds + RING_OFF, g2, S2, E2, tid); }
#endif
        } else if (type == T_THIN) {
            GET_TID()
            const int sub = L * 3 + kind;
            for (int crep = 0; crep < 1 + PROBE_CONV2; ++crep)
            if (sub + 1 < 3 * DEPTH) {
                const int nk = (sub + 1) % 3, nL = (sub + 1) / 3, nj = nL >> 1;
                const float* gn = gains + ((size_t)nL * 6 + (nk == 0 ? 0 : (nk == 1 ? 2 : 4))) * D;
                if (nk != 1) { const size_t o = (size_t)(nL * 2 + (nk >> 1)) * D * DFF;
                    conv_gateup(args.in[2] + o, args.in[3] + o, P_WA, gn, scr, gw, NGW, lane); conv_plain<DFF, D>(args.in[4] + o, (bf16*)(ws + WS_W2_FFN), nullptr, scr, gw, NGW, lane); }
                else if ((nL & 1) == 0) { conv_plain<D, NGRP * ATT_COLS>(args.in[5] + (size_t)nj * D * NGRP * ATT_COLS, P_WA, gn, scr, gw, NGW, lane); conv_plain<D, D>(args.in[6] + (size_t)nj * D * D, (bf16*)(ws + WS_W2_ATT), nullptr, scr, gw, NGW, lane); }
                else { const float* rw = args.in[8] + (size_t)nj * D * RET_COLS;
                    conv_cols<D, RET_COLS, D>(rw, 0, P_WA, 0, gn, scr, gw, NGW, lane); conv_cols<D, RET_COLS, 2 * DV>(rw, 2 * D + DV, P_WA, D, gn, scr, gw, NGW, lane);
                    conv_cols<D, RET_COLS, D>(rw, D, P_WA, D + 2 * DV, gn, scr, gw, NGW, lane); conv_cols<D, RET_COLS, DV>(rw, 2 * D, P_WA, 2 * D + 2 * DV, gn, scr, gw, NGW, lane);
                    conv_plain<DV, D>(args.in[9] + (size_t)nj * DV * D, (bf16*)(ws + WS_W2_RET), nullptr, scr, gw, NGW, lane); }
            }
            asm volatile("" ::: "memory");
            const float* gpost = gains + ((size_t)L * 6 + (kind == 0 ? 1 : (kind == 1 ? 3 : 5))) * D;
            thin_rows(P_F, P_XH, gpost, kind == 1 ? 1.0f : 0.5f, RS, sub + 1 < 3 * DEPTH ? nullptr : out, gw, NGW, lane);
        } else if (type == T_APROJ) {
            GET_TID()
            { pg8::Gemm g{P_XH, P_WA + (size_t)aux * ATT_COLS * D, M, ATT_COLS, D, 0}; pg8::StaticOrder S; S.init(M, ATT_COLS, G, bid);
              pg8::stage_scales(lds + RING_OFF, S, RS, false, 0, tid);
              pg8::EpiPlain E{P_BIG, ATT_COLS, (const LAS float*)(lds + RING_OFF + pg8::RS_TAB_OFF)};
              pg8::gemm_phase<pg8::EpiPlain, pg8::StaticOrder, true, true>(lds + RING_OFF, g, S, E, tid); }
        } else if (type == T_ATT) {
            GET_TID()
            const int ldil = 2 * aux;
            attn_group_mfma2(P_BIG, P_BIAS + aux * 16 * 129, ldil, aux == 0, P_OACC, P_LSE, lds + RING_OFF, tid, bid, G);
        } else if (type == T_RPROJ) {
            GET_TID()
            { pg8::Gemm g{P_XH + (size_t)aux * MH * D, P_WA, MH, RP_COLS, D, 0}; pg8::StaticOrder S; S.init(MH, RP_COLS, G, bid);
              pg8::stage_scales(lds + RING_OFF, S, RS + (size_t)aux * MH, false, 0, tid);
              pg8::EpiRet E{P_BIG, RP_COLS, (const LAS float*)(lds + RING_OFF + pg8::RS_TAB_OFF)};
              pg8::gemm_phase<pg8::EpiRet, pg8::StaticOrder, true, true>(lds + RING_OFF, g, S, E, tid); }
            { GET_TID()
              pg8::Gemm g{P_WA + (size_t)RP_COLS * D, P_XH + (size_t)aux * MH * D, DV, MH, D, 0}; pg8::StaticOrder S; S.init(DV, MH, G, bid);
              pg8::stage_scales(lds + RING_OFF, S, RS + (size_t)aux * MH, true, 0, tid);
              pg8::EpiVT E{(bf16*)(ws + WS_RVT), MH, 0, (const LAS float*)(lds + RING_OFF + pg8::RS_TAB_OFF)};
              pg8::gemm_phase<pg8::EpiVT, pg8::StaticOrder, true, true>(lds + RING_OFF, g, S, E, tid); }
        } else if (type == T_RCORE) {
            GET_TID()
            static_assert(RC_LDS <= RING_BYTES, "retention core LDS tiles");
            ret_core_mfma<0>(P_BIG, (const bf16*)(ws + WS_RVT), args.in[10] + jj * 2 * HR, P_YC + (size_t)aux * MH * DV, (bf16*)out, lds + RING_OFF, tid, bid, G);
#if PROBE_RC >= 0
            { GET_TID() ret_core_mfma<PROBE_RC>(P_BIG, (const bf16*)(ws + WS_RVT), args.in[10] + jj * 2 * HR, (bf16*)out + (size_t)MH * DV, (bf16*)out + (size_t)MH * DV, lds + RING_OFF, tid, bid, G); }
#endif
        } else {
            GET_TID()
            ret_combine(P_BIG, P_YC + (size_t)aux * MH * DV, (const bf16*)out, gw, NGW, lane);
        }
        if (ph + 1 < args.ph_hi) { XcdBarrier b_; b_.bar = (unsigned*)(ws + WS_CTL) + CW_BAR; b_.x = xb_xcc_id(); b_.st = MISC + 8; xcd_barrier(b_);
#if PROBE_BAR2
            xcd_barrier(b_);
#endif
        }
        if (PROBE_REPEAT) {
            if (!again && ((PROBE_REPEAT >> type) & 1) && (type != T_ATT || aux == 0) && ph + 1 < args.ph_hi) { again = true; --ph; } else again = false; }
    }
}

extern "C" void kernel_launch(void* const* d_in, const int* in_sizes, int n_in, void* d_out, int out_size, void* d_ws, size_t ws_size, hipStream_t stream) {
    static int grid = 0;
    if (grid == 0) {
        if (n_in != 11 || in_sizes[0] != M * D || out_size != M * D || ws_size < WS_END) { fprintf(stderr, "kernel_launch: unexpected shapes / workspace (n_in %d, ws %zu, need %zu); nothing launched\n", n_in, ws_size, (size_t)WS_END); grid = -1; return; }
        int dev = 0, cus = 0, per_cu = 0;
        if (hipGetDevice(&dev) != hipSuccess || hipDeviceGetAttribute(&cus, hipDeviceAttributeMultiprocessorCount, dev) != hipSuccess) { grid = -1; return; }
        if (hipFuncSetAttribute((const void*)mk_fwd, hipFuncAttributeMaxDynamicSharedMemorySize, LDS_BYTES) != hipSuccess) { fprintf(stderr, "kernel_launch: hipFuncSetAttribute failed\n"); grid = -1; return; }
        if (hipOccupancyMaxActiveBlocksPerMultiprocessor(&per_cu, (const void*)mk_fwd, NTHREADS, LDS_BYTES) != hipSuccess || per_cu < 1) { fprintf(stderr, "kernel_launch: occupancy query reports %d workgroups per CU\n", per_cu); }
        (void)hipGetLastError();
        grid = cus;
    }
    if (grid < 0) return;
    if (hipMemsetAsync((char*)d_ws + WS_CTL, 0, CTL_ZERO_BYTES, stream) != hipSuccess) return;
    Args a{};
    for (int i = 0; i < 11; ++i) a.in[i] = (const float*)d_in[i];
    a.out = (float*)d_out; a.ws = (unsigned char*)d_ws;
#if MK_ONE_LAUNCH
    a.ph_lo = 0; a.ph_hi = NPHASES;
    hipLaunchKernelGGL(mk_fwd, dim3(grid), dim3(NTHREADS), LDS_BYTES, stream, a);
#else
    for (int p = 0; p < NPHASES; ++p) { a.ph_lo = p; a.ph_hi = p + 1; hipLaunchKernelGGL(mk_fwd, dim3(grid), dim3(NTHREADS), LDS_BYTES, stream, a); }
#endif
}
```

```cpp
#include <hip/hip_runtime.h>
#include <cstdio>
#include <cstdint>
#ifndef PROBE_REPEAT
#define PROBE_REPEAT 0
#endif
#ifndef PROBE_THIN2
#define PROBE_THIN2 0
#endif
#ifndef PROBE_ATT2
#define PROBE_ATT2 0
#endif
#ifndef PROBE_CONV2
#define PROBE_CONV2 0
#endif
#ifndef PROBE_FGM
#define PROBE_FGM 0
#endif
#ifndef PROBE_RC
#define PROBE_RC -1
#endif
#ifndef PROBE_G1V
#define PROBE_G1V -1
#endif
#ifndef PROBE_BAR2
#define PROBE_BAR2 0
#endif
#ifndef PROBE_MFMA
#define PROBE_MFMA 0
#endif
#ifndef PROBE_TWICE
#define PROBE_TWICE 0
#endif
#ifndef PROBE_TOUCH
#define PROBE_TOUCH 0
#endif
#ifndef MK_ONE_LAUNCH
#define MK_ONE_LAUNCH 1
#endif
namespace pg8 {
#define PG8_LAS __attribute__((address_space(3)))
typedef unsigned short bf16_t;
typedef short bf16x8 __attribute__((ext_vector_type(8)));
typedef float f32x4 __attribute__((ext_vector_type(4)));
typedef unsigned u32x4 __attribute__((ext_vector_type(4)));
constexpr int BM = 256, BK = 64, HALF = 128, HTB = HALF * BK * 2  , STAGE_BYTES = 8 * HTB, NXCD = 8, WGM = 8;

__host__ __device__ __forceinline__ int lds_byte(int r, int c) { const int st = (r >> 4) * 2 + (c >> 5), rr = r & 15, cc = c & 31, ob = rr * 64 + cc * 2; return st * 1024 + (ob ^ (((ob >> 9) & 1) << 5)); }
__host__ __device__ __forceinline__ void stage_rc(int b, int& R, int& C) { const int st = b / 1024, sb = b % 1024, swz = sb ^ (((sb >> 9) & 1) << 5); R = (st >> 1) * 16 + swz / 64; C = (st & 1) * 32 + (swz % 64) / 2; }
__host__ __device__ __forceinline__ int perm32(int rho) { const int n = rho >> 4, i = rho & 15; return 8 * (i >> 2) + 4 * n + (i & 3); }

struct Unit { int pm, pn, idx; };
struct Gemm { const bf16_t* A; const bf16_t* Bt; int M, N, K; int ldil; };

struct StaticOrder {
    int nM, nN, nwg, G, c;
    __host__ __device__ void init(int M, int N, int G_, int c_) { nM = M / BM; nN = N / BM; nwg = nM * nN; G = G_; c = c_; }
    __host__ __device__ bool next(int i, Unit& u) const {
        const long L = (long)i * G + c; if (L >= nwg) return false;
        int wgid = (int)L; { const int q = nwg / NXCD, r = nwg % NXCD, xcd = wgid % NXCD, off = wgid / NXCD; wgid = (xcd < r ? xcd * (q + 1) : r * (q + 1) + (xcd - r) * q) + off; }
        const int nig = WGM * nN, gid = wgid / nig, fm = gid * WGM, gsz = (nM - fm) < WGM ? (nM - fm) : WGM;
        u.pm = fm + ((wgid % nig) % gsz); u.pn = (wgid % nig) / gsz; u.idx = i; return true;
    }
    __device__ __forceinline__ void a_ready(const Unit&) const {}
    __device__ __forceinline__ void done(const Unit&) const {}
};

__device__ __forceinline__ unsigned cvt_pk_bf16(float lo, float hi) { unsigned r; asm volatile("v_cvt_pk_bf16_f32 %0, %1, %2" : "=v"(r) : "v"(lo), "v"(hi)); return r; }
typedef float f32x2 __attribute__((ext_vector_type(2)));

__device__ __forceinline__ float fast_sigmoid(float g) { return __builtin_amdgcn_rcpf(1.0f + __builtin_amdgcn_exp2f(-1.4426950409f * g)); }
constexpr int RS_TAB_OFF = 131072;
template <class Sched> __device__ __forceinline__ void stage_scales(PG8_LAS unsigned char* lds, const Sched& S, const float* rs, bool cols, int ldil, int tid) {
    PG8_LAS float* tab = (PG8_LAS float*)(lds + RS_TAB_OFF); Unit u;
    if (tid < 256) { const int lper = 8 - ldil, c = tid, tm = ((c & ((1 << lper) - 1)) << ldil) + (c >> lper);
        for (int i = 0; i < 16 && S.next(i, u); ++i) tab[i * 256 + tid] = rs[cols ? u.pn * BM + tm : u.pm * BM + tid]; }
    __syncthreads();
}
struct EpiPlain {
    static constexpr bool PERM = true, AFTER_DRAIN = false;
    bf16_t* O; int ldc; const PG8_LAS float* tab;
    __device__ __forceinline__ void operator()(const f32x4 (&acc)[2][2][4][2], const Unit& u, int wr, int wc, int fr, int fq) const {
        const int row0 = u.pm * BM + wr * 64 + fr, col0 = u.pn * BM + wc * 32 + 8 * fq;
#pragma unroll
        for (int ai = 0; ai < 2; ++ai)
#pragma unroll
            for (int m = 0; m < 4; ++m) { const int row = row0 + ai * HALF + m * 16; bf16_t* rowp = O + (size_t)row * ldc + col0; const float r = tab ? tab[u.idx * 256 + (row & 255)] : 1.0f;
#pragma unroll
                for (int bj = 0; bj < 2; ++bj) { const f32x4 v0 = acc[ai][bj][m][0] * r, v1 = acc[ai][bj][m][1] * r;
                    u32x4 w; w.x = cvt_pk_bf16(v0[0], v0[1]); w.y = cvt_pk_bf16(v0[2], v0[3]); w.z = cvt_pk_bf16(v1[0], v1[1]); w.w = cvt_pk_bf16(v1[2], v1[3]);
                    *(u32x4*)(rowp + bj * HALF) = w; } }
    }
};
template <int CHEAP = 0  > struct EpiSwiGLUT {
    static constexpr bool PERM = true, AFTER_DRAIN = false;
    bf16_t* O; int ldc; const PG8_LAS float* tab;
    __device__ __forceinline__ void operator()(const f32x4 (&acc)[2][2][4][2], const Unit& u, int wr, int wc, int fr, int fq) const {
        const int row0 = u.pm * BM + wr * 64 + fr, col0 = CHEAP ? ((u.pn * HALF + wc * 32 + 8 * fq) & 1023) : (u.pn * HALF + wc * 32 + 8 * fq);
#pragma unroll
        for (int ai = 0; ai < 2; ++ai)
#pragma unroll
            for (int m = 0; m < 4; ++m) { const int row = row0 + ai * HALF + m * 16; bf16_t* rowp = O + (size_t)row * ldc + col0; const float r = tab[u.idx * 256 + (row & 255)];
                float o[8];
#pragma unroll
                for (int n = 0; n < 2; ++n)
#pragma unroll
                    for (int e = 0; e < 4; ++e) { const float g = acc[ai][0][m][n][e] * r, up = acc[ai][1][m][n][e] * r; o[n * 4 + e] = CHEAP ? g * up : g * fast_sigmoid(g) * up; }
                u32x4 w; w.x = cvt_pk_bf16(o[0], o[1]); w.y = cvt_pk_bf16(o[2], o[3]); w.z = cvt_pk_bf16(o[4], o[5]); w.w = cvt_pk_bf16(o[6], o[7]);
                if (CHEAP == 2) { if (w.x == 0x12345678u && w.y == w.z) *(u32x4*)rowp = w; } else *(u32x4*)rowp = w; }
    }
};
typedef EpiSwiGLUT<0> EpiSwiGLU;
struct EpiRet {
    static constexpr bool PERM = true, AFTER_DRAIN = false;
    bf16_t* O; int ldc; const PG8_LAS float* tab;
    __device__ __forceinline__ void operator()(const f32x4 (&acc)[2][2][4][2], const Unit& u, int wr, int wc, int fr, int fq) const {
        const int row0 = u.pm * BM + wr * 64 + fr, col0 = u.pn * BM + wc * 32 + 8 * fq;
        if (u.pn < 4 || u.pn >= 20) {
            const float osc = (u.pn >= 4) ? 0.0625f : 1.0f;
            float invf[8];
#pragma unroll
            for (int q = 0; q < 8; ++q) { const int j = wc * 32 + 8 * fq + q; invf[q] = __builtin_amdgcn_exp2f(-(float)j * (13.287712379549449f / 127.0f)) * 0.15915494309189535f; }
#pragma unroll
            for (int ai = 0; ai < 2; ++ai)
#pragma unroll
                for (int m = 0; m < 4; ++m) { const int row = row0 + ai * HALF + m * 16; const float pos = (float)(row & 2047), r = tab[u.idx * 256 + (row & 255)] * osc;
                    bf16_t* rowp = O + (size_t)row * ldc + col0;
                    float o1[8], o2[8];
#pragma unroll
                    for (int n = 0; n < 2; ++n)
#pragma unroll
                        for (int e = 0; e < 4; ++e) { const int q = n * 4 + e; float t = pos * invf[q]; t = __builtin_amdgcn_fractf(t);
                            const float sn = __builtin_amdgcn_sinf(t), cs = __builtin_amdgcn_cosf(t);
                            const float a = acc[ai][0][m][n][e], b = acc[ai][1][m][n][e];
                            o1[q] = (a * cs - b * sn) * r; o2[q] = (a * sn + b * cs) * r; }
                    u32x4 w; w.x = cvt_pk_bf16(o1[0], o1[1]); w.y = cvt_pk_bf16(o1[2], o1[3]); w.z = cvt_pk_bf16(o1[4], o1[5]); w.w = cvt_pk_bf16(o1[6], o1[7]);
                    *(u32x4*)rowp = w;
                    w.x = cvt_pk_bf16(o2[0], o2[1]); w.y = cvt_pk_bf16(o2[2], o2[3]); w.z = cvt_pk_bf16(o2[4], o2[5]); w.w = cvt_pk_bf16(o2[6], o2[7]);
                    *(u32x4*)(rowp + HALF) = w; }
        } else {
#pragma unroll
            for (int ai = 0; ai < 2; ++ai)
#pragma unroll
                for (int m = 0; m < 4; ++m) { const int row = row0 + ai * HALF + m * 16; bf16_t* rowp = O + (size_t)row * ldc + col0; const float r = tab[u.idx * 256 + (row & 255)];
#pragma unroll
                    for (int bj = 0; bj < 2; ++bj) { const f32x4 v0 = acc[ai][bj][m][0] * r, v1 = acc[ai][bj][m][1] * r;
                        u32x4 w; w.x = cvt_pk_bf16(v0[0], v0[1]); w.y = cvt_pk_bf16(v0[2], v0[3]); w.z = cvt_pk_bf16(v1[0], v1[1]); w.w = cvt_pk_bf16(v1[2], v1[3]);
                        *(u32x4*)(rowp + bj * HALF) = w; } }
        }
    }
};

struct EpiVT {
    static constexpr bool PERM = true, AFTER_DRAIN = false;
    bf16_t* O; int ldc; int ldil; const PG8_LAS float* tab;
    __device__ __forceinline__ void operator()(const f32x4 (&acc)[2][2][4][2], const Unit& u, int wr, int wc, int fr, int fq) const {
        const int lper = 8 - ldil, per = 1 << lper, Ls = 2048 >> ldil, b = u.pn >> 3, pl = u.pn & 7;
        const int row0 = u.pm * BM + wr * 64 + fr;
        int colb[2]; float cs[2][8];
#pragma unroll
        for (int bj = 0; bj < 2; ++bj) { const int c0 = bj * HALF + wc * 32 + 8 * fq; colb[bj] = b * 2048 + (c0 >> lper) * Ls + pl * per + (c0 & (per - 1));
            const f32x4 a = *(const PG8_LAS f32x4*)(tab + u.idx * 256 + c0), b4 = *(const PG8_LAS f32x4*)(tab + u.idx * 256 + c0 + 4);
            cs[bj][0] = a[0]; cs[bj][1] = a[1]; cs[bj][2] = a[2]; cs[bj][3] = a[3]; cs[bj][4] = b4[0]; cs[bj][5] = b4[1]; cs[bj][6] = b4[2]; cs[bj][7] = b4[3]; }
#pragma unroll
        for (int ai = 0; ai < 2; ++ai)
#pragma unroll
            for (int m = 0; m < 4; ++m) { bf16_t* rowp = O + (size_t)(row0 + ai * HALF + m * 16) * ldc;
#pragma unroll
                for (int bj = 0; bj < 2; ++bj) { const f32x4 v0 = acc[ai][bj][m][0], v1 = acc[ai][bj][m][1];
                    u32x4 w; w.x = cvt_pk_bf16(v0[0] * cs[bj][0], v0[1] * cs[bj][1]); w.y = cvt_pk_bf16(v0[2] * cs[bj][2], v0[3] * cs[bj][3]); w.z = cvt_pk_bf16(v1[0] * cs[bj][4], v1[1] * cs[bj][5]); w.w = cvt_pk_bf16(v1[2] * cs[bj][6], v1[3] * cs[bj][7]);
                    *(u32x4*)(rowp + colb[bj]) = w; } }
    }
};

struct EpiKVT {
    static constexpr bool PERM = true, AFTER_DRAIN = false;
    bf16_t* OK; bf16_t* OV; int ldc; const PG8_LAS float* tab;
    __device__ __forceinline__ void operator()(const f32x4 (&acc)[2][2][4][2], const Unit& u, int wr, int wc, int fr, int fq) const {
        const int col0 = u.pn * BM + wc * 32 + 8 * fq;
        float cs[2][8];
#pragma unroll
        for (int bj = 0; bj < 2; ++bj) { const int cl = bj * HALF + wc * 32 + 8 * fq; const f32x4 a = *(const PG8_LAS f32x4*)(tab + u.idx * 256 + cl), b = *(const PG8_LAS f32x4*)(tab + u.idx * 256 + cl + 4);
            cs[bj][0] = a[0]; cs[bj][1] = a[1]; cs[bj][2] = a[2]; cs[bj][3] = a[3]; cs[bj][4] = b[0]; cs[bj][5] = b[1]; cs[bj][6] = b[2]; cs[bj][7] = b[3]; }
        if (u.pm < 4) {
#pragma unroll
            for (int m = 0; m < 4; ++m) { const int j = wr * 64 + m * 16 + fr;
                const float invf = __builtin_amdgcn_exp2f(-(float)j * (13.287712379549449f / 127.0f)) * 0.15915494309189535f;
                bf16_t* r1 = OK + (size_t)(u.pm * BM + j) * ldc + col0; bf16_t* r2 = r1 + (size_t)HALF * ldc;
#pragma unroll
                for (int bj = 0; bj < 2; ++bj) { float o1[8], o2[8];
#pragma unroll
                    for (int n = 0; n < 2; ++n)
#pragma unroll
                        for (int e = 0; e < 4; ++e) { const int q = n * 4 + e; const float pos = (float)((col0 + bj * HALF + q) & 2047); float t = pos * invf; t = __builtin_amdgcn_fractf(t);
                            const float sn = __builtin_amdgcn_sinf(t), cn = __builtin_amdgcn_cosf(t), sc = cs[bj][q] * 0.0625f;
                            const float a = acc[0][bj][m][n][e], b = acc[1][bj][m][n][e];
                            o1[q] = (a * cn - b * sn) * sc; o2[q] = (a * sn + b * cn) * sc; }
                    u32x4 w; w.x = cvt_pk_bf16(o1[0], o1[1]); w.y = cvt_pk_bf16(o1[2], o1[3]); w.z = cvt_pk_bf16(o1[4], o1[5]); w.w = cvt_pk_bf16(o1[6], o1[7]);
                    *(u32x4*)(r1 + bj * HALF) = w;
                    w.x = cvt_pk_bf16(o2[0], o2[1]); w.y = cvt_pk_bf16(o2[2], o2[3]); w.z = cvt_pk_bf16(o2[4], o2[5]); w.w = cvt_pk_bf16(o2[6], o2[7]);
                    *(u32x4*)(r2 + bj * HALF) = w; } }
        } else {
            const int row0 = (u.pm - 4) * BM + wr * 64 + fr;
#pragma unroll
            for (int ai = 0; ai < 2; ++ai)
#pragma unroll
                for (int m = 0; m < 4; ++m) { bf16_t* rowp = OV + (size_t)(row0 + ai * HALF + m * 16) * ldc + col0;
#pragma unroll
                    for (int bj = 0; bj < 2; ++bj) { const f32x4 v0 = acc[ai][bj][m][0], v1 = acc[ai][bj][m][1];
                        u32x4 w; w.x = cvt_pk_bf16(v0[0] * cs[bj][0], v0[1] * cs[bj][1]); w.y = cvt_pk_bf16(v0[2] * cs[bj][2], v0[3] * cs[bj][3]); w.z = cvt_pk_bf16(v1[0] * cs[bj][4], v1[1] * cs[bj][5]); w.w = cvt_pk_bf16(v1[2] * cs[bj][6], v1[3] * cs[bj][7]);
                        *(u32x4*)(rowp + bj * HALF) = w; } }
        }
    }
};

template <class Epi, class Sched, bool ALIGN_EPI = false, bool SP2 = false>
__device__ __forceinline__ void gemm_phase(PG8_LAS unsigned char* lds, const Gemm g, const Sched& S, const Epi& E, const int tid) {
    const int wid = __builtin_amdgcn_readfirstlane(tid >> 6), lane = tid & 63, wr = wid >> 2, wc = wid & 3, fr = lane & 15, fq = lane >> 4;
    const int K = g.K, nt = K / BK;
    unsigned voffA[2], voffB[2], voffB1[2];
#pragma unroll
    for (int i = 0; i < 2; ++i) { int R, C; stage_rc(tid * 16 + i * 8192, R, C); const int Rb = Epi::PERM ? ((R & ~31) + perm32(R & 31)) : R;
        voffA[i] = (unsigned)(R * K + C) * 2u; { const int ld = g.ldil, lper = 8 - ld, pm1 = (1 << lper) - 1; const int c0 = Rb, c1 = 128 + Rb; voffB[i] = (unsigned)((((c0 & pm1) << ld) + (c0 >> lper)) * K + C) * 2u; voffB1[i] = (unsigned)((((c1 & pm1) << ld) + (c1 >> lper)) * K + C) * 2u; } }
    const size_t kstep = (size_t)(BK * 2);
    const size_t hstep = (size_t)HALF * K * 2;
    const size_t tstep = 2 * hstep;
    const unsigned ldsw = (unsigned)wid * 1024u;
    const int aoff = lds_byte(wr * 64 + fr, fq * 8), boff = lds_byte(wc * 32 + fr, fq * 8);
#define PG8_SA(b, h) (((b) * 2 + (h)) * HTB)
#define PG8_SB(b, h) ((4 + (b) * 2 + (h)) * HTB)
#define PG8_STAGE(bufoff, gbase, voff) do { _Pragma("unroll") for (int _i = 0; _i < 2; ++_i) \
        __builtin_amdgcn_global_load_lds((const unsigned*)((const char*)(gbase) + (voff)[_i]), (PG8_LAS unsigned*)(lds + (bufoff) + ldsw + _i * 8192), 16, 0, 0); } while (0)
#define PG8_LDA(dst, b, h) do { _Pragma("unroll") for (int m = 0; m < 4; ++m) _Pragma("unroll") for (int k = 0; k < 2; ++k) dst[m][k] = *(const PG8_LAS bf16x8*)(lds + PG8_SA(b, h) + aoff + m * 2048 + k * 1024); } while (0)
#define PG8_LDB(dst, b, h) do { _Pragma("unroll") for (int n = 0; n < 2; ++n) _Pragma("unroll") for (int k = 0; k < 2; ++k) dst[n][k] = *(const PG8_LAS bf16x8*)(lds + PG8_SB(b, h) + boff + n * 2048 + k * 1024); } while (0)
#define PG8_MMA(ai, bj, At, Bt) do { __builtin_amdgcn_s_setprio(1); _Pragma("unroll") for (int m = 0; m < 4; ++m) _Pragma("unroll") for (int n = 0; n < 2; ++n) _Pragma("unroll") for (int k = 0; k < 2; ++k) \
        acc[ai][bj][m][n] = __builtin_amdgcn_mfma_f32_16x16x32_bf16(Bt[n][k], At[m][k], acc[ai][bj][m][n], 0, 0, 0); __builtin_amdgcn_s_setprio(0); } while (0)
#define PG8_WAIT_V(n) asm volatile("s_waitcnt vmcnt(" #n ")" ::: "memory")
#define PG8_WAIT_L(n) asm volatile("s_waitcnt lgkmcnt(" #n ")" ::: "memory")
#define PG8_BAR __builtin_amdgcn_s_barrier()
#define PG8_SCHED __builtin_amdgcn_sched_barrier(0)
    Unit cur, nxt; int ui = 0;
    if (!S.next(0, cur)) return;
    f32x4 acc[2][2][4][2];
#pragma unroll
    for (int a = 0; a < 2; ++a)
#pragma unroll
        for (int b = 0; b < 2; ++b)
#pragma unroll
            for (int m = 0; m < 4; ++m)
#pragma unroll
                for (int n = 0; n < 2; ++n) acc[a][b][m][n] = (f32x4){0.f, 0.f, 0.f, 0.f};
    bf16x8 At[4][2], B0[2][2], B1[2][2];
    const char* cA = (const char*)g.A + (size_t)cur.pm * tstep; const char* cB = (const char*)g.Bt + (size_t)cur.pn * tstep;
    S.a_ready(cur);
    if constexpr (SP2) {
        PG8_STAGE(PG8_SB(0, 0), cB, voffB); PG8_STAGE(PG8_SB(0, 1), cB, voffB1); PG8_STAGE(PG8_SA(0, 0), cA, voffA); PG8_STAGE(PG8_SA(0, 1), cA + hstep, voffA);
        if (wr == 1) PG8_BAR;
        PG8_WAIT_V(2); PG8_BAR;
        PG8_STAGE(PG8_SB(1, 0), cB + kstep, voffB); PG8_STAGE(PG8_SA(1, 0), cA + kstep, voffA); PG8_STAGE(PG8_SB(1, 1), cB + kstep, voffB1);
        PG8_WAIT_V(6); PG8_BAR;
    } else {
        PG8_STAGE(PG8_SB(0, 0), cB, voffB); PG8_STAGE(PG8_SA(0, 0), cA, voffA); PG8_STAGE(PG8_SB(0, 1), cB, voffB1); PG8_STAGE(PG8_SA(0, 1), cA + hstep, voffA);
        if (wr == 1) PG8_BAR;
        PG8_WAIT_V(4); PG8_BAR;
        PG8_STAGE(PG8_SB(1, 0), cB + kstep, voffB); PG8_STAGE(PG8_SA(1, 0), cA + kstep, voffA); PG8_STAGE(PG8_SB(1, 1), cB + kstep, voffB1);
        PG8_WAIT_V(6); PG8_BAR;
    }
    for (;;) {
        const bool has_next = S.next(ui + 1, nxt);
        const char* nA = has_next ? (const char*)g.A + (size_t)nxt.pm * tstep : cA; const char* nB = has_next ? (const char*)g.Bt + (size_t)nxt.pn * tstep : cB;
        for (int t = 0; t < nt; t += 2) {
            const bool last = (t == nt - 2);
            const char* a1 = cA + (size_t)(t + 1) * kstep;
            const char* a2 = last ? nA : cA + (size_t)(t + 2) * kstep; const char* b2 = last ? nB : cB + (size_t)(t + 2) * kstep;
            const char* a3 = a2 + kstep; const char* b3 = b2 + kstep;
            if (last && has_next) S.a_ready(nxt);
            if constexpr (SP2) {
            PG8_LDB(B0, 0, 0); PG8_LDB(B1, 0, 1); PG8_SCHED; PG8_LDA(At, 0, 0); PG8_STAGE(PG8_SA(1, 1), a1 + hstep, voffA);
            PG8_WAIT_V(8); PG8_WAIT_L(0); PG8_BAR; PG8_MMA(0, 0, At, B0); PG8_MMA(0, 1, At, B1); PG8_BAR; PG8_SCHED;
            PG8_LDA(At, 0, 1); PG8_STAGE(PG8_SB(0, 0), b2, voffB); PG8_STAGE(PG8_SB(0, 1), b2, voffB1); PG8_STAGE(PG8_SA(0, 0), a2, voffA);
            PG8_WAIT_V(8); PG8_WAIT_L(0); PG8_BAR; PG8_MMA(1, 0, At, B0); PG8_MMA(1, 1, At, B1); PG8_BAR; PG8_SCHED;
            PG8_LDB(B0, 1, 0); PG8_LDB(B1, 1, 1); PG8_SCHED; PG8_LDA(At, 1, 0); PG8_STAGE(PG8_SA(0, 1), a2 + hstep, voffA);
            PG8_WAIT_V(8); PG8_WAIT_L(0); PG8_BAR; PG8_MMA(0, 0, At, B0); PG8_MMA(0, 1, At, B1); PG8_BAR; PG8_SCHED;
            PG8_LDA(At, 1, 1); PG8_STAGE(PG8_SB(1, 0), b3, voffB); PG8_STAGE(PG8_SB(1, 1), b3, voffB1); PG8_STAGE(PG8_SA(1, 0), a3, voffA);
            PG8_WAIT_V(8); PG8_WAIT_L(0); PG8_BAR; PG8_MMA(1, 0, At, B0); PG8_MMA(1, 1, At, B1); PG8_BAR; PG8_SCHED;
            } else {
            PG8_LDB(B0, 0, 0); PG8_SCHED; PG8_LDA(At, 0, 0); PG8_STAGE(PG8_SA(1, 1), a1 + hstep, voffA);
            PG8_WAIT_L(8); PG8_BAR; PG8_WAIT_L(0); PG8_MMA(0, 0, At, B0); PG8_BAR; PG8_SCHED;
            PG8_LDB(B1, 0, 1); PG8_STAGE(PG8_SB(0, 0), b2, voffB);
            PG8_BAR; PG8_WAIT_L(0); PG8_MMA(0, 1, At, B1); PG8_BAR;
            PG8_LDA(At, 0, 1); PG8_STAGE(PG8_SA(0, 0), a2, voffA);
            PG8_BAR; PG8_WAIT_L(0); PG8_MMA(1, 0, At, B0); PG8_BAR; PG8_SCHED;
            PG8_STAGE(PG8_SB(0, 1), b2, voffB1);
            PG8_WAIT_V(6); PG8_BAR; PG8_MMA(1, 1, At, B1); PG8_BAR;
            PG8_LDB(B0, 1, 0); PG8_SCHED; PG8_LDA(At, 1, 0); PG8_STAGE(PG8_SA(0, 1), a2 + hstep, voffA);
            PG8_WAIT_L(8); PG8_BAR; PG8_WAIT_L(0); PG8_MMA(0, 0, At, B0); PG8_BAR; PG8_SCHED;
            PG8_LDB(B1, 1, 1); PG8_STAGE(PG8_SB(1, 0), b3, voffB);
            PG8_BAR; PG8_WAIT_L(0); PG8_MMA(0, 1, At, B1); PG8_BAR;
            PG8_LDA(At, 1, 1); PG8_STAGE(PG8_SA(1, 0), a3, voffA);
            PG8_BAR; PG8_WAIT_L(0); PG8_MMA(1, 0, At, B0); PG8_BAR; PG8_SCHED;
            PG8_STAGE(PG8_SB(1, 1), b3, voffB1);
            PG8_WAIT_V(6); PG8_BAR; PG8_MMA(1, 1, At, B1); PG8_BAR;
            }
        }
        if constexpr (ALIGN_EPI) { if (wr == 0) PG8_BAR; }
        if constexpr (!Epi::AFTER_DRAIN) { E(acc, cur, wr, wc, fr, fq); S.done(cur); }
        if (!has_next) break;
#pragma unroll
        for (int a = 0; a < 2; ++a)
#pragma unroll
            for (int b = 0; b < 2; ++b)
#pragma unroll
                for (int m = 0; m < 4; ++m)
#pragma unroll
                    for (int n = 0; n < 2; ++n) acc[a][b][m][n] = (f32x4){0.f, 0.f, 0.f, 0.f};
        cur = nxt; cA = nA; cB = nB; ++ui;
        if constexpr (ALIGN_EPI) { if (wr == 1) PG8_BAR; }
    }
    PG8_WAIT_V(0);
    if constexpr (!ALIGN_EPI) { if (wr == 0) PG8_BAR; }
    PG8_BAR;
    if constexpr (Epi::AFTER_DRAIN) { E.fused(acc, cur, wr, wc, fr, fq, lds, wid, lane); S.done(cur); }
#undef PG8_SA
#undef PG8_SB
#undef PG8_STAGE
#undef PG8_LDA
#undef PG8_LDB
#undef PG8_MMA
#undef PG8_WAIT_V
#undef PG8_WAIT_L
#undef PG8_BAR
#undef PG8_SCHED
}
}

constexpr int BATCH = 16, SEQ = 2048, D = 1024, M = BATCH * SEQ, DEPTH = 4, DFF = 2816;
constexpr int NGRP = 3, HA = 16, DHA = 64, ATT_COLS = 3 * D;
constexpr int HR = 4, DKR = 256, DVR = 512, DV = HR * DVR, RET_COLS = 2 * D + 3 * DV;
constexpr int MH = M / 2;
constexpr float NORM_EPS = 1e-6f;
constexpr int NWAVES = 8, NTHREADS = NWAVES * 64;
constexpr int NPHASES = 1 + DEPTH * 14;

__device__ const unsigned char T5_BUCKET[3][129] = {
{11,11,11,11,11,11,11,11,11,11,11,11,11,11,11,10,10,10,10,10,10,10,10,10,10,10,10,10,10,10,10,10,10,10,10,10,10,10,9,9,9,9,9,9,9,9,9,9,9,9,8,8,8,8,8,8,8,7,6,5,4,3,2,1,0,17,18,19,20,21,22,23,24,24,24,24,24,24,24,25,25,25,25,25,25,25,25,25,25,25,25,26,26,26,26,26,26,26,26,26,26,26,26,26,26,26,26,26,26,26,26,26,26,26,27,27,27,27,27,27,27,27,27,27,27,27,27,27,27},
{13,13,13,13,13,13,13,13,13,13,13,13,13,13,13,13,13,13,13,13,13,13,13,12,12,12,12,12,12,12,12,12,12,12,12,12,12,12,12,12,12,12,11,11,11,11,11,11,11,11,11,11,10,10,10,10,10,10,9,9,9,8,8,4,0,20,24,24,25,25,25,26,26,26,26,26,26,27,27,27,27,27,27,27,27,27,27,28,28,28,28,28,28,28,28,28,28,28,28,28,28,28,28,28,28,28,29,29,29,29,29,29,29,29,29,29,29,29,29,29,29,29,29,29,29,29,29,29,29},
{15,15,15,15,15,15,15,15,15,15,15,15,15,15,15,15,15,15,15,15,15,15,15,15,15,15,15,15,15,15,14,14,14,14,14,14,14,14,14,14,14,14,14,14,14,13,13,13,13,13,13,13,13,13,12,12,12,12,12,11,11,10,10,9,0,25,26,26,27,27,28,28,28,28,28,29,29,29,29,29,29,29,29,29,30,30,30,30,30,30,30,30,30,30,30,30,30,30,30,31,31,31,31,31,31,31,31,31,31,31,31,31,31,31,31,31,31,31,31,31,31,31,31,31,31,31,31,31,31}};

constexpr size_t MiB = 1u << 20;
constexpr size_t WS_CTL = 0, CTL_ZERO_BYTES = 1 * MiB;
constexpr size_t WS_BIAS = 1 * MiB;
constexpr size_t WS_RS = WS_BIAS + 256 * 1024;
constexpr size_t WS_W = 2 * MiB;
constexpr size_t WS_W2_FFN = WS_W + (size_t)2 * DFF * D * 2;
constexpr size_t WS_W2_ATT = WS_W + (size_t)NGRP * ATT_COLS * D * 2;
constexpr size_t WS_W2_RET = WS_W + (size_t)RET_COLS * D * 2;
constexpr size_t WS_XH = 26 * MiB;
constexpr size_t WS_YC = 90 * MiB;
constexpr size_t WS_BIG = 218 * MiB;
constexpr size_t WS_F = 410 * MiB;
constexpr size_t WS_RVT = 410 * MiB;
constexpr size_t WS_RKT = 474 * MiB;
constexpr size_t WS_OACC = 474 * MiB;
constexpr size_t WS_LSE = 538 * MiB;
constexpr size_t WS_END = 540 * MiB;
static_assert(WS_W2_FFN + (size_t)D * DFF * 2 <= WS_XH && WS_W2_ATT + (size_t)D * D * 2 <= WS_XH && WS_W2_RET + (size_t)D * DV * 2 <= WS_XH, "weight region");
constexpr int RP_COLS = 2 * D + 2 * DV;
static_assert(WS_XH + (size_t)M * D * 2 == WS_YC && WS_YC + (size_t)M * DV * 2 == WS_BIG && WS_BIG + (size_t)MH * RP_COLS * 2 == WS_F && WS_F + (size_t)M * D * 2 == WS_RKT && WS_RVT + (size_t)DV * MH * 2 == WS_RKT && WS_RKT + (size_t)D * MH * 2 <= WS_LSE && WS_OACC + (size_t)M * D * 2 == WS_LSE, "d_ws map");
static_assert((size_t)M * DFF * 2 <= 192 * MiB && (size_t)M * ATT_COLS * 2 <= 192 * MiB && WS_LSE + (size_t)M * 16 * 4 <= WS_END, "d_ws map");
constexpr int CW_BAR = 4096;

constexpr int RING_OFF = 0, RING_BYTES = 149504;
constexpr int LDSCTL_OFF = RING_BYTES, MISC_OFF = LDSCTL_OFF + 320;
constexpr int LDS_BYTES = RING_BYTES + 512;
static_assert(MISC_OFF + 128 <= LDS_BYTES, "LDS map");

#define LAS __attribute__((address_space(3)))
typedef unsigned short bf16;
typedef unsigned v4u __attribute__((ext_vector_type(4)));
typedef unsigned v2u __attribute__((ext_vector_type(2)));
typedef float f32x4 __attribute__((ext_vector_type(4)));
#define LDS_WAIT() asm volatile("s_waitcnt lgkmcnt(0)" ::: "memory")
__device__ __forceinline__ unsigned f2bf(float f) { unsigned u = __builtin_bit_cast(unsigned, f); return (u + 0x7fffu + ((u >> 16) & 1u)) >> 16; }
__device__ __forceinline__ unsigned pk2(float lo, float hi) { return f2bf(lo) | (f2bf(hi) << 16); }
__device__ __forceinline__ float bflo(unsigned w) { return __builtin_bit_cast(float, w << 16); }
__device__ __forceinline__ float bfhi(unsigned w) { return __builtin_bit_cast(float, w & 0xffff0000u); }
template <int O> __device__ __forceinline__ float swz_xor(float v) { return __builtin_bit_cast(float, __builtin_amdgcn_ds_swizzle(__builtin_bit_cast(int, v), (O << 10) | 0x1f)); }
__device__ __forceinline__ float wave_sum(float v) {
    v += swz_xor<1>(v); v += swz_xor<2>(v); v += swz_xor<4>(v); v += swz_xor<8>(v); v += swz_xor<16>(v);
    return __builtin_bit_cast(float, __builtin_amdgcn_readlane(__builtin_bit_cast(int, v), 0)) + __builtin_bit_cast(float, __builtin_amdgcn_readlane(__builtin_bit_cast(int, v), 32));
}
__device__ __forceinline__ float get_xor32(float v, int lane) { return __builtin_bit_cast(float, __builtin_amdgcn_ds_bpermute((lane ^ 32) << 2, __builtin_bit_cast(int, v))); }

#define XB_TMO      128
#define XB_XCNT(j)  (256  + 64 * (j))
#define XB_XSUB(j)  (1280 + 64 * (j))
#define XB_XGEN(j)  (2304 + 64 * (j))
#define XB_TOP      3328
#define XB_TOPGEN   3392
#define XCD_BAR_WORDS 3456
#define XB_SPIN_CAP (1u << 18)

__device__ __forceinline__ unsigned xb_ld(unsigned* p)              { return __hip_atomic_load(p, __ATOMIC_RELAXED, __HIP_MEMORY_SCOPE_AGENT); }
__device__ __forceinline__ unsigned xb_add(unsigned* p, unsigned v) { return __hip_atomic_fetch_add(p, v, __ATOMIC_RELAXED, __HIP_MEMORY_SCOPE_AGENT); }
__device__ __forceinline__ unsigned xb_xcc_id() { return (unsigned)__builtin_amdgcn_s_getreg((3 << 11) | 20) & 0xFu; }
#define XB_SPIN(cond, bar) do { unsigned _sp = 0; while (cond) { __builtin_amdgcn_s_sleep(1); \
    if ((++_sp & 255u) == 0u) { if (xb_ld(&(bar)[XB_TMO])) break; if (_sp > XB_SPIN_CAP) { atomicAdd(&(bar)[XB_TMO], 1u); break; } } } } while (0)

struct XcdBarrier {
    unsigned* bar; unsigned x;
    volatile LAS unsigned* st;
};

__device__ __forceinline__ XcdBarrier xcd_barrier_post(unsigned* bar, volatile LAS unsigned* st) {
    XcdBarrier b; b.bar = bar; b.x = xb_xcc_id(); b.st = st;
    if (threadIdx.x == 0) (void)xb_add(&bar[XB_XCNT(b.x)], 1u);
    return b;
}
__device__ __forceinline__ void xcd_barrier_complete(unsigned* bar, unsigned x, unsigned& nloc, unsigned& nx) {
    const unsigned G = gridDim.x * gridDim.y * gridDim.z;
    unsigned sum, cnt, mine, sp = 0u;
    for (;;) {
        sum = 0u; cnt = 0u; mine = 0u;
#pragma unroll
        for (unsigned j = 0; j < 16; ++j) { const unsigned c = xb_ld(&bar[XB_XCNT(j)]); sum += c; cnt += (c > 0u) ? 1u : 0u; mine = (j == x) ? c : mine; }
        if (sum == G) break;
        __builtin_amdgcn_s_sleep(1);
        if ((++sp & 255u) == 0u) { if (xb_ld(&bar[XB_TMO])) break; if (sp > XB_SPIN_CAP) { atomicAdd(&bar[XB_TMO], 1u); break; } }
    }
    nloc = mine > 0u ? mine : 1u; nx = cnt > 0u ? cnt : 1u;
}

__device__ __forceinline__ void xcd_barrier(const XcdBarrier& b) {
    asm volatile("s_waitcnt vmcnt(0)" ::: "memory");
    __syncthreads();
    if (threadIdx.x == 0) {
        unsigned* bar = b.bar;
        __builtin_amdgcn_s_waitcnt(0);
        unsigned nloc = b.st[0], nx = b.st[1];
        if (nloc == 0u) { xcd_barrier_complete(bar, b.x, nloc, nx); b.st[0] = nloc; b.st[1] = nx; }
        const unsigned old = xb_add(&bar[XB_XSUB(b.x)], 1u);
        const unsigned gen = old / nloc;
        if (old + 1u == (gen + 1u) * nloc) {
            __builtin_amdgcn_fence(__ATOMIC_RELEASE, "agent");
            asm volatile("s_waitcnt vmcnt(0)" ::: "memory");
            const unsigned og = xb_add(&bar[XB_TOP], 1u);
            const unsigned tg = og / nx;
            if (og + 1u == (tg + 1u) * nx) xb_add(&bar[XB_TOPGEN], 1u);
            else XB_SPIN(xb_ld(&bar[XB_TOPGEN]) == tg, bar);
            __builtin_amdgcn_fence(__ATOMIC_ACQUIRE, "agent");
            xb_add(&bar[XB_XGEN(b.x)], 1u);
            asm volatile("s_waitcnt vmcnt(0)" ::: "memory");
        } else {
            XB_SPIN(xb_ld(&bar[XB_XGEN(b.x)]) == gen, bar);
            __builtin_amdgcn_fence(__ATOMIC_ACQUIRE, "agent");
            asm volatile("s_waitcnt vmcnt(0)" ::: "memory");
        }
    }
    __syncthreads();
}


constexpr int CV_SCR = 64 * 65 * 4;
__device__ __forceinline__ void conv_item(const float* W, int srcN, int k0, int n0, bf16* WT, int dstK, int drow0, const float* gain, LAS float* scr, int lane) {
    { const float* src = W + (size_t)(k0 + (lane >> 4)) * srcN + n0 + (lane & 15) * 4; LAS float* d = scr + (lane >> 4) * 65 + (lane & 15) * 4;
#pragma unroll
      for (int i = 0; i < 16; ++i) { const f32x4 v = __builtin_nontemporal_load((const f32x4*)(src + (size_t)(4 * i) * srcN));     d[4 * i * 65 + 0] = v.x; d[4 * i * 65 + 1] = v.y; d[4 * i * 65 + 2] = v.z; d[4 * i * 65 + 3] = v.w; } }
    LDS_WAIT(); asm volatile("" ::: "memory");
    const int c = lane & 7;
    float gk[8];
#pragma unroll
    for (int i = 0; i < 8; ++i) gk[i] = gain ? gain[k0 + 8 * c + i] : 1.0f;
#pragma unroll
    for (int j = 0; j < 8; ++j) { const int n = (lane >> 3) + 8 * j; const LAS float* s = scr + (8 * c) * 65 + n;
        v4u o; o.x = pk2(s[0 * 65] * gk[0], s[1 * 65] * gk[1]); o.y = pk2(s[2 * 65] * gk[2], s[3 * 65] * gk[3]); o.z = pk2(s[4 * 65] * gk[4], s[5 * 65] * gk[5]); o.w = pk2(s[6 * 65] * gk[6], s[7 * 65] * gk[7]);
        *(v4u*)(WT + (size_t)(drow0 + n) * dstK + k0 + 8 * c) = o; }
    LDS_WAIT(); asm volatile("" ::: "memory");
}
template <int K, int N, int NC> __device__ __forceinline__ void conv_cols(const float* W, int c0, bf16* WT, int r0, const float* gain, LAS float* scr, int gw, int NGW, int lane) {
    constexpr int nblk = NC / 64, nitems = (K / 64) * nblk;
    for (int it = gw; it < nitems; it += NGW) { const int kb = it / nblk, nb = it % nblk; conv_item(W, N, 64 * kb, c0 + 64 * nb, WT, K, r0 + 64 * nb, gain, scr, lane); }
}
template <int K, int N> __device__ __forceinline__ void conv_plain(const float* W, bf16* WT, const float* gain, LAS float* scr, int gw, int NGW, int lane) { conv_cols<K, N, N>(W, 0, WT, 0, gain, scr, gw, NGW, lane); }
__device__ __forceinline__ void conv_gateup(const float* Wg, const float* Wu, bf16* WT, const float* gain, LAS float* scr, int gw, int NGW, int lane) {
    constexpr int nblk = 2 * DFF / 64, nitems = (D / 64) * nblk;
    for (int it = gw; it < nitems; it += NGW) { const int kb = it / nblk, nb = it % nblk, n0 = 64 * nb, pn = n0 >> 8, bj = (n0 >> 7) & 1, c0 = n0 & 127;
        conv_item(bj ? Wu : Wg, DFF, 64 * kb, 128 * pn + c0, WT, D, n0, gain, scr, lane); }
}

__device__ __forceinline__ void unpack8(const v4u w, float (&f)[8]) { f[0] = bflo(w.x); f[1] = bfhi(w.x); f[2] = bflo(w.y); f[3] = bfhi(w.y); f[4] = bflo(w.z); f[5] = bfhi(w.z); f[6] = bflo(w.w); f[7] = bfhi(w.w); }
__device__ __forceinline__ void p0_rows(const float* xin, bf16* XB, float* RS, int gw, int NGW, int lane) {
    for (int m = gw; m < M; m += NGW) {
        float ss = 0.f;
#pragma unroll
        for (int j = 0; j < 2; ++j) { const float* p = xin + (size_t)m * D + 512 * j + 8 * lane; const f32x4 a = __builtin_nontemporal_load((const f32x4*)p), b = __builtin_nontemporal_load((const f32x4*)(p + 4));
            ss += (a.x * a.x + a.y * a.y) + (a.z * a.z + a.w * a.w) + (b.x * b.x + b.y * b.y) + (b.z * b.z + b.w * b.w);
            v4u w; w.x = pk2(a.x, a.y); w.y = pk2(a.z, a.w); w.z = pk2(b.x, b.y); w.w = pk2(b.z, b.w); *(v4u*)(XB + (size_t)m * D + 512 * j + 8 * lane) = w; }
        ss = wave_sum(ss);
        if (lane == 0) RS[m] = __builtin_amdgcn_rsqf(ss * (1.f / D) + NORM_EPS);
    }
}
__device__ __forceinline__ void thin_rows(const bf16* Fin, bf16* XB, const float* gpost, float cpost, float* RS, float* outf, int gw, int NGW, int lane) {
    float gp[2][8];
#pragma unroll
    for (int j = 0; j < 2; ++j) { const f32x4 a = *(const f32x4*)(gpost + 512 * j + 8 * lane), b = *(const f32x4*)(gpost + 512 * j + 8 * lane + 4);
        gp[j][0] = a.x; gp[j][1] = a.y; gp[j][2] = a.z; gp[j][3] = a.w; gp[j][4] = b.x; gp[j][5] = b.y; gp[j][6] = b.z; gp[j][7] = b.w; }
    for (int m = gw; m < M; m += NGW) {
        float x[2][8], f[2][8]; float ss = 0.f;
#pragma unroll
        for (int j = 0; j < 2; ++j) { unpack8(*(const v4u*)(XB + (size_t)m * D + 512 * j + 8 * lane), x[j]); unpack8(*(const v4u*)(Fin + (size_t)m * D + 512 * j + 8 * lane), f[j]);
#pragma unroll
            for (int q = 0; q < 8; ++q) ss += f[j][q] * f[j][q]; }
        const float rF = cpost * __builtin_amdgcn_rsqf(wave_sum(ss) * (1.f / D) + NORM_EPS);
        float s2 = 0.f;
#pragma unroll
        for (int j = 0; j < 2; ++j)
#pragma unroll
            for (int q = 0; q < 8; ++q) { x[j][q] += f[j][q] * gp[j][q] * rF; s2 += x[j][q] * x[j][q]; }
        if (outf) {
#pragma unroll
            for (int j = 0; j < 2; ++j) { float* p = outf + (size_t)m * D + 512 * j + 8 * lane; __builtin_nontemporal_store((f32x4){x[j][0], x[j][1], x[j][2], x[j][3]}, (f32x4*)p); __builtin_nontemporal_store((f32x4){x[j][4], x[j][5], x[j][6], x[j][7]}, (f32x4*)(p + 4)); }
        } else {
#pragma unroll
            for (int j = 0; j < 2; ++j) { v4u w; w.x = pk2(x[j][0], x[j][1]); w.y = pk2(x[j][2], x[j][3]); w.z = pk2(x[j][4], x[j][5]); w.w = pk2(x[j][6], x[j][7]); *(v4u*)(XB + (size_t)m * D + 512 * j + 8 * lane) = w; }
            s2 = wave_sum(s2);
            if (lane == 0) RS[m] = __builtin_amdgcn_rsqf(s2 * (1.f / D) + NORM_EPS);
        }
    }
}

__device__ __forceinline__ void attn_group_scalar(const bf16* P, const float* bias2, int dil, int first, bf16* OACC, float* LSE, int gw, int NGW, int lane) {
    const int Ls = SEQ / dil, tbn = Ls / 64;
    constexpr float SC = 0.125f * 1.4426950409f;
    for (int w = gw; w < BATCH * HA * 32; w += NGW) {
        const int tb = w % tbn, r = (w / tbn) % dil, h = (w >> 5) & 15, b = w >> 9;
        const int t = tb * 64 + lane; const size_t row = (size_t)b * SEQ + (size_t)t * dil + r;
        float q[64], acc[64];
        { const v4u* qp = (const v4u*)(P + row * ATT_COLS + h * 64);
#pragma unroll
          for (int c = 0; c < 8; ++c) { const v4u x = qp[c]; q[8 * c + 0] = bflo(x.x); q[8 * c + 1] = bfhi(x.x); q[8 * c + 2] = bflo(x.y); q[8 * c + 3] = bfhi(x.y); q[8 * c + 4] = bflo(x.z); q[8 * c + 5] = bfhi(x.z); q[8 * c + 6] = bflo(x.w); q[8 * c + 7] = bfhi(x.w); } }
#pragma unroll
        for (int c = 0; c < 64; ++c) acc[c] = 0.f;
        float mx = -INFINITY, l = 0.f;
        for (int kk = 0; kk < 129; ++kk) {
            const int tk = t - 64 + kk;
            if (tk >= 0 && tk < Ls) {
                const size_t krow = (size_t)b * SEQ + (size_t)tk * dil + r;
                const v4u* kp = (const v4u*)(P + krow * ATT_COLS + D + h * 64);
                float s = 0.f;
#pragma unroll
                for (int c = 0; c < 8; ++c) { const v4u x = kp[c];
                    s += q[8 * c + 0] * bflo(x.x) + q[8 * c + 1] * bfhi(x.x) + q[8 * c + 2] * bflo(x.y) + q[8 * c + 3] * bfhi(x.y) + q[8 * c + 4] * bflo(x.z) + q[8 * c + 5] * bfhi(x.z) + q[8 * c + 6] * bflo(x.w) + q[8 * c + 7] * bfhi(x.w); }
                s = s * SC + bias2[h * 129 + kk];
                const float mn = fmaxf(mx, s), a = exp2f(mx - mn), p = exp2f(s - mn);
                l = l * a + p; mx = mn;
                const v4u* vp = (const v4u*)(P + krow * ATT_COLS + 2 * D + h * 64);
#pragma unroll
                for (int c = 0; c < 8; ++c) { const v4u x = vp[c];
                    acc[8 * c + 0] = acc[8 * c + 0] * a + p * bflo(x.x); acc[8 * c + 1] = acc[8 * c + 1] * a + p * bfhi(x.x); acc[8 * c + 2] = acc[8 * c + 2] * a + p * bflo(x.y); acc[8 * c + 3] = acc[8 * c + 3] * a + p * bfhi(x.y);
                    acc[8 * c + 4] = acc[8 * c + 4] * a + p * bflo(x.z); acc[8 * c + 5] = acc[8 * c + 5] * a + p * bfhi(x.z); acc[8 * c + 6] = acc[8 * c + 6] * a + p * bflo(x.w); acc[8 * c + 7] = acc[8 * c + 7] * a + p * bfhi(x.w); }
            }
        }
        const float il = 1.f / l; float lse = mx + log2f(l);
        float wn = il, wo = 0.f;
        if (!first) { const float lo = LSE[row * 16 + h]; const float mm = fmaxf(lo, lse), eo = exp2f(lo - mm), en = exp2f(lse - mm), inv = 1.f / (eo + en); wn = en * inv * il; wo = eo * inv; lse = mm + log2f(eo + en); }
        LSE[row * 16 + h] = lse;
        v4u* op = (v4u*)(OACC + row * D + h * 64);
#pragma unroll
        for (int c = 0; c < 8; ++c) { v4u x = (v4u){0u, 0u, 0u, 0u}; if (!first) x = op[c];
            v4u y; y.x = pk2(wn * acc[8 * c + 0] + wo * bflo(x.x), wn * acc[8 * c + 1] + wo * bfhi(x.x)); y.y = pk2(wn * acc[8 * c + 2] + wo * bflo(x.y), wn * acc[8 * c + 3] + wo * bfhi(x.y));
            y.z = pk2(wn * acc[8 * c + 4] + wo * bflo(x.z), wn * acc[8 * c + 5] + wo * bfhi(x.z)); y.w = pk2(wn * acc[8 * c + 6] + wo * bflo(x.w), wn * acc[8 * c + 7] + wo * bfhi(x.w)); op[c] = y; }
    }
}

__device__ __forceinline__ void ret_core_scalar(const bf16* P, const bf16* KT, const bf16* VT, const float* decay_logit  , bf16* YF, bf16* YB, int useKT, int gw, int NGW, int lane) {
    const int el = lane & 15, dq = lane >> 4;
    for (int w = gw; w < 8 * HR * 2 * 32; w += NGW) {
        const int eb = w & 31, dir = (w >> 5) & 1, h = (w >> 6) & 3, bl = w >> 8;
        const int e = eb * 16 + el;
        const float gamma = 1.0f - expf(decay_logit[dir * HR + h]);
        bf16* Y = dir ? YB : YF;
        float S[64];
#pragma unroll
        for (int c = 0; c < 64; ++c) S[c] = 0.f;
        for (int ti = 0; ti < SEQ; ++ti) {
            const int s = dir ? (SEQ - 1 - ti) : ti; const size_t row = (size_t)bl * SEQ + s;
            const bf16* pr = P + row * RP_COLS;
            const float v = __builtin_bit_cast(float, (unsigned)VT[(size_t)(h * DVR + e) * MH + row] << 16);
            const v4u* qp = (const v4u*)(pr + h * DKR + dq * 64); const v4u* kp = (const v4u*)(pr + D + 2 * DV + h * DKR + dq * 64);
            float y = 0.f;
#pragma unroll
            for (int c = 0; c < 8; ++c) { v4u kx = kp[c]; const v4u qx = qp[c];
                if (useKT) { const bf16* kt = KT + (size_t)(h * DKR + dq * 64 + 8 * c) * MH + row;
                    kx.x = (unsigned)kt[0] | ((unsigned)kt[MH] << 16); kx.y = (unsigned)kt[2 * (size_t)MH] | ((unsigned)kt[3 * (size_t)MH] << 16);
                    kx.z = (unsigned)kt[4 * (size_t)MH] | ((unsigned)kt[5 * (size_t)MH] << 16); kx.w = (unsigned)kt[6 * (size_t)MH] | ((unsigned)kt[7 * (size_t)MH] << 16); }
                S[8 * c + 0] = S[8 * c + 0] * gamma + bflo(kx.x) * v; y += bflo(qx.x) * S[8 * c + 0];
                S[8 * c + 1] = S[8 * c + 1] * gamma + bfhi(kx.x) * v; y += bfhi(qx.x) * S[8 * c + 1];
                S[8 * c + 2] = S[8 * c + 2] * gamma + bflo(kx.y) * v; y += bflo(qx.y) * S[8 * c + 2];
                S[8 * c + 3] = S[8 * c + 3] * gamma + bfhi(kx.y) * v; y += bfhi(qx.y) * S[8 * c + 3];
                S[8 * c + 4] = S[8 * c + 4] * gamma + bflo(kx.z) * v; y += bflo(qx.z) * S[8 * c + 4];
                S[8 * c + 5] = S[8 * c + 5] * gamma + bfhi(kx.z) * v; y += bfhi(qx.z) * S[8 * c + 5];
                S[8 * c + 6] = S[8 * c + 6] * gamma + bflo(kx.w) * v; y += bflo(qx.w) * S[8 * c + 6];
                S[8 * c + 7] = S[8 * c + 7] * gamma + bfhi(kx.w) * v; y += bfhi(qx.w) * S[8 * c + 7]; }
            y += __shfl_xor(y, 16); y += __shfl_xor(y, 32);
            if (dq == 0) Y[row * DV + h * DVR + e] = (bf16)f2bf(y);
        }
    }
}

__device__ __forceinline__ void ret_combine(const bf16* P, bf16* YF  , const bf16* YB, int gw, int NGW, int lane) {
    for (int m = gw; m < MH; m += NGW) {
#pragma unroll
        for (int j = 0; j < 4; ++j) {
            const int idx = j * 512 + lane * 8;
            const v4u a = *(const v4u*)(YF + (size_t)m * DV + idx), bq = *(const v4u*)(YB + (size_t)m * DV + idx);
            const v4u gfv = *(const v4u*)(P + (size_t)m * RP_COLS + D + idx), gbv = *(const v4u*)(P + (size_t)m * RP_COLS + D + DV + idx);
            float yf[8] = {bflo(a.x), bfhi(a.x), bflo(a.y), bfhi(a.y), bflo(a.z), bfhi(a.z), bflo(a.w), bfhi(a.w)};
            float yb[8] = {bflo(bq.x), bfhi(bq.x), bflo(bq.y), bfhi(bq.y), bflo(bq.z), bfhi(bq.z), bflo(bq.w), bfhi(bq.w)};
            float gf[8] = {bflo(gfv.x), bfhi(gfv.x), bflo(gfv.y), bfhi(gfv.y), bflo(gfv.z), bfhi(gfv.z), bflo(gfv.w), bfhi(gfv.w)};
            float gb[8] = {bflo(gbv.x), bfhi(gbv.x), bflo(gbv.y), bfhi(gbv.y), bflo(gbv.z), bfhi(gbv.z), bflo(gbv.w), bfhi(gbv.w)};
            float sf = 0.f, sb = 0.f;
#pragma unroll
            for (int c = 0; c < 8; ++c) { sf += yf[c]; sb += yb[c]; }
            const float muf = wave_sum(sf) * (1.f / DVR), mub = wave_sum(sb) * (1.f / DVR);
            float qf = 0.f, qb = 0.f;
#pragma unroll
            for (int c = 0; c < 8; ++c) { yf[c] -= muf; yb[c] -= mub; qf += yf[c] * yf[c]; qb += yb[c] * yb[c]; }
            const float rf = __builtin_amdgcn_rsqf(wave_sum(qf) * (1.f / DVR) + NORM_EPS), rb = __builtin_amdgcn_rsqf(wave_sum(qb) * (1.f / DVR) + NORM_EPS);
            float o[8];
#pragma unroll
            for (int c = 0; c < 8; ++c) o[c] = gf[c] * pg8::fast_sigmoid(gf[c]) * yf[c] * rf + gb[c] * pg8::fast_sigmoid(gb[c]) * yb[c] * rb;
            v4u w; w.x = pk2(o[0], o[1]); w.y = pk2(o[2], o[3]); w.z = pk2(o[4], o[5]); w.w = pk2(o[6], o[7]);
            *(v4u*)(YF + (size_t)m * DV + idx) = w;
        }
    }
}

typedef float f32x16 __attribute__((ext_vector_type(16)));
typedef short bf16x8s __attribute__((ext_vector_type(8)));
typedef float f32x2_t __attribute__((ext_vector_type(2))); typedef __bf16 bf16x2_t __attribute__((ext_vector_type(2)));
__device__ __forceinline__ unsigned cvtpk(float lo, float hi) { f32x2_t v = {lo, hi}; bf16x2_t b = __builtin_convertvector(v, bf16x2_t); return __builtin_bit_cast(unsigned, b); }
__device__ __forceinline__ void attn_group_mfma(const bf16* QK, const bf16* VT, const float* bias2g, int dil, int first, bf16* OACC, float* LSE, LAS unsigned char* lds, int tid, int gw, int NGW) {
    LAS float* tab = (LAS float*)lds;
    for (int i = tid; i < 16 * 192; i += NTHREADS) { const int h = i / 192, o = i % 192 - 96; tab[i] = (o >= -64 && o <= 64) ? bias2g[h * 129 + o + 64] : -1e30f; }
    __syncthreads();
    const int lane = tid & 63, r = lane & 31, hh = lane >> 5;
    const int Ls = SEQ / dil, nqb = Ls / 32;
    constexpr float SC = 0.125f * 1.4426950409f;
    constexpr int NU = BATCH * HA * 64;
    const int upw = (NU + NGW - 1) / NGW;
    for (int u = gw * upw; u < (gw + 1) * upw && u < NU; ++u) {
        const int qb = u % nqb, rr = (u / nqb) % dil, h = (u >> 6) & 15, b = u >> 10, t0 = qb * 32;
        const size_t rowq = (size_t)b * SEQ + (size_t)(t0 + r) * dil + rr;
        bf16x8s qf[4];
#pragma unroll
        for (int ks = 0; ks < 4; ++ks) qf[ks] = *(const bf16x8s*)(QK + rowq * 2048 + h * 64 + 16 * ks + 8 * hh);
        f32x16 S[5];
#pragma unroll
        for (int kb = 0; kb < 5; ++kb) {
            int t = t0 - 64 + 32 * kb + r; t = t < 0 ? 0 : (t > Ls - 1 ? Ls - 1 : t);
            const bf16* kp = QK + ((size_t)b * SEQ + (size_t)t * dil + rr) * 2048 + 1024 + h * 64 + 8 * hh;
            bf16x8s kf[4];
#pragma unroll
            for (int ks = 0; ks < 4; ++ks) kf[ks] = *(const bf16x8s*)(kp + 16 * ks);
#pragma unroll
            for (int i = 0; i < 16; ++i) S[kb][i] = 0.f;
#pragma unroll
            for (int ks = 0; ks < 4; ++ks) S[kb] = __builtin_amdgcn_mfma_f32_32x32x16_bf16(kf[ks], qf[ks], S[kb], 0, 0, 0);
        }
        const LAS float* tb = tab + h * 192 + (32 + 4 * hh - r);
        float mx = -1e30f;
#pragma unroll
        for (int kb = 0; kb < 5; ++kb)
#pragma unroll
            for (int i = 0; i < 16; ++i) { const int krel = 32 * kb + (i & 3) + 8 * (i >> 2); const int kt = t0 - 64 + krel + 4 * hh;
                float s = S[kb][i] * SC + tb[krel]; s = (kt < 0 || kt >= Ls) ? -1e30f : s; S[kb][i] = s; mx = fmaxf(mx, s); }
        mx = fmaxf(mx, get_xor32(mx, lane));
        float l = 0.f;
#pragma unroll
        for (int kb = 0; kb < 5; ++kb)
#pragma unroll
            for (int i = 0; i < 16; ++i) { const float p = __builtin_amdgcn_exp2f(S[kb][i] - mx); S[kb][i] = p; l += p; }
        l += get_xor32(l, lane);
        f32x16 O[2];
#pragma unroll
        for (int db = 0; db < 2; ++db)
#pragma unroll
            for (int i = 0; i < 16; ++i) O[db][i] = 0.f;
        const bf16* vbase = VT + (size_t)(h * 64 + r) * M + (size_t)b * SEQ + (size_t)rr * Ls;
#pragma unroll
        for (int kb = 0; kb < 5; ++kb)
#pragma unroll
            for (int s2 = 0; s2 < 2; ++s2) {
                v4u pw; pw.x = cvtpk(S[kb][8 * s2 + 0], S[kb][8 * s2 + 1]); pw.y = cvtpk(S[kb][8 * s2 + 2], S[kb][8 * s2 + 3]); pw.z = cvtpk(S[kb][8 * s2 + 4], S[kb][8 * s2 + 5]); pw.w = cvtpk(S[kb][8 * s2 + 6], S[kb][8 * s2 + 7]);
                const bf16x8s pf = __builtin_bit_cast(bf16x8s, pw);
                int ta = t0 - 64 + 32 * kb + 16 * s2 + 4 * hh, tb2 = ta + 8;
                ta = (ta < 0 || ta >= Ls) ? 0 : ta; tb2 = (tb2 < 0 || tb2 >= Ls) ? 0 : tb2;
#pragma unroll
                for (int db = 0; db < 2; ++db) { const bf16* vp = vbase + (size_t)(32 * db) * M;
                    const v2u lo = *(const v2u*)(vp + ta), hi = *(const v2u*)(vp + tb2);
                    const v4u vw = (v4u){lo.x, lo.y, hi.x, hi.y};
                    O[db] = __builtin_amdgcn_mfma_f32_32x32x16_bf16(__builtin_bit_cast(bf16x8s, vw), pf, O[db], 0, 0, 0); }
            }
        const float il = 1.f / l; float lse = mx + log2f(l);
        const size_t row = rowq;
        float wn = il, wo = 0.f;
        if (!first) { const float lo = LSE[row * 16 + h]; const float mm = fmaxf(lo, lse), eo = exp2f(lo - mm), en = exp2f(lse - mm), inv = 1.f / (eo + en); wn = en * inv * il; wo = eo * inv; lse = mm + log2f(eo + en); }
        if (hh == 0) LSE[row * 16 + h] = lse;
#pragma unroll
        for (int db = 0; db < 2; ++db)
#pragma unroll
            for (int gq = 0; gq < 4; ++gq) { v2u* op = (v2u*)(OACC + row * D + h * 64 + 32 * db + 8 * gq + 4 * hh);
                v2u x = (v2u){0u, 0u}; if (!first) x = *op;
                v2u y; y.x = cvtpk(wn * O[db][4 * gq + 0] + wo * bflo(x.x), wn * O[db][4 * gq + 1] + wo * bfhi(x.x)); y.y = cvtpk(wn * O[db][4 * gq + 2] + wo * bflo(x.y), wn * O[db][4 * gq + 3] + wo * bfhi(x.y));
                *op = y; }
    }
}

constexpr int RC_ST = 0, RC_RG = 65536, RC_NSLOT = 5, RC_LDS = RC_RG + RC_NSLOT * 16384;
__device__ __forceinline__ int sl_swz(int ob) { return ob ^ (((ob >> 9) & 1) << 5); }
template <int VAR  >
__device__ __forceinline__ void ret_core_mfma(const bf16* P, const bf16* VT, const float* decay_logit  , bf16* YF, bf16* YB, LAS unsigned char* lds, const int tid, const int bid, const int G) {
    typedef short bf16x8v __attribute__((ext_vector_type(8)));
    const int w = __builtin_amdgcn_readfirstlane(tid >> 6), lane = tid & 63, fr = lane & 15, fq = lane >> 4, wr = w >> 2, wc = w & 3;
#define RC_DMA(gptr, ldsoff) __builtin_amdgcn_global_load_lds((const unsigned*)(gptr), (LAS unsigned*)(lds + (ldsoff)), 16, 0, 0)
#define RC_WAITV(n) asm volatile("s_waitcnt vmcnt(" #n ")" ::: "memory")
#define RC_WAITL() asm volatile("s_waitcnt lgkmcnt(0)" ::: "memory")
#define RC_BAR() do { asm volatile("" ::: "memory"); __builtin_amdgcn_s_barrier(); asm volatile("" ::: "memory"); } while (0)
#define RC_MFMA(b, a, c) __builtin_amdgcn_mfma_f32_16x16x32_bf16((b), (a), (c), 0, 0, 0)
#define RC_NEXT(sl) ((sl) == RC_NSLOT - 1 ? 0 : (sl) + 1)
#define RC_PREV(sl) ((sl) == 0 ? RC_NSLOT - 1 : (sl) - 1)
    const int dob = sl_swz(lane * 16), drow = 16 * w + (dob >> 6), dcc = (dob & 63) >> 1;
    const int aoff = 4 * wr * 1024 + sl_swz(fr * 64 + fq * 16), boff = 2 * wc * 1024 + sl_swz(fr * 64 + fq * 16);
    for (int u = bid; u < 256; u += G) {
        const int xcd = u & 7, idx = u >> 3, es = idx & 3, cmb = (idx >> 2) * 8 + xcd, dir = cmb & 1, h = (cmb >> 1) & 3, bl = cmb >> 3;
        const float lg = __builtin_amdgcn_logf(1.0f - __builtin_amdgcn_exp2f(decay_logit[dir * HR + h] * 1.4426950409f));
        const float cdec = __builtin_amdgcn_exp2f(lg * 128.f);
        bf16* Y = dir ? YB : YF;
        const size_t rowbase = (size_t)bl * SEQ;
        const bf16* qsrc = P + (rowbase + drow) * RP_COLS + h * DKR + dcc;
        const bf16* ksrc = qsrc + (D + 2 * DV);
        const bf16* vsrc = VT + (size_t)(h * DVR + es * 128 + drow) * MH + rowbase + dcc;
        const bf16* vown = VT + (size_t)(h * DVR + es * 128 + 16 * w + fr) * MH + rowbase + 8 * fq;
        { const v4u z = (v4u){0u, 0u, 0u, 0u};
#pragma unroll
          for (int i = 0; i < 8; ++i) *(LAS v4u*)(lds + RC_ST + (i * NTHREADS + tid) * 16) = z; }
        f32x4 acc4[16];
#pragma unroll
        for (int n = 0; n < 16; ++n) acc4[n] = (f32x4){0.f, 0.f, 0.f, 0.f};
#define RC_ISSUE(st, tk, sl) do { if ((st) < 8) { const size_t to_ = (size_t)(tk) * RP_COLS + 32 * (st); RC_DMA(qsrc + to_, RC_RG + (sl) * 16384 + w * 1024); RC_DMA(ksrc + to_, RC_RG + (sl) * 16384 + 8192 + w * 1024); } \
                                  else RC_DMA(vsrc + (tk) + 32 * ((st) - 8), RC_RG + (sl) * 16384 + w * 1024); } while (0)
        v4u vnx[4];
        { const int tok0 = dir ? 128 * 15 : 0;
#pragma unroll
          for (int js = 0; js < 4; ++js) vnx[js] = *(const v4u*)(vown + tok0 + 32 * js);
          RC_ISSUE(0, tok0, 0); RC_ISSUE(1, tok0, 1); RC_ISSUE(2, tok0, 2); RC_ISSUE(3, tok0, 3); }
        RC_WAITL();
        int slot = 0;
        for (int c = 0; c < 16; ++c) {
            const int tok0 = 128 * (dir ? 15 - c : c), tokn = 128 * (dir ? (c < 15 ? 14 - c : 0) : (c < 15 ? c + 1 : 15));
            float lgc = lg; int zo = 0; asm volatile("" : "+v"(lgc), "+v"(zo));
            int lc = lane; asm volatile("" : "+v"(lc)); const int frc = lc & 15, fqc = lc >> 4;
            bf16x8v Avs[4];
#pragma unroll
            for (int js = 0; js < 4; ++js) { const v4u kw = vnx[js]; float kd[8];
#pragma unroll
                for (int q = 0; q < 8; ++q) { const int j = 32 * js + 8 * fqc + q; kd[q] = __builtin_amdgcn_exp2f(lgc * (dir ? (float)j : (float)(127 - j))); }
                v4u sw; sw.x = cvtpk(bflo(kw.x) * kd[0], bfhi(kw.x) * kd[1]); sw.y = cvtpk(bflo(kw.y) * kd[2], bfhi(kw.y) * kd[3]); sw.z = cvtpk(bflo(kw.z) * kd[4], bfhi(kw.z) * kd[5]); sw.w = cvtpk(bflo(kw.w) * kd[6], bfhi(kw.w) * kd[7]);
                Avs[js] = __builtin_bit_cast(bf16x8v, sw); }
#pragma unroll
            for (int n = 0; n < 16; ++n) acc4[n] = acc4[n] * cdec;
            const int jj = 8 * fqc + (frc >> 2);
            const unsigned trA = (unsigned)((jj >> 4) * 1024 + sl_swz((jj & 15) * 64 + 8 * (frc & 3))), trB = (unsigned)(((jj + 4) >> 4) * 1024 + sl_swz(((jj + 4) & 15) * 64 + 8 * (frc & 3)));
            f32x4 accA[4][2], accY[4][2];
#pragma unroll
            for (int m = 0; m < 4; ++m)
#pragma unroll
                for (int n = 0; n < 2; ++n) { accA[m][n] = (f32x4){0.f, 0.f, 0.f, 0.f}; accY[m][n] = (f32x4){0.f, 0.f, 0.f, 0.f}; }
#pragma unroll
            for (int ks = 0; ks < 8; ++ks) {
                if (ks < 4) { if (c == 0) RC_WAITV(6); else RC_WAITV(14); } else if (ks == 4) RC_WAITV(6); else if (ks == 5) RC_WAITV(5); else if (ks == 6) RC_WAITV(4); else RC_WAITV(3);
                RC_BAR();
                { const int s4 = RC_PREV(slot);
                  if (ks + 4 < 12) RC_ISSUE(ks + 4, tok0, s4); else RC_ISSUE(ks + 4 - 12, tokn, s4); }
                bf16x8v At[4], Bk[2], Bs[2];
                const LAS unsigned char* sq = lds + RC_RG + slot * 16384;
#pragma unroll
                for (int m = 0; m < 4; ++m) At[m] = *(const LAS bf16x8v*)(sq + aoff + m * 1024);
#pragma unroll
                for (int n = 0; n < 2; ++n) { Bk[n] = *(const LAS bf16x8v*)(sq + 8192 + boff + n * 1024); Bs[n] = *(const LAS bf16x8v*)(lds + RC_ST + ks * 8192 + boff + n * 1024); }
                RC_WAITL();
#pragma unroll
                for (int m = 0; m < 4; ++m)
#pragma unroll
                    for (int n = 0; n < 2; ++n) { accA[m][n] = RC_MFMA(Bk[n], At[m], accA[m][n]); accY[m][n] = RC_MFMA(Bs[n], At[m], accY[m][n]); }
                { const unsigned kb = (unsigned)(size_t)(sq + 8192);
#pragma unroll
                  for (int nl = 0; nl < 2; ++nl) { const unsigned a0 = kb + (trA ^ (nl << 5)), a1 = kb + (trB ^ (nl << 5));
                      v2u l0, h0, l1, h1, l2, h2, l3, h3;
                      asm volatile("ds_read_b64_tr_b16 %0, %8\n\tds_read_b64_tr_b16 %1, %9\n\tds_read_b64_tr_b16 %2, %8 offset:2048\n\tds_read_b64_tr_b16 %3, %9 offset:2048\n\t"
                                   "ds_read_b64_tr_b16 %4, %8 offset:4096\n\tds_read_b64_tr_b16 %5, %9 offset:4096\n\tds_read_b64_tr_b16 %6, %8 offset:6144\n\tds_read_b64_tr_b16 %7, %9 offset:6144\n\ts_waitcnt lgkmcnt(0)"
                                   : "=&v"(l0), "=&v"(h0), "=&v"(l1), "=&v"(h1), "=&v"(l2), "=&v"(h2), "=&v"(l3), "=&v"(h3) : "v"(a0), "v"(a1) : "memory");
                      acc4[2 * ks + nl] = RC_MFMA(__builtin_bit_cast(bf16x8v, ((v4u){l0.x, l0.y, h0.x, h0.y})), Avs[0], acc4[2 * ks + nl]);
                      acc4[2 * ks + nl] = RC_MFMA(__builtin_bit_cast(bf16x8v, ((v4u){l1.x, l1.y, h1.x, h1.y})), Avs[1], acc4[2 * ks + nl]);
                      acc4[2 * ks + nl] = RC_MFMA(__builtin_bit_cast(bf16x8v, ((v4u){l2.x, l2.y, h2.x, h2.y})), Avs[2], acc4[2 * ks + nl]);
                      acc4[2 * ks + nl] = RC_MFMA(__builtin_bit_cast(bf16x8v, ((v4u){l3.x, l3.y, h3.x, h3.y})), Avs[3], acc4[2 * ks + nl]); } }
                slot = RC_NEXT(slot);
            }
#pragma unroll
            for (int m = 0; m < 4; ++m)
#pragma unroll
                for (int n = 0; n < 2; ++n) { accY[m][n] = accY[m][n] * __builtin_amdgcn_exp2f(lgc * (dir ? (float)(128 - (64 * wr + 16 * m + frc)) : (float)(64 * wr + 16 * m + frc + 1)));
                    const int i = 64 * wr + 16 * m + frc;
#pragma unroll
                    for (int ii = 0; ii < 4; ++ii) { const int j = 32 * wc + 16 * n + 4 * fqc + ii; const int dd = dir ? j - i : i - j;
                        accA[m][n][ii] = dd >= 0 ? accA[m][n][ii] * __builtin_amdgcn_exp2f(lgc * (float)dd) : 0.f; } }
            RC_BAR();
#pragma unroll
            for (int m = 0; m < 4; ++m)
#pragma unroll
                for (int n = 0; n < 2; ++n) { v2u pw; pw.x = cvtpk(accA[m][n][0], accA[m][n][1]); pw.y = cvtpk(accA[m][n][2], accA[m][n][3]);
                    *(LAS v2u*)(lds + RC_ST + wc * 8192 + (4 * wr + m) * 1024 + sl_swz(frc * 64 + (16 * n + 4 * fqc) * 2)) = pw; }
#pragma unroll
            for (int js = 0; js < 4; ++js) vnx[js] = *(const v4u*)(vown + tokn + 32 * js + zo);
            RC_WAITL();
#pragma unroll
            for (int js = 0; js < 4; ++js) {
                if (js == 0) RC_WAITV(7); else if (js == 1) RC_WAITV(8); else if (js == 2) RC_WAITV(9); else RC_WAITV(10);
                RC_BAR();
                { const int s4 = RC_PREV(slot); RC_ISSUE(js, tokn, s4); }
                bf16x8v At[4], Bv[2];
                const LAS unsigned char* sv = lds + RC_RG + slot * 16384;
#pragma unroll
                for (int m = 0; m < 4; ++m) At[m] = *(const LAS bf16x8v*)(lds + RC_ST + js * 8192 + aoff + m * 1024);
#pragma unroll
                for (int n = 0; n < 2; ++n) Bv[n] = *(const LAS bf16x8v*)(sv + boff + n * 1024);
                RC_WAITL();
#pragma unroll
                for (int m = 0; m < 4; ++m)
#pragma unroll
                    for (int n = 0; n < 2; ++n) accY[m][n] = RC_MFMA(Bv[n], At[m], accY[m][n]);
                slot = RC_NEXT(slot);
            }
#pragma unroll
            for (int m = 0; m < 4; ++m)
#pragma unroll
                for (int n = 0; n < 2; ++n) { v2u pw; pw.x = cvtpk(accY[m][n][0], accY[m][n][1]); pw.y = cvtpk(accY[m][n][2], accY[m][n][3]);
                    *(v2u*)(Y + (rowbase + tok0 + 64 * wr + 16 * m + frc + zo) * DV + h * DVR + es * 128 + 32 * wc + 16 * n + 4 * fqc) = pw; }
            RC_BAR();
#pragma unroll
            for (int n = 0; n < 16; ++n) { v2u pw; pw.x = cvtpk(acc4[n][0], acc4[n][1]); pw.y = cvtpk(acc4[n][2], acc4[n][3]);
                *(LAS v2u*)(lds + RC_ST + (n >> 1) * 8192 + w * 1024 + sl_swz(frc * 64 + (16 * (n & 1) + 4 * fqc) * 2)) = pw; }
            RC_WAITL();
        }
        RC_WAITV(0); RC_BAR();
    }
#undef RC_DMA
#undef RC_WAITV
#undef RC_WAITL
#undef RC_BAR
#undef RC_MFMA
#undef RC_NEXT
#undef RC_PREV
#undef RC_ISSUE
}

constexpr int AT_KROW = 144, AT_KB = 256 * AT_KROW, AT_VB = AT_KB, AT_HALF = AT_KB + AT_VB + 768, AT_LD = 3 * D;
static_assert(2 * AT_HALF <= RING_BYTES, "attention tiles");
__device__ __forceinline__ void attn_group_mfma2(const bf16* QK, const float* bias2g, int ldil, int first, bf16* OACC, float* LSE, LAS unsigned char* lds, const int tid, const int bid, const int G) {
    const int wave = __builtin_amdgcn_readfirstlane(tid >> 6), lane = tid & 63, r = lane & 31, hh = lane >> 5, hw = wave >> 2, wq = wave & 3, tih0 = tid & 255;
    LAS unsigned char* Kl = lds + hw * AT_HALF; LAS unsigned char* Vl = Kl + AT_KB; LAS float* tab = (LAS float*)(Vl + AT_VB);
    const int Ls = SEQ >> ldil, lq4 = 4 - ldil, nq4m = (1 << lq4) - 1, dilm = (1 << ldil) - 1;
    constexpr float SC = 0.125f * 1.4426950409f;
    constexpr int NP = BATCH * HA * 16 / 2;
    const int npp = (NP + G - 1) / G;
    v4u kreg[8], vreg[8];
#define AT_FETCH_K(su_) do { int tih = tih0; asm volatile("" : "+v"(tih)); const int su__ = (su_); const int q4_ = su__ & nq4m, rr_ = (su__ >> lq4) & dilm, h_ = (su__ >> 4) & 15, b_ = su__ >> 8, ks_ = q4_ * 128 - 64; \
        _Pragma("unroll") for (int j = 0; j < 8; ++j) { const int pi = j * 256 + tih, row = pi >> 3, ch = pi & 7; int kt = ks_ + row; kt = kt < 0 ? 0 : (kt > Ls - 1 ? Ls - 1 : kt); \
            kreg[j] = *(const v4u*)(QK + ((size_t)b_ * SEQ + ((size_t)kt << ldil) + rr_) * AT_LD + D + h_ * 64 + ch * 8); } } while (0)
#define AT_FETCH_V(su_) do { int tih = tih0; asm volatile("" : "+v"(tih)); const int su__ = (su_); const int q4_ = su__ & nq4m, rr_ = (su__ >> lq4) & dilm, h_ = (su__ >> 4) & 15, b_ = su__ >> 8, ks_ = q4_ * 128 - 64; \
        _Pragma("unroll") for (int j = 0; j < 8; ++j) { const int pi = j * 256 + tih, row = pi >> 3, ch = pi & 7; int kt = ks_ + row; kt = kt < 0 ? 0 : (kt > Ls - 1 ? Ls - 1 : kt); \
            vreg[j] = *(const v4u*)(QK + ((size_t)b_ * SEQ + ((size_t)kt << ldil) + rr_) * AT_LD + 2 * D + h_ * 64 + ch * 8); } } while (0)
    if (bid * npp < NP) { AT_FETCH_K(2 * (bid * npp) + hw); AT_FETCH_V(2 * (bid * npp) + hw); }
    for (int it = 0; it < npp; ++it) {
        const int p = bid * npp + it; if (p >= NP) break;
        const int su = 2 * p + hw, q4 = su & nq4m, rr = (su >> lq4) & dilm, h = (su >> 4) & 15, b = su >> 8, t0 = q4 * 128 + 32 * wq;
        asm volatile("" ::: "memory"); __builtin_amdgcn_s_barrier(); asm volatile("" ::: "memory");
        int tih = tih0; asm volatile("" : "+v"(tih));
#pragma unroll
        for (int j = 0; j < 8; ++j) { const int pi = j * 256 + tih; *(LAS v4u*)(Kl + (pi >> 3) * AT_KROW + (pi & 7) * 16) = kreg[j]; }
#pragma unroll
        for (int j = 0; j < 8; ++j) { const int pi = j * 256 + tih; *(LAS v4u*)(Vl + (pi >> 3) * AT_KROW + (pi & 7) * 16) = vreg[j]; }
        if (tih < 192) { const int o = tih - 96; tab[tih] = (o >= -64 && o <= 64) ? bias2g[h * 129 + o + 64] : -1e30f; }
        const size_t rowq = (size_t)b * SEQ + ((size_t)(t0 + r) << ldil) + rr;
        bf16x8s qf[4];
#pragma unroll
        for (int ks = 0; ks < 4; ++ks) qf[ks] = *(const bf16x8s*)(QK + rowq * AT_LD + h * 64 + 16 * ks + 8 * hh);
        asm volatile("s_waitcnt lgkmcnt(0)" ::: "memory"); __builtin_amdgcn_s_barrier(); asm volatile("" ::: "memory");
        f32x16 S[5];
#pragma unroll
        for (int kb = 0; kb < 5; ++kb) {
            const LAS unsigned char* kp = Kl + (32 * wq + 32 * kb + r) * AT_KROW + 16 * hh;
#pragma unroll
            for (int i = 0; i < 16; ++i) S[kb][i] = 0.f;
#pragma unroll
            for (int ks = 0; ks < 4; ++ks) S[kb] = __builtin_amdgcn_mfma_f32_32x32x16_bf16(*(const LAS bf16x8s*)(kp + 32 * ks), qf[ks], S[kb], 0, 0, 0);
        }
        const bool more = it + 1 < npp && p + 1 < NP;
        __builtin_amdgcn_sched_barrier(0);
        if (more) AT_FETCH_K(2 * (p + 1) + hw);
        __builtin_amdgcn_sched_barrier(0);
        const LAS float* tb = tab + (32 + 4 * hh - r);
        float mx = -1e30f;
#pragma unroll
        for (int kb = 0; kb < 5; ++kb)
#pragma unroll
            for (int i = 0; i < 16; ++i) { const int krel = 32 * kb + (i & 3) + 8 * (i >> 2); const int kt = t0 - 64 + krel + 4 * hh;
                float s = S[kb][i] * SC + tb[krel]; s = (kt < 0 || kt >= Ls) ? -1e30f : s; S[kb][i] = s; mx = fmaxf(mx, s); }
        mx = fmaxf(mx, get_xor32(mx, lane));
        float l = 0.f;
#pragma unroll
        for (int kb = 0; kb < 5; ++kb)
#pragma unroll
            for (int i = 0; i < 16; ++i) { const float pv = __builtin_amdgcn_exp2f(S[kb][i] - mx); S[kb][i] = pv; l += pv; }
        l += get_xor32(l, lane);
        f32x16 O[2];
#pragma unroll
        for (int db = 0; db < 2; ++db)
#pragma unroll
            for (int i = 0; i < 16; ++i) O[db][i] = 0.f;
#pragma unroll
        for (int kb = 0; kb < 5; ++kb) {
            if (kb == 3) { __builtin_amdgcn_sched_barrier(0); if (more) AT_FETCH_V(2 * (p + 1) + hw); __builtin_amdgcn_sched_barrier(0); }
#pragma unroll
            for (int s2 = 0; s2 < 2; ++s2) {
                v4u pw; pw.x = cvtpk(S[kb][8 * s2 + 0], S[kb][8 * s2 + 1]); pw.y = cvtpk(S[kb][8 * s2 + 2], S[kb][8 * s2 + 3]); pw.z = cvtpk(S[kb][8 * s2 + 4], S[kb][8 * s2 + 5]); pw.w = cvtpk(S[kb][8 * s2 + 6], S[kb][8 * s2 + 7]);
                const bf16x8s pf = __builtin_bit_cast(bf16x8s, pw);
                typedef short s16x4 __attribute__((ext_vector_type(4)));
                const LAS unsigned char* vb = Vl + (32 * wq + 32 * kb + 16 * s2 + 4 * hh + ((lane & 15) >> 2)) * AT_KROW + (16 * ((lane >> 4) & 1) + 4 * (lane & 3)) * 2;
#pragma unroll
                for (int db = 0; db < 2; ++db) {
                    const v2u lo = __builtin_bit_cast(v2u, __builtin_amdgcn_ds_read_tr16_b64_v4i16((LAS s16x4*)(vb + 64 * db))), hi = __builtin_bit_cast(v2u, __builtin_amdgcn_ds_read_tr16_b64_v4i16((LAS s16x4*)(vb + 64 * db + 8 * AT_KROW)));
                    const v4u vw = (v4u){lo.x, lo.y, hi.x, hi.y};
                    O[db] = __builtin_amdgcn_mfma_f32_32x32x16_bf16(__builtin_bit_cast(bf16x8s, vw), pf, O[db], 0, 0, 0); }
            }
        }
        const float il = __builtin_amdgcn_rcpf(l); float lse = mx + __builtin_amdgcn_logf(l);
        const size_t row = rowq;
        float wn = il, wo = 0.f;
        if (!first) { const float lo = LSE[row * 16 + h]; const float mm = fmaxf(lo, lse), eo = __builtin_amdgcn_exp2f(lo - mm), en = __builtin_amdgcn_exp2f(lse - mm), inv = __builtin_amdgcn_rcpf(eo + en); wn = en * inv * il; wo = eo * inv; lse = mm + __builtin_amdgcn_logf(eo + en); }
        if (hh == 0) LSE[row * 16 + h] = lse;
#pragma unroll
        for (int db = 0; db < 2; ++db)
#pragma unroll
            for (int gq = 0; gq < 4; ++gq) { v2u* op = (v2u*)(OACC + row * D + h * 64 + 32 * db + 8 * gq + 4 * hh);
                v2u x = (v2u){0u, 0u}; if (!first) x = *op;
                v2u y; y.x = cvtpk(wn * O[db][4 * gq + 0] + wo * bflo(x.x), wn * O[db][4 * gq + 1] + wo * bfhi(x.x)); y.y = cvtpk(wn * O[db][4 * gq + 2] + wo * bflo(x.y), wn * O[db][4 * gq + 3] + wo * bfhi(x.y));
                *op = y; }
    }
#undef AT_FETCH_K
#undef AT_FETCH_V
    __syncthreads();
}


struct Args { const float* in[11]; float* out; unsigned char* ws; int ph_lo, ph_hi; };
__global__ void __launch_bounds__(NTHREADS, 2) mk_fwd(Args args) {
    extern __shared__ __attribute__((aligned(16))) unsigned char lds_raw[];
    LAS unsigned char* lds = (LAS unsigned char*)lds_raw;
    volatile LAS unsigned* MISC = (volatile LAS unsigned*)(lds + MISC_OFF);
    const int wave0 = __builtin_amdgcn_readfirstlane(threadIdx.x >> 6);
    for (int u = threadIdx.x; u < (LDS_BYTES - LDSCTL_OFF) / 4; u += NTHREADS) ((LAS unsigned*)(lds + LDSCTL_OFF))[u] = 0u;
    __syncthreads();
    (void)xcd_barrier_post((unsigned*)(args.ws + WS_CTL) + CW_BAR, MISC + 8);
    bool again = false;
#if PROBE_TWICE
    for (int pass_ = 0; pass_ < 2; ++pass_)
#endif
    for (int ph = args.ph_lo; ph < args.ph_hi; ++ph) {
        unsigned char* ws = args.ws; asm volatile("" : "+s"(ws));
        int bid = blockIdx.x, G = gridDim.x; asm volatile("" : "+s"(bid), "+s"(G));
        const int gw = bid * NWAVES + wave0, NGW = G * NWAVES;
#define GET_TID() int tid; asm volatile("v_mbcnt_lo_u32_b32 %0, -1, 0\n\tv_mbcnt_hi_u32_b32 %0, -1, %0" : "=v"(tid)); const int lane = tid; tid += wave0 * 64; (void)lane;
        LAS float* scr = (LAS float*)(lds + RING_OFF + wave0 * CV_SCR);
        const float* gains = args.in[1]; float* out = args.out;
        float* RS = (float*)(ws + WS_RS);
        enum { T_P0, T_G1, T_FG, T_THIN, T_APROJ, T_ATT, T_RPROJ, T_RCORE, T_RCOMB };
        int type, L = 0, kind = 0, aux = 0;
        if (ph == 0) type = T_P0;
        else { const int p = ph - 1, q = p % 14; L = p / 14;
            if (q < 3) { kind = 0; type = q == 0 ? T_G1 : (q == 1 ? T_FG : T_THIN); }
            else if (q >= 11) { kind = 2; type = q == 11 ? T_G1 : (q == 12 ? T_FG : T_THIN); }
            else { kind = 1; const int r = q - 3;
                if (r == 6) type = T_FG; else if (r == 7) type = T_THIN;
                else if ((L & 1) == 0) { aux = r >> 1; type = (r & 1) ? T_ATT : T_APROJ; }
                else { aux = r / 3; const int st = r % 3; type = st == 0 ? T_RPROJ : (st == 1 ? T_RCORE : T_RCOMB); } } }
        const bool is_att = (L & 1) == 0; const int jj = L >> 1;
#define P_BIAS ((float*)(ws + WS_BIAS))
#define P_WA   ((bf16*)(ws + WS_W))
#define P_XH   ((bf16*)(ws + WS_XH))
#define P_BIG  ((bf16*)(ws + WS_BIG))
#define P_F    ((bf16*)(ws + WS_F))
#define P_YC   ((bf16*)(ws + WS_YC))
#define P_OACC ((bf16*)(ws + WS_OACC))
#define P_LSE  ((float*)(ws + WS_LSE))
        if (type == T_P0) {
            GET_TID()
#if PROBE_TOUCH
            {
                const size_t tix = (size_t)(bid >> 3) * NTHREADS + tid, nthr = (size_t)(G >> 3) * NTHREADS; unsigned accw = 0;
                for (size_t o = tix * 65536; o < WS_END; o += nthr * 65536) accw += *(const volatile unsigned*)(ws + o);
                for (size_t o = tix * 65536; o < (size_t)M * D * 4; o += nthr * 65536) { accw += *(const volatile unsigned*)((const char*)args.in[0] + o); accw += *(const volatile unsigned*)((const char*)out + o); }
                for (size_t o = tix * 65536; o < (size_t)DEPTH * 2 * D * DFF * 4; o += nthr * 65536) { accw += *(const volatile unsigned*)((const char*)args.in[2] + o); accw += *(const volatile unsigned*)((const char*)args.in[3] + o); accw += *(const volatile unsigned*)((const char*)args.in[4] + o); }
                for (size_t o = tix * 65536; o < (size_t)2 * D * NGRP * ATT_COLS * 4; o += nthr * 65536) accw += *(const volatile unsigned*)((const char*)args.in[5] + o);
                for (size_t o = tix * 65536; o < (size_t)2 * D * RET_COLS * 4; o += nthr * 65536) accw += *(const volatile unsigned*)((const char*)args.in[8] + o);
                if (accw == 0x12345677u) P_BIAS[70000] = 1.f; }
#endif
            const float* rel_bias = args.in[7];
            if (bid == 0) for (int i = tid; i < 3 * 16 * 129; i += NTHREADS) { const int g = i / (16 * 129), h = (i / 129) % 16, kk = i % 129; P_BIAS[i] = rel_bias[(g * 16 + h) * 32 + T5_BUCKET[g][kk]] * 1.4426950409f; }
            conv_gateup(args.in[2], args.in[3], P_WA, gains, scr, gw, NGW, lane);
            conv_plain<DFF, D>(args.in[4], (bf16*)(ws + WS_W2_FFN), nullptr, scr, gw, NGW, lane);
            p0_rows(args.in[0], P_XH, RS, gw, NGW, lane);
#if PROBE_MFMA
            {
                typedef short bx8 __attribute__((ext_vector_type(8)));
                bx8 a = {1, 2, 3, 4, 5, 6, 7, (short)lane}, b = {3, 1, 4, 1, 5, 9, 2, (short)(lane + 1)};
                f32x4 c0 = {0, 0, 0, 0}, c1 = c0, c2 = c0, c3 = c0, c4 = c0, c5 = c0, c6 = c0, c7 = c0;
                for (int it = 0; it < PROBE_MFMA; ++it) {
#pragma unroll
                    for (int r = 0; r < 4; ++r) {
                        c0 = __builtin_amdgcn_mfma_f32_16x16x32_bf16(a, b, c0, 0, 0, 0); c1 = __builtin_amdgcn_mfma_f32_16x16x32_bf16(a, b, c1, 0, 0, 0); c2 = __builtin_amdgcn_mfma_f32_16x16x32_bf16(a, b, c2, 0, 0, 0); c3 = __builtin_amdgcn_mfma_f32_16x16x32_bf16(a, b, c3, 0, 0, 0);
                        c4 = __builtin_amdgcn_mfma_f32_16x16x32_bf16(a, b, c4, 0, 0, 0); c5 = __builtin_amdgcn_mfma_f32_16x16x32_bf16(a, b, c5, 0, 0, 0); c6 = __builtin_amdgcn_mfma_f32_16x16x32_bf16(a, b, c6, 0, 0, 0); c7 = __builtin_amdgcn_mfma_f32_16x16x32_bf16(a, b, c7, 0, 0, 0); }
                    asm volatile("" : "+v"(a), "+v"(b)); }
                const f32x4 t = c0 + c1 + c2 + c3 + c4 + c5 + c6 + c7;
                if (t.x + t.y + t.z + t.w == 12345.678f) P_BIAS[60000 + tid] = t.x;
            }
#endif
        } else if (type == T_G1) {
            GET_TID()
            pg8::Gemm g{P_XH, P_WA, M, 2 * DFF, D, 0}; pg8::StaticOrder S; S.init(M, 2 * DFF, G, bid);
            pg8::stage_scales(lds + RING_OFF, S, RS, false, 0, tid);
            pg8::EpiSwiGLU E{P_BIG, DFF, (const LAS float*)(lds + RING_OFF + pg8::RS_TAB_OFF)};
            pg8::gemm_phase<pg8::EpiSwiGLU, pg8::StaticOrder, true, true>(lds + RING_OFF, g, S, E, tid);
#if PROBE_G1V >= 0
            { GET_TID() pg8::Gemm g2{P_XH, P_WA, M, 2 * DFF, D, 0}; pg8::StaticOrder S2; S2.init(M, 2 * DFF, G, bid);
              pg8::EpiSwiGLUT<PROBE_G1V> E2{PROBE_G1V ? P_F : P_BIG, PROBE_G1V ? D : DFF, (const LAS float*)(lds + RING_OFF + pg8::RS_TAB_OFF)};
              pg8::gemm_phase<pg8::EpiSwiGLUT<PROBE_G1V>, pg8::StaticOrder, true, true>(lds + RING_OFF, g2, S2, E2, tid); }
#endif
        } else if (type == T_FG) {
            GET_TID()
            const size_t fA = kind != 1 ? WS_BIG : (is_att ? WS_OACC : WS_YC), fB = kind != 1 ? WS_W2_FFN : (is_att ? WS_W2_ATT : WS_W2_RET); const int fK = kind != 1 ? DFF : (is_att ? D : DV);
            pg8::Gemm g{(const bf16*)(ws + fA), (const bf16*)(ws + fB), M, D, fK, 0}; pg8::StaticOrder S; S.init(M, D, G, bid);
            pg8::EpiPlain E{P_F, D, (const LAS float*)nullptr};
            pg8::gemm_phase<pg8::EpiPlain, pg8::StaticOrder, true, true>(lds + RING_OFF, g, S, E, tid);
#if PROBE_FGM
            if (kind != 1) { GET_TID()
                pg8::Gemm g2{(const bf16*)(ws + fA), (const bf16*)(ws + fB), PROBE_FGM, D, fK, 0}; pg8::StaticOrder S2; S2.init(PROBE_FGM, D, G, bid);
                pg8::EpiPlain E2{P_XH, D, (const LAS float*)nullptr};
                pg8::gemm_phase<pg8::EpiPlain, pg8::StaticOrder, true, true>(lds + RING_OFF, g2, S2, E2, tid); }
#endif
        } else if (type == T_THIN) {
            GET_TID()
            const int sub = L * 3 + kind;
            for (int crep = 0; crep < 1 + PROBE_CONV2; ++crep)
            if (sub + 1 < 3 * DEPTH) {
                const int nk = (sub + 1) % 3, nL = (sub + 1) / 3, nj = nL >> 1;
                const float* gn = gains + ((size_t)nL * 6 + (nk == 0 ? 0 : (nk == 1 ? 2 : 4))) * D;
                if (nk != 1) { const size_t o = (size_t)(nL * 2 + (nk >> 1)) * D * DFF;
                    conv_gateup(args.in[2] + o, args.in[3] + o, P_WA, gn, scr, gw, NGW, lane); conv_plain<DFF, D>(args.in[4] + o, (bf16*)(ws + WS_W2_FFN), nullptr, scr, gw, NGW, lane); }
                else if ((nL & 1) == 0) { conv_plain<D, NGRP * ATT_COLS>(args.in[5] + (size_t)nj * D * NGRP * ATT_COLS, P_WA, gn, scr, gw, NGW, lane); conv_plain<D, D>(args.in[6] + (size_t)nj * D * D, (bf16*)(ws + WS_W2_ATT), nullptr, scr, gw, NGW, lane); }
                else { const float* rw = args.in[8] + (size_t)nj * D * RET_COLS;
                    conv_cols<D, RET_COLS, D>(rw, 0, P_WA, 0, gn, scr, gw, NGW, lane); conv_cols<D, RET_COLS, 2 * DV>(rw, 2 * D + DV, P_WA, D, gn, scr, gw, NGW, lane);
                    conv_cols<D, RET_COLS, D>(rw, D, P_WA, D + 2 * DV, gn, scr, gw, NGW, lane); conv_cols<D, RET_COLS, DV>(rw, 2 * D, P_WA, 2 * D + 2 * DV, gn, scr, gw, NGW, lane);
                    conv_plain<DV, D>(args.in[9] + (size_t)nj * DV * D, (bf16*)(ws + WS_W2_RET), nullptr, scr, gw, NGW, lane); }
            }
            asm volatile("" ::: "memory");
            const float* gpost = gains + ((size_t)L * 6 + (kind == 0 ? 1 : (kind == 1 ? 3 : 5))) * D;
            thin_rows(P_F, P_XH, gpost, kind == 1 ? 1.0f : 0.5f, RS, sub + 1 < 3 * DEPTH ? nullptr : out, gw, NGW, lane);
        } else if (type == T_APROJ) {
            GET_TID()
            { pg8::Gemm g{P_XH, P_WA + (size_t)aux * ATT_COLS * D, M, ATT_COLS, D, 0}; pg8::StaticOrder S; S.init(M, ATT_COLS, G, bid);
              pg8::stage_scales(lds + RING_OFF, S, RS, false, 0, tid);
              pg8::EpiPlain E{P_BIG, ATT_COLS, (const LAS float*)(lds + RING_OFF + pg8::RS_TAB_OFF)};
              pg8::gemm_phase<pg8::EpiPlain, pg8::StaticOrder, true, true>(lds + RING_OFF, g, S, E, tid); }
        } else if (type == T_ATT) {
            GET_TID()
            const int ldil = 2 * aux;
            attn_group_mfma2(P_BIG, P_BIAS + aux * 16 * 129, ldil, aux == 0, P_OACC, P_LSE, lds + RING_OFF, tid, bid, G);
        } else if (type == T_RPROJ) {
            GET_TID()
            { pg8::Gemm g{P_XH + (size_t)aux * MH * D, P_WA, MH, RP_COLS, D, 0}; pg8::StaticOrder S; S.init(MH, RP_COLS, G, bid);
              pg8::stage_scales(lds + RING_OFF, S, RS + (size_t)aux * MH, false, 0, tid);
              pg8::EpiRet E{P_BIG, RP_COLS, (const LAS float*)(lds + RING_OFF + pg8::RS_TAB_OFF)};
              pg8::gemm_phase<pg8::EpiRet, pg8::StaticOrder, true, true>(lds + RING_OFF, g, S, E, tid); }
            { GET_TID()
              pg8::Gemm g{P_WA + (size_t)RP_COLS * D, P_XH + (size_t)aux * MH * D, DV, MH, D, 0}; pg8::StaticOrder S; S.init(DV, MH, G, bid);
              pg8::stage_scales(lds + RING_OFF, S, RS + (size_t)aux * MH, true, 0, tid);
              pg8::EpiVT E{(bf16*)(ws + WS_RVT), MH, 0, (const LAS float*)(lds + RING_OFF + pg8::RS_TAB_OFF)};
              pg8::gemm_phase<pg8::EpiVT, pg8::StaticOrder, true, true>(lds + RING_OFF, g, S, E, tid); }
        } else if (type == T_RCORE) {
            GET_TID()
            static_assert(RC_LDS <= RING_BYTES, "retention core LDS tiles");
            ret_core_mfma<0>(P_BIG, (const bf16*)(ws + WS_RVT), args.in[10] + jj * 2 * HR, P_YC + (size_t)aux * MH * DV, (bf16*)out, lds + RING_OFF, tid, bid, G);
#if PROBE_RC >= 0
            { GET_TID() ret_core_mfma<PROBE_RC>(P_BIG, (const bf16*)(ws + WS_RVT), args.in[10] + jj * 2 * HR, (bf16*)out + (size_t)MH * DV, (bf16*)out + (size_t)MH * DV, lds + RING_OFF, tid, bid, G); }
#endif
        } else {
            GET_TID()
            ret_combine(P_BIG, P_YC + (size_t)aux * MH * DV, (const bf16*)out, gw, NGW, lane);
        }
        if (ph + 1 < args.ph_hi || PROBE_TWICE) { XcdBarrier b_; b_.bar = (unsigned*)(ws + WS_CTL) + CW_BAR; b_.x = xb_xcc_id(); b_.st = MISC + 8; xcd_barrier(b_);
#if PROBE_BAR2
            xcd_barrier(b_);
#endif
        }
        if (PROBE_REPEAT) {
            if (!again && ((PROBE_REPEAT >> type) & 1) && (type != T_ATT || aux == 0) && ph + 1 < args.ph_hi) { again = true; --ph; } else again = false; }
    }
}

extern "C" void kernel_launch(void* const* d_in, const int* in_sizes, int n_in, void* d_out, int out_size, void* d_ws, size_t ws_size, hipStream_t stream) {
    static int grid = 0;
    if (grid == 0) {
        if (n_in != 11 || in_sizes[0] != M * D || out_size != M * D || ws_size < WS_END) { fprintf(stderr, "kernel_launch: unexpected shapes / workspace (n_in %d, ws %zu, need %zu); nothing launched\n", n_in, ws_size, (size_t)WS_END); grid = -1; return; }
        int dev = 0, cus = 0, per_cu = 0;
        if (hipGetDevice(&dev) != hipSuccess || hipDeviceGetAttribute(&cus, hipDeviceAttributeMultiprocessorCount, dev) != hipSuccess) { grid = -1; return; }
        if (hipFuncSetAttribute((const void*)mk_fwd, hipFuncAttributeMaxDynamicSharedMemorySize, LDS_BYTES) != hipSuccess) { fprintf(stderr, "kernel_launch: hipFuncSetAttribute failed\n"); grid = -1; return; }
        if (hipOccupancyMaxActiveBlocksPerMultiprocessor(&per_cu, (const void*)mk_fwd, NTHREADS, LDS_BYTES) != hipSuccess || per_cu < 1) { fprintf(stderr, "kernel_launch: occupancy query reports %d workgroups per CU\n", per_cu); }
        (void)hipGetLastError();
        grid = cus;
    }
    if (grid < 0) return;
    if (hipMemsetAsync((char*)d_ws + WS_CTL, 0, CTL_ZERO_BYTES, stream) != hipSuccess) return;
    Args a{};
    for (int i = 0; i < 11; ++i) a.in[i] = (const float*)d_in[i];
    a.out = (float*)d_out; a.ws = (unsigned char*)d_ws;
#if MK_ONE_LAUNCH
    a.ph_lo = 0; a.ph_hi = NPHASES;
    hipLaunchKernelGGL(mk_fwd, dim3(grid), dim3(NTHREADS), LDS_BYTES, stream, a);
#else
    for (int p = 0; p < NPHASES; ++p) { a.ph_lo = p; a.ph_hi = p + 1; hipLaunchKernelGGL(mk_fwd, dim3(grid), dim3(NTHREADS), LDS_BYTES, stream, a); }
#endif
}
```

```cpp
#include <hip/hip_runtime.h>
#include <cstdio>
#include <cstdint>
#ifndef PROBE_REPEAT
#define PROBE_REPEAT 0
#endif
#ifndef PROBE_THIN2
#define PROBE_THIN2 0
#endif
#ifndef PROBE_ATT2
#define PROBE_ATT2 0
#endif
#ifndef PROBE_CONV2
#define PROBE_CONV2 0
#endif
#ifndef PROBE_FGM
#define PROBE_FGM 0
#endif
#ifndef PROBE_RC
#define PROBE_RC -1
#endif
#ifndef PROBE_G1V
#define PROBE_G1V -1
#endif
#ifndef PROBE_BAR2
#define PROBE_BAR2 0
#endif
#ifndef PROBE_MFMA
#define PROBE_MFMA 0
#endif
#ifndef PROBE_TWICE
#define PROBE_TWICE 0
#endif
#ifndef PROBE_TOUCH
#define PROBE_TOUCH 0
#endif
#ifndef MK_ONE_LAUNCH
#define MK_ONE_LAUNCH 1
#endif
namespace pg8 {
#define PG8_LAS __attribute__((address_space(3)))
typedef unsigned short bf16_t;
typedef short bf16x8 __attribute__((ext_vector_type(8)));
typedef float f32x4 __attribute__((ext_vector_type(4)));
typedef unsigned u32x4 __attribute__((ext_vector_type(4)));
constexpr int BM = 256, BK = 64, HALF = 128, HTB = HALF * BK * 2  , STAGE_BYTES = 8 * HTB, NXCD = 8, WGM = 8;

__host__ __device__ __forceinline__ int lds_byte(int r, int c) { const int st = (r >> 4) * 2 + (c >> 5), rr = r & 15, cc = c & 31, ob = rr * 64 + cc * 2; return st * 1024 + (ob ^ (((ob >> 9) & 1) << 5)); }
__host__ __device__ __forceinline__ void stage_rc(int b, int& R, int& C) { const int st = b / 1024, sb = b % 1024, swz = sb ^ (((sb >> 9) & 1) << 5); R = (st >> 1) * 16 + swz / 64; C = (st & 1) * 32 + (swz % 64) / 2; }
__host__ __device__ __forceinline__ int perm32(int rho) { const int n = rho >> 4, i = rho & 15; return 8 * (i >> 2) + 4 * n + (i & 3); }

struct Unit { int pm, pn, idx; };
struct Gemm { const bf16_t* A; const bf16_t* Bt; int M, N, K; int ldil; };

struct StaticOrder {
    int nM, nN, nwg, G, c;
    __host__ __device__ void init(int M, int N, int G_, int c_) { nM = M / BM; nN = N / BM; nwg = nM * nN; G = G_; c = c_; }
    __host__ __device__ bool next(int i, Unit& u) const {
        const long L = (long)i * G + c; if (L >= nwg) return false;
        int wgid = (int)L; { const int q = nwg / NXCD, r = nwg % NXCD, xcd = wgid % NXCD, off = wgid / NXCD; wgid = (xcd < r ? xcd * (q + 1) : r * (q + 1) + (xcd - r) * q) + off; }
        const int nig = WGM * nN, gid = wgid / nig, fm = gid * WGM, gsz = (nM - fm) < WGM ? (nM - fm) : WGM;
        u.pm = fm + ((wgid % nig) % gsz); u.pn = (wgid % nig) / gsz; u.idx = i; return true;
    }
    __device__ __forceinline__ void a_ready(const Unit&) const {}
    __device__ __forceinline__ void done(const Unit&) const {}
};

__device__ __forceinline__ unsigned cvt_pk_bf16(float lo, float hi) { unsigned r; asm volatile("v_cvt_pk_bf16_f32 %0, %1, %2" : "=v"(r) : "v"(lo), "v"(hi)); return r; }
typedef float f32x2 __attribute__((ext_vector_type(2)));

__device__ __forceinline__ float fast_sigmoid(float g) { return __builtin_amdgcn_rcpf(1.0f + __builtin_amdgcn_exp2f(-1.4426950409f * g)); }
constexpr int RS_TAB_OFF = 131072;
template <class Sched> __device__ __forceinline__ void stage_scales(PG8_LAS unsigned char* lds, const Sched& S, const float* rs, bool cols, int ldil, int tid) {
    PG8_LAS float* tab = (PG8_LAS float*)(lds + RS_TAB_OFF); Unit u;
    if (tid < 256) { const int lper = 8 - ldil, c = tid, tm = ((c & ((1 << lper) - 1)) << ldil) + (c >> lper);
        for (int i = 0; i < 16 && S.next(i, u); ++i) tab[i * 256 + tid] = rs[cols ? u.pn * BM + tm : u.pm * BM + tid]; }
    __syncthreads();
}
struct EpiPlain {
    static constexpr bool PERM = true, AFTER_DRAIN = false;
    bf16_t* O; int ldc; const PG8_LAS float* tab;
    __device__ __forceinline__ void operator()(const f32x4 (&acc)[2][2][4][2], const Unit& u, int wr, int wc, int fr, int fq) const {
        const int row0 = u.pm * BM + wr * 64 + fr, col0 = u.pn * BM + wc * 32 + 8 * fq;
#pragma unroll
        for (int ai = 0; ai < 2; ++ai)
#pragma unroll
            for (int m = 0; m < 4; ++m) { const int row = row0 + ai * HALF + m * 16; bf16_t* rowp = O + (size_t)row * ldc + col0; const float r = tab ? tab[u.idx * 256 + (row & 255)] : 1.0f;
#pragma unroll
                for (int bj = 0; bj < 2; ++bj) { const f32x4 v0 = acc[ai][bj][m][0] * r, v1 = acc[ai][bj][m][1] * r;
                    u32x4 w; w.x = cvt_pk_bf16(v0[0], v0[1]); w.y = cvt_pk_bf16(v0[2], v0[3]); w.z = cvt_pk_bf16(v1[0], v1[1]); w.w = cvt_pk_bf16(v1[2], v1[3]);
                    *(u32x4*)(rowp + bj * HALF) = w; } }
    }
};
template <int CHEAP = 0  > struct EpiSwiGLUT {
    static constexpr bool PERM = true, AFTER_DRAIN = false;
    bf16_t* O; int ldc; const PG8_LAS float* tab;
    __device__ __forceinline__ void operator()(const f32x4 (&acc)[2][2][4][2], const Unit& u, int wr, int wc, int fr, int fq) const {
        const int row0 = u.pm * BM + wr * 64 + fr, col0 = CHEAP ? ((u.pn * HALF + wc * 32 + 8 * fq) & 1023) : (u.pn * HALF + wc * 32 + 8 * fq);
#pragma unroll
        for (int ai = 0; ai < 2; ++ai)
#pragma unroll
            for (int m = 0; m < 4; ++m) { const int row = row0 + ai * HALF + m * 16; bf16_t* rowp = O + (size_t)row * ldc + col0; const float r = tab[u.idx * 256 + (row & 255)];
                float o[8];
#pragma unroll
                for (int n = 0; n < 2; ++n)
#pragma unroll
                    for (int e = 0; e < 4; ++e) { const float g = acc[ai][0][m][n][e] * r, up = acc[ai][1][m][n][e] * r; o[n * 4 + e] = CHEAP ? g * up : g * fast_sigmoid(g) * up; }
                u32x4 w; w.x = cvt_pk_bf16(o[0], o[1]); w.y = cvt_pk_bf16(o[2], o[3]); w.z = cvt_pk_bf16(o[4], o[5]); w.w = cvt_pk_bf16(o[6], o[7]);
                if (CHEAP == 2) { if (w.x == 0x12345678u && w.y == w.z) *(u32x4*)rowp = w; } else *(u32x4*)rowp = w; }
    }
};
typedef EpiSwiGLUT<0> EpiSwiGLU;
struct EpiRet {
    static constexpr bool PERM = true, AFTER_DRAIN = false;
    bf16_t* O; int ldc; const PG8_LAS float* tab;
    __device__ __forceinline__ void operator()(const f32x4 (&acc)[2][2][4][2], const Unit& u, int wr, int wc, int fr, int fq) const {
        const int row0 = u.pm * BM + wr * 64 + fr, col0 = u.pn * BM + wc * 32 + 8 * fq;
        if (true) {
            const float osc = (u.pn >= 4) ? 0.0625f : 1.0f;
            float invf[8];
#pragma unroll
            for (int q = 0; q < 8; ++q) { const int j = wc * 32 + 8 * fq + q; invf[q] = __builtin_amdgcn_exp2f(-(float)j * (13.287712379549449f / 127.0f)) * 0.15915494309189535f; }
#pragma unroll
            for (int ai = 0; ai < 2; ++ai)
#pragma unroll
                for (int m = 0; m < 4; ++m) { const int row = row0 + ai * HALF + m * 16; const float pos = (float)(row & 2047), r = tab[u.idx * 256 + (row & 255)] * osc;
                    bf16_t* rowp = O + (size_t)row * ldc + col0;
                    float o1[8], o2[8];
#pragma unroll
                    for (int n = 0; n < 2; ++n)
#pragma unroll
                        for (int e = 0; e < 4; ++e) { const int q = n * 4 + e; float t = pos * invf[q]; t = __builtin_amdgcn_fractf(t);
                            const float sn = __builtin_amdgcn_sinf(t), cs = __builtin_amdgcn_cosf(t);
                            const float a = acc[ai][0][m][n][e], b = acc[ai][1][m][n][e];
                            o1[q] = (a * cs - b * sn) * r; o2[q] = (a * sn + b * cs) * r; }
                    u32x4 w; w.x = cvt_pk_bf16(o1[0], o1[1]); w.y = cvt_pk_bf16(o1[2], o1[3]); w.z = cvt_pk_bf16(o1[4], o1[5]); w.w = cvt_pk_bf16(o1[6], o1[7]);
                    *(u32x4*)rowp = w;
                    w.x = cvt_pk_bf16(o2[0], o2[1]); w.y = cvt_pk_bf16(o2[2], o2[3]); w.z = cvt_pk_bf16(o2[4], o2[5]); w.w = cvt_pk_bf16(o2[6], o2[7]);
                    *(u32x4*)(rowp + HALF) = w; }
        } else {
#pragma unroll
            for (int ai = 0; ai < 2; ++ai)
#pragma unroll
                for (int m = 0; m < 4; ++m) { const int row = row0 + ai * HALF + m * 16; bf16_t* rowp = O + (size_t)row * ldc + col0; const float r = tab[u.idx * 256 + (row & 255)];
#pragma unroll
                    for (int bj = 0; bj < 2; ++bj) { const f32x4 v0 = acc[ai][bj][m][0] * r, v1 = acc[ai][bj][m][1] * r;
                        u32x4 w; w.x = cvt_pk_bf16(v0[0], v0[1]); w.y = cvt_pk_bf16(v0[2], v0[3]); w.z = cvt_pk_bf16(v1[0], v1[1]); w.w = cvt_pk_bf16(v1[2], v1[3]);
                        *(u32x4*)(rowp + bj * HALF) = w; } }
        }
    }
};

struct EpiGate {
    static constexpr bool PERM = true, AFTER_DRAIN = false;
    bf16_t* Y; const bf16_t* YB; const float* ST; const PG8_LAS float* tab;
    __device__ __forceinline__ void operator()(const f32x4 (&acc)[2][2][4][2], const Unit& u, int wr, int wc, int fr, int fq) const {
        const int row0 = u.pm * BM + wr * 64 + fr, col0 = u.pn * HALF + wc * 32 + 8 * fq, head = u.pn >> 2;
#pragma unroll
        for (int ai = 0; ai < 2; ++ai)
#pragma unroll
            for (int m = 0; m < 4; ++m) { const int row = row0 + ai * HALF + m * 16; const float r = tab[u.idx * 256 + (row & 255)];
                const f32x4 st = *(const f32x4*)(ST + (size_t)row * 16 + head * 4);
                const float muf = __builtin_amdgcn_ldexpf(st[0], -9), mub = __builtin_amdgcn_ldexpf(st[2], -9); float eps = 1e-6f; asm volatile("" : "+s"(eps));
                const float rf = __builtin_amdgcn_rsqf(fmaxf(__builtin_amdgcn_ldexpf(st[1], -9) - muf * muf, 0.f) + eps), rb = __builtin_amdgcn_rsqf(fmaxf(__builtin_amdgcn_ldexpf(st[3], -9) - mub * mub, 0.f) + eps);
                bf16_t* yp = Y + (size_t)row * 2048 + col0; const bf16_t* bp = YB + (size_t)row * 2048 + col0;
                const u32x4 yfw = *(const u32x4*)yp, ybw = *(const u32x4*)bp;
                float o[8];
#pragma unroll
                for (int n = 0; n < 2; ++n)
#pragma unroll
                    for (int e = 0; e < 4; ++e) { const int q = n * 4 + e; const unsigned wf = yfw[q >> 1], wb = ybw[q >> 1];
                        const float yf = __builtin_bit_cast(float, (q & 1) ? (wf & 0xffff0000u) : (wf << 16)), yb = __builtin_bit_cast(float, (q & 1) ? (wb & 0xffff0000u) : (wb << 16));
                        const float gf = acc[ai][0][m][n][e] * r, gb = acc[ai][1][m][n][e] * r;
                        o[q] = gf * fast_sigmoid(gf) * (yf - muf) * rf + gb * fast_sigmoid(gb) * (yb - mub) * rb; }
                u32x4 w; w.x = cvt_pk_bf16(o[0], o[1]); w.y = cvt_pk_bf16(o[2], o[3]); w.z = cvt_pk_bf16(o[4], o[5]); w.w = cvt_pk_bf16(o[6], o[7]);
                *(u32x4*)yp = w; }
    }
};

struct EpiVT {
    static constexpr bool PERM = true, AFTER_DRAIN = false;
    bf16_t* O; int ldc; int ldil; const PG8_LAS float* tab;
    __device__ __forceinline__ void operator()(const f32x4 (&acc)[2][2][4][2], const Unit& u, int wr, int wc, int fr, int fq) const {
        const int lper = 8 - ldil, per = 1 << lper, Ls = 2048 >> ldil, b = u.pn >> 3, pl = u.pn & 7;
        const int row0 = u.pm * BM + wr * 64 + fr;
        int colb[2]; float cs[2][8];
#pragma unroll
        for (int bj = 0; bj < 2; ++bj) { const int c0 = bj * HALF + wc * 32 + 8 * fq; colb[bj] = b * 2048 + (c0 >> lper) * Ls + pl * per + (c0 & (per - 1));
            const f32x4 a = *(const PG8_LAS f32x4*)(tab + u.idx * 256 + c0), b4 = *(const PG8_LAS f32x4*)(tab + u.idx * 256 + c0 + 4);
            cs[bj][0] = a[0]; cs[bj][1] = a[1]; cs[bj][2] = a[2]; cs[bj][3] = a[3]; cs[bj][4] = b4[0]; cs[bj][5] = b4[1]; cs[bj][6] = b4[2]; cs[bj][7] = b4[3]; }
#pragma unroll
        for (int ai = 0; ai < 2; ++ai)
#pragma unroll
            for (int m = 0; m < 4; ++m) { bf16_t* rowp = O + (size_t)(row0 + ai * HALF + m * 16) * ldc;
#pragma unroll
                for (int bj = 0; bj < 2; ++bj) { const f32x4 v0 = acc[ai][bj][m][0], v1 = acc[ai][bj][m][1];
                    u32x4 w; w.x = cvt_pk_bf16(v0[0] * cs[bj][0], v0[1] * cs[bj][1]); w.y = cvt_pk_bf16(v0[2] * cs[bj][2], v0[3] * cs[bj][3]); w.z = cvt_pk_bf16(v1[0] * cs[bj][4], v1[1] * cs[bj][5]); w.w = cvt_pk_bf16(v1[2] * cs[bj][6], v1[3] * cs[bj][7]);
                    *(u32x4*)(rowp + colb[bj]) = w; } }
    }
};

struct EpiKVT {
    static constexpr bool PERM = true, AFTER_DRAIN = false;
    bf16_t* OK; bf16_t* OV; int ldc; const PG8_LAS float* tab;
    __device__ __forceinline__ void operator()(const f32x4 (&acc)[2][2][4][2], const Unit& u, int wr, int wc, int fr, int fq) const {
        const int col0 = u.pn * BM + wc * 32 + 8 * fq;
        float cs[2][8];
#pragma unroll
        for (int bj = 0; bj < 2; ++bj) { const int cl = bj * HALF + wc * 32 + 8 * fq; const f32x4 a = *(const PG8_LAS f32x4*)(tab + u.idx * 256 + cl), b = *(const PG8_LAS f32x4*)(tab + u.idx * 256 + cl + 4);
            cs[bj][0] = a[0]; cs[bj][1] = a[1]; cs[bj][2] = a[2]; cs[bj][3] = a[3]; cs[bj][4] = b[0]; cs[bj][5] = b[1]; cs[bj][6] = b[2]; cs[bj][7] = b[3]; }
        if (u.pm < 4) {
#pragma unroll
            for (int m = 0; m < 4; ++m) { const int j = wr * 64 + m * 16 + fr;
                const float invf = __builtin_amdgcn_exp2f(-(float)j * (13.287712379549449f / 127.0f)) * 0.15915494309189535f;
                bf16_t* r1 = OK + (size_t)(u.pm * BM + j) * ldc + col0; bf16_t* r2 = r1 + (size_t)HALF * ldc;
#pragma unroll
                for (int bj = 0; bj < 2; ++bj) { float o1[8], o2[8];
#pragma unroll
                    for (int n = 0; n < 2; ++n)
#pragma unroll
                        for (int e = 0; e < 4; ++e) { const int q = n * 4 + e; const float pos = (float)((col0 + bj * HALF + q) & 2047); float t = pos * invf; t = __builtin_amdgcn_fractf(t);
                            const float sn = __builtin_amdgcn_sinf(t), cn = __builtin_amdgcn_cosf(t), sc = cs[bj][q] * 0.0625f;
                            const float a = acc[0][bj][m][n][e], b = acc[1][bj][m][n][e];
                            o1[q] = (a * cn - b * sn) * sc; o2[q] = (a * sn + b * cn) * sc; }
                    u32x4 w; w.x = cvt_pk_bf16(o1[0], o1[1]); w.y = cvt_pk_bf16(o1[2], o1[3]); w.z = cvt_pk_bf16(o1[4], o1[5]); w.w = cvt_pk_bf16(o1[6], o1[7]);
                    *(u32x4*)(r1 + bj * HALF) = w;
                    w.x = cvt_pk_bf16(o2[0], o2[1]); w.y = cvt_pk_bf16(o2[2], o2[3]); w.z = cvt_pk_bf16(o2[4], o2[5]); w.w = cvt_pk_bf16(o2[6], o2[7]);
                    *(u32x4*)(r2 + bj * HALF) = w; } }
        } else {
            const int row0 = (u.pm - 4) * BM + wr * 64 + fr;
#pragma unroll
            for (int ai = 0; ai < 2; ++ai)
#pragma unroll
                for (int m = 0; m < 4; ++m) { bf16_t* rowp = OV + (size_t)(row0 + ai * HALF + m * 16) * ldc + col0;
#pragma unroll
                    for (int bj = 0; bj < 2; ++bj) { const f32x4 v0 = acc[ai][bj][m][0], v1 = acc[ai][bj][m][1];
                        u32x4 w; w.x = cvt_pk_bf16(v0[0] * cs[bj][0], v0[1] * cs[bj][1]); w.y = cvt_pk_bf16(v0[2] * cs[bj][2], v0[3] * cs[bj][3]); w.z = cvt_pk_bf16(v1[0] * cs[bj][4], v1[1] * cs[bj][5]); w.w = cvt_pk_bf16(v1[2] * cs[bj][6], v1[3] * cs[bj][7]);
                        *(u32x4*)(rowp + bj * HALF) = w; } }
        }
    }
};

template <class Epi, class Sched, bool ALIGN_EPI = false, bool SP2 = false>
__device__ __forceinline__ void gemm_phase(PG8_LAS unsigned char* lds, const Gemm g, const Sched& S, const Epi& E, const int tid) {
    const int wid = __builtin_amdgcn_readfirstlane(tid >> 6), lane = tid & 63, wr = wid >> 2, wc = wid & 3, fr = lane & 15, fq = lane >> 4;
    const int K = g.K, nt = K / BK;
    unsigned voffA[2], voffB[2], voffB1[2];
#pragma unroll
    for (int i = 0; i < 2; ++i) { int R, C; stage_rc(tid * 16 + i * 8192, R, C); const int Rb = Epi::PERM ? ((R & ~31) + perm32(R & 31)) : R;
        voffA[i] = (unsigned)(R * K + C) * 2u; { const int ld = g.ldil, lper = 8 - ld, pm1 = (1 << lper) - 1; const int c0 = Rb, c1 = 128 + Rb; voffB[i] = (unsigned)((((c0 & pm1) << ld) + (c0 >> lper)) * K + C) * 2u; voffB1[i] = (unsigned)((((c1 & pm1) << ld) + (c1 >> lper)) * K + C) * 2u; } }
    const size_t kstep = (size_t)(BK * 2);
    const size_t hstep = (size_t)HALF * K * 2;
    const size_t tstep = 2 * hstep;
    const unsigned ldsw = (unsigned)wid * 1024u;
    const int aoff = lds_byte(wr * 64 + fr, fq * 8), boff = lds_byte(wc * 32 + fr, fq * 8);
#define PG8_SA(b, h) (((b) * 2 + (h)) * HTB)
#define PG8_SB(b, h) ((4 + (b) * 2 + (h)) * HTB)
#define PG8_STAGE(bufoff, gbase, voff) do { _Pragma("unroll") for (int _i = 0; _i < 2; ++_i) \
        __builtin_amdgcn_global_load_lds((const unsigned*)((const char*)(gbase) + (voff)[_i]), (PG8_LAS unsigned*)(lds + (bufoff) + ldsw + _i * 8192), 16, 0, 0); } while (0)
#define PG8_LDA(dst, b, h) do { _Pragma("unroll") for (int m = 0; m < 4; ++m) _Pragma("unroll") for (int k = 0; k < 2; ++k) dst[m][k] = *(const PG8_LAS bf16x8*)(lds + PG8_SA(b, h) + aoff + m * 2048 + k * 1024); } while (0)
#define PG8_LDB(dst, b, h) do { _Pragma("unroll") for (int n = 0; n < 2; ++n) _Pragma("unroll") for (int k = 0; k < 2; ++k) dst[n][k] = *(const PG8_LAS bf16x8*)(lds + PG8_SB(b, h) + boff + n * 2048 + k * 1024); } while (0)
#define PG8_MMA(ai, bj, At, Bt) do { __builtin_amdgcn_s_setprio(1); _Pragma("unroll") for (int m = 0; m < 4; ++m) _Pragma("unroll") for (int n = 0; n < 2; ++n) _Pragma("unroll") for (int k = 0; k < 2; ++k) \
        acc[ai][bj][m][n] = __builtin_amdgcn_mfma_f32_16x16x32_bf16(Bt[n][k], At[m][k], acc[ai][bj][m][n], 0, 0, 0); __builtin_amdgcn_s_setprio(0); } while (0)
#define PG8_WAIT_V(n) asm volatile("s_waitcnt vmcnt(" #n ")" ::: "memory")
#define PG8_WAIT_L(n) asm volatile("s_waitcnt lgkmcnt(" #n ")" ::: "memory")
#define PG8_BAR __builtin_amdgcn_s_barrier()
#define PG8_SCHED __builtin_amdgcn_sched_barrier(0)
    Unit cur, nxt; int ui = 0;
    if (!S.next(0, cur)) return;
    f32x4 acc[2][2][4][2];
#pragma unroll
    for (int a = 0; a < 2; ++a)
#pragma unroll
        for (int b = 0; b < 2; ++b)
#pragma unroll
            for (int m = 0; m < 4; ++m)
#pragma unroll
                for (int n = 0; n < 2; ++n) acc[a][b][m][n] = (f32x4){0.f, 0.f, 0.f, 0.f};
    bf16x8 At[4][2], B0[2][2], B1[2][2];
    const char* cA = (const char*)g.A + (size_t)cur.pm * tstep; const char* cB = (const char*)g.Bt + (size_t)cur.pn * tstep;
    S.a_ready(cur);
    if constexpr (SP2) {
        PG8_STAGE(PG8_SB(0, 0), cB, voffB); PG8_STAGE(PG8_SB(0, 1), cB, voffB1); PG8_STAGE(PG8_SA(0, 0), cA, voffA); PG8_STAGE(PG8_SA(0, 1), cA + hstep, voffA);
        if (wr == 1) PG8_BAR;
        PG8_WAIT_V(2); PG8_BAR;
        PG8_STAGE(PG8_SB(1, 0), cB + kstep, voffB); PG8_STAGE(PG8_SA(1, 0), cA + kstep, voffA); PG8_STAGE(PG8_SB(1, 1), cB + kstep, voffB1);
        PG8_WAIT_V(6); PG8_BAR;
    } else {
        PG8_STAGE(PG8_SB(0, 0), cB, voffB); PG8_STAGE(PG8_SA(0, 0), cA, voffA); PG8_STAGE(PG8_SB(0, 1), cB, voffB1); PG8_STAGE(PG8_SA(0, 1), cA + hstep, voffA);
        if (wr == 1) PG8_BAR;
        PG8_WAIT_V(4); PG8_BAR;
        PG8_STAGE(PG8_SB(1, 0), cB + kstep, voffB); PG8_STAGE(PG8_SA(1, 0), cA + kstep, voffA); PG8_STAGE(PG8_SB(1, 1), cB + kstep, voffB1);
        PG8_WAIT_V(6); PG8_BAR;
    }
    for (;;) {
        const bool has_next = S.next(ui + 1, nxt);
        const char* nA = has_next ? (const char*)g.A + (size_t)nxt.pm * tstep : cA; const char* nB = has_next ? (const char*)g.Bt + (size_t)nxt.pn * tstep : cB;
        for (int t = 0; t < nt; t += 2) {
            const bool last = (t == nt - 2);
            const char* a1 = cA + (size_t)(t + 1) * kstep;
            const char* a2 = last ? nA : cA + (size_t)(t + 2) * kstep; const char* b2 = last ? nB : cB + (size_t)(t + 2) * kstep;
            const char* a3 = a2 + kstep; const char* b3 = b2 + kstep;
            if (last && has_next) S.a_ready(nxt);
            if constexpr (SP2) {
            PG8_LDB(B0, 0, 0); PG8_LDB(B1, 0, 1); PG8_SCHED; PG8_LDA(At, 0, 0); PG8_STAGE(PG8_SA(1, 1), a1 + hstep, voffA);
            PG8_WAIT_V(8); PG8_WAIT_L(0); PG8_BAR; PG8_MMA(0, 0, At, B0); PG8_MMA(0, 1, At, B1); PG8_BAR; PG8_SCHED;
            PG8_LDA(At, 0, 1); PG8_STAGE(PG8_SB(0, 0), b2, voffB); PG8_STAGE(PG8_SB(0, 1), b2, voffB1); PG8_STAGE(PG8_SA(0, 0), a2, voffA);
            PG8_WAIT_V(8); PG8_WAIT_L(0); PG8_BAR; PG8_MMA(1, 0, At, B0); PG8_MMA(1, 1, At, B1); PG8_BAR; PG8_SCHED;
            PG8_LDB(B0, 1, 0); PG8_LDB(B1, 1, 1); PG8_SCHED; PG8_LDA(At, 1, 0); PG8_STAGE(PG8_SA(0, 1), a2 + hstep, voffA);
            PG8_WAIT_V(8); PG8_WAIT_L(0); PG8_BAR; PG8_MMA(0, 0, At, B0); PG8_MMA(0, 1, At, B1); PG8_BAR; PG8_SCHED;
            PG8_LDA(At, 1, 1); PG8_STAGE(PG8_SB(1, 0), b3, voffB); PG8_STAGE(PG8_SB(1, 1), b3, voffB1); PG8_STAGE(PG8_SA(1, 0), a3, voffA);
            PG8_WAIT_V(8); PG8_WAIT_L(0); PG8_BAR; PG8_MMA(1, 0, At, B0); PG8_MMA(1, 1, At, B1); PG8_BAR; PG8_SCHED;
            } else {
            PG8_LDB(B0, 0, 0); PG8_SCHED; PG8_LDA(At, 0, 0); PG8_STAGE(PG8_SA(1, 1), a1 + hstep, voffA);
            PG8_WAIT_L(8); PG8_BAR; PG8_WAIT_L(0); PG8_MMA(0, 0, At, B0); PG8_BAR; PG8_SCHED;
            PG8_LDB(B1, 0, 1); PG8_STAGE(PG8_SB(0, 0), b2, voffB);
            PG8_BAR; PG8_WAIT_L(0); PG8_MMA(0, 1, At, B1); PG8_BAR;
            PG8_LDA(At, 0, 1); PG8_STAGE(PG8_SA(0, 0), a2, voffA);
            PG8_BAR; PG8_WAIT_L(0); PG8_MMA(1, 0, At, B0); PG8_BAR; PG8_SCHED;
            PG8_STAGE(PG8_SB(0, 1), b2, voffB1);
            PG8_WAIT_V(6); PG8_BAR; PG8_MMA(1, 1, At, B1); PG8_BAR;
            PG8_LDB(B0, 1, 0); PG8_SCHED; PG8_LDA(At, 1, 0); PG8_STAGE(PG8_SA(0, 1), a2 + hstep, voffA);
            PG8_WAIT_L(8); PG8_BAR; PG8_WAIT_L(0); PG8_MMA(0, 0, At, B0); PG8_BAR; PG8_SCHED;
            PG8_LDB(B1, 1, 1); PG8_STAGE(PG8_SB(1, 0), b3, voffB);
            PG8_BAR; PG8_WAIT_L(0); PG8_MMA(0, 1, At, B1); PG8_BAR;
            PG8_LDA(At, 1, 1); PG8_STAGE(PG8_SA(1, 0), a3, voffA);
            PG8_BAR; PG8_WAIT_L(0); PG8_MMA(1, 0, At, B0); PG8_BAR; PG8_SCHED;
            PG8_STAGE(PG8_SB(1, 1), b3, voffB1);
            PG8_WAIT_V(6); PG8_BAR; PG8_MMA(1, 1, At, B1); PG8_BAR;
            }
        }
        if constexpr (ALIGN_EPI) { if (wr == 0) PG8_BAR; }
        if constexpr (!Epi::AFTER_DRAIN) { E(acc, cur, wr, wc, fr, fq); S.done(cur); }
        if (!has_next) break;
#pragma unroll
        for (int a = 0; a < 2; ++a)
#pragma unroll
            for (int b = 0; b < 2; ++b)
#pragma unroll
                for (int m = 0; m < 4; ++m)
#pragma unroll
                    for (int n = 0; n < 2; ++n) acc[a][b][m][n] = (f32x4){0.f, 0.f, 0.f, 0.f};
        cur = nxt; cA = nA; cB = nB; ++ui;
        if constexpr (ALIGN_EPI) { if (wr == 1) PG8_BAR; }
    }
    PG8_WAIT_V(0);
    if constexpr (!ALIGN_EPI) { if (wr == 0) PG8_BAR; }
    PG8_BAR;
    if constexpr (Epi::AFTER_DRAIN) { E.fused(acc, cur, wr, wc, fr, fq, lds, wid, lane); S.done(cur); }
#undef PG8_SA
#undef PG8_SB
#undef PG8_STAGE
#undef PG8_LDA
#undef PG8_LDB
#undef PG8_MMA
#undef PG8_WAIT_V
#undef PG8_WAIT_L
#undef PG8_BAR
#undef PG8_SCHED
}
}

constexpr int BATCH = 16, SEQ = 2048, D = 1024, M = BATCH * SEQ, DEPTH = 4, DFF = 2816;
constexpr int NGRP = 3, HA = 16, DHA = 64, ATT_COLS = 3 * D;
constexpr int HR = 4, DKR = 256, DVR = 512, DV = HR * DVR, RET_COLS = 2 * D + 3 * DV;
constexpr int MH = M / 2;
constexpr float NORM_EPS = 1e-6f;
constexpr int NWAVES = 8, NTHREADS = NWAVES * 64;
constexpr int NPHASES = 1 + (DEPTH / 2) * (14 + 12);

__device__ const unsigned char T5_BUCKET[3][129] = {
{11,11,11,11,11,11,11,11,11,11,11,11,11,11,11,10,10,10,10,10,10,10,10,10,10,10,10,10,10,10,10,10,10,10,10,10,10,10,9,9,9,9,9,9,9,9,9,9,9,9,8,8,8,8,8,8,8,7,6,5,4,3,2,1,0,17,18,19,20,21,22,23,24,24,24,24,24,24,24,25,25,25,25,25,25,25,25,25,25,25,25,26,26,26,26,26,26,26,26,26,26,26,26,26,26,26,26,26,26,26,26,26,26,26,27,27,27,27,27,27,27,27,27,27,27,27,27,27,27},
{13,13,13,13,13,13,13,13,13,13,13,13,13,13,13,13,13,13,13,13,13,13,13,12,12,12,12,12,12,12,12,12,12,12,12,12,12,12,12,12,12,12,11,11,11,11,11,11,11,11,11,11,10,10,10,10,10,10,9,9,9,8,8,4,0,20,24,24,25,25,25,26,26,26,26,26,26,27,27,27,27,27,27,27,27,27,27,28,28,28,28,28,28,28,28,28,28,28,28,28,28,28,28,28,28,28,29,29,29,29,29,29,29,29,29,29,29,29,29,29,29,29,29,29,29,29,29,29,29},
{15,15,15,15,15,15,15,15,15,15,15,15,15,15,15,15,15,15,15,15,15,15,15,15,15,15,15,15,15,15,14,14,14,14,14,14,14,14,14,14,14,14,14,14,14,13,13,13,13,13,13,13,13,13,12,12,12,12,12,11,11,10,10,9,0,25,26,26,27,27,28,28,28,28,28,29,29,29,29,29,29,29,29,29,30,30,30,30,30,30,30,30,30,30,30,30,30,30,30,31,31,31,31,31,31,31,31,31,31,31,31,31,31,31,31,31,31,31,31,31,31,31,31,31,31,31,31,31,31}};

constexpr size_t MiB = 1u << 20;
constexpr size_t WS_CTL = 0, CTL_ZERO_BYTES = 1 * MiB;
constexpr size_t WS_BIAS = 1 * MiB;
constexpr size_t WS_RS = WS_BIAS + 256 * 1024;
constexpr size_t WS_W = 2 * MiB;
constexpr size_t WS_W2_FFN = WS_W + (size_t)2 * DFF * D * 2;
constexpr size_t WS_W2_ATT = WS_W + (size_t)NGRP * ATT_COLS * D * 2;
constexpr size_t WS_W2_RET = WS_W + (size_t)RET_COLS * D * 2;
constexpr size_t WS_XH = 26 * MiB;
constexpr size_t WS_YC = 90 * MiB;
constexpr size_t WS_BIG = 218 * MiB;
constexpr size_t WS_F = 410 * MiB;
constexpr size_t WS_RVT = 346 * MiB;
constexpr size_t WS_OACC = 474 * MiB;
constexpr size_t WS_LSE = 538 * MiB;
constexpr size_t WS_END = 540 * MiB;
static_assert(WS_W2_FFN + (size_t)D * DFF * 2 <= WS_XH && WS_W2_ATT + (size_t)D * D * 2 <= WS_XH && WS_W2_RET + (size_t)D * DV * 2 <= WS_XH, "weight region");
constexpr int RP_COLS = 2 * D + 2 * DV;
static_assert(WS_XH + (size_t)M * D * 2 == WS_YC && WS_YC + (size_t)M * DV * 2 == WS_BIG && WS_BIG + (size_t)MH * RP_COLS * 2 == WS_F && WS_BIG + (size_t)M * 2 * D * 2 == WS_RVT && WS_RVT + (size_t)DV * M * 2 == WS_OACC && WS_F + (size_t)M * D * 2 == WS_OACC && WS_OACC + (size_t)M * D * 2 == WS_LSE, "d_ws map");
static_assert((size_t)M * DFF * 2 <= 192 * MiB && (size_t)M * ATT_COLS * 2 <= 192 * MiB && WS_LSE + (size_t)M * 16 * 4 <= WS_END, "d_ws map");
constexpr int CW_BAR = 4096;

constexpr int RING_OFF = 0, RING_BYTES = 149504;
constexpr int LDSCTL_OFF = RING_BYTES, MISC_OFF = LDSCTL_OFF + 320;
constexpr int LDS_BYTES = RING_BYTES + 512;
static_assert(MISC_OFF + 128 <= LDS_BYTES, "LDS map");

#define LAS __attribute__((address_space(3)))
typedef unsigned short bf16;
typedef unsigned v4u __attribute__((ext_vector_type(4)));
typedef unsigned v2u __attribute__((ext_vector_type(2)));
typedef float f32x4 __attribute__((ext_vector_type(4)));
#define LDS_WAIT() asm volatile("s_waitcnt lgkmcnt(0)" ::: "memory")
__device__ __forceinline__ unsigned f2bf(float f) { unsigned u = __builtin_bit_cast(unsigned, f); return (u + 0x7fffu + ((u >> 16) & 1u)) >> 16; }
__device__ __forceinline__ unsigned pk2(float lo, float hi) { return f2bf(lo) | (f2bf(hi) << 16); }
__device__ __forceinline__ float bflo(unsigned w) { return __builtin_bit_cast(float, w << 16); }
__device__ __forceinline__ float bfhi(unsigned w) { return __builtin_bit_cast(float, w & 0xffff0000u); }
__device__ __forceinline__ float opaque_f(float c) { float v = c; asm volatile("" : "+s"(v)); return v; }
template <int O> __device__ __forceinline__ float swz_xor(float v) { return __builtin_bit_cast(float, __builtin_amdgcn_ds_swizzle(__builtin_bit_cast(int, v), (O << 10) | 0x1f)); }
__device__ __forceinline__ float wave_sum(float v) {
    v += swz_xor<1>(v); v += swz_xor<2>(v); v += swz_xor<4>(v); v += swz_xor<8>(v); v += swz_xor<16>(v);
    return __builtin_bit_cast(float, __builtin_amdgcn_readlane(__builtin_bit_cast(int, v), 0)) + __builtin_bit_cast(float, __builtin_amdgcn_readlane(__builtin_bit_cast(int, v), 32));
}
__device__ __forceinline__ float get_xor32(float v, int lane) { return __builtin_bit_cast(float, __builtin_amdgcn_ds_bpermute((lane ^ 32) << 2, __builtin_bit_cast(int, v))); }

#define XB_TMO      128
#define XB_XCNT(j)  (256  + 64 * (j))
#define XB_XSUB(j)  (1280 + 64 * (j))
#define XB_XGEN(j)  (2304 + 64 * (j))
#define XB_TOP      3328
#define XB_TOPGEN   3392
#define XCD_BAR_WORDS 3456
#define XB_SPIN_CAP (1u << 18)

__device__ __forceinline__ unsigned xb_ld(unsigned* p)              { return __hip_atomic_load(p, __ATOMIC_RELAXED, __HIP_MEMORY_SCOPE_AGENT); }
__device__ __forceinline__ unsigned xb_add(unsigned* p, unsigned v) { return __hip_atomic_fetch_add(p, v, __ATOMIC_RELAXED, __HIP_MEMORY_SCOPE_AGENT); }
__device__ __forceinline__ unsigned xb_xcc_id() { return (unsigned)__builtin_amdgcn_s_getreg((3 << 11) | 20) & 0xFu; }
#define XB_SPIN(cond, bar) do { unsigned _sp = 0; while (cond) { __builtin_amdgcn_s_sleep(1); \
    if ((++_sp & 255u) == 0u) { if (xb_ld(&(bar)[XB_TMO])) break; if (_sp > XB_SPIN_CAP) { atomicAdd(&(bar)[XB_TMO], 1u); break; } } } } while (0)

struct XcdBarrier {
    unsigned* bar; unsigned x;
    volatile LAS unsigned* st;
};

__device__ __forceinline__ XcdBarrier xcd_barrier_post(unsigned* bar, volatile LAS unsigned* st) {
    XcdBarrier b; b.bar = bar; b.x = xb_xcc_id(); b.st = st;
    if (threadIdx.x == 0) (void)xb_add(&bar[XB_XCNT(b.x)], 1u);
    return b;
}
__device__ __forceinline__ void xcd_barrier_complete(unsigned* bar, unsigned x, unsigned& nloc, unsigned& nx) {
    const unsigned G = gridDim.x * gridDim.y * gridDim.z;
    unsigned sum, cnt, mine, sp = 0u;
    for (;;) {
        sum = 0u; cnt = 0u; mine = 0u;
#pragma unroll
        for (unsigned j = 0; j < 16; ++j) { const unsigned c = xb_ld(&bar[XB_XCNT(j)]); sum += c; cnt += (c > 0u) ? 1u : 0u; mine = (j == x) ? c : mine; }
        if (sum == G) break;
        __builtin_amdgcn_s_sleep(1);
        if ((++sp & 255u) == 0u) { if (xb_ld(&bar[XB_TMO])) break; if (sp > XB_SPIN_CAP) { atomicAdd(&bar[XB_TMO], 1u); break; } }
    }
    nloc = mine > 0u ? mine : 1u; nx = cnt > 0u ? cnt : 1u;
}

__device__ __forceinline__ void xcd_barrier(const XcdBarrier& b) {
    asm volatile("s_waitcnt vmcnt(0)" ::: "memory");
    __syncthreads();
    if (threadIdx.x == 0) {
        unsigned* bar = b.bar;
        __builtin_amdgcn_s_waitcnt(0);
        unsigned nloc = b.st[0], nx = b.st[1];
        if (nloc == 0u) { xcd_barrier_complete(bar, b.x, nloc, nx); b.st[0] = nloc; b.st[1] = nx; }
        const unsigned old = xb_add(&bar[XB_XSUB(b.x)], 1u);
        const unsigned gen = old / nloc;
        if (old + 1u == (gen + 1u) * nloc) {
            __builtin_amdgcn_fence(__ATOMIC_RELEASE, "agent");
            asm volatile("s_waitcnt vmcnt(0)" ::: "memory");
            const unsigned og = xb_add(&bar[XB_TOP], 1u);
            const unsigned tg = og / nx;
            if (og + 1u == (tg + 1u) * nx) xb_add(&bar[XB_TOPGEN], 1u);
            else XB_SPIN(xb_ld(&bar[XB_TOPGEN]) == tg, bar);
            __builtin_amdgcn_fence(__ATOMIC_ACQUIRE, "agent");
            xb_add(&bar[XB_XGEN(b.x)], 1u);
            asm volatile("s_waitcnt vmcnt(0)" ::: "memory");
        } else {
            XB_SPIN(xb_ld(&bar[XB_XGEN(b.x)]) == gen, bar);
            __builtin_amdgcn_fence(__ATOMIC_ACQUIRE, "agent");
            asm volatile("s_waitcnt vmcnt(0)" ::: "memory");
        }
    }
    __syncthreads();
}


constexpr int CV_SCR = 64 * 65 * 4;
__device__ __forceinline__ void conv_item(const float* W, int srcN, int k0, int n0, bf16* WT, int dstK, int drow0, const float* gain, LAS float* scr, int lane) {
    { const float* src = W + (size_t)(k0 + (lane >> 4)) * srcN + n0 + (lane & 15) * 4; LAS float* d = scr + (lane >> 4) * 65 + (lane & 15) * 4;
#pragma unroll
      for (int i = 0; i < 16; ++i) { const f32x4 v = __builtin_nontemporal_load((const f32x4*)(src + (size_t)(4 * i) * srcN));     d[4 * i * 65 + 0] = v.x; d[4 * i * 65 + 1] = v.y; d[4 * i * 65 + 2] = v.z; d[4 * i * 65 + 3] = v.w; } }
    LDS_WAIT(); asm volatile("" ::: "memory");
    const int c = lane & 7;
    float gk[8];
#pragma unroll
    for (int i = 0; i < 8; ++i) gk[i] = gain ? gain[k0 + 8 * c + i] : 1.0f;
#pragma unroll
    for (int j = 0; j < 8; ++j) { const int n = (lane >> 3) + 8 * j; const LAS float* s = scr + (8 * c) * 65 + n;
        v4u o; o.x = pk2(s[0 * 65] * gk[0], s[1 * 65] * gk[1]); o.y = pk2(s[2 * 65] * gk[2], s[3 * 65] * gk[3]); o.z = pk2(s[4 * 65] * gk[4], s[5 * 65] * gk[5]); o.w = pk2(s[6 * 65] * gk[6], s[7 * 65] * gk[7]);
        *(v4u*)(WT + (size_t)(drow0 + n) * dstK + k0 + 8 * c) = o; }
    LDS_WAIT(); asm volatile("" ::: "memory");
}
template <int K, int N, int NC> __device__ __forceinline__ void conv_cols(const float* W, int c0, bf16* WT, int r0, const float* gain, LAS float* scr, int gw, int NGW, int lane) {
    constexpr int nblk = NC / 64, nitems = (K / 64) * nblk;
    for (int it = gw; it < nitems; it += NGW) { const int kb = it / nblk, nb = it % nblk; conv_item(W, N, 64 * kb, c0 + 64 * nb, WT, K, r0 + 64 * nb, gain, scr, lane); }
}
template <int K, int N> __device__ __forceinline__ void conv_plain(const float* W, bf16* WT, const float* gain, LAS float* scr, int gw, int NGW, int lane) { conv_cols<K, N, N>(W, 0, WT, 0, gain, scr, gw, NGW, lane); }
__device__ __forceinline__ void conv_gateup(const float* Wg, const float* Wu, bf16* WT, const float* gain, LAS float* scr, int gw, int NGW, int lane) {
    constexpr int nblk = 2 * DFF / 64, nitems = (D / 64) * nblk;
    for (int it = gw; it < nitems; it += NGW) { const int kb = it / nblk, nb = it % nblk, n0 = 64 * nb, pn = n0 >> 8, bj = (n0 >> 7) & 1, c0 = n0 & 127;
        conv_item(bj ? Wu : Wg, DFF, 64 * kb, 128 * pn + c0, WT, D, n0, gain, scr, lane); }
}

template <int N> __device__ __forceinline__ void conv_gates(const float* W, int c_f, int c_b, bf16* WT, int r0, const float* gain, LAS float* scr, int gw, int NGW, int lane) {
    constexpr int nblk = 2 * DV / 64, nitems = (D / 64) * nblk;
    for (int it = gw; it < nitems; it += NGW) { const int kb = it / nblk, nb = it % nblk, n0 = 64 * nb, pn = n0 >> 8, bj = (n0 >> 7) & 1, c0 = n0 & 127;
        conv_item(W, N, 64 * kb, (bj ? c_b : c_f) + 128 * pn + c0, WT, D, r0 + n0, gain, scr, lane); }
}

__device__ __forceinline__ void unpack8(const v4u w, float (&f)[8]) { f[0] = bflo(w.x); f[1] = bfhi(w.x); f[2] = bflo(w.y); f[3] = bfhi(w.y); f[4] = bflo(w.z); f[5] = bfhi(w.z); f[6] = bflo(w.w); f[7] = bfhi(w.w); }
__device__ __forceinline__ void p0_rows(const float* xin, bf16* XB, float* RS, int gw, int NGW, int lane) {
    for (int m = gw; m < M; m += NGW) {
        float ss = 0.f;
#pragma unroll
        for (int j = 0; j < 2; ++j) { const float* p = xin + (size_t)m * D + 512 * j + 8 * lane; const f32x4 a = __builtin_nontemporal_load((const f32x4*)p), b = __builtin_nontemporal_load((const f32x4*)(p + 4));
            ss += (a.x * a.x + a.y * a.y) + (a.z * a.z + a.w * a.w) + (b.x * b.x + b.y * b.y) + (b.z * b.z + b.w * b.w);
            v4u w; w.x = pk2(a.x, a.y); w.y = pk2(a.z, a.w); w.z = pk2(b.x, b.y); w.w = pk2(b.z, b.w); *(v4u*)(XB + (size_t)m * D + 512 * j + 8 * lane) = w; }
        ss = wave_sum(ss);
        if (lane == 0) RS[m] = __builtin_amdgcn_rsqf(ss * (1.f / D) + opaque_f(NORM_EPS));
    }
}
__device__ __forceinline__ void thin_rows(const bf16* Fin, bf16* XB, const float* gpost, float cpost, float* RS, float* outf, int gw, int NGW, int lane) {
    float gp[2][8];
#pragma unroll
    for (int j = 0; j < 2; ++j) { const f32x4 a = *(const f32x4*)(gpost + 512 * j + 8 * lane), b = *(const f32x4*)(gpost + 512 * j + 8 * lane + 4);
        gp[j][0] = a.x; gp[j][1] = a.y; gp[j][2] = a.z; gp[j][3] = a.w; gp[j][4] = b.x; gp[j][5] = b.y; gp[j][6] = b.z; gp[j][7] = b.w; }
    for (int m = gw; m < M; m += NGW) {
        float x[2][8], f[2][8]; float ss = 0.f;
#pragma unroll
        for (int j = 0; j < 2; ++j) { unpack8(*(const v4u*)(XB + (size_t)m * D + 512 * j + 8 * lane), x[j]); unpack8(*(const v4u*)(Fin + (size_t)m * D + 512 * j + 8 * lane), f[j]);
#pragma unroll
            for (int q = 0; q < 8; ++q) ss += f[j][q] * f[j][q]; }
        const float rF = cpost * __builtin_amdgcn_rsqf(wave_sum(ss) * (1.f / D) + opaque_f(NORM_EPS));
        float s2 = 0.f;
#pragma unroll
        for (int j = 0; j < 2; ++j)
#pragma unroll
            for (int q = 0; q < 8; ++q) { x[j][q] += f[j][q] * gp[j][q] * rF; s2 += x[j][q] * x[j][q]; }
        if (outf) {
#pragma unroll
            for (int j = 0; j < 2; ++j) { float* p = outf + (size_t)m * D + 512 * j + 8 * lane; __builtin_nontemporal_store((f32x4){x[j][0], x[j][1], x[j][2], x[j][3]}, (f32x4*)p); __builtin_nontemporal_store((f32x4){x[j][4], x[j][5], x[j][6], x[j][7]}, (f32x4*)(p + 4)); }
        } else {
#pragma unroll
            for (int j = 0; j < 2; ++j) { v4u w; w.x = pk2(x[j][0], x[j][1]); w.y = pk2(x[j][2], x[j][3]); w.z = pk2(x[j][4], x[j][5]); w.w = pk2(x[j][6], x[j][7]); *(v4u*)(XB + (size_t)m * D + 512 * j + 8 * lane) = w; }
            s2 = wave_sum(s2);
            if (lane == 0) RS[m] = __builtin_amdgcn_rsqf(s2 * (1.f / D) + opaque_f(NORM_EPS));
        }
    }
}

__device__ __forceinline__ void attn_group_scalar(const bf16* P, const float* bias2, int dil, int first, bf16* OACC, float* LSE, int gw, int NGW, int lane) {
    const int Ls = SEQ / dil, tbn = Ls / 64;
    constexpr float SC = 0.125f * 1.4426950409f;
    for (int w = gw; w < BATCH * HA * 32; w += NGW) {
        const int tb = w % tbn, r = (w / tbn) % dil, h = (w >> 5) & 15, b = w >> 9;
        const int t = tb * 64 + lane; const size_t row = (size_t)b * SEQ + (size_t)t * dil + r;
        float q[64], acc[64];
        { const v4u* qp = (const v4u*)(P + row * ATT_COLS + h * 64);
#pragma unroll
          for (int c = 0; c < 8; ++c) { const v4u x = qp[c]; q[8 * c + 0] = bflo(x.x); q[8 * c + 1] = bfhi(x.x); q[8 * c + 2] = bflo(x.y); q[8 * c + 3] = bfhi(x.y); q[8 * c + 4] = bflo(x.z); q[8 * c + 5] = bfhi(x.z); q[8 * c + 6] = bflo(x.w); q[8 * c + 7] = bfhi(x.w); } }
#pragma unroll
        for (int c = 0; c < 64; ++c) acc[c] = 0.f;
        float mx = -INFINITY, l = 0.f;
        for (int kk = 0; kk < 129; ++kk) {
            const int tk = t - 64 + kk;
            if (tk >= 0 && tk < Ls) {
                const size_t krow = (size_t)b * SEQ + (size_t)tk * dil + r;
                const v4u* kp = (const v4u*)(P + krow * ATT_COLS + D + h * 64);
                float s = 0.f;
#pragma unroll
                for (int c = 0; c < 8; ++c) { const v4u x = kp[c];
                    s += q[8 * c + 0] * bflo(x.x) + q[8 * c + 1] * bfhi(x.x) + q[8 * c + 2] * bflo(x.y) + q[8 * c + 3] * bfhi(x.y) + q[8 * c + 4] * bflo(x.z) + q[8 * c + 5] * bfhi(x.z) + q[8 * c + 6] * bflo(x.w) + q[8 * c + 7] * bfhi(x.w); }
                s = s * SC + bias2[h * 129 + kk];
                const float mn = fmaxf(mx, s), a = exp2f(mx - mn), p = exp2f(s - mn);
                l = l * a + p; mx = mn;
                const v4u* vp = (const v4u*)(P + krow * ATT_COLS + 2 * D + h * 64);
#pragma unroll
                for (int c = 0; c < 8; ++c) { const v4u x = vp[c];
                    acc[8 * c + 0] = acc[8 * c + 0] * a + p * bflo(x.x); acc[8 * c + 1] = acc[8 * c + 1] * a + p * bfhi(x.x); acc[8 * c + 2] = acc[8 * c + 2] * a + p * bflo(x.y); acc[8 * c + 3] = acc[8 * c + 3] * a + p * bfhi(x.y);
                    acc[8 * c + 4] = acc[8 * c + 4] * a + p * bflo(x.z); acc[8 * c + 5] = acc[8 * c + 5] * a + p * bfhi(x.z); acc[8 * c + 6] = acc[8 * c + 6] * a + p * bflo(x.w); acc[8 * c + 7] = acc[8 * c + 7] * a + p * bfhi(x.w); }
            }
        }
        const float il = 1.f / l; float lse = mx + log2f(l);
        float wn = il, wo = 0.f;
        if (!first) { const float lo = LSE[row * 16 + h]; const float mm = fmaxf(lo, lse), eo = exp2f(lo - mm), en = exp2f(lse - mm), inv = 1.f / (eo + en); wn = en * inv * il; wo = eo * inv; lse = mm + log2f(eo + en); }
        LSE[row * 16 + h] = lse;
        v4u* op = (v4u*)(OACC + row * D + h * 64);
#pragma unroll
        for (int c = 0; c < 8; ++c) { v4u x = (v4u){0u, 0u, 0u, 0u}; if (!first) x = op[c];
            v4u y; y.x = pk2(wn * acc[8 * c + 0] + wo * bflo(x.x), wn * acc[8 * c + 1] + wo * bfhi(x.x)); y.y = pk2(wn * acc[8 * c + 2] + wo * bflo(x.y), wn * acc[8 * c + 3] + wo * bfhi(x.y));
            y.z = pk2(wn * acc[8 * c + 4] + wo * bflo(x.z), wn * acc[8 * c + 5] + wo * bfhi(x.z)); y.w = pk2(wn * acc[8 * c + 6] + wo * bflo(x.w), wn * acc[8 * c + 7] + wo * bfhi(x.w)); op[c] = y; }
    }
}

__device__ __forceinline__ void ret_core_scalar(const bf16* P, const bf16* KT, const bf16* VT, const float* decay_logit  , bf16* YF, bf16* YB, int useKT, int gw, int NGW, int lane) {
    const int el = lane & 15, dq = lane >> 4;
    for (int w = gw; w < 8 * HR * 2 * 32; w += NGW) {
        const int eb = w & 31, dir = (w >> 5) & 1, h = (w >> 6) & 3, bl = w >> 8;
        const int e = eb * 16 + el;
        const float gamma = 1.0f - expf(decay_logit[dir * HR + h]);
        bf16* Y = dir ? YB : YF;
        float S[64];
#pragma unroll
        for (int c = 0; c < 64; ++c) S[c] = 0.f;
        for (int ti = 0; ti < SEQ; ++ti) {
            const int s = dir ? (SEQ - 1 - ti) : ti; const size_t row = (size_t)bl * SEQ + s;
            const bf16* pr = P + row * RP_COLS;
            const float v = __builtin_bit_cast(float, (unsigned)VT[(size_t)(h * DVR + e) * MH + row] << 16);
            const v4u* qp = (const v4u*)(pr + h * DKR + dq * 64); const v4u* kp = (const v4u*)(pr + D + 2 * DV + h * DKR + dq * 64);
            float y = 0.f;
#pragma unroll
            for (int c = 0; c < 8; ++c) { v4u kx = kp[c]; const v4u qx = qp[c];
                if (useKT) { const bf16* kt = KT + (size_t)(h * DKR + dq * 64 + 8 * c) * MH + row;
                    kx.x = (unsigned)kt[0] | ((unsigned)kt[MH] << 16); kx.y = (unsigned)kt[2 * (size_t)MH] | ((unsigned)kt[3 * (size_t)MH] << 16);
                    kx.z = (unsigned)kt[4 * (size_t)MH] | ((unsigned)kt[5 * (size_t)MH] << 16); kx.w = (unsigned)kt[6 * (size_t)MH] | ((unsigned)kt[7 * (size_t)MH] << 16); }
                S[8 * c + 0] = S[8 * c + 0] * gamma + bflo(kx.x) * v; y += bflo(qx.x) * S[8 * c + 0];
                S[8 * c + 1] = S[8 * c + 1] * gamma + bfhi(kx.x) * v; y += bfhi(qx.x) * S[8 * c + 1];
                S[8 * c + 2] = S[8 * c + 2] * gamma + bflo(kx.y) * v; y += bflo(qx.y) * S[8 * c + 2];
                S[8 * c + 3] = S[8 * c + 3] * gamma + bfhi(kx.y) * v; y += bfhi(qx.y) * S[8 * c + 3];
                S[8 * c + 4] = S[8 * c + 4] * gamma + bflo(kx.z) * v; y += bflo(qx.z) * S[8 * c + 4];
                S[8 * c + 5] = S[8 * c + 5] * gamma + bfhi(kx.z) * v; y += bfhi(qx.z) * S[8 * c + 5];
                S[8 * c + 6] = S[8 * c + 6] * gamma + bflo(kx.w) * v; y += bflo(qx.w) * S[8 * c + 6];
                S[8 * c + 7] = S[8 * c + 7] * gamma + bfhi(kx.w) * v; y += bfhi(qx.w) * S[8 * c + 7]; }
            y += __shfl_xor(y, 16); y += __shfl_xor(y, 32);
            if (dq == 0) Y[row * DV + h * DVR + e] = (bf16)f2bf(y);
        }
    }
}

__device__ __forceinline__ void ret_combine(const bf16* P, bf16* YF  , const bf16* YB, int gw, int NGW, int lane) {
    for (int m = gw; m < MH; m += NGW) {
#pragma unroll
        for (int j = 0; j < 4; ++j) {
            const int idx = j * 512 + lane * 8;
            const v4u a = *(const v4u*)(YF + (size_t)m * DV + idx), bq = *(const v4u*)(YB + (size_t)m * DV + idx);
            const v4u gfv = *(const v4u*)(P + (size_t)m * RP_COLS + D + idx), gbv = *(const v4u*)(P + (size_t)m * RP_COLS + D + DV + idx);
            float yf[8] = {bflo(a.x), bfhi(a.x), bflo(a.y), bfhi(a.y), bflo(a.z), bfhi(a.z), bflo(a.w), bfhi(a.w)};
            float yb[8] = {bflo(bq.x), bfhi(bq.x), bflo(bq.y), bfhi(bq.y), bflo(bq.z), bfhi(bq.z), bflo(bq.w), bfhi(bq.w)};
            float gf[8] = {bflo(gfv.x), bfhi(gfv.x), bflo(gfv.y), bfhi(gfv.y), bflo(gfv.z), bfhi(gfv.z), bflo(gfv.w), bfhi(gfv.w)};
            float gb[8] = {bflo(gbv.x), bfhi(gbv.x), bflo(gbv.y), bfhi(gbv.y), bflo(gbv.z), bfhi(gbv.z), bflo(gbv.w), bfhi(gbv.w)};
            float sf = 0.f, sb = 0.f;
#pragma unroll
            for (int c = 0; c < 8; ++c) { sf += yf[c]; sb += yb[c]; }
            const float muf = wave_sum(sf) * (1.f / DVR), mub = wave_sum(sb) * (1.f / DVR);
            float qf = 0.f, qb = 0.f;
#pragma unroll
            for (int c = 0; c < 8; ++c) { yf[c] -= muf; yb[c] -= mub; qf += yf[c] * yf[c]; qb += yb[c] * yb[c]; }
            const float rf = __builtin_amdgcn_rsqf(wave_sum(qf) * (1.f / DVR) + NORM_EPS), rb = __builtin_amdgcn_rsqf(wave_sum(qb) * (1.f / DVR) + NORM_EPS);
            float o[8];
#pragma unroll
            for (int c = 0; c < 8; ++c) o[c] = gf[c] * pg8::fast_sigmoid(gf[c]) * yf[c] * rf + gb[c] * pg8::fast_sigmoid(gb[c]) * yb[c] * rb;
            v4u w; w.x = pk2(o[0], o[1]); w.y = pk2(o[2], o[3]); w.z = pk2(o[4], o[5]); w.w = pk2(o[6], o[7]);
            *(v4u*)(YF + (size_t)m * DV + idx) = w;
        }
    }
}

typedef float f32x16 __attribute__((ext_vector_type(16)));
typedef short bf16x8s __attribute__((ext_vector_type(8)));
typedef float f32x2_t __attribute__((ext_vector_type(2))); typedef __bf16 bf16x2_t __attribute__((ext_vector_type(2)));
__device__ __forceinline__ unsigned cvtpk(float lo, float hi) { f32x2_t v = {lo, hi}; bf16x2_t b = __builtin_convertvector(v, bf16x2_t); return __builtin_bit_cast(unsigned, b); }
__device__ __forceinline__ void attn_group_mfma(const bf16* QK, const bf16* VT, const float* bias2g, int dil, int first, bf16* OACC, float* LSE, LAS unsigned char* lds, int tid, int gw, int NGW) {
    LAS float* tab = (LAS float*)lds;
    for (int i = tid; i < 16 * 192; i += NTHREADS) { const int h = i / 192, o = i % 192 - 96; tab[i] = (o >= -64 && o <= 64) ? bias2g[h * 129 + o + 64] : -1e30f; }
    __syncthreads();
    const int lane = tid & 63, r = lane & 31, hh = lane >> 5;
    const int Ls = SEQ / dil, nqb = Ls / 32;
    constexpr float SC = 0.125f * 1.4426950409f;
    constexpr int NU = BATCH * HA * 64;
    const int upw = (NU + NGW - 1) / NGW;
    for (int u = gw * upw; u < (gw + 1) * upw && u < NU; ++u) {
        const int qb = u % nqb, rr = (u / nqb) % dil, h = (u >> 6) & 15, b = u >> 10, t0 = qb * 32;
        const size_t rowq = (size_t)b * SEQ + (size_t)(t0 + r) * dil + rr;
        bf16x8s qf[4];
#pragma unroll
        for (int ks = 0; ks < 4; ++ks) qf[ks] = *(const bf16x8s*)(QK + rowq * 2048 + h * 64 + 16 * ks + 8 * hh);
        f32x16 S[5];
#pragma unroll
        for (int kb = 0; kb < 5; ++kb) {
            int t = t0 - 64 + 32 * kb + r; t = t < 0 ? 0 : (t > Ls - 1 ? Ls - 1 : t);
            const bf16* kp = QK + ((size_t)b * SEQ + (size_t)t * dil + rr) * 2048 + 1024 + h * 64 + 8 * hh;
            bf16x8s kf[4];
#pragma unroll
            for (int ks = 0; ks < 4; ++ks) kf[ks] = *(const bf16x8s*)(kp + 16 * ks);
#pragma unroll
            for (int i = 0; i < 16; ++i) S[kb][i] = 0.f;
#pragma unroll
            for (int ks = 0; ks < 4; ++ks) S[kb] = __builtin_amdgcn_mfma_f32_32x32x16_bf16(kf[ks], qf[ks], S[kb], 0, 0, 0);
        }
        const LAS float* tb = tab + h * 192 + (32 + 4 * hh - r);
        float mx = -1e30f;
#pragma unroll
        for (int kb = 0; kb < 5; ++kb)
#pragma unroll
            for (int i = 0; i < 16; ++i) { const int krel = 32 * kb + (i & 3) + 8 * (i >> 2); const int kt = t0 - 64 + krel + 4 * hh;
                float s = S[kb][i] * SC + tb[krel]; s = (kt < 0 || kt >= Ls) ? -1e30f : s; S[kb][i] = s; mx = fmaxf(mx, s); }
        mx = fmaxf(mx, get_xor32(mx, lane));
        float l = 0.f;
#pragma unroll
        for (int kb = 0; kb < 5; ++kb)
#pragma unroll
            for (int i = 0; i < 16; ++i) { const float p = __builtin_amdgcn_exp2f(S[kb][i] - mx); S[kb][i] = p; l += p; }
        l += get_xor32(l, lane);
        f32x16 O[2];
#pragma unroll
        for (int db = 0; db < 2; ++db)
#pragma unroll
            for (int i = 0; i < 16; ++i) O[db][i] = 0.f;
        const bf16* vbase = VT + (size_t)(h * 64 + r) * M + (size_t)b * SEQ + (size_t)rr * Ls;
#pragma unroll
        for (int kb = 0; kb < 5; ++kb)
#pragma unroll
            for (int s2 = 0; s2 < 2; ++s2) {
                v4u pw; pw.x = cvtpk(S[kb][8 * s2 + 0], S[kb][8 * s2 + 1]); pw.y = cvtpk(S[kb][8 * s2 + 2], S[kb][8 * s2 + 3]); pw.z = cvtpk(S[kb][8 * s2 + 4], S[kb][8 * s2 + 5]); pw.w = cvtpk(S[kb][8 * s2 + 6], S[kb][8 * s2 + 7]);
                const bf16x8s pf = __builtin_bit_cast(bf16x8s, pw);
                int ta = t0 - 64 + 32 * kb + 16 * s2 + 4 * hh, tb2 = ta + 8;
                ta = (ta < 0 || ta >= Ls) ? 0 : ta; tb2 = (tb2 < 0 || tb2 >= Ls) ? 0 : tb2;
#pragma unroll
                for (int db = 0; db < 2; ++db) { const bf16* vp = vbase + (size_t)(32 * db) * M;
                    const v2u lo = *(const v2u*)(vp + ta), hi = *(const v2u*)(vp + tb2);
                    const v4u vw = (v4u){lo.x, lo.y, hi.x, hi.y};
                    O[db] = __builtin_amdgcn_mfma_f32_32x32x16_bf16(__builtin_bit_cast(bf16x8s, vw), pf, O[db], 0, 0, 0); }
            }
        const float il = 1.f / l; float lse = mx + log2f(l);
        const size_t row = rowq;
        float wn = il, wo = 0.f;
        if (!first) { const float lo = LSE[row * 16 + h]; const float mm = fmaxf(lo, lse), eo = exp2f(lo - mm), en = exp2f(lse - mm), inv = 1.f / (eo + en); wn = en * inv * il; wo = eo * inv; lse = mm + log2f(eo + en); }
        if (hh == 0) LSE[row * 16 + h] = lse;
#pragma unroll
        for (int db = 0; db < 2; ++db)
#pragma unroll
            for (int gq = 0; gq < 4; ++gq) { v2u* op = (v2u*)(OACC + row * D + h * 64 + 32 * db + 8 * gq + 4 * hh);
                v2u x = (v2u){0u, 0u}; if (!first) x = *op;
                v2u y; y.x = cvtpk(wn * O[db][4 * gq + 0] + wo * bflo(x.x), wn * O[db][4 * gq + 1] + wo * bfhi(x.x)); y.y = cvtpk(wn * O[db][4 * gq + 2] + wo * bflo(x.y), wn * O[db][4 * gq + 3] + wo * bfhi(x.y));
                *op = y; }
    }
}

constexpr int RQK = 2 * D;
constexpr int RC_ST = 0, RC_RG = 65536, RC_NSLOT = 5, RC_LDS = RC_RG + RC_NSLOT * 16384;
__device__ __forceinline__ int sl_swz(int ob) { return ob ^ (((ob >> 9) & 1) << 5); }
template <int VAR  >
__device__ __forceinline__ void ret_core_mfma(const bf16* P, const bf16* VT, const float* decay_logit  , bf16* YF, bf16* YB, float* PT, LAS unsigned char* lds, const int tid, const int bid, const int G) {
    typedef short bf16x8v __attribute__((ext_vector_type(8)));
    const int w = __builtin_amdgcn_readfirstlane(tid >> 6), lane = tid & 63, fr = lane & 15, fq = lane >> 4, wr = w >> 2, wc = w & 3;
#define RC_DMA(gptr, ldsoff) __builtin_amdgcn_global_load_lds((const unsigned*)(gptr), (LAS unsigned*)(lds + (ldsoff)), 16, 0, 0)
#define RC_WAITV(n) asm volatile("s_waitcnt vmcnt(" #n ")" ::: "memory")
#define RC_WAITL() asm volatile("s_waitcnt lgkmcnt(0)" ::: "memory")
#define RC_BAR() do { asm volatile("" ::: "memory"); __builtin_amdgcn_s_barrier(); asm volatile("" ::: "memory"); } while (0)
#define RC_MFMA(b, a, c) __builtin_amdgcn_mfma_f32_16x16x32_bf16((b), (a), (c), 0, 0, 0)
#define RC_NEXT(sl) ((sl) == RC_NSLOT - 1 ? 0 : (sl) + 1)
#define RC_PREV(sl) ((sl) == 0 ? RC_NSLOT - 1 : (sl) - 1)
    const int dob = sl_swz(lane * 16), drow = 16 * w + (dob >> 6), dcc = (dob & 63) >> 1;
    const int aoff = 4 * wr * 1024 + sl_swz(fr * 64 + fq * 16), boff = 2 * wc * 1024 + sl_swz(fr * 64 + fq * 16);
    for (int u = bid; u < 512; u += G) {
        const int xcd = u & 7, idx = u >> 3, es = idx & 3, cmb = (idx >> 2) * 8 + xcd, dir = cmb & 1, h = (cmb >> 1) & 3, bl = cmb >> 3;
        const float lg = __builtin_amdgcn_logf(1.0f - __builtin_amdgcn_exp2f(decay_logit[dir * HR + h] * 1.4426950409f));
        const float cdec = __builtin_amdgcn_exp2f(lg * 128.f);
        bf16* Y = dir ? YB : YF;
        const size_t rowbase = (size_t)bl * SEQ;
        const bf16* qsrc = P + (rowbase + drow) * RQK + h * DKR + dcc;
        const bf16* ksrc = qsrc + D;
        const bf16* vsrc = VT + (size_t)(h * DVR + es * 128 + drow) * M + rowbase + dcc;
        const bf16* vown = VT + (size_t)(h * DVR + es * 128 + 16 * w + fr) * M + rowbase + 8 * fq;
        { const v4u z = (v4u){0u, 0u, 0u, 0u};
#pragma unroll
          for (int i = 0; i < 8; ++i) *(LAS v4u*)(lds + RC_ST + (i * NTHREADS + tid) * 16) = z; }
        f32x4 acc4[16];
#pragma unroll
        for (int n = 0; n < 16; ++n) acc4[n] = (f32x4){0.f, 0.f, 0.f, 0.f};
#define RC_ISSUE(st, tk, sl) do { if ((st) < 8) { const size_t to_ = (size_t)(tk) * RQK + 32 * (st); RC_DMA(qsrc + to_, RC_RG + (sl) * 16384 + w * 1024); RC_DMA(ksrc + to_, RC_RG + (sl) * 16384 + 8192 + w * 1024); } \
                                  else RC_DMA(vsrc + (tk) + 32 * ((st) - 8), RC_RG + (sl) * 16384 + w * 1024); } while (0)
        v4u vnx[4];
        { const int tok0 = dir ? 128 * 15 : 0;
#pragma unroll
          for (int js = 0; js < 4; ++js) vnx[js] = *(const v4u*)(vown + tok0 + 32 * js);
          RC_ISSUE(0, tok0, 0); RC_ISSUE(1, tok0, 1); RC_ISSUE(2, tok0, 2); RC_ISSUE(3, tok0, 3); }
        RC_WAITL();
        int slot = 0;
        for (int c = 0; c < 16; ++c) {
            const int tok0 = 128 * (dir ? 15 - c : c), tokn = 128 * (dir ? (c < 15 ? 14 - c : 0) : (c < 15 ? c + 1 : 15));
            float lgc = lg; int zo = 0; asm volatile("" : "+v"(lgc), "+v"(zo));
            int lc = lane; asm volatile("" : "+v"(lc)); const int frc = lc & 15, fqc = lc >> 4;
            bf16x8v Avs[4];
#pragma unroll
            for (int js = 0; js < 4; ++js) { const v4u kw = vnx[js]; float kd[8];
#pragma unroll
                for (int q = 0; q < 8; ++q) { const int j = 32 * js + 8 * fqc + q; kd[q] = __builtin_amdgcn_exp2f(lgc * (dir ? (float)j : (float)(127 - j))); }
                v4u sw; sw.x = cvtpk(bflo(kw.x) * kd[0], bfhi(kw.x) * kd[1]); sw.y = cvtpk(bflo(kw.y) * kd[2], bfhi(kw.y) * kd[3]); sw.z = cvtpk(bflo(kw.z) * kd[4], bfhi(kw.z) * kd[5]); sw.w = cvtpk(bflo(kw.w) * kd[6], bfhi(kw.w) * kd[7]);
                Avs[js] = __builtin_bit_cast(bf16x8v, sw); }
#pragma unroll
            for (int n = 0; n < 16; ++n) acc4[n] = acc4[n] * cdec;
            const int jj = 8 * fqc + (frc >> 2);
            const unsigned trA = (unsigned)((jj >> 4) * 1024 + sl_swz((jj & 15) * 64 + 8 * (frc & 3))), trB = (unsigned)(((jj + 4) >> 4) * 1024 + sl_swz(((jj + 4) & 15) * 64 + 8 * (frc & 3)));
            f32x4 accA[4][2], accY[4][2];
#pragma unroll
            for (int m = 0; m < 4; ++m)
#pragma unroll
                for (int n = 0; n < 2; ++n) { accA[m][n] = (f32x4){0.f, 0.f, 0.f, 0.f}; accY[m][n] = (f32x4){0.f, 0.f, 0.f, 0.f}; }
#pragma unroll
            for (int ks = 0; ks < 8; ++ks) {
                if (ks < 4) { if (c == 0) RC_WAITV(6); else RC_WAITV(18); } else if (ks == 4) RC_WAITV(6); else if (ks == 5) RC_WAITV(5); else if (ks == 6) RC_WAITV(4); else RC_WAITV(3);
                RC_BAR();
                { const int s4 = RC_PREV(slot);
                  if (ks + 4 < 12) RC_ISSUE(ks + 4, tok0, s4); else RC_ISSUE(ks + 4 - 12, tokn, s4); }
                bf16x8v At[4], Bk[2], Bs[2];
                const LAS unsigned char* sq = lds + RC_RG + slot * 16384;
#pragma unroll
                for (int m = 0; m < 4; ++m) At[m] = *(const LAS bf16x8v*)(sq + aoff + m * 1024);
#pragma unroll
                for (int n = 0; n < 2; ++n) { Bk[n] = *(const LAS bf16x8v*)(sq + 8192 + boff + n * 1024); Bs[n] = *(const LAS bf16x8v*)(lds + RC_ST + ks * 8192 + boff + n * 1024); }
                RC_WAITL();
#pragma unroll
                for (int m = 0; m < 4; ++m)
#pragma unroll
                    for (int n = 0; n < 2; ++n) { accA[m][n] = RC_MFMA(Bk[n], At[m], accA[m][n]); accY[m][n] = RC_MFMA(Bs[n], At[m], accY[m][n]); }
                { const unsigned kb = (unsigned)(size_t)(sq + 8192);
#pragma unroll
                  for (int nl = 0; nl < 2; ++nl) { const unsigned a0 = kb + (trA ^ (nl << 5)), a1 = kb + (trB ^ (nl << 5));
                      v2u l0, h0, l1, h1, l2, h2, l3, h3;
                      asm volatile("ds_read_b64_tr_b16 %0, %8\n\tds_read_b64_tr_b16 %1, %9\n\tds_read_b64_tr_b16 %2, %8 offset:2048\n\tds_read_b64_tr_b16 %3, %9 offset:2048\n\t"
                                   "ds_read_b64_tr_b16 %4, %8 offset:4096\n\tds_read_b64_tr_b16 %5, %9 offset:4096\n\tds_read_b64_tr_b16 %6, %8 offset:6144\n\tds_read_b64_tr_b16 %7, %9 offset:6144\n\ts_waitcnt lgkmcnt(0)"
                                   : "=&v"(l0), "=&v"(h0), "=&v"(l1), "=&v"(h1), "=&v"(l2), "=&v"(h2), "=&v"(l3), "=&v"(h3) : "v"(a0), "v"(a1) : "memory");
                      acc4[2 * ks + nl] = RC_MFMA(__builtin_bit_cast(bf16x8v, ((v4u){l0.x, l0.y, h0.x, h0.y})), Avs[0], acc4[2 * ks + nl]);
                      acc4[2 * ks + nl] = RC_MFMA(__builtin_bit_cast(bf16x8v, ((v4u){l1.x, l1.y, h1.x, h1.y})), Avs[1], acc4[2 * ks + nl]);
                      acc4[2 * ks + nl] = RC_MFMA(__builtin_bit_cast(bf16x8v, ((v4u){l2.x, l2.y, h2.x, h2.y})), Avs[2], acc4[2 * ks + nl]);
                      acc4[2 * ks + nl] = RC_MFMA(__builtin_bit_cast(bf16x8v, ((v4u){l3.x, l3.y, h3.x, h3.y})), Avs[3], acc4[2 * ks + nl]); } }
                slot = RC_NEXT(slot);
            }
#pragma unroll
            for (int m = 0; m < 4; ++m)
#pragma unroll
                for (int n = 0; n < 2; ++n) { accY[m][n] = accY[m][n] * __builtin_amdgcn_exp2f(lgc * (dir ? (float)(128 - (64 * wr + 16 * m + frc)) : (float)(64 * wr + 16 * m + frc + 1)));
                    const int i = 64 * wr + 16 * m + frc;
#pragma unroll
                    for (int ii = 0; ii < 4; ++ii) { const int j = 32 * wc + 16 * n + 4 * fqc + ii; const int dd = dir ? j - i : i - j;
                        accA[m][n][ii] = dd >= 0 ? accA[m][n][ii] * __builtin_amdgcn_exp2f(lgc * (float)dd) : 0.f; } }
            RC_BAR();
#pragma unroll
            for (int m = 0; m < 4; ++m)
#pragma unroll
                for (int n = 0; n < 2; ++n) { v2u pw; pw.x = cvtpk(accA[m][n][0], accA[m][n][1]); pw.y = cvtpk(accA[m][n][2], accA[m][n][3]);
                    *(LAS v2u*)(lds + RC_ST + wc * 8192 + (4 * wr + m) * 1024 + sl_swz(frc * 64 + (16 * n + 4 * fqc) * 2)) = pw; }
#pragma unroll
            for (int js = 0; js < 4; ++js) vnx[js] = *(const v4u*)(vown + tokn + 32 * js + zo);
            RC_WAITL();
#pragma unroll
            for (int js = 0; js < 4; ++js) {
                if (js == 0) RC_WAITV(7); else if (js == 1) RC_WAITV(8); else if (js == 2) RC_WAITV(9); else RC_WAITV(10);
                RC_BAR();
                { const int s4 = RC_PREV(slot); RC_ISSUE(js, tokn, s4); }
                bf16x8v At[4], Bv[2];
                const LAS unsigned char* sv = lds + RC_RG + slot * 16384;
#pragma unroll
                for (int m = 0; m < 4; ++m) At[m] = *(const LAS bf16x8v*)(lds + RC_ST + js * 8192 + aoff + m * 1024);
#pragma unroll
                for (int n = 0; n < 2; ++n) Bv[n] = *(const LAS bf16x8v*)(sv + boff + n * 1024);
                RC_WAITL();
#pragma unroll
                for (int m = 0; m < 4; ++m)
#pragma unroll
                    for (int n = 0; n < 2; ++n) accY[m][n] = RC_MFMA(Bv[n], At[m], accY[m][n]);
                slot = RC_NEXT(slot);
            }
#pragma unroll
            for (int m = 0; m < 4; ++m)
#pragma unroll
                for (int n = 0; n < 2; ++n) { v2u pw; pw.x = cvtpk(accY[m][n][0], accY[m][n][1]); pw.y = cvtpk(accY[m][n][2], accY[m][n][3]);
                    *(v2u*)(Y + (rowbase + tok0 + 64 * wr + 16 * m + frc + zo) * DV + h * DVR + es * 128 + 32 * wc + 16 * n + 4 * fqc) = pw; }
#pragma unroll
            for (int m = 0; m < 4; ++m) { float sv = 0.f, sq = 0.f;
#pragma unroll
                for (int n = 0; n < 2; ++n)
#pragma unroll
                    for (int ii = 0; ii < 4; ++ii) { const float yv = accY[m][n][ii]; sv += yv; sq += yv * yv; }
                sv += swz_xor<16>(sv); sq += swz_xor<16>(sq); sv += get_xor32(sv, lc); sq += get_xor32(sq, lc);
                float* sp = PT + ((((rowbase + tok0 + 64 * wr + 16 * m + frc + zo) * 4 + h) * 2 + dir) * 16 + es * 4 + wc) * 2;
                if (fqc == 0) *(f32x2_t*)sp = (f32x2_t){sv, sq}; }
            RC_BAR();
#pragma unroll
            for (int n = 0; n < 16; ++n) { v2u pw; pw.x = cvtpk(acc4[n][0], acc4[n][1]); pw.y = cvtpk(acc4[n][2], acc4[n][3]);
                *(LAS v2u*)(lds + RC_ST + (n >> 1) * 8192 + w * 1024 + sl_swz(frc * 64 + (16 * (n & 1) + 4 * fqc) * 2)) = pw; }
            RC_WAITL();
        }
        RC_WAITV(0); RC_BAR();
    }
#undef RC_DMA
#undef RC_WAITV
#undef RC_WAITL
#undef RC_BAR
#undef RC_MFMA
#undef RC_NEXT
#undef RC_PREV
#undef RC_ISSUE
}

__device__ __forceinline__ void ret_stats(const float* PT, float* ST, int gtid, int nthr) {
    for (int i = gtid; i < M * 8; i += nthr) { const f32x4* p = (const f32x4*)(PT + (size_t)i * 32); float sv = 0.f, sq = 0.f;
#pragma unroll
        for (int k = 0; k < 8; ++k) { const f32x4 v = p[k]; sv += v.x + v.z; sq += v.y + v.w; }
        *(f32x2_t*)(ST + (size_t)i * 2) = (f32x2_t){sv, sq}; }
}

constexpr int AT_KROW = 144, AT_KB = 256 * AT_KROW, AT_VB = AT_KB, AT_HALF = AT_KB + AT_VB + 768, AT_LD = 3 * D;
static_assert(2 * AT_HALF <= RING_BYTES, "attention tiles");
__device__ __forceinline__ void attn_group_mfma2(const bf16* QK, const float* bias2g, int ldil, int first, bf16* OACC, float* LSE, LAS unsigned char* lds, const int tid, const int bid, const int G) {
    const int wave = __builtin_amdgcn_readfirstlane(tid >> 6), lane = tid & 63, r = lane & 31, hh = lane >> 5, hw = wave >> 2, wq = wave & 3, tih0 = tid & 255;
    LAS unsigned char* Kl = lds + hw * AT_HALF; LAS unsigned char* Vl = Kl + AT_KB; LAS float* tab = (LAS float*)(Vl + AT_VB);
    const int Ls = SEQ >> ldil, lq4 = 4 - ldil, nq4m = (1 << lq4) - 1, dilm = (1 << ldil) - 1;
    constexpr float SC = 0.125f * 1.4426950409f;
    const float NEGBIG = opaque_f(-1e30f);
    constexpr int NP = BATCH * HA * 16 / 2;
    const int npp = (NP + G - 1) / G;
    v4u kreg[8], vreg[8];
#define AT_FETCH_K(su_) do { int tih = tih0; asm volatile("" : "+v"(tih)); const int su__ = (su_); const int q4_ = su__ & nq4m, rr_ = (su__ >> lq4) & dilm, h_ = (su__ >> 4) & 15, b_ = su__ >> 8, ks_ = q4_ * 128 - 64; \
        _Pragma("unroll") for (int j = 0; j < 8; ++j) { const int pi = j * 256 + tih, row = pi >> 3, ch = pi & 7; int kt = ks_ + row; kt = kt < 0 ? 0 : (kt > Ls - 1 ? Ls - 1 : kt); \
            kreg[j] = *(const v4u*)(QK + ((size_t)b_ * SEQ + ((size_t)kt << ldil) + rr_) * AT_LD + D + h_ * 64 + ch * 8); } } while (0)
#define AT_FETCH_V(su_) do { int tih = tih0; asm volatile("" : "+v"(tih)); const int su__ = (su_); const int q4_ = su__ & nq4m, rr_ = (su__ >> lq4) & dilm, h_ = (su__ >> 4) & 15, b_ = su__ >> 8, ks_ = q4_ * 128 - 64; \
        _Pragma("unroll") for (int j = 0; j < 8; ++j) { const int pi = j * 256 + tih, row = pi >> 3, ch = pi & 7; int kt = ks_ + row; kt = kt < 0 ? 0 : (kt > Ls - 1 ? Ls - 1 : kt); \
            vreg[j] = *(const v4u*)(QK + ((size_t)b_ * SEQ + ((size_t)kt << ldil) + rr_) * AT_LD + 2 * D + h_ * 64 + ch * 8); } } while (0)
    if (bid * npp < NP) { AT_FETCH_K(2 * (bid * npp) + hw); AT_FETCH_V(2 * (bid * npp) + hw); }
    for (int it = 0; it < npp; ++it) {
        const int p = bid * npp + it; if (p >= NP) break;
        const int su = 2 * p + hw, q4 = su & nq4m, rr = (su >> lq4) & dilm, h = (su >> 4) & 15, b = su >> 8, t0 = q4 * 128 + 32 * wq;
        asm volatile("" ::: "memory"); __builtin_amdgcn_s_barrier(); asm volatile("" ::: "memory");
        int tih = tih0; asm volatile("" : "+v"(tih));
#pragma unroll
        for (int j = 0; j < 8; ++j) { const int pi = j * 256 + tih; *(LAS v4u*)(Kl + (pi >> 3) * AT_KROW + (pi & 7) * 16) = kreg[j]; }
#pragma unroll
        for (int j = 0; j < 8; ++j) { const int pi = j * 256 + tih; *(LAS v4u*)(Vl + (pi >> 3) * AT_KROW + (pi & 7) * 16) = vreg[j]; }
        if (tih < 192) { const int o = tih - 96; tab[tih] = (o >= -64 && o <= 64) ? bias2g[h * 129 + o + 64] : NEGBIG; }
        const size_t rowq = (size_t)b * SEQ + ((size_t)(t0 + r) << ldil) + rr;
        bf16x8s qf[4];
#pragma unroll
        for (int ks = 0; ks < 4; ++ks) qf[ks] = *(const bf16x8s*)(QK + rowq * AT_LD + h * 64 + 16 * ks + 8 * hh);
        asm volatile("s_waitcnt lgkmcnt(0)" ::: "memory"); __builtin_amdgcn_s_barrier(); asm volatile("" ::: "memory");
        f32x16 S[5];
#pragma unroll
        for (int kb = 0; kb < 5; ++kb) {
            const LAS unsigned char* kp = Kl + (32 * wq + 32 * kb + r) * AT_KROW + 16 * hh;
#pragma unroll
            for (int i = 0; i < 16; ++i) S[kb][i] = 0.f;
#pragma unroll
            for (int ks = 0; ks < 4; ++ks) S[kb] = __builtin_amdgcn_mfma_f32_32x32x16_bf16(*(const LAS bf16x8s*)(kp + 32 * ks), qf[ks], S[kb], 0, 0, 0);
        }
        const bool more = it + 1 < npp && p + 1 < NP;
        __builtin_amdgcn_sched_barrier(0);
        if (more) AT_FETCH_K(2 * (p + 1) + hw);
        __builtin_amdgcn_sched_barrier(0);
        const LAS float* tb = tab + (32 + 4 * hh - r);
        float mx = NEGBIG;
        int kt0 = t0 - 64 + 4 * hh; asm volatile("" : "+v"(kt0));
#pragma unroll
        for (int kb = 0; kb < 5; ++kb)
#pragma unroll
            for (int i = 0; i < 16; ++i) { const int krel = 32 * kb + (i & 3) + 8 * (i >> 2);
                float s = S[kb][i] * SC + tb[krel]; s = ((unsigned)(kt0 + krel) >= (unsigned)Ls) ? NEGBIG : s; S[kb][i] = s; mx = fmaxf(mx, s); }
        mx = fmaxf(mx, get_xor32(mx, lane));
        float l = 0.f;
#pragma unroll
        for (int kb = 0; kb < 5; ++kb)
#pragma unroll
            for (int i = 0; i < 16; ++i) { const float pv = __builtin_amdgcn_exp2f(S[kb][i] - mx); S[kb][i] = pv; l += pv; }
        l += get_xor32(l, lane);
        f32x16 O[2];
#pragma unroll
        for (int db = 0; db < 2; ++db)
#pragma unroll
            for (int i = 0; i < 16; ++i) O[db][i] = 0.f;
#pragma unroll
        for (int kb = 0; kb < 5; ++kb) {
            if (kb == 3) { __builtin_amdgcn_sched_barrier(0); if (more) AT_FETCH_V(2 * (p + 1) + hw); __builtin_amdgcn_sched_barrier(0); }
#pragma unroll
            for (int s2 = 0; s2 < 2; ++s2) {
                v4u pw; pw.x = cvtpk(S[kb][8 * s2 + 0], S[kb][8 * s2 + 1]); pw.y = cvtpk(S[kb][8 * s2 + 2], S[kb][8 * s2 + 3]); pw.z = cvtpk(S[kb][8 * s2 + 4], S[kb][8 * s2 + 5]); pw.w = cvtpk(S[kb][8 * s2 + 6], S[kb][8 * s2 + 7]);
                const bf16x8s pf = __builtin_bit_cast(bf16x8s, pw);
                typedef short s16x4 __attribute__((ext_vector_type(4)));
                const LAS unsigned char* vb = Vl + (32 * wq + 32 * kb + 16 * s2 + 4 * hh + ((lane & 15) >> 2)) * AT_KROW + (16 * ((lane >> 4) & 1) + 4 * (lane & 3)) * 2;
#pragma unroll
                for (int db = 0; db < 2; ++db) {
                    const v2u lo = __builtin_bit_cast(v2u, __builtin_amdgcn_ds_read_tr16_b64_v4i16((LAS s16x4*)(vb + 64 * db))), hi = __builtin_bit_cast(v2u, __builtin_amdgcn_ds_read_tr16_b64_v4i16((LAS s16x4*)(vb + 64 * db + 8 * AT_KROW)));
                    const v4u vw = (v4u){lo.x, lo.y, hi.x, hi.y};
                    O[db] = __builtin_amdgcn_mfma_f32_32x32x16_bf16(__builtin_bit_cast(bf16x8s, vw), pf, O[db], 0, 0, 0); }
            }
        }
        const float il = __builtin_amdgcn_rcpf(l); float lse = mx + __builtin_amdgcn_logf(l);
        const size_t row = rowq;
        float wn = il, wo = 0.f;
        if (!first) { const float lo = LSE[row * 16 + h]; const float mm = fmaxf(lo, lse), eo = __builtin_amdgcn_exp2f(lo - mm), en = __builtin_amdgcn_exp2f(lse - mm), inv = __builtin_amdgcn_rcpf(eo + en); wn = en * inv * il; wo = eo * inv; lse = mm + __builtin_amdgcn_logf(eo + en); }
        if (hh == 0) LSE[row * 16 + h] = lse;
#pragma unroll
        for (int db = 0; db < 2; ++db)
#pragma unroll
            for (int gq = 0; gq < 4; ++gq) { v2u* op = (v2u*)(OACC + row * D + h * 64 + 32 * db + 8 * gq + 4 * hh);
                v2u x = (v2u){0u, 0u}; if (!first) x = *op;
                v2u y; y.x = cvtpk(wn * O[db][4 * gq + 0] + wo * bflo(x.x), wn * O[db][4 * gq + 1] + wo * bfhi(x.x)); y.y = cvtpk(wn * O[db][4 * gq + 2] + wo * bflo(x.y), wn * O[db][4 * gq + 3] + wo * bfhi(x.y));
                *op = y; }
    }
#undef AT_FETCH_K
#undef AT_FETCH_V
    __syncthreads();
}


struct Args { const float* in[11]; float* out; unsigned char* ws; int ph_lo, ph_hi; };
__global__ void __launch_bounds__(NTHREADS, 2) mk_fwd(Args args) {
    extern __shared__ __attribute__((aligned(16))) unsigned char lds_raw[];
    LAS unsigned char* lds = (LAS unsigned char*)lds_raw;
    volatile LAS unsigned* MISC = (volatile LAS unsigned*)(lds + MISC_OFF);
    const int wave0 = __builtin_amdgcn_readfirstlane(threadIdx.x >> 6);
    for (int u = threadIdx.x; u < (LDS_BYTES - LDSCTL_OFF) / 4; u += NTHREADS) ((LAS unsigned*)(lds + LDSCTL_OFF))[u] = 0u;
    __syncthreads();
    (void)xcd_barrier_post((unsigned*)(args.ws + WS_CTL) + CW_BAR, MISC + 8);
    bool again = false;
#if PROBE_TWICE
    for (int pass_ = 0; pass_ < 2; ++pass_)
#endif
    for (int ph = args.ph_lo; ph < args.ph_hi; ++ph) {
        unsigned char* ws = args.ws; asm volatile("" : "+s"(ws));
        int bid = blockIdx.x, G = gridDim.x; asm volatile("" : "+s"(bid), "+s"(G));
        const int gw = bid * NWAVES + wave0, NGW = G * NWAVES;
#define GET_TID() int tid; asm volatile("v_mbcnt_lo_u32_b32 %0, -1, 0\n\tv_mbcnt_hi_u32_b32 %0, -1, %0" : "=v"(tid)); const int lane = tid; tid += wave0 * 64; (void)lane;
        LAS float* scr = (LAS float*)(lds + RING_OFF + wave0 * CV_SCR);
        const float* gains = args.in[1]; float* out = args.out;
        float* RS = (float*)(ws + WS_RS);
        enum { T_P0, T_G1, T_FG, T_THIN, T_APROJ, T_ATT, T_RPROJ, T_RCORE, T_RGATE, T_RSTAT };
        int type, L = 0, kind = 0, aux = 0;
        if (ph == 0) type = T_P0;
        else { const int p = ph - 1, pp = p % 26, odd = pp >= 14, q = odd ? pp - 14 : pp, nmix = odd ? 6 : 8;
            L = 2 * (p / 26) + odd;
            if (q < 3) { kind = 0; type = q == 0 ? T_G1 : (q == 1 ? T_FG : T_THIN); }
            else if (q >= 3 + nmix) { kind = 2; const int r = q - 3 - nmix; type = r == 0 ? T_G1 : (r == 1 ? T_FG : T_THIN); }
            else { kind = 1; const int r = q - 3;
                if (r == nmix - 2) type = T_FG; else if (r == nmix - 1) type = T_THIN;
                else if (!odd) { aux = r >> 1; type = (r & 1) ? T_ATT : T_APROJ; }
                else type = r == 0 ? T_RPROJ : (r == 1 ? T_RCORE : (r == 2 ? T_RSTAT : T_RGATE)); } }
        const bool is_att = (L & 1) == 0; const int jj = L >> 1;
#define P_BIAS ((float*)(ws + WS_BIAS))
#define P_WA   ((bf16*)(ws + WS_W))
#define P_XH   ((bf16*)(ws + WS_XH))
#define P_BIG  ((bf16*)(ws + WS_BIG))
#define P_F    ((bf16*)(ws + WS_F))
#define P_YC   ((bf16*)(ws + WS_YC))
#define P_OACC ((bf16*)(ws + WS_OACC))
#define P_LSE  ((float*)(ws + WS_LSE))
        if (type == T_P0) {
            GET_TID()
#if PROBE_TOUCH
            {
                const size_t tix = (size_t)(bid >> 3) * NTHREADS + tid, nthr = (size_t)(G >> 3) * NTHREADS; unsigned accw = 0;
                for (size_t o = tix * 65536; o < WS_END; o += nthr * 65536) accw += *(const volatile unsigned*)(ws + o);
                for (size_t o = tix * 65536; o < (size_t)M * D * 4; o += nthr * 65536) { accw += *(const volatile unsigned*)((const char*)args.in[0] + o); accw += *(const volatile unsigned*)((const char*)out + o); }
                for (size_t o = tix * 65536; o < (size_t)DEPTH * 2 * D * DFF * 4; o += nthr * 65536) { accw += *(const volatile unsigned*)((const char*)args.in[2] + o); accw += *(const volatile unsigned*)((const char*)args.in[3] + o); accw += *(const volatile unsigned*)((const char*)args.in[4] + o); }
                for (size_t o = tix * 65536; o < (size_t)2 * D * NGRP * ATT_COLS * 4; o += nthr * 65536) accw += *(const volatile unsigned*)((const char*)args.in[5] + o);
                for (size_t o = tix * 65536; o < (size_t)2 * D * RET_COLS * 4; o += nthr * 65536) accw += *(const volatile unsigned*)((const char*)args.in[8] + o);
                if (accw == 0x12345677u) P_BIAS[70000] = 1.f; }
#endif
            const float* rel_bias = args.in[7];
            if (bid == 0) for (int i = tid; i < 3 * 16 * 129; i += NTHREADS) { const int g = i / (16 * 129), h = (i / 129) % 16, kk = i % 129; P_BIAS[i] = rel_bias[(g * 16 + h) * 32 + T5_BUCKET[g][kk]] * 1.4426950409f; }
            conv_gateup(args.in[2], args.in[3], P_WA, gains, scr, gw, NGW, lane);
            conv_plain<DFF, D>(args.in[4], (bf16*)(ws + WS_W2_FFN), nullptr, scr, gw, NGW, lane);
            p0_rows(args.in[0], P_XH, RS, gw, NGW, lane);
#if PROBE_MFMA
            {
                typedef short bx8 __attribute__((ext_vector_type(8)));
                bx8 a = {1, 2, 3, 4, 5, 6, 7, (short)lane}, b = {3, 1, 4, 1, 5, 9, 2, (short)(lane + 1)};
                f32x4 c0 = {0, 0, 0, 0}, c1 = c0, c2 = c0, c3 = c0, c4 = c0, c5 = c0, c6 = c0, c7 = c0;
                for (int it = 0; it < PROBE_MFMA; ++it) {
#pragma unroll
                    for (int r = 0; r < 4; ++r) {
                        c0 = __builtin_amdgcn_mfma_f32_16x16x32_bf16(a, b, c0, 0, 0, 0); c1 = __builtin_amdgcn_mfma_f32_16x16x32_bf16(a, b, c1, 0, 0, 0); c2 = __builtin_amdgcn_mfma_f32_16x16x32_bf16(a, b, c2, 0, 0, 0); c3 = __builtin_amdgcn_mfma_f32_16x16x32_bf16(a, b, c3, 0, 0, 0);
                        c4 = __builtin_amdgcn_mfma_f32_16x16x32_bf16(a, b, c4, 0, 0, 0); c5 = __builtin_amdgcn_mfma_f32_16x16x32_bf16(a, b, c5, 0, 0, 0); c6 = __builtin_amdgcn_mfma_f32_16x16x32_bf16(a, b, c6, 0, 0, 0); c7 = __builtin_amdgcn_mfma_f32_16x16x32_bf16(a, b, c7, 0, 0, 0); }
                    asm volatile("" : "+v"(a), "+v"(b)); }
                const f32x4 t = c0 + c1 + c2 + c3 + c4 + c5 + c6 + c7;
                if (t.x + t.y + t.z + t.w == 12345.678f) P_BIAS[60000 + tid] = t.x;
            }
#endif
        } else if (type == T_G1) {
            GET_TID()
            pg8::Gemm g{P_XH, P_WA, M, 2 * DFF, D, 0}; pg8::StaticOrder S; S.init(M, 2 * DFF, G, bid);
            pg8::stage_scales(lds + RING_OFF, S, RS, false, 0, tid);
            pg8::EpiSwiGLU E{P_BIG, DFF, (const LAS float*)(lds + RING_OFF + pg8::RS_TAB_OFF)};
            pg8::gemm_phase<pg8::EpiSwiGLU, pg8::StaticOrder, true, true>(lds + RING_OFF, g, S, E, tid);
#if PROBE_G1V >= 0
            { GET_TID() pg8::Gemm g2{P_XH, P_WA, M, 2 * DFF, D, 0}; pg8::StaticOrder S2; S2.init(M, 2 * DFF, G, bid);
              pg8::EpiSwiGLUT<PROBE_G1V> E2{PROBE_G1V ? P_F : P_BIG, PROBE_G1V ? D : DFF, (const LAS float*)(lds + RING_OFF + pg8::RS_TAB_OFF)};
              pg8::gemm_phase<pg8::EpiSwiGLUT<PROBE_G1V>, pg8::StaticOrder, true, true>(lds + RING_OFF, g2, S2, E2, tid); }
#endif
        } else if (type == T_FG) {
            GET_TID()
            const size_t fA = kind != 1 ? WS_BIG : (is_att ? WS_OACC : WS_YC), fB = kind != 1 ? WS_W2_FFN : (is_att ? WS_W2_ATT : WS_W2_RET); const int fK = kind != 1 ? DFF : (is_att ? D : DV);
            pg8::Gemm g{(const bf16*)(ws + fA), (const bf16*)(ws + fB), M, D, fK, 0}; pg8::StaticOrder S; S.init(M, D, G, bid);
            pg8::EpiPlain E{P_F, D, (const LAS float*)nullptr};
            pg8::gemm_phase<pg8::EpiPlain, pg8::StaticOrder, true, true>(lds + RING_OFF, g, S, E, tid);
#if PROBE_FGM
            if (kind != 1) { GET_TID()
                pg8::Gemm g2{(const bf16*)(ws + fA), (const bf16*)(ws + fB), PROBE_FGM, D, fK, 0}; pg8::StaticOrder S2; S2.init(PROBE_FGM, D, G, bid);
                pg8::EpiPlain E2{P_XH, D, (const LAS float*)nullptr};
                pg8::gemm_phase<pg8::EpiPlain, pg8::StaticOrder, true, true>(lds + RING_OFF, g2, S2, E2, tid); }
#endif
        } else if (type == T_THIN) {
            GET_TID()
            const int sub = L * 3 + kind;
            for (int crep = 0; crep < 1 + PROBE_CONV2; ++crep)
            if (sub + 1 < 3 * DEPTH) {
                const int nk = (sub + 1) % 3, nL = (sub + 1) / 3, nj = nL >> 1;
                const float* gn = gains + ((size_t)nL * 6 + (nk == 0 ? 0 : (nk == 1 ? 2 : 4))) * D;
                if (nk != 1) { const size_t o = (size_t)(nL * 2 + (nk >> 1)) * D * DFF;
                    conv_gateup(args.in[2] + o, args.in[3] + o, P_WA, gn, scr, gw, NGW, lane); conv_plain<DFF, D>(args.in[4] + o, (bf16*)(ws + WS_W2_FFN), nullptr, scr, gw, NGW, lane); }
                else if ((nL & 1) == 0) { conv_plain<D, NGRP * ATT_COLS>(args.in[5] + (size_t)nj * D * NGRP * ATT_COLS, P_WA, gn, scr, gw, NGW, lane); conv_plain<D, D>(args.in[6] + (size_t)nj * D * D, (bf16*)(ws + WS_W2_ATT), nullptr, scr, gw, NGW, lane); }
                else { const float* rw = args.in[8] + (size_t)nj * D * RET_COLS;
                    conv_cols<D, RET_COLS, 2 * D + DV>(rw, 0, P_WA, 0, gn, scr, gw, NGW, lane); conv_gates<RET_COLS>(rw, 2 * D + DV, 2 * D + 2 * DV, P_WA, 2 * D + DV, gn, scr, gw, NGW, lane);
                    conv_plain<DV, D>(args.in[9] + (size_t)nj * DV * D, (bf16*)(ws + WS_W2_RET), nullptr, scr, gw, NGW, lane); }
            }
            asm volatile("" ::: "memory");
            const float* gpost = gains + ((size_t)L * 6 + (kind == 0 ? 1 : (kind == 1 ? 3 : 5))) * D;
            thin_rows(P_F, P_XH, gpost, kind == 1 ? 1.0f : 0.5f, RS, sub + 1 < 3 * DEPTH ? nullptr : out, gw, NGW, lane);
        } else if (type == T_APROJ) {
            GET_TID()
            { pg8::Gemm g{P_XH, P_WA + (size_t)aux * ATT_COLS * D, M, ATT_COLS, D, 0}; pg8::StaticOrder S; S.init(M, ATT_COLS, G, bid);
              pg8::stage_scales(lds + RING_OFF, S, RS, false, 0, tid);
              pg8::EpiPlain E{P_BIG, ATT_COLS, (const LAS float*)(lds + RING_OFF + pg8::RS_TAB_OFF)};
              pg8::gemm_phase<pg8::EpiPlain, pg8::StaticOrder, true, true>(lds + RING_OFF, g, S, E, tid); }
        } else if (type == T_ATT) {
            GET_TID()
            const int ldil = 2 * aux;
            attn_group_mfma2(P_BIG, P_BIAS + aux * 16 * 129, ldil, aux == 0, P_OACC, P_LSE, lds + RING_OFF, tid, bid, G);
        } else if (type == T_RPROJ) {
            GET_TID()
            { pg8::Gemm g{P_XH, P_WA, M, 2 * D, D, 0}; pg8::StaticOrder S; S.init(M, 2 * D, G, bid);
              pg8::stage_scales(lds + RING_OFF, S, RS, false, 0, tid);
              pg8::EpiRet E{P_BIG, 2 * D, (const LAS float*)(lds + RING_OFF + pg8::RS_TAB_OFF)};
              pg8::gemm_phase<pg8::EpiRet, pg8::StaticOrder, true, true>(lds + RING_OFF, g, S, E, tid); }
            { GET_TID()
              pg8::Gemm g{P_WA + (size_t)2 * D * D, P_XH, DV, M, D, 0}; pg8::StaticOrder S; S.init(DV, M, G, bid);
              pg8::stage_scales(lds + RING_OFF, S, RS, true, 0, tid);
              pg8::EpiVT E{(bf16*)(ws + WS_RVT), M, 0, (const LAS float*)(lds + RING_OFF + pg8::RS_TAB_OFF)};
              pg8::gemm_phase<pg8::EpiVT, pg8::StaticOrder, true, true>(lds + RING_OFF, g, S, E, tid); }
        } else if (type == T_RCORE) {
            GET_TID()
            static_assert(RC_LDS <= RING_BYTES, "retention core LDS tiles");
            ret_core_mfma<0>(P_BIG, (const bf16*)(ws + WS_RVT), args.in[10] + jj * 2 * HR, P_YC, (bf16*)out, (float*)(ws + WS_OACC), lds + RING_OFF, tid, bid, G);
        } else if (type == T_RSTAT) {
            GET_TID()
            ret_stats((const float*)(ws + WS_OACC), P_LSE, bid * NTHREADS + tid, G * NTHREADS);
        } else {
            GET_TID()
            pg8::Gemm g{P_XH, P_WA + (size_t)(2 * D + DV) * D, M, 2 * DV, D, 0}; pg8::StaticOrder S; S.init(M, 2 * DV, G, bid);
            pg8::stage_scales(lds + RING_OFF, S, RS, false, 0, tid);
            pg8::EpiGate E{P_YC, (const bf16*)out, P_LSE, (const LAS float*)(lds + RING_OFF + pg8::RS_TAB_OFF)};
            pg8::gemm_phase<pg8::EpiGate, pg8::StaticOrder, true, true>(lds + RING_OFF, g, S, E, tid);
        }
        if (ph + 1 < args.ph_hi || PROBE_TWICE) { XcdBarrier b_; b_.bar = (unsigned*)(ws + WS_CTL) + CW_BAR; b_.x = xb_xcc_id(); b_.st = MISC + 8; xcd_barrier(b_);
#if PROBE_BAR2
            xcd_barrier(b_);
#endif
        }
        if (PROBE_REPEAT) {
            if (!again && ((PROBE_REPEAT >> type) & 1) && (type != T_ATT || aux == 0) && ph + 1 < args.ph_hi) { again = true; --ph; } else again = false; }
    }
}

extern "C" void kernel_launch(void* const* d_in, const int* in_sizes, int n_in, void* d_out, int out_size, void* d_ws, size_t ws_size, hipStream_t stream) {
    static int grid = 0;
    if (grid == 0) {
        if (n_in != 11 || in_sizes[0] != M * D || out_size != M * D || ws_size < WS_END) { fprintf(stderr, "kernel_launch: unexpected shapes / workspace (n_in %d, ws %zu, need %zu); nothing launched\n", n_in, ws_size, (size_t)WS_END); grid = -1; return; }
        int dev = 0, cus = 0, per_cu = 0;
        if (hipGetDevice(&dev) != hipSuccess || hipDeviceGetAttribute(&cus, hipDeviceAttributeMultiprocessorCount, dev) != hipSuccess) { grid = -1; return; }
        if (hipFuncSetAttribute((const void*)mk_fwd, hipFuncAttributeMaxDynamicSharedMemorySize, LDS_BYTES) != hipSuccess) { fprintf(stderr, "kernel_launch: hipFuncSetAttribute failed\n"); grid = -1; return; }
        if (hipOccupancyMaxActiveBlocksPerMultiprocessor(&per_cu, (const void*)mk_fwd, NTHREADS, LDS_BYTES) != hipSuccess || per_cu < 1) { fprintf(stderr, "kernel_launch: occupancy query reports %d workgroups per CU\n", per_cu); }
        (void)hipGetLastError();
        grid = cus;
    }
    if (grid < 0) return;
    if (hipMemsetAsync((char*)d_ws + WS_CTL, 0, CTL_ZERO_BYTES, stream) != hipSuccess) return;
    Args a{};
    for (int i = 0; i < 11; ++i) a.in[i] = (const float*)d_in[i];
    a.out = (float*)d_out; a.ws = (unsigned char*)d_ws;
#if MK_ONE_LAUNCH
    a.ph_lo = 0; a.ph_hi = NPHASES;
    hipLaunchKernelGGL(mk_fwd, dim3(grid), dim3(NTHREADS), LDS_BYTES, stream, a);
#else
    for (int p = 0; p < NPHASES; ++p) { a.ph_lo = p; a.ph_hi = p + 1; hipLaunchKernelGGL(mk_fwd, dim3(grid), dim3(NTHREADS), LDS_BYTES, stream, a); }
#endif
}
```

```cpp
#include <hip/hip_runtime.h>
#include <cstdio>
#include <cstdint>
#ifndef PROBE_REPEAT
#define PROBE_REPEAT 0
#endif
#ifndef PROBE_THIN2
#define PROBE_THIN2 0
#endif
#ifndef PROBE_ATT2
#define PROBE_ATT2 0
#endif
#ifndef PROBE_CONV2
#define PROBE_CONV2 0
#endif
#ifndef PROBE_FGM
#define PROBE_FGM 0
#endif
#ifndef PROBE_RC
#define PROBE_RC -1
#endif
#ifndef PROBE_G1V
#define PROBE_G1V -1
#endif
#ifndef PROBE_BAR2
#define PROBE_BAR2 0
#endif
#ifndef PROBE_MFMA
#define PROBE_MFMA 0
#endif
#ifndef PROBE_TWICE
#define PROBE_TWICE 0
#endif
#ifndef PROBE_TOUCH
#define PROBE_TOUCH 0
#endif
#ifndef MK_ONE_LAUNCH
#define MK_ONE_LAUNCH 1
#endif
namespace pg8 {
#define PG8_LAS __attribute__((address_space(3)))
typedef unsigned short bf16_t;
typedef short bf16x8 __attribute__((ext_vector_type(8)));
typedef float f32x4 __attribute__((ext_vector_type(4)));
typedef unsigned u32x4 __attribute__((ext_vector_type(4)));
constexpr int BM = 256, BK = 64, HALF = 128, HTB = HALF * BK * 2  , STAGE_BYTES = 8 * HTB, NXCD = 8, WGM = 8;

__host__ __device__ __forceinline__ int lds_byte(int r, int c) { const int st = (r >> 4) * 2 + (c >> 5), rr = r & 15, cc = c & 31, ob = rr * 64 + cc * 2; return st * 1024 + (ob ^ (((ob >> 9) & 1) << 5)); }
__host__ __device__ __forceinline__ void stage_rc(int b, int& R, int& C) { const int st = b / 1024, sb = b % 1024, swz = sb ^ (((sb >> 9) & 1) << 5); R = (st >> 1) * 16 + swz / 64; C = (st & 1) * 32 + (swz % 64) / 2; }
__host__ __device__ __forceinline__ int perm32(int rho) { const int n = rho >> 4, i = rho & 15; return 8 * (i >> 2) + 4 * n + (i & 3); }

struct Unit { int pm, pn, idx; };
struct Gemm { const bf16_t* A; const bf16_t* Bt; int M, N, K; int ldil; };

struct StaticOrder {
    int nM, nN, nwg, G, c;
    __host__ __device__ void init(int M, int N, int G_, int c_) { nM = M / BM; nN = N / BM; nwg = nM * nN; G = G_; c = c_; }
    __host__ __device__ bool next(int i, Unit& u) const {
        const long L = (long)i * G + c; if (L >= nwg) return false;
        int wgid = (int)L; { const int q = nwg / NXCD, r = nwg % NXCD, xcd = wgid % NXCD, off = wgid / NXCD; wgid = (xcd < r ? xcd * (q + 1) : r * (q + 1) + (xcd - r) * q) + off; }
        const int nig = WGM * nN, gid = wgid / nig, fm = gid * WGM, gsz = (nM - fm) < WGM ? (nM - fm) : WGM;
        u.pm = fm + ((wgid % nig) % gsz); u.pn = (wgid % nig) / gsz; u.idx = i; return true;
    }
    __device__ __forceinline__ void a_ready(const Unit&) const {}
    __device__ __forceinline__ void done(const Unit&) const {}
};

__device__ __forceinline__ unsigned cvt_pk_bf16(float lo, float hi) { unsigned r; asm volatile("v_cvt_pk_bf16_f32 %0, %1, %2" : "=v"(r) : "v"(lo), "v"(hi)); return r; }
typedef float f32x2 __attribute__((ext_vector_type(2)));

__device__ __forceinline__ float fast_sigmoid(float g) { return __builtin_amdgcn_rcpf(1.0f + __builtin_amdgcn_exp2f(-1.4426950409f * g)); }
constexpr int RS_TAB_OFF = 131072;
template <class Sched> __device__ __forceinline__ void stage_scales(PG8_LAS unsigned char* lds, const Sched& S, const float* rs, bool cols, int ldil, int tid) {
    PG8_LAS float* tab = (PG8_LAS float*)(lds + RS_TAB_OFF); Unit u;
    if (tid < 256) { const int lper = 8 - ldil, c = tid, tm = ((c & ((1 << lper) - 1)) << ldil) + (c >> lper);
        for (int i = 0; i < 16 && S.next(i, u); ++i) tab[i * 256 + tid] = rs[cols ? u.pn * BM + tm : u.pm * BM + tid]; }
    __syncthreads();
}
struct EpiPlain {
    static constexpr bool PERM = true, AFTER_DRAIN = false;
    bf16_t* O; int ldc; const PG8_LAS float* tab;
    __device__ __forceinline__ void operator()(const f32x4 (&acc)[2][2][4][2], const Unit& u, int wr, int wc, int fr, int fq) const {
        const int row0 = u.pm * BM + wr * 64 + fr, col0 = u.pn * BM + wc * 32 + 8 * fq;
#pragma unroll
        for (int ai = 0; ai < 2; ++ai)
#pragma unroll
            for (int m = 0; m < 4; ++m) { const int row = row0 + ai * HALF + m * 16; bf16_t* rowp = O + (size_t)row * ldc + col0; const float r = tab ? tab[u.idx * 256 + (row & 255)] : 1.0f;
#pragma unroll
                for (int bj = 0; bj < 2; ++bj) { const f32x4 v0 = acc[ai][bj][m][0] * r, v1 = acc[ai][bj][m][1] * r;
                    u32x4 w; w.x = cvt_pk_bf16(v0[0], v0[1]); w.y = cvt_pk_bf16(v0[2], v0[3]); w.z = cvt_pk_bf16(v1[0], v1[1]); w.w = cvt_pk_bf16(v1[2], v1[3]);
                    *(u32x4*)(rowp + bj * HALF) = w; } }
    }
};
template <int CHEAP = 0  > struct EpiSwiGLUT {
    static constexpr bool PERM = true, AFTER_DRAIN = false;
    bf16_t* O; int ldc; const PG8_LAS float* tab;
    __device__ __forceinline__ void operator()(const f32x4 (&acc)[2][2][4][2], const Unit& u, int wr, int wc, int fr, int fq) const {
        const int row0 = u.pm * BM + wr * 64 + fr, col0 = CHEAP ? ((u.pn * HALF + wc * 32 + 8 * fq) & 1023) : (u.pn * HALF + wc * 32 + 8 * fq);
#pragma unroll
        for (int ai = 0; ai < 2; ++ai)
#pragma unroll
            for (int m = 0; m < 4; ++m) { const int row = row0 + ai * HALF + m * 16; bf16_t* rowp = O + (size_t)row * ldc + col0; const float r = tab[u.idx * 256 + (row & 255)];
                float o[8];
#pragma unroll
                for (int n = 0; n < 2; ++n)
#pragma unroll
                    for (int e = 0; e < 4; ++e) { const float g = acc[ai][0][m][n][e] * r, up = acc[ai][1][m][n][e] * r; o[n * 4 + e] = CHEAP ? g * up : g * fast_sigmoid(g) * up; }
                u32x4 w; w.x = cvt_pk_bf16(o[0], o[1]); w.y = cvt_pk_bf16(o[2], o[3]); w.z = cvt_pk_bf16(o[4], o[5]); w.w = cvt_pk_bf16(o[6], o[7]);
                if (CHEAP == 2) { if (w.x == 0x12345678u && w.y == w.z) *(u32x4*)rowp = w; } else *(u32x4*)rowp = w; }
    }
};
typedef EpiSwiGLUT<0> EpiSwiGLU;
struct EpiRet {
    static constexpr bool PERM = true, AFTER_DRAIN = false;
    bf16_t* O; int ldc; const PG8_LAS float* tab;
    __device__ __forceinline__ void operator()(const f32x4 (&acc)[2][2][4][2], const Unit& u, int wr, int wc, int fr, int fq) const {
        const int row0 = u.pm * BM + wr * 64 + fr, col0 = u.pn * BM + wc * 32 + 8 * fq;
        if (true) {
            const float osc = (u.pn >= 4) ? 0.0625f : 1.0f;
            float invf[8];
#pragma unroll
            for (int q = 0; q < 8; ++q) { const int j = wc * 32 + 8 * fq + q; invf[q] = __builtin_amdgcn_exp2f(-(float)j * (13.287712379549449f / 127.0f)) * 0.15915494309189535f; }
#pragma unroll
            for (int ai = 0; ai < 2; ++ai)
#pragma unroll
                for (int m = 0; m < 4; ++m) { const int row = row0 + ai * HALF + m * 16; const float pos = (float)(row & 2047), r = tab[u.idx * 256 + (row & 255)] * osc;
                    bf16_t* rowp = O + (size_t)row * ldc + col0;
                    float o1[8], o2[8];
#pragma unroll
                    for (int n = 0; n < 2; ++n)
#pragma unroll
                        for (int e = 0; e < 4; ++e) { const int q = n * 4 + e; float t = pos * invf[q]; t = __builtin_amdgcn_fractf(t);
                            const float sn = __builtin_amdgcn_sinf(t), cs = __builtin_amdgcn_cosf(t);
                            const float a = acc[ai][0][m][n][e], b = acc[ai][1][m][n][e];
                            o1[q] = (a * cs - b * sn) * r; o2[q] = (a * sn + b * cs) * r; }
                    u32x4 w; w.x = cvt_pk_bf16(o1[0], o1[1]); w.y = cvt_pk_bf16(o1[2], o1[3]); w.z = cvt_pk_bf16(o1[4], o1[5]); w.w = cvt_pk_bf16(o1[6], o1[7]);
                    *(u32x4*)rowp = w;
                    w.x = cvt_pk_bf16(o2[0], o2[1]); w.y = cvt_pk_bf16(o2[2], o2[3]); w.z = cvt_pk_bf16(o2[4], o2[5]); w.w = cvt_pk_bf16(o2[6], o2[7]);
                    *(u32x4*)(rowp + HALF) = w; }
        } else {
#pragma unroll
            for (int ai = 0; ai < 2; ++ai)
#pragma unroll
                for (int m = 0; m < 4; ++m) { const int row = row0 + ai * HALF + m * 16; bf16_t* rowp = O + (size_t)row * ldc + col0; const float r = tab[u.idx * 256 + (row & 255)];
#pragma unroll
                    for (int bj = 0; bj < 2; ++bj) { const f32x4 v0 = acc[ai][bj][m][0] * r, v1 = acc[ai][bj][m][1] * r;
                        u32x4 w; w.x = cvt_pk_bf16(v0[0], v0[1]); w.y = cvt_pk_bf16(v0[2], v0[3]); w.z = cvt_pk_bf16(v1[0], v1[1]); w.w = cvt_pk_bf16(v1[2], v1[3]);
                        *(u32x4*)(rowp + bj * HALF) = w; } }
        }
    }
};

struct EpiGate {
    static constexpr bool PERM = true, AFTER_DRAIN = false;
    bf16_t* Y; const bf16_t* YB; const float* ST; const PG8_LAS float* tab;
    __device__ __forceinline__ void operator()(const f32x4 (&acc)[2][2][4][2], const Unit& u, int wr, int wc, int fr, int fq) const {
        const int row0 = u.pm * BM + wr * 64 + fr, col0 = u.pn * HALF + wc * 32 + 8 * fq, head = u.pn >> 2;
#pragma unroll
        for (int ai = 0; ai < 2; ++ai)
#pragma unroll
            for (int m = 0; m < 4; ++m) { const int row = row0 + ai * HALF + m * 16; const float r = tab[u.idx * 256 + (row & 255)];
                const f32x4 st = *(const f32x4*)(ST + (size_t)row * 16 + head * 4);
                const float muf = __builtin_amdgcn_ldexpf(st[0], -9), mub = __builtin_amdgcn_ldexpf(st[2], -9); float eps = 1e-6f; asm volatile("" : "+s"(eps));
                const float rf = __builtin_amdgcn_rsqf(fmaxf(__builtin_amdgcn_ldexpf(st[1], -9) - muf * muf, 0.f) + eps), rb = __builtin_amdgcn_rsqf(fmaxf(__builtin_amdgcn_ldexpf(st[3], -9) - mub * mub, 0.f) + eps);
                bf16_t* yp = Y + (size_t)row * 2048 + col0; const bf16_t* bp = YB + (size_t)row * 2048 + col0;
                const u32x4 yfw = *(const u32x4*)yp, ybw = *(const u32x4*)bp;
                float o[8];
#pragma unroll
                for (int n = 0; n < 2; ++n)
#pragma unroll
                    for (int e = 0; e < 4; ++e) { const int q = n * 4 + e; const unsigned wf = yfw[q >> 1], wb = ybw[q >> 1];
                        const float yf = __builtin_bit_cast(float, (q & 1) ? (wf & 0xffff0000u) : (wf << 16)), yb = __builtin_bit_cast(float, (q & 1) ? (wb & 0xffff0000u) : (wb << 16));
                        const float gf = acc[ai][0][m][n][e] * r, gb = acc[ai][1][m][n][e] * r;
                        o[q] = gf * fast_sigmoid(gf) * (yf - muf) * rf + gb * fast_sigmoid(gb) * (yb - mub) * rb; }
                u32x4 w; w.x = cvt_pk_bf16(o[0], o[1]); w.y = cvt_pk_bf16(o[2], o[3]); w.z = cvt_pk_bf16(o[4], o[5]); w.w = cvt_pk_bf16(o[6], o[7]);
                *(u32x4*)yp = w; }
    }
};

struct EpiVT {
    static constexpr bool PERM = true, AFTER_DRAIN = false;
    bf16_t* O; int ldc; int ldil; const PG8_LAS float* tab;
    __device__ __forceinline__ void operator()(const f32x4 (&acc)[2][2][4][2], const Unit& u, int wr, int wc, int fr, int fq) const {
        const int lper = 8 - ldil, per = 1 << lper, Ls = 2048 >> ldil, b = u.pn >> 3, pl = u.pn & 7;
        const int row0 = u.pm * BM + wr * 64 + fr;
        int colb[2]; float cs[2][8];
#pragma unroll
        for (int bj = 0; bj < 2; ++bj) { const int c0 = bj * HALF + wc * 32 + 8 * fq; colb[bj] = b * 2048 + (c0 >> lper) * Ls + pl * per + (c0 & (per - 1));
            const f32x4 a = *(const PG8_LAS f32x4*)(tab + u.idx * 256 + c0), b4 = *(const PG8_LAS f32x4*)(tab + u.idx * 256 + c0 + 4);
            cs[bj][0] = a[0]; cs[bj][1] = a[1]; cs[bj][2] = a[2]; cs[bj][3] = a[3]; cs[bj][4] = b4[0]; cs[bj][5] = b4[1]; cs[bj][6] = b4[2]; cs[bj][7] = b4[3]; }
#pragma unroll
        for (int ai = 0; ai < 2; ++ai)
#pragma unroll
            for (int m = 0; m < 4; ++m) { bf16_t* rowp = O + (size_t)(row0 + ai * HALF + m * 16) * ldc;
#pragma unroll
                for (int bj = 0; bj < 2; ++bj) { const f32x4 v0 = acc[ai][bj][m][0], v1 = acc[ai][bj][m][1];
                    u32x4 w; w.x = cvt_pk_bf16(v0[0] * cs[bj][0], v0[1] * cs[bj][1]); w.y = cvt_pk_bf16(v0[2] * cs[bj][2], v0[3] * cs[bj][3]); w.z = cvt_pk_bf16(v1[0] * cs[bj][4], v1[1] * cs[bj][5]); w.w = cvt_pk_bf16(v1[2] * cs[bj][6], v1[3] * cs[bj][7]);
                    *(u32x4*)(rowp + colb[bj]) = w; } }
    }
};

struct EpiKVT {
    static constexpr bool PERM = true, AFTER_DRAIN = false;
    bf16_t* OK; bf16_t* OV; int ldc; const PG8_LAS float* tab;
    __device__ __forceinline__ void operator()(const f32x4 (&acc)[2][2][4][2], const Unit& u, int wr, int wc, int fr, int fq) const {
        const int col0 = u.pn * BM + wc * 32 + 8 * fq;
        float cs[2][8];
#pragma unroll
        for (int bj = 0; bj < 2; ++bj) { const int cl = bj * HALF + wc * 32 + 8 * fq; const f32x4 a = *(const PG8_LAS f32x4*)(tab + u.idx * 256 + cl), b = *(const PG8_LAS f32x4*)(tab + u.idx * 256 + cl + 4);
            cs[bj][0] = a[0]; cs[bj][1] = a[1]; cs[bj][2] = a[2]; cs[bj][3] = a[3]; cs[bj][4] = b[0]; cs[bj][5] = b[1]; cs[bj][6] = b[2]; cs[bj][7] = b[3]; }
        if (u.pm < 4) {
#pragma unroll
            for (int m = 0; m < 4; ++m) { const int j = wr * 64 + m * 16 + fr;
                const float invf = __builtin_amdgcn_exp2f(-(float)j * (13.287712379549449f / 127.0f)) * 0.15915494309189535f;
                bf16_t* r1 = OK + (size_t)(u.pm * BM + j) * ldc + col0; bf16_t* r2 = r1 + (size_t)HALF * ldc;
#pragma unroll
                for (int bj = 0; bj < 2; ++bj) { float o1[8], o2[8];
#pragma unroll
                    for (int n = 0; n < 2; ++n)
#pragma unroll
                        for (int e = 0; e < 4; ++e) { const int q = n * 4 + e; const float pos = (float)((col0 + bj * HALF + q) & 2047); float t = pos * invf; t = __builtin_amdgcn_fractf(t);
                            const float sn = __builtin_amdgcn_sinf(t), cn = __builtin_amdgcn_cosf(t), sc = cs[bj][q] * 0.0625f;
                            const float a = acc[0][bj][m][n][e], b = acc[1][bj][m][n][e];
                            o1[q] = (a * cn - b * sn) * sc; o2[q] = (a * sn + b * cn) * sc; }
                    u32x4 w; w.x = cvt_pk_bf16(o1[0], o1[1]); w.y = cvt_pk_bf16(o1[2], o1[3]); w.z = cvt_pk_bf16(o1[4], o1[5]); w.w = cvt_pk_bf16(o1[6], o1[7]);
                    *(u32x4*)(r1 + bj * HALF) = w;
                    w.x = cvt_pk_bf16(o2[0], o2[1]); w.y = cvt_pk_bf16(o2[2], o2[3]); w.z = cvt_pk_bf16(o2[4], o2[5]); w.w = cvt_pk_bf16(o2[6], o2[7]);
                    *(u32x4*)(r2 + bj * HALF) = w; } }
        } else {
            const int row0 = (u.pm - 4) * BM + wr * 64 + fr;
#pragma unroll
            for (int ai = 0; ai < 2; ++ai)
#pragma unroll
                for (int m = 0; m < 4; ++m) { bf16_t* rowp = OV + (size_t)(row0 + ai * HALF + m * 16) * ldc + col0;
#pragma unroll
                    for (int bj = 0; bj < 2; ++bj) { const f32x4 v0 = acc[ai][bj][m][0], v1 = acc[ai][bj][m][1];
                        u32x4 w; w.x = cvt_pk_bf16(v0[0] * cs[bj][0], v0[1] * cs[bj][1]); w.y = cvt_pk_bf16(v0[2] * cs[bj][2], v0[3] * cs[bj][3]); w.z = cvt_pk_bf16(v1[0] * cs[bj][4], v1[1] * cs[bj][5]); w.w = cvt_pk_bf16(v1[2] * cs[bj][6], v1[3] * cs[bj][7]);
                        *(u32x4*)(rowp + bj * HALF) = w; } }
        }
    }
};

template <class Epi, class Sched, bool ALIGN_EPI = false, bool SP2 = false>
__device__ __forceinline__ void gemm_phase(PG8_LAS unsigned char* lds, const Gemm g, const Sched& S, const Epi& E, const int tid) {
    const int wid = __builtin_amdgcn_readfirstlane(tid >> 6), lane = tid & 63, wr = wid >> 2, wc = wid & 3, fr = lane & 15, fq = lane >> 4;
    const int K = g.K, nt = K / BK;
    unsigned voffA[2], voffB[2], voffB1[2];
#pragma unroll
    for (int i = 0; i < 2; ++i) { int R, C; stage_rc(tid * 16 + i * 8192, R, C); const int Rb = Epi::PERM ? ((R & ~31) + perm32(R & 31)) : R;
        voffA[i] = (unsigned)(R * K + C) * 2u; { const int ld = g.ldil, lper = 8 - ld, pm1 = (1 << lper) - 1; const int c0 = Rb, c1 = 128 + Rb; voffB[i] = (unsigned)((((c0 & pm1) << ld) + (c0 >> lper)) * K + C) * 2u; voffB1[i] = (unsigned)((((c1 & pm1) << ld) + (c1 >> lper)) * K + C) * 2u; } }
    const size_t kstep = (size_t)(BK * 2);
    const size_t hstep = (size_t)HALF * K * 2;
    const size_t tstep = 2 * hstep;
    const unsigned ldsw = (unsigned)wid * 1024u;
    const int aoff = lds_byte(wr * 64 + fr, fq * 8), boff = lds_byte(wc * 32 + fr, fq * 8);
#define PG8_SA(b, h) (((b) * 2 + (h)) * HTB)
#define PG8_SB(b, h) ((4 + (b) * 2 + (h)) * HTB)
#define PG8_STAGE(bufoff, gbase, voff) do { _Pragma("unroll") for (int _i = 0; _i < 2; ++_i) \
        __builtin_amdgcn_global_load_lds((const unsigned*)((const char*)(gbase) + (voff)[_i]), (PG8_LAS unsigned*)(lds + (bufoff) + ldsw + _i * 8192), 16, 0, 0); } while (0)
#define PG8_LDA(dst, b, h) do { _Pragma("unroll") for (int m = 0; m < 4; ++m) _Pragma("unroll") for (int k = 0; k < 2; ++k) dst[m][k] = *(const PG8_LAS bf16x8*)(lds + PG8_SA(b, h) + aoff + m * 2048 + k * 1024); } while (0)
#define PG8_LDB(dst, b, h) do { _Pragma("unroll") for (int n = 0; n < 2; ++n) _Pragma("unroll") for (int k = 0; k < 2; ++k) dst[n][k] = *(const PG8_LAS bf16x8*)(lds + PG8_SB(b, h) + boff + n * 2048 + k * 1024); } while (0)
#define PG8_MMA(ai, bj, At, Bt) do { __builtin_amdgcn_s_setprio(1); _Pragma("unroll") for (int m = 0; m < 4; ++m) _Pragma("unroll") for (int n = 0; n < 2; ++n) _Pragma("unroll") for (int k = 0; k < 2; ++k) \
        acc[ai][bj][m][n] = __builtin_amdgcn_mfma_f32_16x16x32_bf16(Bt[n][k], At[m][k], acc[ai][bj][m][n], 0, 0, 0); __builtin_amdgcn_s_setprio(0); } while (0)
#define PG8_WAIT_V(n) asm volatile("s_waitcnt vmcnt(" #n ")" ::: "memory")
#define PG8_WAIT_L(n) asm volatile("s_waitcnt lgkmcnt(" #n ")" ::: "memory")
#define PG8_BAR __builtin_amdgcn_s_barrier()
#define PG8_SCHED __builtin_amdgcn_sched_barrier(0)
    Unit cur, nxt; int ui = 0;
    if (!S.next(0, cur)) return;
    f32x4 acc[2][2][4][2];
#pragma unroll
    for (int a = 0; a < 2; ++a)
#pragma unroll
        for (int b = 0; b < 2; ++b)
#pragma unroll
            for (int m = 0; m < 4; ++m)
#pragma unroll
                for (int n = 0; n < 2; ++n) acc[a][b][m][n] = (f32x4){0.f, 0.f, 0.f, 0.f};
    bf16x8 At[4][2], B0[2][2], B1[2][2];
    const char* cA = (const char*)g.A + (size_t)cur.pm * tstep; const char* cB = (const char*)g.Bt + (size_t)cur.pn * tstep;
    S.a_ready(cur);
    if constexpr (SP2) {
        PG8_STAGE(PG8_SB(0, 0), cB, voffB); PG8_STAGE(PG8_SB(0, 1), cB, voffB1); PG8_STAGE(PG8_SA(0, 0), cA, voffA); PG8_STAGE(PG8_SA(0, 1), cA + hstep, voffA);
        if (wr == 1) PG8_BAR;
        PG8_WAIT_V(2); PG8_BAR;
        PG8_STAGE(PG8_SB(1, 0), cB + kstep, voffB); PG8_STAGE(PG8_SA(1, 0), cA + kstep, voffA); PG8_STAGE(PG8_SB(1, 1), cB + kstep, voffB1);
        PG8_WAIT_V(6); PG8_BAR;
    } else {
        PG8_STAGE(PG8_SB(0, 0), cB, voffB); PG8_STAGE(PG8_SA(0, 0), cA, voffA); PG8_STAGE(PG8_SB(0, 1), cB, voffB1); PG8_STAGE(PG8_SA(0, 1), cA + hstep, voffA);
        if (wr == 1) PG8_BAR;
        PG8_WAIT_V(4); PG8_BAR;
        PG8_STAGE(PG8_SB(1, 0), cB + kstep, voffB); PG8_STAGE(PG8_SA(1, 0), cA + kstep, voffA); PG8_STAGE(PG8_SB(1, 1), cB + kstep, voffB1);
        PG8_WAIT_V(6); PG8_BAR;
    }
    for (;;) {
        const bool has_next = S.next(ui + 1, nxt);
        const char* nA = has_next ? (const char*)g.A + (size_t)nxt.pm * tstep : cA; const char* nB = has_next ? (const char*)g.Bt + (size_t)nxt.pn * tstep : cB;
        for (int t = 0; t < nt; t += 2) {
            const bool last = (t == nt - 2);
            const char* a1 = cA + (size_t)(t + 1) * kstep;
            const char* a2 = last ? nA : cA + (size_t)(t + 2) * kstep; const char* b2 = last ? nB : cB + (size_t)(t + 2) * kstep;
            const char* a3 = a2 + kstep; const char* b3 = b2 + kstep;
            if (last && has_next) S.a_ready(nxt);
            if constexpr (SP2) {
            PG8_LDB(B0, 0, 0); PG8_LDB(B1, 0, 1); PG8_SCHED; PG8_LDA(At, 0, 0); PG8_STAGE(PG8_SA(1, 1), a1 + hstep, voffA);
            PG8_WAIT_V(8); PG8_WAIT_L(0); PG8_BAR; PG8_MMA(0, 0, At, B0); PG8_MMA(0, 1, At, B1); PG8_BAR; PG8_SCHED;
            PG8_LDA(At, 0, 1); PG8_STAGE(PG8_SB(0, 0), b2, voffB); PG8_STAGE(PG8_SB(0, 1), b2, voffB1); PG8_STAGE(PG8_SA(0, 0), a2, voffA);
            PG8_WAIT_V(8); PG8_WAIT_L(0); PG8_BAR; PG8_MMA(1, 0, At, B0); PG8_MMA(1, 1, At, B1); PG8_BAR; PG8_SCHED;
            PG8_LDB(B0, 1, 0); PG8_LDB(B1, 1, 1); PG8_SCHED; PG8_LDA(At, 1, 0); PG8_STAGE(PG8_SA(0, 1), a2 + hstep, voffA);
            PG8_WAIT_V(8); PG8_WAIT_L(0); PG8_BAR; PG8_MMA(0, 0, At, B0); PG8_MMA(0, 1, At, B1); PG8_BAR; PG8_SCHED;
            PG8_LDA(At, 1, 1); PG8_STAGE(PG8_SB(1, 0), b3, voffB); PG8_STAGE(PG8_SB(1, 1), b3, voffB1); PG8_STAGE(PG8_SA(1, 0), a3, voffA);
            PG8_WAIT_V(8); PG8_WAIT_L(0); PG8_BAR; PG8_MMA(1, 0, At, B0); PG8_MMA(1, 1, At, B1); PG8_BAR; PG8_SCHED;
            } else {
            PG8_LDB(B0, 0, 0); PG8_SCHED; PG8_LDA(At, 0, 0); PG8_STAGE(PG8_SA(1, 1), a1 + hstep, voffA);
            PG8_WAIT_L(8); PG8_BAR; PG8_WAIT_L(0); PG8_MMA(0, 0, At, B0); PG8_BAR; PG8_SCHED;
            PG8_LDB(B1, 0, 1); PG8_STAGE(PG8_SB(0, 0), b2, voffB);
            PG8_BAR; PG8_WAIT_L(0); PG8_MMA(0, 1, At, B1); PG8_BAR;
            PG8_LDA(At, 0, 1); PG8_STAGE(PG8_SA(0, 0), a2, voffA);
            PG8_BAR; PG8_WAIT_L(0); PG8_MMA(1, 0, At, B0); PG8_BAR; PG8_SCHED;
            PG8_STAGE(PG8_SB(0, 1), b2, voffB1);
            PG8_WAIT_V(6); PG8_BAR; PG8_MMA(1, 1, At, B1); PG8_BAR;
            PG8_LDB(B0, 1, 0); PG8_SCHED; PG8_LDA(At, 1, 0); PG8_STAGE(PG8_SA(0, 1), a2 + hstep, voffA);
            PG8_WAIT_L(8); PG8_BAR; PG8_WAIT_L(0); PG8_MMA(0, 0, At, B0); PG8_BAR; PG8_SCHED;
            PG8_LDB(B1, 1, 1); PG8_STAGE(PG8_SB(1, 0), b3, voffB);
            PG8_BAR; PG8_WAIT_L(0); PG8_MMA(0, 1, At, B1); PG8_BAR;
            PG8_LDA(At, 1, 1); PG8_STAGE(PG8_SA(1, 0), a3, voffA);
            PG8_BAR; PG8_WAIT_L(0); PG8_MMA(1, 0, At, B0); PG8_BAR; PG8_SCHED;
            PG8_STAGE(PG8_SB(1, 1), b3, voffB1);
            PG8_WAIT_V(6); PG8_BAR; PG8_MMA(1, 1, At, B1); PG8_BAR;
            }
        }
        if constexpr (ALIGN_EPI) { if (wr == 0) PG8_BAR; }
        if constexpr (!Epi::AFTER_DRAIN) { E(acc, cur, wr, wc, fr, fq); S.done(cur); }
        if (!has_next) break;
#pragma unroll
        for (int a = 0; a < 2; ++a)
#pragma unroll
            for (int b = 0; b < 2; ++b)
#pragma unroll
                for (int m = 0; m < 4; ++m)
#pragma unroll
                    for (int n = 0; n < 2; ++n) acc[a][b][m][n] = (f32x4){0.f, 0.f, 0.f, 0.f};
        cur = nxt; cA = nA; cB = nB; ++ui;
        if constexpr (ALIGN_EPI) { if (wr == 1) PG8_BAR; }
    }
    PG8_WAIT_V(0);
    if constexpr (!ALIGN_EPI) { if (wr == 0) PG8_BAR; }
    PG8_BAR;
    if constexpr (Epi::AFTER_DRAIN) { E.fused(acc, cur, wr, wc, fr, fq, lds, wid, lane); S.done(cur); }
#undef PG8_SA
#undef PG8_SB
#undef PG8_STAGE
#undef PG8_LDA
#undef PG8_LDB
#undef PG8_MMA
#undef PG8_WAIT_V
#undef PG8_WAIT_L
#undef PG8_BAR
#undef PG8_SCHED
}
}

constexpr int BATCH = 16, SEQ = 2048, D = 1024, M = BATCH * SEQ, DEPTH = 4, DFF = 2816;
constexpr int NGRP = 3, HA = 16, DHA = 64, ATT_COLS = 3 * D;
constexpr int HR = 4, DKR = 256, DVR = 512, DV = HR * DVR, RET_COLS = 2 * D + 3 * DV;
constexpr int MH = M / 2;
constexpr float NORM_EPS = 1e-6f;
constexpr int NWAVES = 8, NTHREADS = NWAVES * 64;
constexpr int NPHASES = 1 + (DEPTH / 2) * (14 + 12);

__device__ const unsigned char T5_BUCKET[3][129] = {
{11,11,11,11,11,11,11,11,11,11,11,11,11,11,11,10,10,10,10,10,10,10,10,10,10,10,10,10,10,10,10,10,10,10,10,10,10,10,9,9,9,9,9,9,9,9,9,9,9,9,8,8,8,8,8,8,8,7,6,5,4,3,2,1,0,17,18,19,20,21,22,23,24,24,24,24,24,24,24,25,25,25,25,25,25,25,25,25,25,25,25,26,26,26,26,26,26,26,26,26,26,26,26,26,26,26,26,26,26,26,26,26,26,26,27,27,27,27,27,27,27,27,27,27,27,27,27,27,27},
{13,13,13,13,13,13,13,13,13,13,13,13,13,13,13,13,13,13,13,13,13,13,13,12,12,12,12,12,12,12,12,12,12,12,12,12,12,12,12,12,12,12,11,11,11,11,11,11,11,11,11,11,10,10,10,10,10,10,9,9,9,8,8,4,0,20,24,24,25,25,25,26,26,26,26,26,26,27,27,27,27,27,27,27,27,27,27,28,28,28,28,28,28,28,28,28,28,28,28,28,28,28,28,28,28,28,29,29,29,29,29,29,29,29,29,29,29,29,29,29,29,29,29,29,29,29,29,29,29},
{15,15,15,15,15,15,15,15,15,15,15,15,15,15,15,15,15,15,15,15,15,15,15,15,15,15,15,15,15,15,14,14,14,14,14,14,14,14,14,14,14,14,14,14,14,13,13,13,13,13,13,13,13,13,12,12,12,12,12,11,11,10,10,9,0,25,26,26,27,27,28,28,28,28,28,29,29,29,29,29,29,29,29,29,30,30,30,30,30,30,30,30,30,30,30,30,30,30,30,31,31,31,31,31,31,31,31,31,31,31,31,31,31,31,31,31,31,31,31,31,31,31,31,31,31,31,31,31,31}};

constexpr size_t MiB = 1u << 20;
constexpr size_t WS_CTL = 0, CTL_ZERO_BYTES = 1 * MiB;
constexpr size_t WS_BIAS = 1 * MiB;
constexpr size_t WS_RS = WS_BIAS + 256 * 1024;
constexpr size_t WS_W = 2 * MiB;
constexpr size_t WS_W2_FFN = WS_W + (size_t)2 * DFF * D * 2;
constexpr size_t WS_W2_ATT = WS_W + (size_t)NGRP * ATT_COLS * D * 2;
constexpr size_t WS_W2_RET = WS_W + (size_t)RET_COLS * D * 2;
constexpr size_t WS_XH = 26 * MiB;
constexpr size_t WS_YC = 90 * MiB;
constexpr size_t WS_BIG = 218 * MiB;
constexpr size_t WS_F = 410 * MiB;
constexpr size_t WS_RVT = 346 * MiB;
constexpr size_t WS_OACC = 474 * MiB;
constexpr size_t WS_LSE = 538 * MiB;
constexpr size_t WS_END = 540 * MiB;
static_assert(WS_W2_FFN + (size_t)D * DFF * 2 <= WS_XH && WS_W2_ATT + (size_t)D * D * 2 <= WS_XH && WS_W2_RET + (size_t)D * DV * 2 <= WS_XH, "weight region");
constexpr int RP_COLS = 2 * D + 2 * DV;
static_assert(WS_XH + (size_t)M * D * 2 == WS_YC && WS_YC + (size_t)M * DV * 2 == WS_BIG && WS_BIG + (size_t)MH * RP_COLS * 2 == WS_F && WS_BIG + (size_t)M * 2 * D * 2 == WS_RVT && WS_RVT + (size_t)DV * M * 2 == WS_OACC && WS_F + (size_t)M * D * 2 == WS_OACC && WS_OACC + (size_t)M * D * 2 == WS_LSE, "d_ws map");
static_assert((size_t)M * DFF * 2 <= 192 * MiB && (size_t)M * ATT_COLS * 2 <= 192 * MiB && WS_LSE + (size_t)M * 16 * 4 <= WS_END, "d_ws map");
constexpr int CW_BAR = 4096;

constexpr int RING_OFF = 0, RING_BYTES = 149504;
constexpr int LDSCTL_OFF = RING_BYTES, MISC_OFF = LDSCTL_OFF + 320;
constexpr int LDS_BYTES = RING_BYTES + 512;
static_assert(MISC_OFF + 128 <= LDS_BYTES, "LDS map");

#define LAS __attribute__((address_space(3)))
typedef unsigned short bf16;
typedef unsigned v4u __attribute__((ext_vector_type(4)));
typedef unsigned v2u __attribute__((ext_vector_type(2)));
typedef float f32x4 __attribute__((ext_vector_type(4)));
#define LDS_WAIT() asm volatile("s_waitcnt lgkmcnt(0)" ::: "memory")
__device__ __forceinline__ unsigned f2bf(float f) { unsigned u = __builtin_bit_cast(unsigned, f); return (u + 0x7fffu + ((u >> 16) & 1u)) >> 16; }
__device__ __forceinline__ unsigned pk2(float lo, float hi) { return f2bf(lo) | (f2bf(hi) << 16); }
__device__ __forceinline__ float bflo(unsigned w) { return __builtin_bit_cast(float, w << 16); }
__device__ __forceinline__ float bfhi(unsigned w) { return __builtin_bit_cast(float, w & 0xffff0000u); }
__device__ __forceinline__ float opaque_f(float c) { float v = c; asm volatile("" : "+s"(v)); return v; }
template <int O> __device__ __forceinline__ float swz_xor(float v) { return __builtin_bit_cast(float, __builtin_amdgcn_ds_swizzle(__builtin_bit_cast(int, v), (O << 10) | 0x1f)); }
__device__ __forceinline__ float wave_sum(float v) {
    v += swz_xor<1>(v); v += swz_xor<2>(v); v += swz_xor<4>(v); v += swz_xor<8>(v); v += swz_xor<16>(v);
    return __builtin_bit_cast(float, __builtin_amdgcn_readlane(__builtin_bit_cast(int, v), 0)) + __builtin_bit_cast(float, __builtin_amdgcn_readlane(__builtin_bit_cast(int, v), 32));
}
__device__ __forceinline__ float get_xor32(float v, int lane) { return __builtin_bit_cast(float, __builtin_amdgcn_ds_bpermute((lane ^ 32) << 2, __builtin_bit_cast(int, v))); }

#define XB_TMO      128
#define XB_XCNT(j)  (256  + 64 * (j))
#define XB_XSUB(j)  (1280 + 64 * (j))
#define XB_XGEN(j)  (2304 + 64 * (j))
#define XB_TOP      3328
#define XB_TOPGEN   3392
#define XCD_BAR_WORDS 3456
#define XB_SPIN_CAP (1u << 18)

__device__ __forceinline__ unsigned xb_ld(unsigned* p)              { return __hip_atomic_load(p, __ATOMIC_RELAXED, __HIP_MEMORY_SCOPE_AGENT); }
__device__ __forceinline__ unsigned xb_add(unsigned* p, unsigned v) { return __hip_atomic_fetch_add(p, v, __ATOMIC_RELAXED, __HIP_MEMORY_SCOPE_AGENT); }
__device__ __forceinline__ unsigned xb_xcc_id() { return (unsigned)__builtin_amdgcn_s_getreg((3 << 11) | 20) & 0xFu; }
#define XB_SPIN(cond, bar) do { unsigned _sp = 0; while (cond) { __builtin_amdgcn_s_sleep(1); \
    if ((++_sp & 255u) == 0u) { if (xb_ld(&(bar)[XB_TMO])) break; if (_sp > XB_SPIN_CAP) { atomicAdd(&(bar)[XB_TMO], 1u); break; } } } } while (0)

struct XcdBarrier {
    unsigned* bar; unsigned x;
    volatile LAS unsigned* st;
};

__device__ __forceinline__ XcdBarrier xcd_barrier_post(unsigned* bar, volatile LAS unsigned* st) {
    XcdBarrier b; b.bar = bar; b.x = xb_xcc_id(); b.st = st;
    if (threadIdx.x == 0) (void)xb_add(&bar[XB_XCNT(b.x)], 1u);
    return b;
}
__device__ __forceinline__ void xcd_barrier_complete(unsigned* bar, unsigned x, unsigned& nloc, unsigned& nx) {
    const unsigned G = gridDim.x * gridDim.y * gridDim.z;
    unsigned sum, cnt, mine, sp = 0u;
    for (;;) {
        sum = 0u; cnt = 0u; mine = 0u;
#pragma unroll
        for (unsigned j = 0; j < 16; ++j) { const unsigned c = xb_ld(&bar[XB_XCNT(j)]); sum += c; cnt += (c > 0u) ? 1u : 0u; mine = (j == x) ? c : mine; }
        if (sum == G) break;
        __builtin_amdgcn_s_sleep(1);
        if ((++sp & 255u) == 0u) { if (xb_ld(&bar[XB_TMO])) break; if (sp > XB_SPIN_CAP) { atomicAdd(&bar[XB_TMO], 1u); break; } }
    }
    nloc = mine > 0u ? mine : 1u; nx = cnt > 0u ? cnt : 1u;
}

__device__ __forceinline__ void xcd_barrier(const XcdBarrier& b) {
    asm volatile("s_waitcnt vmcnt(0)" ::: "memory");
    __syncthreads();
    if (threadIdx.x == 0) {
        unsigned* bar = b.bar;
        __builtin_amdgcn_s_waitcnt(0);
        unsigned nloc = b.st[0], nx = b.st[1];
        if (nloc == 0u) { xcd_barrier_complete(bar, b.x, nloc, nx); b.st[0] = nloc; b.st[1] = nx; }
        const unsigned old = xb_add(&bar[XB_XSUB(b.x)], 1u);
        const unsigned gen = old / nloc;
        if (old + 1u == (gen + 1u) * nloc) {
            __builtin_amdgcn_fence(__ATOMIC_RELEASE, "agent");
            asm volatile("s_waitcnt vmcnt(0)" ::: "memory");
            const unsigned og = xb_add(&bar[XB_TOP], 1u);
            const unsigned tg = og / nx;
            if (og + 1u == (tg + 1u) * nx) xb_add(&bar[XB_TOPGEN], 1u);
            else XB_SPIN(xb_ld(&bar[XB_TOPGEN]) == tg, bar);
            __builtin_amdgcn_fence(__ATOMIC_ACQUIRE, "agent");
            xb_add(&bar[XB_XGEN(b.x)], 1u);
            asm volatile("s_waitcnt vmcnt(0)" ::: "memory");
        } else {
            XB_SPIN(xb_ld(&bar[XB_XGEN(b.x)]) == gen, bar);
            __builtin_amdgcn_fence(__ATOMIC_ACQUIRE, "agent");
            asm volatile("s_waitcnt vmcnt(0)" ::: "memory");
        }
    }
    __syncthreads();
}


constexpr int CV_SCR = 64 * 65 * 4;
__device__ __forceinline__ void conv_item(const float* W, int srcN, int k0, int n0, bf16* WT, int dstK, int drow0, const float* gain, LAS float* scr, int lane) {
    { const float* src = W + (size_t)(k0 + (lane >> 4)) * srcN + n0 + (lane & 15) * 4; LAS float* d = scr + (lane >> 4) * 65 + (lane & 15) * 4;
#pragma unroll
      for (int i = 0; i < 16; ++i) { const f32x4 v = __builtin_nontemporal_load((const f32x4*)(src + (size_t)(4 * i) * srcN));     d[4 * i * 65 + 0] = v.x; d[4 * i * 65 + 1] = v.y; d[4 * i * 65 + 2] = v.z; d[4 * i * 65 + 3] = v.w; } }
    LDS_WAIT(); asm volatile("" ::: "memory");
    const int c = lane & 7;
    float gk[8];
#pragma unroll
    for (int i = 0; i < 8; ++i) gk[i] = gain ? gain[k0 + 8 * c + i] : 1.0f;
#pragma unroll
    for (int j = 0; j < 8; ++j) { const int n = (lane >> 3) + 8 * j; const LAS float* s = scr + (8 * c) * 65 + n;
        v4u o; o.x = pk2(s[0 * 65] * gk[0], s[1 * 65] * gk[1]); o.y = pk2(s[2 * 65] * gk[2], s[3 * 65] * gk[3]); o.z = pk2(s[4 * 65] * gk[4], s[5 * 65] * gk[5]); o.w = pk2(s[6 * 65] * gk[6], s[7 * 65] * gk[7]);
        *(v4u*)(WT + (size_t)(drow0 + n) * dstK + k0 + 8 * c) = o; }
    LDS_WAIT(); asm volatile("" ::: "memory");
}
template <int K, int N, int NC> __device__ __forceinline__ void conv_cols(const float* W, int c0, bf16* WT, int r0, const float* gain, LAS float* scr, int gw, int NGW, int lane) {
    constexpr int nblk = NC / 64, nitems = (K / 64) * nblk;
    for (int it = gw; it < nitems; it += NGW) { const int kb = it / nblk, nb = it % nblk; conv_item(W, N, 64 * kb, c0 + 64 * nb, WT, K, r0 + 64 * nb, gain, scr, lane); }
}
template <int K, int N> __device__ __forceinline__ void conv_plain(const float* W, bf16* WT, const float* gain, LAS float* scr, int gw, int NGW, int lane) { conv_cols<K, N, N>(W, 0, WT, 0, gain, scr, gw, NGW, lane); }
__device__ __forceinline__ void conv_gateup(const float* Wg, const float* Wu, bf16* WT, const float* gain, LAS float* scr, int gw, int NGW, int lane) {
    constexpr int nblk = 2 * DFF / 64, nitems = (D / 64) * nblk;
    for (int it = gw; it < nitems; it += NGW) { const int kb = it / nblk, nb = it % nblk, n0 = 64 * nb, pn = n0 >> 8, bj = (n0 >> 7) & 1, c0 = n0 & 127;
        conv_item(bj ? Wu : Wg, DFF, 64 * kb, 128 * pn + c0, WT, D, n0, gain, scr, lane); }
}

template <int N> __device__ __forceinline__ void conv_gates(const float* W, int c_f, int c_b, bf16* WT, int r0, const float* gain, LAS float* scr, int gw, int NGW, int lane) {
    constexpr int nblk = 2 * DV / 64, nitems = (D / 64) * nblk;
    for (int it = gw; it < nitems; it += NGW) { const int kb = it / nblk, nb = it % nblk, n0 = 64 * nb, pn = n0 >> 8, bj = (n0 >> 7) & 1, c0 = n0 & 127;
        conv_item(W, N, 64 * kb, (bj ? c_b : c_f) + 128 * pn + c0, WT, D, r0 + n0, gain, scr, lane); }
}

__device__ __forceinline__ void unpack8(const v4u w, float (&f)[8]) { f[0] = bflo(w.x); f[1] = bfhi(w.x); f[2] = bflo(w.y); f[3] = bfhi(w.y); f[4] = bflo(w.z); f[5] = bfhi(w.z); f[6] = bflo(w.w); f[7] = bfhi(w.w); }
__device__ __forceinline__ void p0_rows(const float* xin, bf16* XB, float* RS, int gw, int NGW, int lane) {
    for (int m = gw; m < M; m += NGW) {
        float ss = 0.f;
#pragma unroll
        for (int j = 0; j < 2; ++j) { const float* p = xin + (size_t)m * D + 512 * j + 8 * lane; const f32x4 a = __builtin_nontemporal_load((const f32x4*)p), b = __builtin_nontemporal_load((const f32x4*)(p + 4));
            ss += (a.x * a.x + a.y * a.y) + (a.z * a.z + a.w * a.w) + (b.x * b.x + b.y * b.y) + (b.z * b.z + b.w * b.w);
            v4u w; w.x = pk2(a.x, a.y); w.y = pk2(a.z, a.w); w.z = pk2(b.x, b.y); w.w = pk2(b.z, b.w); *(v4u*)(XB + (size_t)m * D + 512 * j + 8 * lane) = w; }
        ss = wave_sum(ss);
        if (lane == 0) RS[m] = __builtin_amdgcn_rsqf(ss * (1.f / D) + opaque_f(NORM_EPS));
    }
}
__device__ __forceinline__ void thin_rows(const bf16* Fin, bf16* XB, const float* gpost, float cpost, float* RS, float* outf, int gw, int NGW, int lane) {
    float gp[2][8];
#pragma unroll
    for (int j = 0; j < 2; ++j) { const f32x4 a = *(const f32x4*)(gpost + 512 * j + 8 * lane), b = *(const f32x4*)(gpost + 512 * j + 8 * lane + 4);
        gp[j][0] = a.x; gp[j][1] = a.y; gp[j][2] = a.z; gp[j][3] = a.w; gp[j][4] = b.x; gp[j][5] = b.y; gp[j][6] = b.z; gp[j][7] = b.w; }
    const float eps = opaque_f(NORM_EPS);
    for (int m0 = gw; m0 < M; m0 += 2 * NGW) {
        v4u xw[2][2], fw[2][2];
#pragma unroll
        for (int t = 0; t < 2; ++t) { const int m = m0 + t * NGW < M ? m0 + t * NGW : m0;
#pragma unroll
            for (int j = 0; j < 2; ++j) { xw[t][j] = *(const v4u*)(XB + (size_t)m * D + 512 * j + 8 * lane); fw[t][j] = *(const v4u*)(Fin + (size_t)m * D + 512 * j + 8 * lane); } }
#pragma unroll
        for (int t = 0; t < 2; ++t) { const int m = m0 + t * NGW; if (m >= M) break;
            float x[2][8], f[2][8]; float ss = 0.f;
#pragma unroll
            for (int j = 0; j < 2; ++j) { unpack8(xw[t][j], x[j]); unpack8(fw[t][j], f[j]);
#pragma unroll
                for (int q = 0; q < 8; ++q) ss += f[j][q] * f[j][q]; }
            const float rF = cpost * __builtin_amdgcn_rsqf(wave_sum(ss) * (1.f / D) + eps);
            float s2 = 0.f;
#pragma unroll
            for (int j = 0; j < 2; ++j)
#pragma unroll
                for (int q = 0; q < 8; ++q) { x[j][q] += f[j][q] * gp[j][q] * rF; s2 += x[j][q] * x[j][q]; }
            if (outf) {
#pragma unroll
                for (int j = 0; j < 2; ++j) { float* p = outf + (size_t)m * D + 512 * j + 8 * lane; __builtin_nontemporal_store((f32x4){x[j][0], x[j][1], x[j][2], x[j][3]}, (f32x4*)p); __builtin_nontemporal_store((f32x4){x[j][4], x[j][5], x[j][6], x[j][7]}, (f32x4*)(p + 4)); }
            } else {
#pragma unroll
                for (int j = 0; j < 2; ++j) { v4u w; w.x = pk2(x[j][0], x[j][1]); w.y = pk2(x[j][2], x[j][3]); w.z = pk2(x[j][4], x[j][5]); w.w = pk2(x[j][6], x[j][7]); *(v4u*)(XB + (size_t)m * D + 512 * j + 8 * lane) = w; }
                s2 = wave_sum(s2);
                if (lane == 0) RS[m] = __builtin_amdgcn_rsqf(s2 * (1.f / D) + eps);
            }
        }
    }
}

__device__ __forceinline__ void attn_group_scalar(const bf16* P, const float* bias2, int dil, int first, bf16* OACC, float* LSE, int gw, int NGW, int lane) {
    const int Ls = SEQ / dil, tbn = Ls / 64;
    constexpr float SC = 0.125f * 1.4426950409f;
    for (int w = gw; w < BATCH * HA * 32; w += NGW) {
        const int tb = w % tbn, r = (w / tbn) % dil, h = (w >> 5) & 15, b = w >> 9;
        const int t = tb * 64 + lane; const size_t row = (size_t)b * SEQ + (size_t)t * dil + r;
        float q[64], acc[64];
        { const v4u* qp = (const v4u*)(P + row * ATT_COLS + h * 64);
#pragma unroll
          for (int c = 0; c < 8; ++c) { const v4u x = qp[c]; q[8 * c + 0] = bflo(x.x); q[8 * c + 1] = bfhi(x.x); q[8 * c + 2] = bflo(x.y); q[8 * c + 3] = bfhi(x.y); q[8 * c + 4] = bflo(x.z); q[8 * c + 5] = bfhi(x.z); q[8 * c + 6] = bflo(x.w); q[8 * c + 7] = bfhi(x.w); } }
#pragma unroll
        for (int c = 0; c < 64; ++c) acc[c] = 0.f;
        float mx = -INFINITY, l = 0.f;
        for (int kk = 0; kk < 129; ++kk) {
            const int tk = t - 64 + kk;
            if (tk >= 0 && tk < Ls) {
                const size_t krow = (size_t)b * SEQ + (size_t)tk * dil + r;
                const v4u* kp = (const v4u*)(P + krow * ATT_COLS + D + h * 64);
                float s = 0.f;
#pragma unroll
                for (int c = 0; c < 8; ++c) { const v4u x = kp[c];
                    s += q[8 * c + 0] * bflo(x.x) + q[8 * c + 1] * bfhi(x.x) + q[8 * c + 2] * bflo(x.y) + q[8 * c + 3] * bfhi(x.y) + q[8 * c + 4] * bflo(x.z) + q[8 * c + 5] * bfhi(x.z) + q[8 * c + 6] * bflo(x.w) + q[8 * c + 7] * bfhi(x.w); }
                s = s * SC + bias2[h * 129 + kk];
                const float mn = fmaxf(mx, s), a = exp2f(mx - mn), p = exp2f(s - mn);
                l = l * a + p; mx = mn;
                const v4u* vp = (const v4u*)(P + krow * ATT_COLS + 2 * D + h * 64);
#pragma unroll
                for (int c = 0; c < 8; ++c) { const v4u x = vp[c];
                    acc[8 * c + 0] = acc[8 * c + 0] * a + p * bflo(x.x); acc[8 * c + 1] = acc[8 * c + 1] * a + p * bfhi(x.x); acc[8 * c + 2] = acc[8 * c + 2] * a + p * bflo(x.y); acc[8 * c + 3] = acc[8 * c + 3] * a + p * bfhi(x.y);
                    acc[8 * c + 4] = acc[8 * c + 4] * a + p * bflo(x.z); acc[8 * c + 5] = acc[8 * c + 5] * a + p * bfhi(x.z); acc[8 * c + 6] = acc[8 * c + 6] * a + p * bflo(x.w); acc[8 * c + 7] = acc[8 * c + 7] * a + p * bfhi(x.w); }
            }
        }
        const float il = 1.f / l; float lse = mx + log2f(l);
        float wn = il, wo = 0.f;
        if (!first) { const float lo = LSE[row * 16 + h]; const float mm = fmaxf(lo, lse), eo = exp2f(lo - mm), en = exp2f(lse - mm), inv = 1.f / (eo + en); wn = en * inv * il; wo = eo * inv; lse = mm + log2f(eo + en); }
        LSE[row * 16 + h] = lse;
        v4u* op = (v4u*)(OACC + row * D + h * 64);
#pragma unroll
        for (int c = 0; c < 8; ++c) { v4u x = (v4u){0u, 0u, 0u, 0u}; if (!first) x = op[c];
            v4u y; y.x = pk2(wn * acc[8 * c + 0] + wo * bflo(x.x), wn * acc[8 * c + 1] + wo * bfhi(x.x)); y.y = pk2(wn * acc[8 * c + 2] + wo * bflo(x.y), wn * acc[8 * c + 3] + wo * bfhi(x.y));
            y.z = pk2(wn * acc[8 * c + 4] + wo * bflo(x.z), wn * acc[8 * c + 5] + wo * bfhi(x.z)); y.w = pk2(wn * acc[8 * c + 6] + wo * bflo(x.w), wn * acc[8 * c + 7] + wo * bfhi(x.w)); op[c] = y; }
    }
}

__device__ __forceinline__ void ret_core_scalar(const bf16* P, const bf16* KT, const bf16* VT, const float* decay_logit  , bf16* YF, bf16* YB, int useKT, int gw, int NGW, int lane) {
    const int el = lane & 15, dq = lane >> 4;
    for (int w = gw; w < 8 * HR * 2 * 32; w += NGW) {
        const int eb = w & 31, dir = (w >> 5) & 1, h = (w >> 6) & 3, bl = w >> 8;
        const int e = eb * 16 + el;
        const float gamma = 1.0f - expf(decay_logit[dir * HR + h]);
        bf16* Y = dir ? YB : YF;
        float S[64];
#pragma unroll
        for (int c = 0; c < 64; ++c) S[c] = 0.f;
        for (int ti = 0; ti < SEQ; ++ti) {
            const int s = dir ? (SEQ - 1 - ti) : ti; const size_t row = (size_t)bl * SEQ + s;
            const bf16* pr = P + row * RP_COLS;
            const float v = __builtin_bit_cast(float, (unsigned)VT[(size_t)(h * DVR + e) * MH + row] << 16);
            const v4u* qp = (const v4u*)(pr + h * DKR + dq * 64); const v4u* kp = (const v4u*)(pr + D + 2 * DV + h * DKR + dq * 64);
            float y = 0.f;
#pragma unroll
            for (int c = 0; c < 8; ++c) { v4u kx = kp[c]; const v4u qx = qp[c];
                if (useKT) { const bf16* kt = KT + (size_t)(h * DKR + dq * 64 + 8 * c) * MH + row;
                    kx.x = (unsigned)kt[0] | ((unsigned)kt[MH] << 16); kx.y = (unsigned)kt[2 * (size_t)MH] | ((unsigned)kt[3 * (size_t)MH] << 16);
                    kx.z = (unsigned)kt[4 * (size_t)MH] | ((unsigned)kt[5 * (size_t)MH] << 16); kx.w = (unsigned)kt[6 * (size_t)MH] | ((unsigned)kt[7 * (size_t)MH] << 16); }
                S[8 * c + 0] = S[8 * c + 0] * gamma + bflo(kx.x) * v; y += bflo(qx.x) * S[8 * c + 0];
                S[8 * c + 1] = S[8 * c + 1] * gamma + bfhi(kx.x) * v; y += bfhi(qx.x) * S[8 * c + 1];
                S[8 * c + 2] = S[8 * c + 2] * gamma + bflo(kx.y) * v; y += bflo(qx.y) * S[8 * c + 2];
                S[8 * c + 3] = S[8 * c + 3] * gamma + bfhi(kx.y) * v; y += bfhi(qx.y) * S[8 * c + 3];
                S[8 * c + 4] = S[8 * c + 4] * gamma + bflo(kx.z) * v; y += bflo(qx.z) * S[8 * c + 4];
                S[8 * c + 5] = S[8 * c + 5] * gamma + bfhi(kx.z) * v; y += bfhi(qx.z) * S[8 * c + 5];
                S[8 * c + 6] = S[8 * c + 6] * gamma + bflo(kx.w) * v; y += bflo(qx.w) * S[8 * c + 6];
                S[8 * c + 7] = S[8 * c + 7] * gamma + bfhi(kx.w) * v; y += bfhi(qx.w) * S[8 * c + 7]; }
            y += __shfl_xor(y, 16); y += __shfl_xor(y, 32);
            if (dq == 0) Y[row * DV + h * DVR + e] = (bf16)f2bf(y);
        }
    }
}

__device__ __forceinline__ void ret_combine(const bf16* P, bf16* YF  , const bf16* YB, int gw, int NGW, int lane) {
    for (int m = gw; m < MH; m += NGW) {
#pragma unroll
        for (int j = 0; j < 4; ++j) {
            const int idx = j * 512 + lane * 8;
            const v4u a = *(const v4u*)(YF + (size_t)m * DV + idx), bq = *(const v4u*)(YB + (size_t)m * DV + idx);
            const v4u gfv = *(const v4u*)(P + (size_t)m * RP_COLS + D + idx), gbv = *(const v4u*)(P + (size_t)m * RP_COLS + D + DV + idx);
            float yf[8] = {bflo(a.x), bfhi(a.x), bflo(a.y), bfhi(a.y), bflo(a.z), bfhi(a.z), bflo(a.w), bfhi(a.w)};
            float yb[8] = {bflo(bq.x), bfhi(bq.x), bflo(bq.y), bfhi(bq.y), bflo(bq.z), bfhi(bq.z), bflo(bq.w), bfhi(bq.w)};
            float gf[8] = {bflo(gfv.x), bfhi(gfv.x), bflo(gfv.y), bfhi(gfv.y), bflo(gfv.z), bfhi(gfv.z), bflo(gfv.w), bfhi(gfv.w)};
            float gb[8] = {bflo(gbv.x), bfhi(gbv.x), bflo(gbv.y), bfhi(gbv.y), bflo(gbv.z), bfhi(gbv.z), bflo(gbv.w), bfhi(gbv.w)};
            float sf = 0.f, sb = 0.f;
#pragma unroll
            for (int c = 0; c < 8; ++c) { sf += yf[c]; sb += yb[c]; }
            const float muf = wave_sum(sf) * (1.f / DVR), mub = wave_sum(sb) * (1.f / DVR);
            float qf = 0.f, qb = 0.f;
#pragma unroll
            for (int c = 0; c < 8; ++c) { yf[c] -= muf; yb[c] -= mub; qf += yf[c] * yf[c]; qb += yb[c] * yb[c]; }
            const float rf = __builtin_amdgcn_rsqf(wave_sum(qf) * (1.f / DVR) + NORM_EPS), rb = __builtin_amdgcn_rsqf(wave_sum(qb) * (1.f / DVR) + NORM_EPS);
            float o[8];
#pragma unroll
            for (int c = 0; c < 8; ++c) o[c] = gf[c] * pg8::fast_sigmoid(gf[c]) * yf[c] * rf + gb[c] * pg8::fast_sigmoid(gb[c]) * yb[c] * rb;
            v4u w; w.x = pk2(o[0], o[1]); w.y = pk2(o[2], o[3]); w.z = pk2(o[4], o[5]); w.w = pk2(o[6], o[7]);
            *(v4u*)(YF + (size_t)m * DV + idx) = w;
        }
    }
}

typedef float f32x16 __attribute__((ext_vector_type(16)));
typedef short bf16x8s __attribute__((ext_vector_type(8)));
typedef float f32x2_t __attribute__((ext_vector_type(2))); typedef __bf16 bf16x2_t __attribute__((ext_vector_type(2)));
__device__ __forceinline__ unsigned cvtpk(float lo, float hi) { f32x2_t v = {lo, hi}; bf16x2_t b = __builtin_convertvector(v, bf16x2_t); return __builtin_bit_cast(unsigned, b); }
__device__ __forceinline__ void attn_group_mfma(const bf16* QK, const bf16* VT, const float* bias2g, int dil, int first, bf16* OACC, float* LSE, LAS unsigned char* lds, int tid, int gw, int NGW) {
    LAS float* tab = (LAS float*)lds;
    for (int i = tid; i < 16 * 192; i += NTHREADS) { const int h = i / 192, o = i % 192 - 96; tab[i] = (o >= -64 && o <= 64) ? bias2g[h * 129 + o + 64] : -1e30f; }
    __syncthreads();
    const int lane = tid & 63, r = lane & 31, hh = lane >> 5;
    const int Ls = SEQ / dil, nqb = Ls / 32;
    constexpr float SC = 0.125f * 1.4426950409f;
    constexpr int NU = BATCH * HA * 64;
    const int upw = (NU + NGW - 1) / NGW;
    for (int u = gw * upw; u < (gw + 1) * upw && u < NU; ++u) {
        const int qb = u % nqb, rr = (u / nqb) % dil, h = (u >> 6) & 15, b = u >> 10, t0 = qb * 32;
        const size_t rowq = (size_t)b * SEQ + (size_t)(t0 + r) * dil + rr;
        bf16x8s qf[4];
#pragma unroll
        for (int ks = 0; ks < 4; ++ks) qf[ks] = *(const bf16x8s*)(QK + rowq * 2048 + h * 64 + 16 * ks + 8 * hh);
        f32x16 S[5];
#pragma unroll
        for (int kb = 0; kb < 5; ++kb) {
            int t = t0 - 64 + 32 * kb + r; t = t < 0 ? 0 : (t > Ls - 1 ? Ls - 1 : t);
            const bf16* kp = QK + ((size_t)b * SEQ + (size_t)t * dil + rr) * 2048 + 1024 + h * 64 + 8 * hh;
            bf16x8s kf[4];
#pragma unroll
            for (int ks = 0; ks < 4; ++ks) kf[ks] = *(const bf16x8s*)(kp + 16 * ks);
#pragma unroll
            for (int i = 0; i < 16; ++i) S[kb][i] = 0.f;
#pragma unroll
            for (int ks = 0; ks < 4; ++ks) S[kb] = __builtin_amdgcn_mfma_f32_32x32x16_bf16(kf[ks], qf[ks], S[kb], 0, 0, 0);
        }
        const LAS float* tb = tab + h * 192 + (32 + 4 * hh - r);
        float mx = -1e30f;
#pragma unroll
        for (int kb = 0; kb < 5; ++kb)
#pragma unroll
            for (int i = 0; i < 16; ++i) { const int krel = 32 * kb + (i & 3) + 8 * (i >> 2); const int kt = t0 - 64 + krel + 4 * hh;
                float s = S[kb][i] * SC + tb[krel]; s = (kt < 0 || kt >= Ls) ? -1e30f : s; S[kb][i] = s; mx = fmaxf(mx, s); }
        mx = fmaxf(mx, get_xor32(mx, lane));
        float l = 0.f;
#pragma unroll
        for (int kb = 0; kb < 5; ++kb)
#pragma unroll
            for (int i = 0; i < 16; ++i) { const float p = __builtin_amdgcn_exp2f(S[kb][i] - mx); S[kb][i] = p; l += p; }
        l += get_xor32(l, lane);
        f32x16 O[2];
#pragma unroll
        for (int db = 0; db < 2; ++db)
#pragma unroll
            for (int i = 0; i < 16; ++i) O[db][i] = 0.f;
        const bf16* vbase = VT + (size_t)(h * 64 + r) * M + (size_t)b * SEQ + (size_t)rr * Ls;
#pragma unroll
        for (int kb = 0; kb < 5; ++kb)
#pragma unroll
            for (int s2 = 0; s2 < 2; ++s2) {
                v4u pw; pw.x = cvtpk(S[kb][8 * s2 + 0], S[kb][8 * s2 + 1]); pw.y = cvtpk(S[kb][8 * s2 + 2], S[kb][8 * s2 + 3]); pw.z = cvtpk(S[kb][8 * s2 + 4], S[kb][8 * s2 + 5]); pw.w = cvtpk(S[kb][8 * s2 + 6], S[kb][8 * s2 + 7]);
                const bf16x8s pf = __builtin_bit_cast(bf16x8s, pw);
                int ta = t0 - 64 + 32 * kb + 16 * s2 + 4 * hh, tb2 = ta + 8;
                ta = (ta < 0 || ta >= Ls) ? 0 : ta; tb2 = (tb2 < 0 || tb2 >= Ls) ? 0 : tb2;
#pragma unroll
                for (int db = 0; db < 2; ++db) { const bf16* vp = vbase + (size_t)(32 * db) * M;
                    const v2u lo = *(const v2u*)(vp + ta), hi = *(const v2u*)(vp + tb2);
                    const v4u vw = (v4u){lo.x, lo.y, hi.x, hi.y};
                    O[db] = __builtin_amdgcn_mfma_f32_32x32x16_bf16(__builtin_bit_cast(bf16x8s, vw), pf, O[db], 0, 0, 0); }
            }
        const float il = 1.f / l; float lse = mx + log2f(l);
        const size_t row = rowq;
        float wn = il, wo = 0.f;
        if (!first) { const float lo = LSE[row * 16 + h]; const float mm = fmaxf(lo, lse), eo = exp2f(lo - mm), en = exp2f(lse - mm), inv = 1.f / (eo + en); wn = en * inv * il; wo = eo * inv; lse = mm + log2f(eo + en); }
        if (hh == 0) LSE[row * 16 + h] = lse;
#pragma unroll
        for (int db = 0; db < 2; ++db)
#pragma unroll
            for (int gq = 0; gq < 4; ++gq) { v2u* op = (v2u*)(OACC + row * D + h * 64 + 32 * db + 8 * gq + 4 * hh);
                v2u x = (v2u){0u, 0u}; if (!first) x = *op;
                v2u y; y.x = cvtpk(wn * O[db][4 * gq + 0] + wo * bflo(x.x), wn * O[db][4 * gq + 1] + wo * bfhi(x.x)); y.y = cvtpk(wn * O[db][4 * gq + 2] + wo * bflo(x.y), wn * O[db][4 * gq + 3] + wo * bfhi(x.y));
                *op = y; }
    }
}

constexpr int RQK = 2 * D;
constexpr int RC_ST = 0, RC_RG = 65536, RC_NSLOT = 5, RC_LDS = RC_RG + RC_NSLOT * 16384;
__device__ __forceinline__ int sl_swz(int ob) { return ob ^ (((ob >> 9) & 1) << 5); }
template <int VAR  >
__device__ __forceinline__ void ret_core_mfma(const bf16* P, const bf16* VT, const float* decay_logit  , bf16* YF, bf16* YB, float* PT, LAS unsigned char* lds, const int tid, const int bid, const int G) {
    typedef short bf16x8v __attribute__((ext_vector_type(8)));
    const int w = __builtin_amdgcn_readfirstlane(tid >> 6), lane = tid & 63, fr = lane & 15, fq = lane >> 4, wr = w >> 2, wc = w & 3;
#define RC_DMA(gptr, ldsoff) __builtin_amdgcn_global_load_lds((const unsigned*)(gptr), (LAS unsigned*)(lds + (ldsoff)), 16, 0, 0)
#define RC_WAITV(n) asm volatile("s_waitcnt vmcnt(" #n ")" ::: "memory")
#define RC_WAITL() asm volatile("s_waitcnt lgkmcnt(0)" ::: "memory")
#define RC_BAR() do { asm volatile("" ::: "memory"); __builtin_amdgcn_s_barrier(); asm volatile("" ::: "memory"); } while (0)
#define RC_MFMA(b, a, c) __builtin_amdgcn_mfma_f32_16x16x32_bf16((b), (a), (c), 0, 0, 0)
#define RC_NEXT(sl) ((sl) == RC_NSLOT - 1 ? 0 : (sl) + 1)
#define RC_PREV(sl) ((sl) == 0 ? RC_NSLOT - 1 : (sl) - 1)
    const int dob = sl_swz(lane * 16), drow = 16 * w + (dob >> 6), dcc = (dob & 63) >> 1;
    const int aoff = 4 * wr * 1024 + sl_swz(fr * 64 + fq * 16), boff = 2 * wc * 1024 + sl_swz(fr * 64 + fq * 16);
    for (int u = bid; u < 512; u += G) {
        const int xcd = u & 7, idx = u >> 3, es = idx & 3, cmb = (idx >> 2) * 8 + xcd, dir = cmb & 1, h = (cmb >> 1) & 3, bl = cmb >> 3;
        const float lg = __builtin_amdgcn_logf(1.0f - __builtin_amdgcn_exp2f(decay_logit[dir * HR + h] * 1.4426950409f));
        const float cdec = __builtin_amdgcn_exp2f(lg * 128.f);
        bf16* Y = dir ? YB : YF;
        const size_t rowbase = (size_t)bl * SEQ;
        const bf16* qsrc = P + (rowbase + drow) * RQK + h * DKR + dcc;
        const bf16* ksrc = qsrc + D;
        const bf16* vsrc = VT + (size_t)(h * DVR + es * 128 + drow) * M + rowbase + dcc;
        const bf16* vown = VT + (size_t)(h * DVR + es * 128 + 16 * w + fr) * M + rowbase + 8 * fq;
        { const v4u z = (v4u){0u, 0u, 0u, 0u};
#pragma unroll
          for (int i = 0; i < 8; ++i) *(LAS v4u*)(lds + RC_ST + (i * NTHREADS + tid) * 16) = z; }
        f32x4 acc4[16];
#pragma unroll
        for (int n = 0; n < 16; ++n) acc4[n] = (f32x4){0.f, 0.f, 0.f, 0.f};
#define RC_ISSUE(st, tk, sl) do { if ((st) < 8) { const size_t to_ = (size_t)(tk) * RQK + 32 * (st); RC_DMA(qsrc + to_, RC_RG + (sl) * 16384 + w * 1024); RC_DMA(ksrc + to_, RC_RG + (sl) * 16384 + 8192 + w * 1024); } \
                                  else RC_DMA(vsrc + (tk) + 32 * ((st) - 8), RC_RG + (sl) * 16384 + w * 1024); } while (0)
        v4u vnx[4];
        { const int tok0 = dir ? 128 * 15 : 0;
#pragma unroll
          for (int js = 0; js < 4; ++js) vnx[js] = *(const v4u*)(vown + tok0 + 32 * js);
          RC_ISSUE(0, tok0, 0); RC_ISSUE(1, tok0, 1); RC_ISSUE(2, tok0, 2); RC_ISSUE(3, tok0, 3); }
        RC_WAITL();
        int slot = 0;
        for (int c = 0; c < 16; ++c) {
            const int tok0 = 128 * (dir ? 15 - c : c), tokn = 128 * (dir ? (c < 15 ? 14 - c : 0) : (c < 15 ? c + 1 : 15));
            float lgc = lg; int zo = 0; asm volatile("" : "+v"(lgc), "+v"(zo));
            int lc = lane; asm volatile("" : "+v"(lc)); const int frc = lc & 15, fqc = lc >> 4;
            bf16x8v Avs[4];
#pragma unroll
            for (int js = 0; js < 4; ++js) { const v4u kw = vnx[js]; float kd[8];
#pragma unroll
                for (int q = 0; q < 8; ++q) { const int j = 32 * js + 8 * fqc + q; kd[q] = __builtin_amdgcn_exp2f(lgc * (dir ? (float)j : (float)(127 - j))); }
                v4u sw; sw.x = cvtpk(bflo(kw.x) * kd[0], bfhi(kw.x) * kd[1]); sw.y = cvtpk(bflo(kw.y) * kd[2], bfhi(kw.y) * kd[3]); sw.z = cvtpk(bflo(kw.z) * kd[4], bfhi(kw.z) * kd[5]); sw.w = cvtpk(bflo(kw.w) * kd[6], bfhi(kw.w) * kd[7]);
                Avs[js] = __builtin_bit_cast(bf16x8v, sw); }
#pragma unroll
            for (int n = 0; n < 16; ++n) acc4[n] = acc4[n] * cdec;
            const int jj = 8 * fqc + (frc >> 2);
            const unsigned trA = (unsigned)((jj >> 4) * 1024 + sl_swz((jj & 15) * 64 + 8 * (frc & 3))), trB = (unsigned)(((jj + 4) >> 4) * 1024 + sl_swz(((jj + 4) & 15) * 64 + 8 * (frc & 3)));
            f32x4 accA[4][2], accY[4][2];
#pragma unroll
            for (int m = 0; m < 4; ++m)
#pragma unroll
                for (int n = 0; n < 2; ++n) { accA[m][n] = (f32x4){0.f, 0.f, 0.f, 0.f}; accY[m][n] = (f32x4){0.f, 0.f, 0.f, 0.f}; }
#pragma unroll
            for (int ks = 0; ks < 8; ++ks) {
                if (ks < 4) { if (c == 0) RC_WAITV(6); else RC_WAITV(18); } else if (ks == 4) RC_WAITV(6); else if (ks == 5) RC_WAITV(5); else if (ks == 6) RC_WAITV(4); else RC_WAITV(3);
                RC_BAR();
                { const int s4 = RC_PREV(slot);
                  if (ks + 4 < 12) RC_ISSUE(ks + 4, tok0, s4); else RC_ISSUE(ks + 4 - 12, tokn, s4); }
                bf16x8v At[4], Bk[2], Bs[2];
                const LAS unsigned char* sq = lds + RC_RG + slot * 16384;
#pragma unroll
                for (int m = 0; m < 4; ++m) At[m] = *(const LAS bf16x8v*)(sq + aoff + m * 1024);
#pragma unroll
                for (int n = 0; n < 2; ++n) { Bk[n] = *(const LAS bf16x8v*)(sq + 8192 + boff + n * 1024); Bs[n] = *(const LAS bf16x8v*)(lds + RC_ST + ks * 8192 + boff + n * 1024); }
                RC_WAITL();
#pragma unroll
                for (int m = 0; m < 4; ++m)
#pragma unroll
                    for (int n = 0; n < 2; ++n) { accA[m][n] = RC_MFMA(Bk[n], At[m], accA[m][n]); accY[m][n] = RC_MFMA(Bs[n], At[m], accY[m][n]); }
                { const unsigned kb = (unsigned)(size_t)(sq + 8192);
#pragma unroll
                  for (int nl = 0; nl < 2; ++nl) { const unsigned a0 = kb + (trA ^ (nl << 5)), a1 = kb + (trB ^ (nl << 5));
                      v2u l0, h0, l1, h1, l2, h2, l3, h3;
                      asm volatile("ds_read_b64_tr_b16 %0, %8\n\tds_read_b64_tr_b16 %1, %9\n\tds_read_b64_tr_b16 %2, %8 offset:2048\n\tds_read_b64_tr_b16 %3, %9 offset:2048\n\t"
                                   "ds_read_b64_tr_b16 %4, %8 offset:4096\n\tds_read_b64_tr_b16 %5, %9 offset:4096\n\tds_read_b64_tr_b16 %6, %8 offset:6144\n\tds_read_b64_tr_b16 %7, %9 offset:6144\n\ts_waitcnt lgkmcnt(0)"
                                   : "=&v"(l0), "=&v"(h0), "=&v"(l1), "=&v"(h1), "=&v"(l2), "=&v"(h2), "=&v"(l3), "=&v"(h3) : "v"(a0), "v"(a1) : "memory");
                      acc4[2 * ks + nl] = RC_MFMA(__builtin_bit_cast(bf16x8v, ((v4u){l0.x, l0.y, h0.x, h0.y})), Avs[0], acc4[2 * ks + nl]);
                      acc4[2 * ks + nl] = RC_MFMA(__builtin_bit_cast(bf16x8v, ((v4u){l1.x, l1.y, h1.x, h1.y})), Avs[1], acc4[2 * ks + nl]);
                      acc4[2 * ks + nl] = RC_MFMA(__builtin_bit_cast(bf16x8v, ((v4u){l2.x, l2.y, h2.x, h2.y})), Avs[2], acc4[2 * ks + nl]);
                      acc4[2 * ks + nl] = RC_MFMA(__builtin_bit_cast(bf16x8v, ((v4u){l3.x, l3.y, h3.x, h3.y})), Avs[3], acc4[2 * ks + nl]); } }
                slot = RC_NEXT(slot);
            }
#pragma unroll
            for (int m = 0; m < 4; ++m)
#pragma unroll
                for (int n = 0; n < 2; ++n) { accY[m][n] = accY[m][n] * __builtin_amdgcn_exp2f(lgc * (dir ? (float)(128 - (64 * wr + 16 * m + frc)) : (float)(64 * wr + 16 * m + frc + 1)));
                    const int i = 64 * wr + 16 * m + frc;
#pragma unroll
                    for (int ii = 0; ii < 4; ++ii) { const int j = 32 * wc + 16 * n + 4 * fqc + ii; const int dd = dir ? j - i : i - j;
                        accA[m][n][ii] = dd >= 0 ? accA[m][n][ii] * __builtin_amdgcn_exp2f(lgc * (float)dd) : 0.f; } }
            RC_BAR();
#pragma unroll
            for (int m = 0; m < 4; ++m)
#pragma unroll
                for (int n = 0; n < 2; ++n) { v2u pw; pw.x = cvtpk(accA[m][n][0], accA[m][n][1]); pw.y = cvtpk(accA[m][n][2], accA[m][n][3]);
                    *(LAS v2u*)(lds + RC_ST + wc * 8192 + (4 * wr + m) * 1024 + sl_swz(frc * 64 + (16 * n + 4 * fqc) * 2)) = pw; }
#pragma unroll
            for (int js = 0; js < 4; ++js) vnx[js] = *(const v4u*)(vown + tokn + 32 * js + zo);
            RC_WAITL();
#pragma unroll
            for (int js = 0; js < 4; ++js) {
                if (js == 0) RC_WAITV(7); else if (js == 1) RC_WAITV(8); else if (js == 2) RC_WAITV(9); else RC_WAITV(10);
                RC_BAR();
                { const int s4 = RC_PREV(slot); RC_ISSUE(js, tokn, s4); }
                bf16x8v At[4], Bv[2];
                const LAS unsigned char* sv = lds + RC_RG + slot * 16384;
#pragma unroll
                for (int m = 0; m < 4; ++m) At[m] = *(const LAS bf16x8v*)(lds + RC_ST + js * 8192 + aoff + m * 1024);
#pragma unroll
                for (int n = 0; n < 2; ++n) Bv[n] = *(const LAS bf16x8v*)(sv + boff + n * 1024);
                RC_WAITL();
#pragma unroll
                for (int m = 0; m < 4; ++m)
#pragma unroll
                    for (int n = 0; n < 2; ++n) accY[m][n] = RC_MFMA(Bv[n], At[m], accY[m][n]);
                slot = RC_NEXT(slot);
            }
#pragma unroll
            for (int m = 0; m < 4; ++m)
#pragma unroll
                for (int n = 0; n < 2; ++n) { v2u pw; pw.x = cvtpk(accY[m][n][0], accY[m][n][1]); pw.y = cvtpk(accY[m][n][2], accY[m][n][3]);
                    *(v2u*)(Y + (rowbase + tok0 + 64 * wr + 16 * m + frc + zo) * DV + h * DVR + es * 128 + 32 * wc + 16 * n + 4 * fqc) = pw; }
#pragma unroll
            for (int m = 0; m < 4; ++m) { float sv = 0.f, sq = 0.f;
#pragma unroll
                for (int n = 0; n < 2; ++n)
#pragma unroll
                    for (int ii = 0; ii < 4; ++ii) { const float yv = accY[m][n][ii]; sv += yv; sq += yv * yv; }
                sv += swz_xor<16>(sv); sq += swz_xor<16>(sq); sv += get_xor32(sv, lc); sq += get_xor32(sq, lc);
                float* sp = PT + ((((rowbase + tok0 + 64 * wr + 16 * m + frc + zo) * 4 + h) * 2 + dir) * 16 + es * 4 + wc) * 2;
                if (fqc == 0) *(f32x2_t*)sp = (f32x2_t){sv, sq}; }
            RC_BAR();
#pragma unroll
            for (int n = 0; n < 16; ++n) { v2u pw; pw.x = cvtpk(acc4[n][0], acc4[n][1]); pw.y = cvtpk(acc4[n][2], acc4[n][3]);
                *(LAS v2u*)(lds + RC_ST + (n >> 1) * 8192 + w * 1024 + sl_swz(frc * 64 + (16 * (n & 1) + 4 * fqc) * 2)) = pw; }
            RC_WAITL();
        }
        RC_WAITV(0); RC_BAR();
    }
#undef RC_DMA
#undef RC_WAITV
#undef RC_WAITL
#undef RC_BAR
#undef RC_MFMA
#undef RC_NEXT
#undef RC_PREV
#undef RC_ISSUE
}

__device__ __forceinline__ void ret_stats(const float* PT, float* ST, int gtid, int nthr) {
    for (int i = gtid; i < M * 8; i += nthr) { const f32x4* p = (const f32x4*)(PT + (size_t)i * 32); float sv = 0.f, sq = 0.f;
#pragma unroll
        for (int k = 0; k < 8; ++k) { const f32x4 v = p[k]; sv += v.x + v.z; sq += v.y + v.w; }
        *(f32x2_t*)(ST + (size_t)i * 2) = (f32x2_t){sv, sq}; }
}

constexpr int AT_KROW = 144, AT_KB = 256 * AT_KROW, AT_VB = AT_KB, AT_HALF = AT_KB + AT_VB + 768, AT_LD = 3 * D;
static_assert(2 * AT_HALF <= RING_BYTES, "attention tiles");
__device__ __forceinline__ void attn_group_mfma2(const bf16* QK, const float* bias2g, int ldil, int first, bf16* OACC, float* LSE, LAS unsigned char* lds, const int tid, const int bid, const int G) {
    const int wave = __builtin_amdgcn_readfirstlane(tid >> 6), lane = tid & 63, r = lane & 31, hh = lane >> 5, hw = wave >> 2, wq = wave & 3, tih0 = tid & 255;
    LAS unsigned char* Kl = lds + hw * AT_HALF; LAS unsigned char* Vl = Kl + AT_KB; LAS float* tab = (LAS float*)(Vl + AT_VB);
    const int Ls = SEQ >> ldil, lq4 = 4 - ldil, nq4m = (1 << lq4) - 1, dilm = (1 << ldil) - 1;
    constexpr float SC = 0.125f * 1.4426950409f;
    const float NEGBIG = opaque_f(-1e30f);
    constexpr int NP = BATCH * HA * 16 / 2;
    const int npp = (NP + G - 1) / G;
    v4u kreg[8], vreg[8];
#define AT_FETCH_K(su_) do { int tih = tih0; asm volatile("" : "+v"(tih)); const int su__ = (su_); const int q4_ = su__ & nq4m, rr_ = (su__ >> lq4) & dilm, h_ = (su__ >> 4) & 15, b_ = su__ >> 8, ks_ = q4_ * 128 - 64; \
        _Pragma("unroll") for (int j = 0; j < 8; ++j) { const int pi = j * 256 + tih, row = pi >> 3, ch = pi & 7; int kt = ks_ + row; kt = kt < 0 ? 0 : (kt > Ls - 1 ? Ls - 1 : kt); \
            kreg[j] = *(const v4u*)(QK + ((size_t)b_ * SEQ + ((size_t)kt << ldil) + rr_) * AT_LD + D + h_ * 64 + ch * 8); } } while (0)
#define AT_FETCH_V(su_) do { int tih = tih0; asm volatile("" : "+v"(tih)); const int su__ = (su_); const int q4_ = su__ & nq4m, rr_ = (su__ >> lq4) & dilm, h_ = (su__ >> 4) & 15, b_ = su__ >> 8, ks_ = q4_ * 128 - 64; \
        _Pragma("unroll") for (int j = 0; j < 8; ++j) { const int pi = j * 256 + tih, row = pi >> 3, ch = pi & 7; int kt = ks_ + row; kt = kt < 0 ? 0 : (kt > Ls - 1 ? Ls - 1 : kt); \
            vreg[j] = *(const v4u*)(QK + ((size_t)b_ * SEQ + ((size_t)kt << ldil) + rr_) * AT_LD + 2 * D + h_ * 64 + ch * 8); } } while (0)
    if (bid * npp < NP) { AT_FETCH_K(2 * (bid * npp) + hw); AT_FETCH_V(2 * (bid * npp) + hw); }
    for (int it = 0; it < npp; ++it) {
        const int p = bid * npp + it; if (p >= NP) break;
        const int su = 2 * p + hw, q4 = su & nq4m, rr = (su >> lq4) & dilm, h = (su >> 4) & 15, b = su >> 8, t0 = q4 * 128 + 32 * wq;
        asm volatile("" ::: "memory"); __builtin_amdgcn_s_barrier(); asm volatile("" ::: "memory");
        int tih = tih0; asm volatile("" : "+v"(tih));
#pragma unroll
        for (int j = 0; j < 8; ++j) { const int pi = j * 256 + tih; *(LAS v4u*)(Kl + (pi >> 3) * AT_KROW + (pi & 7) * 16) = kreg[j]; }
#pragma unroll
        for (int j = 0; j < 8; ++j) { const int pi = j * 256 + tih; *(LAS v4u*)(Vl + (pi >> 3) * AT_KROW + (pi & 7) * 16) = vreg[j]; }
        if (tih < 192) { const int o = tih - 96; tab[tih] = (o >= -64 && o <= 64) ? bias2g[h * 129 + o + 64] : NEGBIG; }
        const size_t rowq = (size_t)b * SEQ + ((size_t)(t0 + r) << ldil) + rr;
        bf16x8s qf[4];
#pragma unroll
        for (int ks = 0; ks < 4; ++ks) qf[ks] = *(const bf16x8s*)(QK + rowq * AT_LD + h * 64 + 16 * ks + 8 * hh);
        asm volatile("s_waitcnt lgkmcnt(0)" ::: "memory"); __builtin_amdgcn_s_barrier(); asm volatile("" ::: "memory");
        f32x16 S[5];
#pragma unroll
        for (int kb = 0; kb < 5; ++kb) {
            const LAS unsigned char* kp = Kl + (32 * wq + 32 * kb + r) * AT_KROW + 16 * hh;
#pragma unroll
            for (int i = 0; i < 16; ++i) S[kb][i] = 0.f;
#pragma unroll
            for (int ks = 0; ks < 4; ++ks) S[kb] = __builtin_amdgcn_mfma_f32_32x32x16_bf16(*(const LAS bf16x8s*)(kp + 32 * ks), qf[ks], S[kb], 0, 0, 0);
        }
        const bool more = it + 1 < npp && p + 1 < NP;
        __builtin_amdgcn_sched_barrier(0);
        if (more) AT_FETCH_K(2 * (p + 1) + hw);
        __builtin_amdgcn_sched_barrier(0);
        const LAS float* tb = tab + (32 + 4 * hh - r);
        float mx = NEGBIG;
        int kt0 = t0 - 64 + 4 * hh; asm volatile("" : "+v"(kt0));
#pragma unroll
        for (int kb = 0; kb < 5; ++kb)
#pragma unroll
            for (int i = 0; i < 16; ++i) { const int krel = 32 * kb + (i & 3) + 8 * (i >> 2);
                float s = S[kb][i] * SC + tb[krel]; s = ((unsigned)(kt0 + krel) >= (unsigned)Ls) ? NEGBIG : s; S[kb][i] = s; mx = fmaxf(mx, s); }
        mx = fmaxf(mx, get_xor32(mx, lane));
        float l = 0.f;
#pragma unroll
        for (int kb = 0; kb < 5; ++kb)
#pragma unroll
            for (int i = 0; i < 16; ++i) { const float pv = __builtin_amdgcn_exp2f(S[kb][i] - mx); S[kb][i] = pv; l += pv; }
        l += get_xor32(l, lane);
        f32x16 O[2];
#pragma unroll
        for (int db = 0; db < 2; ++db)
#pragma unroll
            for (int i = 0; i < 16; ++i) O[db][i] = 0.f;
#pragma unroll
        for (int kb = 0; kb < 5; ++kb) {
            if (kb == 3) { __builtin_amdgcn_sched_barrier(0); if (more) AT_FETCH_V(2 * (p + 1) + hw); __builtin_amdgcn_sched_barrier(0); }
#pragma unroll
            for (int s2 = 0; s2 < 2; ++s2) {
                v4u pw; pw.x = cvtpk(S[kb][8 * s2 + 0], S[kb][8 * s2 + 1]); pw.y = cvtpk(S[kb][8 * s2 + 2], S[kb][8 * s2 + 3]); pw.z = cvtpk(S[kb][8 * s2 + 4], S[kb][8 * s2 + 5]); pw.w = cvtpk(S[kb][8 * s2 + 6], S[kb][8 * s2 + 7]);
                const bf16x8s pf = __builtin_bit_cast(bf16x8s, pw);
                typedef short s16x4 __attribute__((ext_vector_type(4)));
                const LAS unsigned char* vb = Vl + (32 * wq + 32 * kb + 16 * s2 + 4 * hh + ((lane & 15) >> 2)) * AT_KROW + (16 * ((lane >> 4) & 1) + 4 * (lane & 3)) * 2;
#pragma unroll
                for (int db = 0; db < 2; ++db) {
                    const v2u lo = __builtin_bit_cast(v2u, __builtin_amdgcn_ds_read_tr16_b64_v4i16((LAS s16x4*)(vb + 64 * db))), hi = __builtin_bit_cast(v2u, __builtin_amdgcn_ds_read_tr16_b64_v4i16((LAS s16x4*)(vb + 64 * db + 8 * AT_KROW)));
                    const v4u vw = (v4u){lo.x, lo.y, hi.x, hi.y};
                    O[db] = __builtin_amdgcn_mfma_f32_32x32x16_bf16(__builtin_bit_cast(bf16x8s, vw), pf, O[db], 0, 0, 0); }
            }
        }
        const float il = __builtin_amdgcn_rcpf(l); float lse = mx + __builtin_amdgcn_logf(l);
        const size_t row = rowq;
        float wn = il, wo = 0.f;
        if (!first) { const float lo = LSE[row * 16 + h]; const float mm = fmaxf(lo, lse), eo = __builtin_amdgcn_exp2f(lo - mm), en = __builtin_amdgcn_exp2f(lse - mm), inv = __builtin_amdgcn_rcpf(eo + en); wn = en * inv * il; wo = eo * inv; lse = mm + __builtin_amdgcn_logf(eo + en); }
        if (hh == 0) LSE[row * 16 + h] = lse;
#pragma unroll
        for (int db = 0; db < 2; ++db)
#pragma unroll
            for (int gq = 0; gq < 4; ++gq) { v2u* op = (v2u*)(OACC + row * D + h * 64 + 32 * db + 8 * gq + 4 * hh);
                v2u x = (v2u){0u, 0u}; if (!first) x = *op;
                v2u y; y.x = cvtpk(wn * O[db][4 * gq + 0] + wo * bflo(x.x), wn * O[db][4 * gq + 1] + wo * bfhi(x.x)); y.y = cvtpk(wn * O[db][4 * gq + 2] + wo * bflo(x.y), wn * O[db][4 * gq + 3] + wo * bfhi(x.y));
                *op = y; }
    }
#undef AT_FETCH_K
#undef AT_FETCH_V
    __syncthreads();
}


struct Args { const float* in[11]; float* out; unsigned char* ws; int ph_lo, ph_hi; };
__global__ void __launch_bounds__(NTHREADS, 2) mk_fwd(Args args) {
    extern __shared__ __attribute__((aligned(16))) unsigned char lds_raw[];
    LAS unsigned char* lds = (LAS unsigned char*)lds_raw;
    volatile LAS unsigned* MISC = (volatile LAS unsigned*)(lds + MISC_OFF);
    const int wave0 = __builtin_amdgcn_readfirstlane(threadIdx.x >> 6);
    for (int u = threadIdx.x; u < (LDS_BYTES - LDSCTL_OFF) / 4; u += NTHREADS) ((LAS unsigned*)(lds + LDSCTL_OFF))[u] = 0u;
    __syncthreads();
    (void)xcd_barrier_post((unsigned*)(args.ws + WS_CTL) + CW_BAR, MISC + 8);
    bool again = false;
#if PROBE_TWICE
    for (int pass_ = 0; pass_ < 2; ++pass_)
#endif
    for (int ph = args.ph_lo; ph < args.ph_hi; ++ph) {
        unsigned char* ws = args.ws; asm volatile("" : "+s"(ws));
        int bid = blockIdx.x, G = gridDim.x; asm volatile("" : "+s"(bid), "+s"(G));
        const int gw = bid * NWAVES + wave0, NGW = G * NWAVES;
#define GET_TID() int tid; asm volatile("v_mbcnt_lo_u32_b32 %0, -1, 0\n\tv_mbcnt_hi_u32_b32 %0, -1, %0" : "=v"(tid)); const int lane = tid; tid += wave0 * 64; (void)lane;
        LAS float* scr = (LAS float*)(lds + RING_OFF + wave0 * CV_SCR);
        const float* gains = args.in[1]; float* out = args.out;
        float* RS = (float*)(ws + WS_RS);
        enum { T_P0, T_G1, T_FG, T_THIN, T_APROJ, T_ATT, T_RPROJ, T_RCORE, T_RGATE, T_RSTAT };
        int type, L = 0, kind = 0, aux = 0;
        if (ph == 0) type = T_P0;
        else { const int p = ph - 1, pp = p % 26, odd = pp >= 14, q = odd ? pp - 14 : pp, nmix = odd ? 6 : 8;
            L = 2 * (p / 26) + odd;
            if (q < 3) { kind = 0; type = q == 0 ? T_G1 : (q == 1 ? T_FG : T_THIN); }
            else if (q >= 3 + nmix) { kind = 2; const int r = q - 3 - nmix; type = r == 0 ? T_G1 : (r == 1 ? T_FG : T_THIN); }
            else { kind = 1; const int r = q - 3;
                if (r == nmix - 2) type = T_FG; else if (r == nmix - 1) type = T_THIN;
                else if (!odd) { aux = r >> 1; type = (r & 1) ? T_ATT : T_APROJ; }
                else type = r == 0 ? T_RPROJ : (r == 1 ? T_RCORE : (r == 2 ? T_RSTAT : T_RGATE)); } }
        const bool is_att = (L & 1) == 0; const int jj = L >> 1;
#define P_BIAS ((float*)(ws + WS_BIAS))
#define P_WA   ((bf16*)(ws + WS_W))
#define P_XH   ((bf16*)(ws + WS_XH))
#define P_BIG  ((bf16*)(ws + WS_BIG))
#define P_F    ((bf16*)(ws + WS_F))
#define P_YC   ((bf16*)(ws + WS_YC))
#define P_OACC ((bf16*)(ws + WS_OACC))
#define P_LSE  ((float*)(ws + WS_LSE))
        if (type == T_P0) {
            GET_TID()
#if PROBE_TOUCH
            {
                const size_t tix = (size_t)(bid >> 3) * NTHREADS + tid, nthr = (size_t)(G >> 3) * NTHREADS; unsigned accw = 0;
                for (size_t o = tix * 65536; o < WS_END; o += nthr * 65536) accw += *(const volatile unsigned*)(ws + o);
                for (size_t o = tix * 65536; o < (size_t)M * D * 4; o += nthr * 65536) { accw += *(const volatile unsigned*)((const char*)args.in[0] + o); accw += *(const volatile unsigned*)((const char*)out + o); }
                for (size_t o = tix * 65536; o < (size_t)DEPTH * 2 * D * DFF * 4; o += nthr * 65536) { accw += *(const volatile unsigned*)((const char*)args.in[2] + o); accw += *(const volatile unsigned*)((const char*)args.in[3] + o); accw += *(const volatile unsigned*)((const char*)args.in[4] + o); }
                for (size_t o = tix * 65536; o < (size_t)2 * D * NGRP * ATT_COLS * 4; o += nthr * 65536) accw += *(const volatile unsigned*)((const char*)args.in[5] + o);
                for (size_t o = tix * 65536; o < (size_t)2 * D * RET_COLS * 4; o += nthr * 65536) accw += *(const volatile unsigned*)((const char*)args.in[8] + o);
                if (accw == 0x12345677u) P_BIAS[70000] = 1.f; }
#endif
            const float* rel_bias = args.in[7];
            if (bid == 0) for (int i = tid; i < 3 * 16 * 129; i += NTHREADS) { const int g = i / (16 * 129), h = (i / 129) % 16, kk = i % 129; P_BIAS[i] = rel_bias[(g * 16 + h) * 32 + T5_BUCKET[g][kk]] * 1.4426950409f; }
            conv_gateup(args.in[2], args.in[3], P_WA, gains, scr, gw, NGW, lane);
            conv_plain<DFF, D>(args.in[4], (bf16*)(ws + WS_W2_FFN), nullptr, scr, gw, NGW, lane);
            p0_rows(args.in[0], P_XH, RS, gw, NGW, lane);
#if PROBE_MFMA
            {
                typedef short bx8 __attribute__((ext_vector_type(8)));
                bx8 a = {1, 2, 3, 4, 5, 6, 7, (short)lane}, b = {3, 1, 4, 1, 5, 9, 2, (short)(lane + 1)};
                f32x4 c0 = {0, 0, 0, 0}, c1 = c0, c2 = c0, c3 = c0, c4 = c0, c5 = c0, c6 = c0, c7 = c0;
                for (int it = 0; it < PROBE_MFMA; ++it) {
#pragma unroll
                    for (int r = 0; r < 4; ++r) {
                        c0 = __builtin_amdgcn_mfma_f32_16x16x32_bf16(a, b, c0, 0, 0, 0); c1 = __builtin_amdgcn_mfma_f32_16x16x32_bf16(a, b, c1, 0, 0, 0); c2 = __builtin_amdgcn_mfma_f32_16x16x32_bf16(a, b, c2, 0, 0, 0); c3 = __builtin_amdgcn_mfma_f32_16x16x32_bf16(a, b, c3, 0, 0, 0);
                        c4 = __builtin_amdgcn_mfma_f32_16x16x32_bf16(a, b, c4, 0, 0, 0); c5 = __builtin_amdgcn_mfma_f32_16x16x32_bf16(a, b, c5, 0, 0, 0); c6 = __builtin_amdgcn_mfma_f32_16x16x32_bf16(a, b, c6, 0, 0, 0); c7 = __builtin_amdgcn_mfma_f32_16x16x32_bf16(a, b, c7, 0, 0, 0); }
                    asm volatile("" : "+v"(a), "+v"(b)); }
                const f32x4 t = c0 + c1 + c2 + c3 + c4 + c5 + c6 + c7;
                if (t.x + t.y + t.z + t.w == 12345.678f) P_BIAS[60000 + tid] = t.x;
            }
#endif
        } else if (type == T_G1) {
            GET_TID()
            pg8::Gemm g{P_XH, P_WA, M, 2 * DFF, D, 0}; pg8::StaticOrder S; S.init(M, 2 * DFF, G, bid);
            pg8::stage_scales(lds + RING_OFF, S, RS, false, 0, tid);
            pg8::EpiSwiGLU E{P_BIG, DFF, (const LAS float*)(lds + RING_OFF + pg8::RS_TAB_OFF)};
            pg8::gemm_phase<pg8::EpiSwiGLU, pg8::StaticOrder, true, true>(lds + RING_OFF, g, S, E, tid);
#if PROBE_G1V >= 0
            { GET_TID() pg8::Gemm g2{P_XH, P_WA, M, 2 * DFF, D, 0}; pg8::StaticOrder S2; S2.init(M, 2 * DFF, G, bid);
              pg8::EpiSwiGLUT<PROBE_G1V> E2{PROBE_G1V ? P_F : P_BIG, PROBE_G1V ? D : DFF, (const LAS float*)(lds + RING_OFF + pg8::RS_TAB_OFF)};
              pg8::gemm_phase<pg8::EpiSwiGLUT<PROBE_G1V>, pg8::StaticOrder, true, true>(lds + RING_OFF, g2, S2, E2, tid); }
#endif
        } else if (type == T_FG) {
            GET_TID()
            const size_t fA = kind != 1 ? WS_BIG : (is_att ? WS_OACC : WS_YC), fB = kind != 1 ? WS_W2_FFN : (is_att ? WS_W2_ATT : WS_W2_RET); const int fK = kind != 1 ? DFF : (is_att ? D : DV);
            pg8::Gemm g{(const bf16*)(ws + fA), (const bf16*)(ws + fB), M, D, fK, 0}; pg8::StaticOrder S; S.init(M, D, G, bid);
            pg8::EpiPlain E{P_F, D, (const LAS float*)nullptr};
            pg8::gemm_phase<pg8::EpiPlain, pg8::StaticOrder, true, true>(lds + RING_OFF, g, S, E, tid);
#if PROBE_FGM
            if (kind != 1) { GET_TID()
                pg8::Gemm g2{(const bf16*)(ws + fA), (const bf16*)(ws + fB), PROBE_FGM, D, fK, 0}; pg8::StaticOrder S2; S2.init(PROBE_FGM, D, G, bid);
                pg8::EpiPlain E2{P_XH, D, (const LAS float*)nullptr};
                pg8::gemm_phase<pg8::EpiPlain, pg8::StaticOrder, true, true>(lds + RING_OFF, g2, S2, E2, tid); }
#endif
        } else if (type == T_THIN) {
            GET_TID()
            const int sub = L * 3 + kind;
            for (int crep = 0; crep < 1 + PROBE_CONV2; ++crep)
            if (sub + 1 < 3 * DEPTH) {
                const int nk = (sub + 1) % 3, nL = (sub + 1) / 3, nj = nL >> 1;
                const float* gn = gains + ((size_t)nL * 6 + (nk == 0 ? 0 : (nk == 1 ? 2 : 4))) * D;
                if (nk != 1) { const size_t o = (size_t)(nL * 2 + (nk >> 1)) * D * DFF;
                    conv_gateup(args.in[2] + o, args.in[3] + o, P_WA, gn, scr, gw, NGW, lane); conv_plain<DFF, D>(args.in[4] + o, (bf16*)(ws + WS_W2_FFN), nullptr, scr, gw, NGW, lane); }
                else if ((nL & 1) == 0) { conv_plain<D, NGRP * ATT_COLS>(args.in[5] + (size_t)nj * D * NGRP * ATT_COLS, P_WA, gn, scr, gw, NGW, lane); conv_plain<D, D>(args.in[6] + (size_t)nj * D * D, (bf16*)(ws + WS_W2_ATT), nullptr, scr, gw, NGW, lane); }
                else { const float* rw = args.in[8] + (size_t)nj * D * RET_COLS;
                    conv_cols<D, RET_COLS, 2 * D + DV>(rw, 0, P_WA, 0, gn, scr, gw, NGW, lane); conv_gates<RET_COLS>(rw, 2 * D + DV, 2 * D + 2 * DV, P_WA, 2 * D + DV, gn, scr, gw, NGW, lane);
                    conv_plain<DV, D>(args.in[9] + (size_t)nj * DV * D, (bf16*)(ws + WS_W2_RET), nullptr, scr, gw, NGW, lane); }
            }
            asm volatile("" ::: "memory");
            const float* gpost = gains + ((size_t)L * 6 + (kind == 0 ? 1 : (kind == 1 ? 3 : 5))) * D;
            thin_rows(P_F, P_XH, gpost, kind == 1 ? 1.0f : 0.5f, RS, sub + 1 < 3 * DEPTH ? nullptr : out, gw, NGW, lane);
        } else if (type == T_APROJ) {
            GET_TID()
            { pg8::Gemm g{P_XH, P_WA + (size_t)aux * ATT_COLS * D, M, ATT_COLS, D, 0}; pg8::StaticOrder S; S.init(M, ATT_COLS, G, bid);
              pg8::stage_scales(lds + RING_OFF, S, RS, false, 0, tid);
              pg8::EpiPlain E{P_BIG, ATT_COLS, (const LAS float*)(lds + RING_OFF + pg8::RS_TAB_OFF)};
              pg8::gemm_phase<pg8::EpiPlain, pg8::StaticOrder, true, true>(lds + RING_OFF, g, S, E, tid); }
        } else if (type == T_ATT) {
            GET_TID()
            const int ldil = 2 * aux;
            attn_group_mfma2(P_BIG, P_BIAS + aux * 16 * 129, ldil, aux == 0, P_OACC, P_LSE, lds + RING_OFF, tid, bid, G);
        } else if (type == T_RPROJ) {
            GET_TID()
            { pg8::Gemm g{P_XH, P_WA, M, 2 * D, D, 0}; pg8::StaticOrder S; S.init(M, 2 * D, G, bid);
              pg8::stage_scales(lds + RING_OFF, S, RS, false, 0, tid);
              pg8::EpiRet E{P_BIG, 2 * D, (const LAS float*)(lds + RING_OFF + pg8::RS_TAB_OFF)};
              pg8::gemm_phase<pg8::EpiRet, pg8::StaticOrder, true, true>(lds + RING_OFF, g, S, E, tid); }
            { GET_TID()
              pg8::Gemm g{P_WA + (size_t)2 * D * D, P_XH, DV, M, D, 0}; pg8::StaticOrder S; S.init(DV, M, G, bid);
              pg8::stage_scales(lds + RING_OFF, S, RS, true, 0, tid);
              pg8::EpiVT E{(bf16*)(ws + WS_RVT), M, 0, (const LAS float*)(lds + RING_OFF + pg8::RS_TAB_OFF)};
              pg8::gemm_phase<pg8::EpiVT, pg8::StaticOrder, true, true>(lds + RING_OFF, g, S, E, tid); }
        } else if (type == T_RCORE) {
            GET_TID()
            static_assert(RC_LDS <= RING_BYTES, "retention core LDS tiles");
            ret_core_mfma<0>(P_BIG, (const bf16*)(ws + WS_RVT), args.in[10] + jj * 2 * HR, P_YC, (bf16*)out, (float*)(ws + WS_OACC), lds + RING_OFF, tid, bid, G);
        } else if (type == T_RSTAT) {
            GET_TID()
            ret_stats((const float*)(ws + WS_OACC), P_LSE, bid * NTHREADS + tid, G * NTHREADS);
        } else {
            GET_TID()
            pg8::Gemm g{P_XH, P_WA + (size_t)(2 * D + DV) * D, M, 2 * DV, D, 0}; pg8::StaticOrder S; S.init(M, 2 * DV, G, bid);
            pg8::stage_scales(lds + RING_OFF, S, RS, false, 0, tid);
            pg8::EpiGate E{P_YC, (const bf16*)out, P_LSE, (const LAS float*)(lds + RING_OFF + pg8::RS_TAB_OFF)};
            pg8::gemm_phase<pg8::EpiGate, pg8::StaticOrder, true, true>(lds + RING_OFF, g, S, E, tid);
        }
        if (ph + 1 < args.ph_hi || PROBE_TWICE) { XcdBarrier b_; b_.bar = (unsigned*)(ws + WS_CTL) + CW_BAR; b_.x = xb_xcc_id(); b_.st = MISC + 8; xcd_barrier(b_);
#if PROBE_BAR2
            xcd_barrier(b_);
#endif
        }
        if (PROBE_REPEAT) {
            if (!again && ((PROBE_REPEAT >> type) & 1) && (type != T_ATT || aux == 0) && ph + 1 < args.ph_hi) { again = true; --ph; } else again = false; }
    }
}

extern "C" void kernel_launch(void* const* d_in, const int* in_sizes, int n_in, void* d_out, int out_size, void* d_ws, size_t ws_size, hipStream_t stream) {
    static int grid = 0;
    if (grid == 0) {
        if (n_in != 11 || in_sizes[0] != M * D || out_size != M * D || ws_size < WS_END) { fprintf(stderr, "kernel_launch: unexpected shapes / workspace (n_in %d, ws %zu, need %zu); nothing launched\n", n_in, ws_size, (size_t)WS_END); grid = -1; return; }
        int dev = 0, cus = 0, per_cu = 0;
        if (hipGetDevice(&dev) != hipSuccess || hipDeviceGetAttribute(&cus, hipDeviceAttributeMultiprocessorCount, dev) != hipSuccess) { grid = -1; return; }
        if (hipFuncSetAttribute((const void*)mk_fwd, hipFuncAttributeMaxDynamicSharedMemorySize, LDS_BYTES) != hipSuccess) { fprintf(stderr, "kernel_launch: hipFuncSetAttribute failed\n"); grid = -1; return; }
        if (hipOccupancyMaxActiveBlocksPerMultiprocessor(&per_cu, (const void*)mk_fwd, NTHREADS, LDS_BYTES) != hipSuccess || per_cu < 1) { fprintf(stderr, "kernel_launch: occupancy query reports %d workgroups per CU\n", per_cu); }
        (void)hipGetLastError();
        grid = cus;
    }
    if (grid < 0) return;
    if (hipMemsetAsync((char*)d_ws + WS_CTL, 0, CTL_ZERO_BYTES, stream) != hipSuccess) return;
    Args a{};
    for (int i = 0; i < 11; ++i) a.in[i] = (const float*)d_in[i];
    a.out = (float*)d_out; a.ws = (unsigned char*)d_ws;
#if MK_ONE_LAUNCH
    a.ph_lo = 0; a.ph_hi = NPHASES;
    hipLaunchKernelGGL(mk_fwd, dim3(grid), dim3(NTHREADS), LDS_BYTES, stream, a);
#else
    for (int p = 0; p < NPHASES; ++p) { a.ph_lo = p; a.ph_hi = p + 1; hipLaunchKernelGGL(mk_fwd, dim3(grid), dim3(NTHREADS), LDS_BYTES, stream, a); }
#endif
}
```

```cpp
#include <hip/hip_runtime.h>
#include <cstdio>
#include <cstdint>
#ifndef PROBE_REPEAT
#define PROBE_REPEAT 0
#endif
#ifndef PROBE_THIN2
#define PROBE_THIN2 0
#endif
#ifndef PROBE_ATT2
#define PROBE_ATT2 0
#endif
#ifndef PROBE_CONV2
#define PROBE_CONV2 0
#endif
#ifndef PROBE_FGM
#define PROBE_FGM 0
#endif
#ifndef PROBE_RC
#define PROBE_RC -1
#endif
#ifndef PROBE_G1V
#define PROBE_G1V -1
#endif
#ifndef PROBE_BAR2
#define PROBE_BAR2 0
#endif
#ifndef PROBE_MFMA
#define PROBE_MFMA 0
#endif
#ifndef PROBE_TWICE
#define PROBE_TWICE 0
#endif
#ifndef PROBE_TOUCH
#define PROBE_TOUCH 0
#endif
#ifndef PROBE_TSEL
#define PROBE_TSEL 0
#endif
#ifndef PROBE_TLO
#define PROBE_TLO 0
#endif
#ifndef PROBE_THI
#define PROBE_THI 1000
#endif
#ifndef PROBE_TMASK
#define PROBE_TMASK 0x3ff
#endif
#ifndef PROBE_TWORK
#define PROBE_TWORK 0
#endif
#ifndef PROBE_TWG
#define PROBE_TWG 0
#endif
#ifndef PROBE_TAMP
#define PROBE_TAMP 1
#endif
#ifndef MK_ONE_LAUNCH
#define MK_ONE_LAUNCH 1
#endif
namespace pg8 {
#define PG8_LAS __attribute__((address_space(3)))
typedef unsigned short bf16_t;
typedef short bf16x8 __attribute__((ext_vector_type(8)));
typedef float f32x4 __attribute__((ext_vector_type(4)));
typedef unsigned u32x4 __attribute__((ext_vector_type(4)));
constexpr int BM = 256, BK = 64, HALF = 128, HTB = HALF * BK * 2  , STAGE_BYTES = 8 * HTB, NXCD = 8, WGM = 8;

__host__ __device__ __forceinline__ int lds_byte(int r, int c) { const int st = (r >> 4) * 2 + (c >> 5), rr = r & 15, cc = c & 31, ob = rr * 64 + cc * 2; return st * 1024 + (ob ^ (((ob >> 9) & 1) << 5)); }
__host__ __device__ __forceinline__ void stage_rc(int b, int& R, int& C) { const int st = b / 1024, sb = b % 1024, swz = sb ^ (((sb >> 9) & 1) << 5); R = (st >> 1) * 16 + swz / 64; C = (st & 1) * 32 + (swz % 64) / 2; }
__host__ __device__ __forceinline__ int perm32(int rho) { const int n = rho >> 4, i = rho & 15; return 8 * (i >> 2) + 4 * n + (i & 3); }

struct Unit { int pm, pn, idx; };
struct Gemm { const bf16_t* A; const bf16_t* Bt; int M, N, K; int ldil; };

struct StaticOrder {
    int nM, nN, nwg, G, c;
    __host__ __device__ void init(int M, int N, int G_, int c_) { nM = M / BM; nN = N / BM; nwg = nM * nN; G = G_; c = c_; }
    __host__ __device__ bool next(int i, Unit& u) const {
        const long L = (long)i * G + c; if (L >= nwg) return false;
        int wgid = (int)L; { const int q = nwg / NXCD, r = nwg % NXCD, xcd = wgid % NXCD, off = wgid / NXCD; wgid = (xcd < r ? xcd * (q + 1) : r * (q + 1) + (xcd - r) * q) + off; }
        const int nig = WGM * nN, gid = wgid / nig, fm = gid * WGM, gsz = (nM - fm) < WGM ? (nM - fm) : WGM;
        u.pm = fm + ((wgid % nig) % gsz); u.pn = (wgid % nig) / gsz; u.idx = i; return true;
    }
    __device__ __forceinline__ void a_ready(const Unit&) const {}
    __device__ __forceinline__ void done(const Unit&) const {}
};

__device__ __forceinline__ unsigned cvt_pk_bf16(float lo, float hi) { unsigned r; asm volatile("v_cvt_pk_bf16_f32 %0, %1, %2" : "=v"(r) : "v"(lo), "v"(hi)); return r; }
typedef float f32x2 __attribute__((ext_vector_type(2)));

__device__ __forceinline__ float fast_sigmoid(float g) { return __builtin_amdgcn_rcpf(1.0f + __builtin_amdgcn_exp2f(-1.4426950409f * g)); }
constexpr int RS_TAB_OFF = 131072;
template <class Sched> __device__ __forceinline__ void stage_scales(PG8_LAS unsigned char* lds, const Sched& S, const float* rs, bool cols, int ldil, int tid) {
    PG8_LAS float* tab = (PG8_LAS float*)(lds + RS_TAB_OFF); Unit u;
    if (tid < 256) { const int lper = 8 - ldil, c = tid, tm = ((c & ((1 << lper) - 1)) << ldil) + (c >> lper);
        float eps = 1e-6f; asm volatile("" : "+s"(eps));
        for (int i = 0; i < 16 && S.next(i, u); ++i) { const f32x4 a = *(const f32x4*)(rs + 4 * (size_t)(cols ? u.pn * BM + tm : u.pm * BM + tid));
            tab[i * 256 + tid] = __builtin_amdgcn_rsqf(((a[0] + a[1]) + (a[2] + a[3])) * (1.0f / 1024.0f) + eps); } }
    __syncthreads();
}
struct EpiPlain {
    static constexpr bool PERM = true, AFTER_DRAIN = false;
    bf16_t* O; int ldc; const PG8_LAS float* tab;
    __device__ __forceinline__ void operator()(const f32x4 (&acc)[2][2][4][2], const Unit& u, int wr, int wc, int fr, int fq) const {
        const int row0 = u.pm * BM + wr * 64 + fr, col0 = u.pn * BM + wc * 32 + 8 * fq;
#pragma unroll
        for (int ai = 0; ai < 2; ++ai)
#pragma unroll
            for (int m = 0; m < 4; ++m) { const int row = row0 + ai * HALF + m * 16; bf16_t* rowp = O + (size_t)row * ldc + col0; const float r = tab ? tab[u.idx * 256 + (row & 255)] : 1.0f;
#pragma unroll
                for (int bj = 0; bj < 2; ++bj) { const f32x4 v0 = acc[ai][bj][m][0] * r, v1 = acc[ai][bj][m][1] * r;
                    u32x4 w; w.x = cvt_pk_bf16(v0[0], v0[1]); w.y = cvt_pk_bf16(v0[2], v0[3]); w.z = cvt_pk_bf16(v1[0], v1[1]); w.w = cvt_pk_bf16(v1[2], v1[3]);
                    *(u32x4*)(rowp + bj * HALF) = w; } }
    }
};
template <int CHEAP = 0  > struct EpiSwiGLUT {
    static constexpr bool PERM = true, AFTER_DRAIN = false;
    bf16_t* O; int ldc; const PG8_LAS float* tab;
    __device__ __forceinline__ void operator()(const f32x4 (&acc)[2][2][4][2], const Unit& u, int wr, int wc, int fr, int fq) const {
        const int row0 = u.pm * BM + wr * 64 + fr, col0 = CHEAP ? ((u.pn * HALF + wc * 32 + 8 * fq) & 1023) : (u.pn * HALF + wc * 32 + 8 * fq);
#pragma unroll
        for (int ai = 0; ai < 2; ++ai)
#pragma unroll
            for (int m = 0; m < 4; ++m) { const int row = row0 + ai * HALF + m * 16; bf16_t* rowp = O + (size_t)row * ldc + col0; const float r = tab[u.idx * 256 + (row & 255)];
                float o[8];
                const float kr = -1.4426950409f * r, r2 = r * r;
#pragma unroll
                for (int n = 0; n < 2; ++n)
#pragma unroll
                    for (int e = 0; e < 4; e += 2) { const f32x2 g2 = {acc[ai][0][m][n][e], acc[ai][0][m][n][e + 1]}, u2 = {acc[ai][1][m][n][e], acc[ai][1][m][n][e + 1]};
                        if (CHEAP) { const f32x2 p = g2 * u2 * r2; o[n * 4 + e] = p[0]; o[n * 4 + e + 1] = p[1]; }
                        else { const f32x2 x = g2 * kr; const f32x2 d = (f32x2){__builtin_amdgcn_exp2f(x[0]), __builtin_amdgcn_exp2f(x[1])} + 1.0f;
                            const f32x2 rc = (f32x2){__builtin_amdgcn_rcpf(d[0]), __builtin_amdgcn_rcpf(d[1])} * r2; const f32x2 p = (g2 * u2) * rc; o[n * 4 + e] = p[0]; o[n * 4 + e + 1] = p[1]; } }
                u32x4 w; w.x = cvt_pk_bf16(o[0], o[1]); w.y = cvt_pk_bf16(o[2], o[3]); w.z = cvt_pk_bf16(o[4], o[5]); w.w = cvt_pk_bf16(o[6], o[7]);
                if (CHEAP == 2) { if (w.x == 0x12345678u && w.y == w.z) *(u32x4*)rowp = w; } else *(u32x4*)rowp = w; }
    }
};
typedef EpiSwiGLUT<0> EpiSwiGLU;
struct EpiRet {
    static constexpr bool PERM = true, AFTER_DRAIN = false;
    bf16_t* O; int ldc; const PG8_LAS float* tab;
    __device__ __forceinline__ void operator()(const f32x4 (&acc)[2][2][4][2], const Unit& u, int wr, int wc, int fr, int fq) const {
        const int row0 = u.pm * BM + wr * 64 + fr, col0 = u.pn * BM + wc * 32 + 8 * fq;
        {
            const float osc = (u.pn >= 4) ? 0.0625f : 1.0f;
            float invf[8];
#pragma unroll
            for (int q = 0; q < 8; ++q) { const int j = wc * 32 + 8 * fq + q; invf[q] = __builtin_amdgcn_exp2f(-(float)j * (13.287712379549449f / 127.0f)) * 0.15915494309189535f; }
#pragma unroll
            for (int ai = 0; ai < 2; ++ai)
#pragma unroll
                for (int m = 0; m < 4; ++m) { const int row = row0 + ai * HALF + m * 16; const float pos = (float)(row & 2047), r = tab[u.idx * 256 + (row & 255)] * osc;
                    bf16_t* rowp = O + (size_t)row * ldc + col0;
                    float o1[8], o2[8];
#pragma unroll
                    for (int n = 0; n < 2; ++n)
#pragma unroll
                        for (int e = 0; e < 4; ++e) { const int q = n * 4 + e; float t = pos * invf[q]; t = __builtin_amdgcn_fractf(t);
                            const float sn = __builtin_amdgcn_sinf(t), cs = __builtin_amdgcn_cosf(t);
                            const float a = acc[ai][0][m][n][e], b = acc[ai][1][m][n][e];
                            o1[q] = (a * cs - b * sn) * r; o2[q] = (a * sn + b * cs) * r; }
                    u32x4 w; w.x = cvt_pk_bf16(o1[0], o1[1]); w.y = cvt_pk_bf16(o1[2], o1[3]); w.z = cvt_pk_bf16(o1[4], o1[5]); w.w = cvt_pk_bf16(o1[6], o1[7]);
                    *(u32x4*)rowp = w;
                    w.x = cvt_pk_bf16(o2[0], o2[1]); w.y = cvt_pk_bf16(o2[2], o2[3]); w.z = cvt_pk_bf16(o2[4], o2[5]); w.w = cvt_pk_bf16(o2[6], o2[7]);
                    *(u32x4*)(rowp + HALF) = w; }
        }
    }
};

struct EpiGate {
    static constexpr bool PERM = true, AFTER_DRAIN = false;
    bf16_t* Y; const bf16_t* YB; const float* ST; const PG8_LAS float* tab;
    __device__ __forceinline__ void operator()(const f32x4 (&acc)[2][2][4][2], const Unit& u, int wr, int wc, int fr, int fq) const {
        const int row0 = u.pm * BM + wr * 64 + fr, col0 = u.pn * HALF + wc * 32 + 8 * fq, head = u.pn >> 2;
#pragma unroll
        for (int ai = 0; ai < 2; ++ai) {
            f32x4 stv[4]; u32x4 yfv[4], ybv[4];
#pragma unroll
            for (int m = 0; m < 4; ++m) { const int row = row0 + ai * HALF + m * 16;
                stv[m] = *(const f32x4*)(ST + (size_t)row * 16 + head * 4); yfv[m] = *(const u32x4*)(Y + (size_t)row * 2048 + col0); ybv[m] = *(const u32x4*)(YB + (size_t)row * 2048 + col0); }
#pragma unroll
            for (int m = 0; m < 4; ++m) { const int row = row0 + ai * HALF + m * 16; const float r = tab[u.idx * 256 + (row & 255)];
                const f32x4 st = stv[m];
                const float muf = __builtin_amdgcn_ldexpf(st[0], -9), mub = __builtin_amdgcn_ldexpf(st[2], -9); float eps = 1e-6f; asm volatile("" : "+s"(eps));
                const float rf = __builtin_amdgcn_rsqf(fmaxf(__builtin_amdgcn_ldexpf(st[1], -9) - muf * muf, 0.f) + eps), rb = __builtin_amdgcn_rsqf(fmaxf(__builtin_amdgcn_ldexpf(st[3], -9) - mub * mub, 0.f) + eps);
                const float cf = rf * r, cb = rb * r, df = -muf * cf, db = -mub * cb, kr = -1.4426950409f * r;
                const u32x4 yfw = yfv[m], ybw = ybv[m];
                float o[8];
#pragma unroll
                for (int n = 0; n < 2; ++n)
#pragma unroll
                    for (int e = 0; e < 4; e += 2) { const int q = n * 4 + e; const unsigned wf = yfw[q >> 1], wb = ybw[q >> 1];
                        const f32x2 yf2 = {__builtin_bit_cast(float, wf << 16), __builtin_bit_cast(float, wf & 0xffff0000u)}, yb2 = {__builtin_bit_cast(float, wb << 16), __builtin_bit_cast(float, wb & 0xffff0000u)};
                        const f32x2 af = {acc[ai][0][m][n][e], acc[ai][0][m][n][e + 1]}, ab = {acc[ai][1][m][n][e], acc[ai][1][m][n][e + 1]};
                        const f32x2 nf = yf2 * cf + df, nb = yb2 * cb + db;
                        const f32x2 xf = __builtin_elementwise_min(af * kr, (f32x2){60.f, 60.f}), xb = __builtin_elementwise_min(ab * kr, (f32x2){60.f, 60.f});
                        const f32x2 pf = (f32x2){__builtin_amdgcn_exp2f(xf[0]), __builtin_amdgcn_exp2f(xf[1])} + 1.0f, pb = (f32x2){__builtin_amdgcn_exp2f(xb[0]), __builtin_amdgcn_exp2f(xb[1])} + 1.0f;
                        const f32x2 den = pf * pb, num = (af * nf) * pb + (ab * nb) * pf;
                        const f32x2 res = num * (f32x2){__builtin_amdgcn_rcpf(den[0]), __builtin_amdgcn_rcpf(den[1])};
                        o[q] = res[0]; o[q + 1] = res[1]; }
                u32x4 w; w.x = cvt_pk_bf16(o[0], o[1]); w.y = cvt_pk_bf16(o[2], o[3]); w.z = cvt_pk_bf16(o[4], o[5]); w.w = cvt_pk_bf16(o[6], o[7]);
                *(u32x4*)(Y + (size_t)row * 2048 + col0) = w; }
        }
    }
};

struct PanelOrder {
    int nM, G, c;
    __host__ __device__ void init(int M, int, int G_, int c_) { nM = M / BM; G = G_; c = c_; }
    __host__ __device__ bool next(int i, Unit& u) const {
        const int L = i * G + c; if (L >= 4 * nM) return false;
        if ((G & 31) == 0 && (4 * nM) % G == 0) { const int j = c >> 3, xcd = c & 7; u.pm = i * (G >> 2) + xcd * (G >> 5) + (j >> 2); u.pn = j & 3; } else { u.pm = L >> 2; u.pn = L & 3; }
        u.idx = i; return true;
    }
    __device__ __forceinline__ void a_ready(const Unit&) const {}
    __device__ __forceinline__ void done(const Unit&) const {}
};
__device__ __forceinline__ float epi_xor16(float v) { return __builtin_bit_cast(float, __builtin_amdgcn_ds_swizzle(__builtin_bit_cast(int, v), (16 << 10) | 0x1f)); }
__device__ __forceinline__ float epi_xor32(float v, int lane) { return __builtin_bit_cast(float, __builtin_amdgcn_ds_bpermute((lane ^ 32) << 2, __builtin_bit_cast(int, v))); }
struct EpiThin {
    static constexpr bool PERM = true, AFTER_DRAIN = false;
    bf16_t* XB; float* OUT; const float* gpost; float cpost; unsigned* PFc; unsigned* PFz; float* RS4; PG8_LAS float* scr;
    __device__ __forceinline__ void operator()(const f32x4 (&acc)[2][2][4][2], const Unit& u, int wr, int wc, int fr, int fq) const {
        const int lane = fr + 16 * fq, tid = (wr * 4 + wc) * 64 + lane;
        const int row0 = u.pm * BM + wr * 64 + fr, col0 = u.pn * BM + wc * 32 + 8 * fq;
        u32x4 xa[4][2];
#pragma unroll
        for (int m = 0; m < 4; ++m)
#pragma unroll
            for (int bj = 0; bj < 2; ++bj) xa[m][bj] = *(const u32x4*)(XB + (size_t)(row0 + m * 16) * 1024 + col0 + bj * HALF);
        float gp[2][8];
#pragma unroll
        for (int bj = 0; bj < 2; ++bj) { const f32x4 a = *(const f32x4*)(gpost + col0 + bj * HALF), b = *(const f32x4*)(gpost + col0 + bj * HALF + 4);
            gp[bj][0] = a[0]; gp[bj][1] = a[1]; gp[bj][2] = a[2]; gp[bj][3] = a[3]; gp[bj][4] = b[0]; gp[bj][5] = b[1]; gp[bj][6] = b[2]; gp[bj][7] = b[3]; }
#pragma unroll
        for (int ai = 0; ai < 2; ++ai)
#pragma unroll
            for (int m = 0; m < 4; ++m) { f32x2 s2v = {0.f, 0.f};
#pragma unroll
                for (int bj = 0; bj < 2; ++bj)
#pragma unroll
                    for (int n = 0; n < 2; ++n) { const f32x2 a0 = {acc[ai][bj][m][n][0], acc[ai][bj][m][n][1]}, a1 = {acc[ai][bj][m][n][2], acc[ai][bj][m][n][3]}; s2v += a0 * a0; s2v += a1 * a1; }
                float s = s2v[0] + s2v[1];
                s += epi_xor16(s); s += epi_xor32(s, lane);
                if (fq == 0) scr[wc * 256 + ai * HALF + wr * 64 + m * 16 + fr] = s; }
        asm volatile("s_waitcnt lgkmcnt(0)" ::: "memory"); __builtin_amdgcn_s_barrier(); asm volatile("" ::: "memory");
        if (tid < 256) {
            const float tot = (scr[tid] + scr[256 + tid]) + (scr[512 + tid] + scr[768 + tid]);
            const size_t gi = (size_t)(u.pm * BM + tid) * 4;
            __hip_atomic_store(PFc + gi + u.pn, __builtin_bit_cast(unsigned, tot) | 0x80000000u, __ATOMIC_RELAXED, __HIP_MEMORY_SCOPE_AGENT);
            __hip_atomic_store(PFz + gi + u.pn, 0u, __ATOMIC_RELAXED, __HIP_MEMORY_SCOPE_AGENT);
            unsigned w0, w1, w2, w3, sp = 0u;
            for (;;) {
                w0 = __hip_atomic_load(PFc + gi + 0, __ATOMIC_RELAXED, __HIP_MEMORY_SCOPE_AGENT); w1 = __hip_atomic_load(PFc + gi + 1, __ATOMIC_RELAXED, __HIP_MEMORY_SCOPE_AGENT);
                w2 = __hip_atomic_load(PFc + gi + 2, __ATOMIC_RELAXED, __HIP_MEMORY_SCOPE_AGENT); w3 = __hip_atomic_load(PFc + gi + 3, __ATOMIC_RELAXED, __HIP_MEMORY_SCOPE_AGENT);
                if ((w0 != 0u) & (w1 != 0u) & (w2 != 0u) & (w3 != 0u)) break;
                __builtin_amdgcn_s_sleep(2);
                if (++sp > (1u << 20)) break;
            }
            const float ssum = (__builtin_bit_cast(float, w0 & 0x7fffffffu) + __builtin_bit_cast(float, w1 & 0x7fffffffu)) + (__builtin_bit_cast(float, w2 & 0x7fffffffu) + __builtin_bit_cast(float, w3 & 0x7fffffffu));
            float eps = 1e-6f; asm volatile("" : "+s"(eps));
            scr[1024 + tid] = cpost * __builtin_amdgcn_rsqf(ssum * (1.0f / 1024.0f) + eps);
        }
        asm volatile("s_waitcnt lgkmcnt(0)" ::: "memory"); __builtin_amdgcn_s_barrier(); asm volatile("" ::: "memory");
#pragma unroll
        for (int ai = 0; ai < 2; ++ai) {
            if (ai == 1) {
#pragma unroll
                for (int m = 0; m < 4; ++m)
#pragma unroll
                    for (int bj = 0; bj < 2; ++bj) xa[m][bj] = *(const u32x4*)(XB + (size_t)(row0 + HALF + m * 16) * 1024 + col0 + bj * HALF); }
#pragma unroll
            for (int m = 0; m < 4; ++m) { const int row = row0 + ai * HALF + m * 16; const float rF = scr[1024 + (row & 255)]; f32x2 s2p = {0.f, 0.f};
#pragma unroll
                for (int bj = 0; bj < 2; ++bj) { const u32x4 xw = xa[m][bj]; float o[8];
#pragma unroll
                    for (int n = 0; n < 2; ++n)
#pragma unroll
                        for (int e = 0; e < 4; e += 2) { const int q = n * 4 + e; const unsigned w = xw[q >> 1];
                            const f32x2 xv = {__builtin_bit_cast(float, w << 16), __builtin_bit_cast(float, w & 0xffff0000u)}, av = {acc[ai][bj][m][n][e], acc[ai][bj][m][n][e + 1]}, gv = {gp[bj][q], gp[bj][q + 1]};
                            const f32x2 ov = xv + av * (gv * rF); s2p += ov * ov; o[q] = ov[0]; o[q + 1] = ov[1]; }
                    if (OUT) { float* op = OUT + (size_t)row * 1024 + col0 + bj * HALF;
                        __builtin_nontemporal_store((f32x4){o[0], o[1], o[2], o[3]}, (f32x4*)op); __builtin_nontemporal_store((f32x4){o[4], o[5], o[6], o[7]}, (f32x4*)(op + 4)); }
                    else { u32x4 w; w.x = cvt_pk_bf16(o[0], o[1]); w.y = cvt_pk_bf16(o[2], o[3]); w.z = cvt_pk_bf16(o[4], o[5]); w.w = cvt_pk_bf16(o[6], o[7]);
                        *(u32x4*)(XB + (size_t)row * 1024 + col0 + bj * HALF) = w; } }
                float s2 = s2p[0] + s2p[1];
                s2 += epi_xor16(s2); s2 += epi_xor32(s2, lane);
                if (fq == 0) scr[wc * 256 + (row & 255)] = s2; }
        }
        asm volatile("s_waitcnt lgkmcnt(0)" ::: "memory"); __builtin_amdgcn_s_barrier(); asm volatile("" ::: "memory");
        if (tid < 256) RS4[(size_t)(u.pm * BM + tid) * 4 + u.pn] = (scr[tid] + scr[256 + tid]) + (scr[512 + tid] + scr[768 + tid]);
    }
};

struct EpiVT {
    static constexpr bool PERM = true, AFTER_DRAIN = false;
    bf16_t* O; int ldc; int ldil; const PG8_LAS float* tab;
    __device__ __forceinline__ void operator()(const f32x4 (&acc)[2][2][4][2], const Unit& u, int wr, int wc, int fr, int fq) const {
        const int lper = 8 - ldil, per = 1 << lper, Ls = 2048 >> ldil, b = u.pn >> 3, pl = u.pn & 7;
        const int row0 = u.pm * BM + wr * 64 + fr;
        int colb[2]; float cs[2][8];
#pragma unroll
        for (int bj = 0; bj < 2; ++bj) { const int c0 = bj * HALF + wc * 32 + 8 * fq; colb[bj] = b * 2048 + (c0 >> lper) * Ls + pl * per + (c0 & (per - 1));
            const f32x4 a = *(const PG8_LAS f32x4*)(tab + u.idx * 256 + c0), b4 = *(const PG8_LAS f32x4*)(tab + u.idx * 256 + c0 + 4);
            cs[bj][0] = a[0]; cs[bj][1] = a[1]; cs[bj][2] = a[2]; cs[bj][3] = a[3]; cs[bj][4] = b4[0]; cs[bj][5] = b4[1]; cs[bj][6] = b4[2]; cs[bj][7] = b4[3]; }
#pragma unroll
        for (int ai = 0; ai < 2; ++ai)
#pragma unroll
            for (int m = 0; m < 4; ++m) { bf16_t* rowp = O + (size_t)(row0 + ai * HALF + m * 16) * ldc;
#pragma unroll
                for (int bj = 0; bj < 2; ++bj) { const f32x4 v0 = acc[ai][bj][m][0], v1 = acc[ai][bj][m][1];
                    u32x4 w; w.x = cvt_pk_bf16(v0[0] * cs[bj][0], v0[1] * cs[bj][1]); w.y = cvt_pk_bf16(v0[2] * cs[bj][2], v0[3] * cs[bj][3]); w.z = cvt_pk_bf16(v1[0] * cs[bj][4], v1[1] * cs[bj][5]); w.w = cvt_pk_bf16(v1[2] * cs[bj][6], v1[3] * cs[bj][7]);
                    *(u32x4*)(rowp + colb[bj]) = w; } }
    }
};
template <class Epi, class Sched, bool ALIGN_EPI = false, bool SP2 = false>
__device__ __forceinline__ void gemm_phase(PG8_LAS unsigned char* lds, const Gemm g, const Sched& S, const Epi& E, const int tid) {
    const int wid = __builtin_amdgcn_readfirstlane(tid >> 6), lane = tid & 63, wr = wid >> 2, wc = wid & 3, fr = lane & 15, fq = lane >> 4;
    const int K = g.K, nt = K / BK;
    unsigned voffA[2], voffB[2], voffB1[2];
#pragma unroll
    for (int i = 0; i < 2; ++i) { int R, C; stage_rc(tid * 16 + i * 8192, R, C); const int Rb = Epi::PERM ? ((R & ~31) + perm32(R & 31)) : R;
        voffA[i] = (unsigned)(R * K + C) * 2u; { const int ld = g.ldil, lper = 8 - ld, pm1 = (1 << lper) - 1; const int c0 = Rb, c1 = 128 + Rb; voffB[i] = (unsigned)((((c0 & pm1) << ld) + (c0 >> lper)) * K + C) * 2u; voffB1[i] = (unsigned)((((c1 & pm1) << ld) + (c1 >> lper)) * K + C) * 2u; } }
    const size_t kstep = (size_t)(BK * 2);
    const size_t hstep = (size_t)HALF * K * 2;
    const size_t tstep = 2 * hstep;
    const unsigned ldsw = (unsigned)wid * 1024u;
    const int aoff = lds_byte(wr * 64 + fr, fq * 8), boff = lds_byte(wc * 32 + fr, fq * 8);
#define PG8_SA(b, h) (((b) * 2 + (h)) * HTB)
#define PG8_SB(b, h) ((4 + (b) * 2 + (h)) * HTB)
#define PG8_STAGE(bufoff, gbase, voff) do { _Pragma("unroll") for (int _i = 0; _i < 2; ++_i) \
        __builtin_amdgcn_global_load_lds((const unsigned*)((const char*)(gbase) + (voff)[_i]), (PG8_LAS unsigned*)(lds + (bufoff) + ldsw + _i * 8192), 16, 0, 0); } while (0)
#define PG8_LDA(dst, b, h) do { _Pragma("unroll") for (int m = 0; m < 4; ++m) _Pragma("unroll") for (int k = 0; k < 2; ++k) dst[m][k] = *(const PG8_LAS bf16x8*)(lds + PG8_SA(b, h) + aoff + m * 2048 + k * 1024); } while (0)
#define PG8_LDB(dst, b, h) do { _Pragma("unroll") for (int n = 0; n < 2; ++n) _Pragma("unroll") for (int k = 0; k < 2; ++k) dst[n][k] = *(const PG8_LAS bf16x8*)(lds + PG8_SB(b, h) + boff + n * 2048 + k * 1024); } while (0)
#define PG8_MMA(ai, bj, At, Bt) do { __builtin_amdgcn_s_setprio(1); _Pragma("unroll") for (int m = 0; m < 4; ++m) _Pragma("unroll") for (int n = 0; n < 2; ++n) _Pragma("unroll") for (int k = 0; k < 2; ++k) \
        acc[ai][bj][m][n] = __builtin_amdgcn_mfma_f32_16x16x32_bf16(Bt[n][k], At[m][k], acc[ai][bj][m][n], 0, 0, 0); __builtin_amdgcn_s_setprio(0); } while (0)
#define PG8_WAIT_V(n) asm volatile("s_waitcnt vmcnt(" #n ")" ::: "memory")
#define PG8_WAIT_L(n) asm volatile("s_waitcnt lgkmcnt(" #n ")" ::: "memory")
#define PG8_BAR __builtin_amdgcn_s_barrier()
#define PG8_SCHED __builtin_amdgcn_sched_barrier(0)
    Unit cur, nxt; int ui = 0;
    if (!S.next(0, cur)) return;
    f32x4 acc[2][2][4][2];
#pragma unroll
    for (int a = 0; a < 2; ++a)
#pragma unroll
        for (int b = 0; b < 2; ++b)
#pragma unroll
            for (int m = 0; m < 4; ++m)
#pragma unroll
                for (int n = 0; n < 2; ++n) acc[a][b][m][n] = (f32x4){0.f, 0.f, 0.f, 0.f};
    bf16x8 At[4][2], B0[2][2], B1[2][2];
    const char* cA = (const char*)g.A + (size_t)cur.pm * tstep; const char* cB = (const char*)g.Bt + (size_t)cur.pn * tstep;
    S.a_ready(cur);
    if constexpr (SP2) {
        PG8_STAGE(PG8_SB(0, 0), cB, voffB); PG8_STAGE(PG8_SB(0, 1), cB, voffB1); PG8_STAGE(PG8_SA(0, 0), cA, voffA); PG8_STAGE(PG8_SA(0, 1), cA + hstep, voffA);
        if (wr == 1) PG8_BAR;
        PG8_WAIT_V(2); PG8_BAR;
        PG8_STAGE(PG8_SB(1, 0), cB + kstep, voffB); PG8_STAGE(PG8_SA(1, 0), cA + kstep, voffA); PG8_STAGE(PG8_SB(1, 1), cB + kstep, voffB1);
        PG8_WAIT_V(6); PG8_BAR;
    } else {
        PG8_STAGE(PG8_SB(0, 0), cB, voffB); PG8_STAGE(PG8_SA(0, 0), cA, voffA); PG8_STAGE(PG8_SB(0, 1), cB, voffB1); PG8_STAGE(PG8_SA(0, 1), cA + hstep, voffA);
        if (wr == 1) PG8_BAR;
        PG8_WAIT_V(4); PG8_BAR;
        PG8_STAGE(PG8_SB(1, 0), cB + kstep, voffB); PG8_STAGE(PG8_SA(1, 0), cA + kstep, voffA); PG8_STAGE(PG8_SB(1, 1), cB + kstep, voffB1);
        PG8_WAIT_V(6); PG8_BAR;
    }
    for (;;) {
        const bool has_next = S.next(ui + 1, nxt);
        const char* nA = has_next ? (const char*)g.A + (size_t)nxt.pm * tstep : cA; const char* nB = has_next ? (const char*)g.Bt + (size_t)nxt.pn * tstep : cB;
        for (int t = 0; t < nt; t += 2) {
            const bool last = (t == nt - 2);
            const char* a1 = cA + (size_t)(t + 1) * kstep;
            const char* a2 = last ? nA : cA + (size_t)(t + 2) * kstep; const char* b2 = last ? nB : cB + (size_t)(t + 2) * kstep;
            const char* a3 = a2 + kstep; const char* b3 = b2 + kstep;
            if (last && has_next) S.a_ready(nxt);
            if constexpr (SP2) {
            PG8_LDB(B0, 0, 0); PG8_LDB(B1, 0, 1); PG8_SCHED; PG8_LDA(At, 0, 0); PG8_STAGE(PG8_SA(1, 1), a1 + hstep, voffA);
            PG8_WAIT_V(8); PG8_WAIT_L(0); PG8_BAR; PG8_MMA(0, 0, At, B0); PG8_MMA(0, 1, At, B1); PG8_BAR; PG8_SCHED;
            PG8_LDA(At, 0, 1); PG8_STAGE(PG8_SB(0, 0), b2, voffB); PG8_STAGE(PG8_SB(0, 1), b2, voffB1); PG8_STAGE(PG8_SA(0, 0), a2, voffA);
            PG8_WAIT_V(8); PG8_WAIT_L(0); PG8_BAR; PG8_MMA(1, 0, At, B0); PG8_MMA(1, 1, At, B1); PG8_BAR; PG8_SCHED;
            PG8_LDB(B0, 1, 0); PG8_LDB(B1, 1, 1); PG8_SCHED; PG8_LDA(At, 1, 0); PG8_STAGE(PG8_SA(0, 1), a2 + hstep, voffA);
            PG8_WAIT_V(8); PG8_WAIT_L(0); PG8_BAR; PG8_MMA(0, 0, At, B0); PG8_MMA(0, 1, At, B1); PG8_BAR; PG8_SCHED;
            PG8_LDA(At, 1, 1); PG8_STAGE(PG8_SB(1, 0), b3, voffB); PG8_STAGE(PG8_SB(1, 1), b3, voffB1); PG8_STAGE(PG8_SA(1, 0), a3, voffA);
            PG8_WAIT_V(8); PG8_WAIT_L(0); PG8_BAR; PG8_MMA(1, 0, At, B0); PG8_MMA(1, 1, At, B1); PG8_BAR; PG8_SCHED;
            } else {
            PG8_LDB(B0, 0, 0); PG8_SCHED; PG8_LDA(At, 0, 0); PG8_STAGE(PG8_SA(1, 1), a1 + hstep, voffA);
            PG8_WAIT_L(8); PG8_BAR; PG8_WAIT_L(0); PG8_MMA(0, 0, At, B0); PG8_BAR; PG8_SCHED;
            PG8_LDB(B1, 0, 1); PG8_STAGE(PG8_SB(0, 0), b2, voffB);
            PG8_BAR; PG8_WAIT_L(0); PG8_MMA(0, 1, At, B1); PG8_BAR;
            PG8_LDA(At, 0, 1); PG8_STAGE(PG8_SA(0, 0), a2, voffA);
            PG8_BAR; PG8_WAIT_L(0); PG8_MMA(1, 0, At, B0); PG8_BAR; PG8_SCHED;
            PG8_STAGE(PG8_SB(0, 1), b2, voffB1);
            PG8_WAIT_V(6); PG8_BAR; PG8_MMA(1, 1, At, B1); PG8_BAR;
            PG8_LDB(B0, 1, 0); PG8_SCHED; PG8_LDA(At, 1, 0); PG8_STAGE(PG8_SA(0, 1), a2 + hstep, voffA);
            PG8_WAIT_L(8); PG8_BAR; PG8_WAIT_L(0); PG8_MMA(0, 0, At, B0); PG8_BAR; PG8_SCHED;
            PG8_LDB(B1, 1, 1); PG8_STAGE(PG8_SB(1, 0), b3, voffB);
            PG8_BAR; PG8_WAIT_L(0); PG8_MMA(0, 1, At, B1); PG8_BAR;
            PG8_LDA(At, 1, 1); PG8_STAGE(PG8_SA(1, 0), a3, voffA);
            PG8_BAR; PG8_WAIT_L(0); PG8_MMA(1, 0, At, B0); PG8_BAR; PG8_SCHED;
            PG8_STAGE(PG8_SB(1, 1), b3, voffB1);
            PG8_WAIT_V(6); PG8_BAR; PG8_MMA(1, 1, At, B1); PG8_BAR;
            }
        }
        if constexpr (ALIGN_EPI) { if (wr == 0) PG8_BAR; }
        if constexpr (!Epi::AFTER_DRAIN) { E(acc, cur, wr, wc, fr, fq); S.done(cur); }
        if (!has_next) break;
#pragma unroll
        for (int a = 0; a < 2; ++a)
#pragma unroll
            for (int b = 0; b < 2; ++b)
#pragma unroll
                for (int m = 0; m < 4; ++m)
#pragma unroll
                    for (int n = 0; n < 2; ++n) acc[a][b][m][n] = (f32x4){0.f, 0.f, 0.f, 0.f};
        cur = nxt; cA = nA; cB = nB; ++ui;
        if constexpr (ALIGN_EPI) { if (wr == 1) PG8_BAR; }
    }
    PG8_WAIT_V(0);
    if constexpr (!ALIGN_EPI) { if (wr == 0) PG8_BAR; }
    PG8_BAR;
    if constexpr (Epi::AFTER_DRAIN) { E.fused(acc, cur, wr, wc, fr, fq, lds, wid, lane); S.done(cur); }
#undef PG8_SA
#undef PG8_SB
#undef PG8_STAGE
#undef PG8_LDA
#undef PG8_LDB
#undef PG8_MMA
#undef PG8_WAIT_V
#undef PG8_WAIT_L
#undef PG8_BAR
#undef PG8_SCHED
}
}

constexpr int BATCH = 16, SEQ = 2048, D = 1024, M = BATCH * SEQ, DEPTH = 4, DFF = 2816;
constexpr int NGRP = 3, HA = 16, DHA = 64, ATT_COLS = 3 * D;
constexpr int HR = 4, DKR = 256, DVR = 512, DV = HR * DVR, RET_COLS = 2 * D + 3 * DV;
constexpr int MH = M / 2;
constexpr float NORM_EPS = 1e-6f;
constexpr int NWAVES = 8, NTHREADS = NWAVES * 64;
constexpr int NPHASES = 1 + (DEPTH / 2) * (11 + 9);

__device__ const unsigned char T5_BUCKET[3][129] = {
{11,11,11,11,11,11,11,11,11,11,11,11,11,11,11,10,10,10,10,10,10,10,10,10,10,10,10,10,10,10,10,10,10,10,10,10,10,10,9,9,9,9,9,9,9,9,9,9,9,9,8,8,8,8,8,8,8,7,6,5,4,3,2,1,0,17,18,19,20,21,22,23,24,24,24,24,24,24,24,25,25,25,25,25,25,25,25,25,25,25,25,26,26,26,26,26,26,26,26,26,26,26,26,26,26,26,26,26,26,26,26,26,26,26,27,27,27,27,27,27,27,27,27,27,27,27,27,27,27},
{13,13,13,13,13,13,13,13,13,13,13,13,13,13,13,13,13,13,13,13,13,13,13,12,12,12,12,12,12,12,12,12,12,12,12,12,12,12,12,12,12,12,11,11,11,11,11,11,11,11,11,11,10,10,10,10,10,10,9,9,9,8,8,4,0,20,24,24,25,25,25,26,26,26,26,26,26,27,27,27,27,27,27,27,27,27,27,28,28,28,28,28,28,28,28,28,28,28,28,28,28,28,28,28,28,28,29,29,29,29,29,29,29,29,29,29,29,29,29,29,29,29,29,29,29,29,29,29,29},
{15,15,15,15,15,15,15,15,15,15,15,15,15,15,15,15,15,15,15,15,15,15,15,15,15,15,15,15,15,15,14,14,14,14,14,14,14,14,14,14,14,14,14,14,14,13,13,13,13,13,13,13,13,13,12,12,12,12,12,11,11,10,10,9,0,25,26,26,27,27,28,28,28,28,28,29,29,29,29,29,29,29,29,29,30,30,30,30,30,30,30,30,30,30,30,30,30,30,30,31,31,31,31,31,31,31,31,31,31,31,31,31,31,31,31,31,31,31,31,31,31,31,31,31,31,31,31,31,31}};

constexpr size_t MiB = 1u << 20;
constexpr size_t WS_CTL = 0;
constexpr size_t WS_PF = 64 * 1024;
constexpr size_t CTL_ZERO_BYTES = WS_PF + (size_t)2 * M * 4 * 4;
constexpr size_t WS_BIAS = 1 * MiB + 256 * 1024;
constexpr size_t WS_RS = 1 * MiB + 512 * 1024;
constexpr size_t WS_W = 2 * MiB;
constexpr size_t WS_W2A = WS_W + 18 * MiB, WS_W2B = 540 * MiB;
static_assert(CTL_ZERO_BYTES <= WS_BIAS && WS_BIAS + 3 * 16 * 129 * 4 <= WS_RS && WS_RS + (size_t)M * 16 == WS_W, "low d_ws map");
constexpr size_t WS_XH = 26 * MiB;
constexpr size_t WS_YC = 90 * MiB;
constexpr size_t WS_BIG = 218 * MiB;
constexpr size_t WS_F = 410 * MiB;
constexpr size_t WS_RVT = 346 * MiB;
constexpr size_t WS_OACC = 474 * MiB;
constexpr size_t WS_LSE = 538 * MiB;
constexpr size_t WS_END = 546 * MiB;
static_assert((size_t)NGRP * ATT_COLS * D * 2 <= 18 * MiB && (size_t)RET_COLS * D * 2 <= 18 * MiB && (size_t)2 * DFF * D * 2 <= 18 * MiB && WS_W2A + (size_t)D * DFF * 2 <= WS_XH && WS_W2B + (size_t)D * DFF * 2 <= WS_END, "weight regions");
constexpr int RP_COLS = 2 * D + 2 * DV;
static_assert(WS_XH + (size_t)M * D * 2 == WS_YC && WS_YC + (size_t)M * DV * 2 == WS_BIG && WS_BIG + (size_t)MH * RP_COLS * 2 == WS_F && WS_BIG + (size_t)M * 2 * D * 2 == WS_RVT && WS_RVT + (size_t)DV * M * 2 == WS_OACC && WS_F + (size_t)M * D * 2 == WS_OACC && WS_OACC + (size_t)M * D * 2 == WS_LSE, "d_ws map");
static_assert((size_t)M * DFF * 2 <= 192 * MiB && (size_t)M * ATT_COLS * 2 <= 192 * MiB && WS_LSE + (size_t)M * 16 * 4 <= WS_END, "d_ws map");
constexpr int CW_BAR = 4096;

constexpr int RING_OFF = 0, RING_BYTES = 149504;
constexpr int LDSCTL_OFF = RING_BYTES, MISC_OFF = LDSCTL_OFF + 320;
constexpr int LDS_BYTES = RING_BYTES + 512 + (PROBE_TSEL ? 64 : 0);
static_assert(MISC_OFF + 128 <= LDS_BYTES, "LDS map");

#define LAS __attribute__((address_space(3)))
typedef unsigned short bf16;
typedef unsigned v4u __attribute__((ext_vector_type(4)));
typedef unsigned v2u __attribute__((ext_vector_type(2)));
typedef float f32x4 __attribute__((ext_vector_type(4)));
#define LDS_WAIT() asm volatile("s_waitcnt lgkmcnt(0)" ::: "memory")
__device__ __forceinline__ unsigned f2bf(float f) { unsigned u = __builtin_bit_cast(unsigned, f); return (u + 0x7fffu + ((u >> 16) & 1u)) >> 16; }
__device__ __forceinline__ unsigned pk2(float lo, float hi) { return f2bf(lo) | (f2bf(hi) << 16); }
__device__ __forceinline__ float bflo(unsigned w) { return __builtin_bit_cast(float, w << 16); }
__device__ __forceinline__ float bfhi(unsigned w) { return __builtin_bit_cast(float, w & 0xffff0000u); }
__device__ __forceinline__ float opaque_f(float c) { float v = c; asm volatile("" : "+s"(v)); return v; }
template <int O> __device__ __forceinline__ float swz_xor(float v) { return __builtin_bit_cast(float, __builtin_amdgcn_ds_swizzle(__builtin_bit_cast(int, v), (O << 10) | 0x1f)); }
__device__ __forceinline__ float wave_sum(float v) {
    v += swz_xor<1>(v); v += swz_xor<2>(v); v += swz_xor<4>(v); v += swz_xor<8>(v); v += swz_xor<16>(v);
    return __builtin_bit_cast(float, __builtin_amdgcn_readlane(__builtin_bit_cast(int, v), 0)) + __builtin_bit_cast(float, __builtin_amdgcn_readlane(__builtin_bit_cast(int, v), 32));
}
__device__ __forceinline__ float get_xor32(float v, int lane) { return __builtin_bit_cast(float, __builtin_amdgcn_ds_bpermute((lane ^ 32) << 2, __builtin_bit_cast(int, v))); }

#define XB_TMO      128
#define XB_XCNT(j)  (256  + 64 * (j))
#define XB_XSUB(j)  (1280 + 64 * (j))
#define XB_XGEN(j)  (2304 + 64 * (j))
#define XB_TOP      3328
#define XB_TOPGEN   3392
#define XCD_BAR_WORDS 3456
#define XB_SPIN_CAP (1u << 18)

__device__ __forceinline__ unsigned xb_ld(unsigned* p)              { return __hip_atomic_load(p, __ATOMIC_RELAXED, __HIP_MEMORY_SCOPE_AGENT); }
__device__ __forceinline__ unsigned xb_add(unsigned* p, unsigned v) { return __hip_atomic_fetch_add(p, v, __ATOMIC_RELAXED, __HIP_MEMORY_SCOPE_AGENT); }
__device__ __forceinline__ unsigned xb_xcc_id() { return (unsigned)__builtin_amdgcn_s_getreg((3 << 11) | 20) & 0xFu; }
#define XB_SPIN(cond, bar) do { unsigned _sp = 0; while (cond) { __builtin_amdgcn_s_sleep(1); \
    if ((++_sp & 255u) == 0u) { if (xb_ld(&(bar)[XB_TMO])) break; if (_sp > XB_SPIN_CAP) { atomicAdd(&(bar)[XB_TMO], 1u); break; } } } } while (0)

struct XcdBarrier {
    unsigned* bar; unsigned x;
    volatile LAS unsigned* st;
};

__device__ __forceinline__ XcdBarrier xcd_barrier_post(unsigned* bar, volatile LAS unsigned* st) {
    XcdBarrier b; b.bar = bar; b.x = xb_xcc_id(); b.st = st;
    if (threadIdx.x == 0) (void)xb_add(&bar[XB_XCNT(b.x)], 1u);
    return b;
}
__device__ __forceinline__ void xcd_barrier_complete(unsigned* bar, unsigned x, unsigned& nloc, unsigned& nx) {
    const unsigned G = gridDim.x * gridDim.y * gridDim.z;
    unsigned sum, cnt, mine, sp = 0u;
    for (;;) {
        sum = 0u; cnt = 0u; mine = 0u;
#pragma unroll
        for (unsigned j = 0; j < 16; ++j) { const unsigned c = xb_ld(&bar[XB_XCNT(j)]); sum += c; cnt += (c > 0u) ? 1u : 0u; mine = (j == x) ? c : mine; }
        if (sum == G) break;
        __builtin_amdgcn_s_sleep(1);
        if ((++sp & 255u) == 0u) { if (xb_ld(&bar[XB_TMO])) break; if (sp > XB_SPIN_CAP) { atomicAdd(&bar[XB_TMO], 1u); break; } }
    }
    nloc = mine > 0u ? mine : 1u; nx = cnt > 0u ? cnt : 1u;
}

__device__ __forceinline__ void xcd_barrier(const XcdBarrier& b) {
    asm volatile("s_waitcnt vmcnt(0)" ::: "memory");
    __syncthreads();
    if (threadIdx.x == 0) {
        unsigned* bar = b.bar;
        __builtin_amdgcn_s_waitcnt(0);
        unsigned nloc = b.st[0], nx = b.st[1];
        if (nloc == 0u) { xcd_barrier_complete(bar, b.x, nloc, nx); b.st[0] = nloc; b.st[1] = nx; }
        const unsigned old = xb_add(&bar[XB_XSUB(b.x)], 1u);
        const unsigned gen = old / nloc;
        if (old + 1u == (gen + 1u) * nloc) {
            __builtin_amdgcn_fence(__ATOMIC_RELEASE, "agent");
            asm volatile("s_waitcnt vmcnt(0)" ::: "memory");
            const unsigned og = xb_add(&bar[XB_TOP], 1u);
            const unsigned tg = og / nx;
            if (og + 1u == (tg + 1u) * nx) xb_add(&bar[XB_TOPGEN], 1u);
            else XB_SPIN(xb_ld(&bar[XB_TOPGEN]) == tg, bar);
            __builtin_amdgcn_fence(__ATOMIC_ACQUIRE, "agent");
            xb_add(&bar[XB_XGEN(b.x)], 1u);
            asm volatile("s_waitcnt vmcnt(0)" ::: "memory");
        } else {
            XB_SPIN(xb_ld(&bar[XB_XGEN(b.x)]) == gen, bar);
            __builtin_amdgcn_fence(__ATOMIC_ACQUIRE, "agent");
            asm volatile("s_waitcnt vmcnt(0)" ::: "memory");
        }
    }
    __syncthreads();
}


constexpr int CV_KR = 32, CV_SCR = 64 * 65 * 4;
struct CvItem { const float* src; int srcN, k0; bf16* dst; int dstK; };
__device__ __forceinline__ void conv_load(const CvItem& I, f32x4 (&v)[CV_KR / 4], int lane) {
    const float* src = I.src + (size_t)(lane >> 4) * I.srcN + (lane & 15) * 4;
#pragma unroll
    for (int i = 0; i < CV_KR / 4; ++i) v[i] = __builtin_nontemporal_load((const f32x4*)(src + (size_t)(4 * i) * I.srcN));
}
__device__ __forceinline__ void conv_store(const CvItem& I, const f32x4 (&v)[CV_KR / 4], const float* gain, LAS float* scr, int lane) {
    { LAS float* d = scr + (lane >> 4) * 65 + (lane & 15) * 4;
#pragma unroll
      for (int i = 0; i < CV_KR / 4; ++i) { d[4 * i * 65 + 0] = v[i].x; d[4 * i * 65 + 1] = v[i].y; d[4 * i * 65 + 2] = v[i].z; d[4 * i * 65 + 3] = v[i].w; } }
    LDS_WAIT(); asm volatile("" ::: "memory");
    constexpr int NPC = CV_KR / 8;
    const int c = lane & (NPC - 1);
    float gk[8];
#pragma unroll
    for (int i = 0; i < 8; ++i) gk[i] = gain ? gain[I.k0 + 8 * c + i] : 1.0f;
#pragma unroll
    for (int j = 0; j < NPC; ++j) { const int n = lane / NPC + (64 / NPC) * j; const LAS float* s = scr + (8 * c) * 65 + n;
        v4u o; o.x = pk2(s[0 * 65] * gk[0], s[1 * 65] * gk[1]); o.y = pk2(s[2 * 65] * gk[2], s[3 * 65] * gk[3]); o.z = pk2(s[4 * 65] * gk[4], s[5 * 65] * gk[5]); o.w = pk2(s[6 * 65] * gk[6], s[7 * 65] * gk[7]);
        *(v4u*)(I.dst + (size_t)n * I.dstK + I.k0 + 8 * c) = o; }
    LDS_WAIT(); asm volatile("" ::: "memory");
}
template <class Dec> __device__ __forceinline__ void conv_run(const Dec& dec, int nitems, const float* gain, LAS float* scr, int gw, int NGW, int lane) {
    int it = gw; if (it >= nitems) return;
    f32x4 va[CV_KR / 4], vb[CV_KR / 4];
    conv_load(dec.item(it), va, lane);
    for (;;) {
        const int it2 = it + NGW; const bool m2 = it2 < nitems;
        if (m2) conv_load(dec.item(it2), vb, lane);
        conv_store(dec.item(it), va, gain, scr, lane); if (!m2) break;
        const int it3 = it2 + NGW; const bool m3 = it3 < nitems;
        if (m3) conv_load(dec.item(it3), va, lane);
        conv_store(dec.item(it2), vb, gain, scr, lane); if (!m3) break;
        it = it3;
    }
}
template <int K, int N, int NC> struct CvCols { const float* W; int c0; bf16* WT; int r0;
    __device__ __forceinline__ CvItem item(int it) const { constexpr int nblk = NC / 64; const int kb = it / nblk, nb = it % nblk, k0 = CV_KR * kb;
        return CvItem{W + (size_t)k0 * N + c0 + 64 * nb, N, k0, WT + (size_t)(r0 + 64 * nb) * K, K}; } };
template <int K, int N, int NC> __device__ __forceinline__ void conv_cols(const float* W, int c0, bf16* WT, int r0, const float* gain, LAS float* scr, int gw, int NGW, int lane) {
    conv_run(CvCols<K, N, NC>{W, c0, WT, r0}, (K / CV_KR) * (NC / 64), gain, scr, gw, NGW, lane);
}
template <int K, int N> __device__ __forceinline__ void conv_plain(const float* W, bf16* WT, const float* gain, LAS float* scr, int gw, int NGW, int lane) { conv_cols<K, N, N>(W, 0, WT, 0, gain, scr, gw, NGW, lane); }
struct CvGateUp { const float* Wg; long dgu; bf16* WT;
    __device__ __forceinline__ CvItem item(int it) const { constexpr int nblk = 2 * DFF / 64; const int kb = it / nblk, nb = it % nblk, k0 = CV_KR * kb, n0 = 64 * nb, pn = n0 >> 8, bj = (n0 >> 7) & 1, c0 = n0 & 127;
        return CvItem{Wg + (bj ? dgu : 0l) + (size_t)k0 * DFF + 128 * pn + c0, DFF, k0, WT + (size_t)n0 * D, D}; } };
__device__ __forceinline__ void conv_gateup(const float* Wg, const float* Wu, bf16* WT, const float* gain, LAS float* scr, int gw, int NGW, int lane) {
    conv_run(CvGateUp{Wg, (long)(Wu - Wg), WT}, (D / CV_KR) * (2 * DFF / 64), gain, scr, gw, NGW, lane);
}

template <int N> struct CvGates { const float* W; int c_f, c_b; bf16* WT; int r0;
    __device__ __forceinline__ CvItem item(int it) const { constexpr int nblk = 2 * DV / 64; const int kb = it / nblk, nb = it % nblk, k0 = CV_KR * kb, n0 = 64 * nb, pn = n0 >> 8, bj = (n0 >> 7) & 1, c0 = n0 & 127;
        return CvItem{W + (size_t)k0 * N + (bj ? c_b : c_f) + 128 * pn + c0, N, k0, WT + (size_t)(r0 + n0) * D, D}; } };
template <int N> __device__ __forceinline__ void conv_gates(const float* W, int c_f, int c_b, bf16* WT, int r0, const float* gain, LAS float* scr, int gw, int NGW, int lane) {
    conv_run(CvGates<N>{W, c_f, c_b, WT, r0}, (D / CV_KR) * (2 * DV / 64), gain, scr, gw, NGW, lane);
}
__device__ __forceinline__ void unpack8(const v4u w, float (&f)[8]) { f[0] = bflo(w.x); f[1] = bfhi(w.x); f[2] = bflo(w.y); f[3] = bfhi(w.y); f[4] = bflo(w.z); f[5] = bfhi(w.z); f[6] = bflo(w.w); f[7] = bfhi(w.w); }
__device__ __forceinline__ void p0_rows(const float* xin, bf16* XB, float* RS, int gw, int NGW, int lane) {
    for (int m = gw; m < M; m += NGW) {
        float ss = 0.f;
#pragma unroll
        for (int j = 0; j < 2; ++j) { const float* p = xin + (size_t)m * D + 512 * j + 8 * lane; const f32x4 a = __builtin_nontemporal_load((const f32x4*)p), b = __builtin_nontemporal_load((const f32x4*)(p + 4));
            ss += (a.x * a.x + a.y * a.y) + (a.z * a.z + a.w * a.w) + (b.x * b.x + b.y * b.y) + (b.z * b.z + b.w * b.w);
            v4u w; w.x = pk2(a.x, a.y); w.y = pk2(a.z, a.w); w.z = pk2(b.x, b.y); w.w = pk2(b.z, b.w); *(v4u*)(XB + (size_t)m * D + 512 * j + 8 * lane) = w; }
        ss = wave_sum(ss);
        if (lane == 0) *(f32x4*)(RS + 4 * (size_t)m) = (f32x4){ss, 0.f, 0.f, 0.f};
    }
}

typedef float f32x16 __attribute__((ext_vector_type(16)));
typedef short bf16x8s __attribute__((ext_vector_type(8)));
typedef float f32x2_t __attribute__((ext_vector_type(2))); typedef __bf16 bf16x2_t __attribute__((ext_vector_type(2)));
__device__ __forceinline__ unsigned cvtpk(float lo, float hi) { f32x2_t v = {lo, hi}; bf16x2_t b = __builtin_convertvector(v, bf16x2_t); return __builtin_bit_cast(unsigned, b); }

constexpr int RQK = 2 * D;
constexpr int RC_ST = 0, RC_RG = 65536, RC_NSLOT = 5, RC_TB = RC_RG + RC_NSLOT * 16384, RC_LDS = RC_TB + 2048;
__device__ __forceinline__ int sl_swz(int ob) { return ob ^ (((ob >> 9) & 1) << 5); }
template <int VAR  >
__device__ __forceinline__ void ret_core_mfma(const bf16* P, const bf16* VT, const float* decay_logit  , bf16* YF, bf16* YB, float* PT, LAS unsigned char* lds, const int tid, const int bid, const int G) {
    typedef short bf16x8v __attribute__((ext_vector_type(8)));
    const int w = __builtin_amdgcn_readfirstlane(tid >> 6), lane = tid & 63, fr = lane & 15, fq = lane >> 4, wr = w >> 2, wc = w & 3;
#define RC_DMA(gptr, ldsoff) __builtin_amdgcn_global_load_lds((const unsigned*)(gptr), (LAS unsigned*)(lds + (ldsoff)), 16, 0, 0)
#define RC_WAITV(n) asm volatile("s_waitcnt vmcnt(" #n ")" ::: "memory")
#define RC_WAITL() asm volatile("s_waitcnt lgkmcnt(0)" ::: "memory")
#define RC_BAR() do { asm volatile("" ::: "memory"); __builtin_amdgcn_s_barrier(); asm volatile("" ::: "memory"); } while (0)
#define RC_MFMA(b, a, c) __builtin_amdgcn_mfma_f32_16x16x32_bf16((b), (a), (c), 0, 0, 0)
#define RC_NEXT(sl) ((sl) == RC_NSLOT - 1 ? 0 : (sl) + 1)
#define RC_PREV(sl) ((sl) == 0 ? RC_NSLOT - 1 : (sl) - 1)
    const int dob = sl_swz(lane * 16), drow = 16 * w + (dob >> 6), dcc = (dob & 63) >> 1;
    const int aoff = 4 * wr * 1024 + sl_swz(fr * 64 + fq * 16), boff = 2 * wc * 1024 + sl_swz(fr * 64 + fq * 16);
    for (int u = bid; u < 512; u += G) {
        const int xcd = u & 7, idx = u >> 3, es = idx & 3, cmb = (idx >> 2) * 8 + xcd, dir = cmb & 1, h = (cmb >> 1) & 3, bl = cmb >> 3;
        const float lg = __builtin_amdgcn_logf(1.0f - __builtin_amdgcn_exp2f(decay_logit[dir * HR + h] * 1.4426950409f));
        const float cdec = __builtin_amdgcn_exp2f(lg * 128.f);
        bf16* Y = dir ? YB : YF;
        const size_t rowbase = (size_t)bl * SEQ;
        const bf16* qsrc = P + (rowbase + drow) * RQK + h * DKR + dcc;
        const bf16* ksrc = qsrc + D;
        const int drowv = (drow & ~31) + 8 * ((drow & 15) >> 2) + 4 * ((drow >> 4) & 1) + (drow & 3);
        const bf16* vsrc = VT + (size_t)(h * DVR + es * 128 + drowv) * M + rowbase + dcc;
        const bf16* vown = VT + (size_t)(h * DVR + es * 128 + 16 * w + fr) * M + rowbase + 8 * fq;
        if (tid < 128) { LAS float* tb = (LAS float*)(lds + RC_TB); const float t = (float)tid;
            tb[tid] = __builtin_amdgcn_exp2f(lg * (dir ? t : 127.f - t)); tb[128 + tid] = __builtin_amdgcn_exp2f(lg * (dir ? -t : t));
            tb[256 + tid] = __builtin_amdgcn_exp2f(lg * (dir ? t : -t)); tb[384 + tid] = __builtin_amdgcn_exp2f(lg * (dir ? 128.f - t : t + 1.f)); }
        { const v4u z = (v4u){0u, 0u, 0u, 0u};
#pragma unroll
          for (int i = 0; i < 8; ++i) *(LAS v4u*)(lds + RC_ST + (i * NTHREADS + tid) * 16) = z; }
        f32x4 acc4[16];
#pragma unroll
        for (int n = 0; n < 16; ++n) acc4[n] = (f32x4){0.f, 0.f, 0.f, 0.f};
#define RC_ISSUE(st, tk, sl) do { if ((st) < 8) { const size_t to_ = (size_t)(tk) * RQK + 32 * (st); RC_DMA(qsrc + to_, RC_RG + (sl) * 16384 + w * 1024); RC_DMA(ksrc + to_, RC_RG + (sl) * 16384 + 8192 + w * 1024); } \
                                  else RC_DMA(vsrc + (tk) + 32 * ((st) - 8), RC_RG + (sl) * 16384 + w * 1024); } while (0)
        v4u vnx[4];
        { const int tok0 = dir ? 128 * 15 : 0;
#pragma unroll
          for (int js = 0; js < 4; ++js) vnx[js] = *(const v4u*)(vown + tok0 + 32 * js);
          RC_ISSUE(0, tok0, 0); RC_ISSUE(1, tok0, 1); RC_ISSUE(2, tok0, 2); RC_ISSUE(3, tok0, 3); }
        RC_WAITL(); RC_BAR();
        int slot = 0;
        for (int c = 0; c < 16; ++c) {
            const int tok0 = 128 * (dir ? 15 - c : c), tokn = 128 * (dir ? (c < 15 ? 14 - c : 0) : (c < 15 ? c + 1 : 15));
            float lgc = lg; int zo = 0; asm volatile("" : "+v"(lgc), "+v"(zo));
            int lc = lane; asm volatile("" : "+v"(lc)); const int frc = lc & 15, fqc = lc >> 4;
            bf16x8v Avs[4];
#pragma unroll
            for (int js = 0; js < 4; ++js) { const v4u kw = vnx[js]; float kd[8];
                { const LAS f32x4* kp = (const LAS f32x4*)(lds + RC_TB + (32 * js + 8 * fqc) * 4); const f32x4 k0 = kp[0], k1 = kp[1];
                  kd[0] = k0[0]; kd[1] = k0[1]; kd[2] = k0[2]; kd[3] = k0[3]; kd[4] = k1[0]; kd[5] = k1[1]; kd[6] = k1[2]; kd[7] = k1[3]; }
                v4u sw; sw.x = cvtpk(bflo(kw.x) * kd[0], bfhi(kw.x) * kd[1]); sw.y = cvtpk(bflo(kw.y) * kd[2], bfhi(kw.y) * kd[3]); sw.z = cvtpk(bflo(kw.z) * kd[4], bfhi(kw.z) * kd[5]); sw.w = cvtpk(bflo(kw.w) * kd[6], bfhi(kw.w) * kd[7]);
                Avs[js] = __builtin_bit_cast(bf16x8v, sw); }
#pragma unroll
            for (int n = 0; n < 16; ++n) acc4[n] = acc4[n] * cdec;
            const int jj = 8 * fqc + (frc >> 2);
            const unsigned trA = (unsigned)((jj >> 4) * 1024 + sl_swz((jj & 15) * 64 + 8 * (frc & 3))), trB = (unsigned)(((jj + 4) >> 4) * 1024 + sl_swz(((jj + 4) & 15) * 64 + 8 * (frc & 3)));
            f32x4 accA[4][2], accY[4][2];
#pragma unroll
            for (int m = 0; m < 4; ++m)
#pragma unroll
                for (int n = 0; n < 2; ++n) { accA[m][n] = (f32x4){0.f, 0.f, 0.f, 0.f}; accY[m][n] = (f32x4){0.f, 0.f, 0.f, 0.f}; }
#pragma unroll
            for (int ks = 0; ks < 8; ++ks) {
                if (ks < 4) { if (c == 0) RC_WAITV(6); else RC_WAITV(18); } else if (ks == 4) RC_WAITV(6); else if (ks == 5) RC_WAITV(5); else if (ks == 6) RC_WAITV(4); else RC_WAITV(3);
                RC_BAR();
                { const int s4 = RC_PREV(slot);
                  if (ks + 4 < 12) RC_ISSUE(ks + 4, tok0, s4); else RC_ISSUE(ks + 4 - 12, tokn, s4); }
                bf16x8v At[4], Bk[2], Bs[2];
                const LAS unsigned char* sq = lds + RC_RG + slot * 16384;
#pragma unroll
                for (int m = 0; m < 4; ++m) At[m] = *(const LAS bf16x8v*)(sq + aoff + m * 1024);
#pragma unroll
                for (int n = 0; n < 2; ++n) { Bk[n] = *(const LAS bf16x8v*)(sq + 8192 + boff + n * 1024); Bs[n] = *(const LAS bf16x8v*)(lds + RC_ST + ks * 8192 + boff + n * 1024); }
                RC_WAITL();
#pragma unroll
                for (int m = 0; m < 4; ++m)
#pragma unroll
                    for (int n = 0; n < 2; ++n) { accA[m][n] = RC_MFMA(Bk[n], At[m], accA[m][n]); accY[m][n] = RC_MFMA(Bs[n], At[m], accY[m][n]); }
                { const unsigned kb = (unsigned)(size_t)(sq + 8192);
#pragma unroll
                  for (int nl = 0; nl < 2; ++nl) { const unsigned a0 = kb + (trA ^ (nl << 5)), a1 = kb + (trB ^ (nl << 5));
                      v2u l0, h0, l1, h1, l2, h2, l3, h3;
                      asm volatile("ds_read_b64_tr_b16 %0, %8\n\tds_read_b64_tr_b16 %1, %9\n\tds_read_b64_tr_b16 %2, %8 offset:2048\n\tds_read_b64_tr_b16 %3, %9 offset:2048\n\t"
                                   "ds_read_b64_tr_b16 %4, %8 offset:4096\n\tds_read_b64_tr_b16 %5, %9 offset:4096\n\tds_read_b64_tr_b16 %6, %8 offset:6144\n\tds_read_b64_tr_b16 %7, %9 offset:6144\n\ts_waitcnt lgkmcnt(0)"
                                   : "=&v"(l0), "=&v"(h0), "=&v"(l1), "=&v"(h1), "=&v"(l2), "=&v"(h2), "=&v"(l3), "=&v"(h3) : "v"(a0), "v"(a1) : "memory");
                      acc4[2 * ks + nl] = RC_MFMA(__builtin_bit_cast(bf16x8v, ((v4u){l0.x, l0.y, h0.x, h0.y})), Avs[0], acc4[2 * ks + nl]);
                      acc4[2 * ks + nl] = RC_MFMA(__builtin_bit_cast(bf16x8v, ((v4u){l1.x, l1.y, h1.x, h1.y})), Avs[1], acc4[2 * ks + nl]);
                      acc4[2 * ks + nl] = RC_MFMA(__builtin_bit_cast(bf16x8v, ((v4u){l2.x, l2.y, h2.x, h2.y})), Avs[2], acc4[2 * ks + nl]);
                      acc4[2 * ks + nl] = RC_MFMA(__builtin_bit_cast(bf16x8v, ((v4u){l3.x, l3.y, h3.x, h3.y})), Avs[3], acc4[2 * ks + nl]); } }
                slot = RC_NEXT(slot);
            }
#pragma unroll
            for (int m = 0; m < 4; ++m)
#pragma unroll
                for (int n = 0; n < 2; ++n) { const int i = 64 * wr + 16 * m + frc;
                    const float qdf = *(const LAS float*)(lds + RC_TB + 1536 + i * 4), rwf = *(const LAS float*)(lds + RC_TB + 512 + i * 4);
                    const f32x4 clf = *(const LAS f32x4*)(lds + RC_TB + 1024 + (32 * wc + 16 * n + 4 * fqc) * 4);
                    accY[m][n] = accY[m][n] * qdf;
#pragma unroll
                    for (int ii = 0; ii < 4; ++ii) { const int j = 32 * wc + 16 * n + 4 * fqc + ii; const int dd = dir ? j - i : i - j;
                        accA[m][n][ii] = dd >= 0 ? accA[m][n][ii] * (rwf * clf[ii]) : 0.f; } }
            RC_BAR();
#pragma unroll
            for (int m = 0; m < 4; ++m)
#pragma unroll
                for (int n = 0; n < 2; ++n) { v2u pw; pw.x = cvtpk(accA[m][n][0], accA[m][n][1]); pw.y = cvtpk(accA[m][n][2], accA[m][n][3]);
                    *(LAS v2u*)(lds + RC_ST + wc * 8192 + (4 * wr + m) * 1024 + sl_swz(frc * 64 + (16 * n + 4 * fqc) * 2)) = pw; }
#pragma unroll
            for (int js = 0; js < 4; ++js) vnx[js] = *(const v4u*)(vown + tokn + 32 * js + zo);
            RC_WAITL();
#pragma unroll
            for (int js = 0; js < 4; ++js) {
                if (js == 0) RC_WAITV(7); else if (js == 1) RC_WAITV(8); else if (js == 2) RC_WAITV(9); else RC_WAITV(10);
                RC_BAR();
                { const int s4 = RC_PREV(slot); RC_ISSUE(js, tokn, s4); }
                bf16x8v At[4], Bv[2];
                const LAS unsigned char* sv = lds + RC_RG + slot * 16384;
#pragma unroll
                for (int m = 0; m < 4; ++m) At[m] = *(const LAS bf16x8v*)(lds + RC_ST + js * 8192 + aoff + m * 1024);
#pragma unroll
                for (int n = 0; n < 2; ++n) Bv[n] = *(const LAS bf16x8v*)(sv + boff + n * 1024);
                RC_WAITL();
#pragma unroll
                for (int m = 0; m < 4; ++m)
#pragma unroll
                    for (int n = 0; n < 2; ++n) accY[m][n] = RC_MFMA(Bv[n], At[m], accY[m][n]);
                slot = RC_NEXT(slot);
            }
#pragma unroll
            for (int m = 0; m < 4; ++m) { v4u pw; pw.x = cvtpk(accY[m][0][0], accY[m][0][1]); pw.y = cvtpk(accY[m][0][2], accY[m][0][3]); pw.z = cvtpk(accY[m][1][0], accY[m][1][1]); pw.w = cvtpk(accY[m][1][2], accY[m][1][3]);
                *(v4u*)(Y + (rowbase + tok0 + 64 * wr + 16 * m + frc + zo) * DV + h * DVR + es * 128 + 32 * wc + 8 * fqc) = pw; }
#pragma unroll
            for (int m = 0; m < 4; ++m) { float sv = 0.f, sq = 0.f;
#pragma unroll
                for (int n = 0; n < 2; ++n)
#pragma unroll
                    for (int ii = 0; ii < 4; ++ii) { const float yv = accY[m][n][ii]; sv += yv; sq += yv * yv; }
                sv += swz_xor<16>(sv); sq += swz_xor<16>(sq); sv += get_xor32(sv, lc); sq += get_xor32(sq, lc);
                float* sp = PT + (((size_t)((h * 2 + dir) * 16 + es * 4 + wc)) * M + (rowbase + tok0 + 64 * wr + 16 * m + frc + zo)) * 2;
                if (fqc == 0) *(f32x2_t*)sp = (f32x2_t){sv, sq}; }
            RC_BAR();
            const int srow = 4 * (2 * (w & 1) + (frc >> 3)) + (frc & 3), ssub = 2 * (w >> 1) + ((frc >> 2) & 1);
#pragma unroll
            for (int n = 0; n < 16; ++n) { v2u pw; pw.x = cvtpk(acc4[n][0], acc4[n][1]); pw.y = cvtpk(acc4[n][2], acc4[n][3]);
                *(LAS v2u*)(lds + RC_ST + (n >> 1) * 8192 + ssub * 1024 + sl_swz(srow * 64 + (16 * (n & 1) + 4 * fqc) * 2)) = pw; }
            RC_WAITL();
        }
        RC_WAITV(0); RC_BAR();
    }
#undef RC_DMA
#undef RC_WAITV
#undef RC_WAITL
#undef RC_BAR
#undef RC_MFMA
#undef RC_NEXT
#undef RC_PREV
#undef RC_ISSUE
}

__device__ __forceinline__ void ret_stats(const float* PT, float* ST, int gtid, int nthr) {
    for (int i = gtid; i < M * 8; i += nthr) { const int hd = i / M, row = i - hd * M; const f32x2_t* p = (const f32x2_t*)PT + (size_t)hd * 16 * M + row; float sv = 0.f, sq = 0.f;
#pragma unroll
        for (int k = 0; k < 16; ++k) { const f32x2_t v = p[(size_t)k * M]; sv += v.x; sq += v.y; }
        *(f32x2_t*)(ST + ((size_t)row * 8 + hd) * 2) = (f32x2_t){sv, sq}; }
}

constexpr int AT_KROW = 144, AT_KB = 256 * AT_KROW, AT_VB = AT_KB, AT_HALF = AT_KB + AT_VB + 768, AT_LD = 3 * D;
static_assert(2 * AT_HALF <= RING_BYTES, "attention tiles");
__device__ __forceinline__ void attn_group_mfma2(const bf16* QK, const float* bias2g, int ldil, int first, bf16* OACC, float* LSE, LAS unsigned char* lds, const int tid, const int bid, const int G) {
    const int wave = __builtin_amdgcn_readfirstlane(tid >> 6), lane = tid & 63, r = lane & 31, hh = lane >> 5, hw = wave >> 2, wq = wave & 3, tih0 = tid & 255;
    LAS unsigned char* Kl = lds + hw * AT_HALF; LAS unsigned char* Vl = Kl + AT_KB; LAS float* tab = (LAS float*)(Vl + AT_VB);
    const int Ls = SEQ >> ldil, lq4 = 4 - ldil, nq4m = (1 << lq4) - 1, dilm = (1 << ldil) - 1;
    constexpr float SC = 0.125f * 1.4426950409f;
    const float NEGBIG = opaque_f(-1e30f);
    constexpr int NP = BATCH * HA * 16 / 2;
    const int npp = (NP + G - 1) / G;
    v4u kreg[8], vreg[8];
#define AT_FETCH_K(su_) do { int tih = tih0; asm volatile("" : "+v"(tih)); const int su__ = (su_); const int q4_ = su__ & nq4m, rr_ = (su__ >> lq4) & dilm, h_ = (su__ >> 4) & 15, b_ = su__ >> 8, ks_ = q4_ * 128 - 64; \
        _Pragma("unroll") for (int j = 0; j < 8; ++j) { const int pi = j * 256 + tih, row = pi >> 3, ch = pi & 7; int kt = ks_ + row; kt = kt < 0 ? 0 : (kt > Ls - 1 ? Ls - 1 : kt); \
            kreg[j] = *(const v4u*)(QK + ((size_t)b_ * SEQ + ((size_t)kt << ldil) + rr_) * AT_LD + D + h_ * 64 + ch * 8); } } while (0)
#define AT_FETCH_V(su_) do { int tih = tih0; asm volatile("" : "+v"(tih)); const int su__ = (su_); const int q4_ = su__ & nq4m, rr_ = (su__ >> lq4) & dilm, h_ = (su__ >> 4) & 15, b_ = su__ >> 8, ks_ = q4_ * 128 - 64; \
        _Pragma("unroll") for (int j = 0; j < 8; ++j) { const int pi = j * 256 + tih, row = pi >> 3, ch = pi & 7; int kt = ks_ + row; kt = kt < 0 ? 0 : (kt > Ls - 1 ? Ls - 1 : kt); \
            vreg[j] = *(const v4u*)(QK + ((size_t)b_ * SEQ + ((size_t)kt << ldil) + rr_) * AT_LD + 2 * D + h_ * 64 + ch * 8); } } while (0)
#define AT_ROWQ(su_) ((size_t)((su_) >> 8) * SEQ + ((size_t)(((su_) & nq4m) * 128 + 32 * wq + r) << ldil) + (((su_) >> lq4) & dilm))
#define AT_FETCH_Q(su_) do { const int su__ = (su_); const bf16* qp_ = QK + AT_ROWQ(su__) * AT_LD + ((su__ >> 4) & 15) * 64 + 8 * hh; \
        _Pragma("unroll") for (int ks = 0; ks < 4; ++ks) qf[ks] = *(const bf16x8s*)(qp_ + 16 * ks); } while (0)
    bf16x8s qf[4]; int htab = -1;
    const bool remap = (G == 256);
#define AT_P(it_) (remap ? ((2 * ((bid * 4 + ((it_) & 3)) >> 7) + (((it_) >> 2) ? 0 : 1)) * 128 + ((bid * 4 + ((it_) & 3)) & 127)) : bid * npp + (it_))
    if (AT_P(0) < NP) { AT_FETCH_K(2 * AT_P(0) + hw); AT_FETCH_V(2 * AT_P(0) + hw); AT_FETCH_Q(2 * AT_P(0) + hw); }
    for (int it = 0; it < npp; ++it) {
        const int p = AT_P(it); if (p >= NP) break;
        const int su = 2 * p + hw, q4 = su & nq4m, rr = (su >> lq4) & dilm, h = (su >> 4) & 15, b = su >> 8, t0 = q4 * 128 + 32 * wq;
        asm volatile("" ::: "memory"); __builtin_amdgcn_s_barrier(); asm volatile("" ::: "memory");
        int tih = tih0; asm volatile("" : "+v"(tih));
#pragma unroll
        for (int j = 0; j < 8; ++j) { const int pi = j * 256 + tih; *(LAS v4u*)(Kl + (pi >> 3) * AT_KROW + (pi & 7) * 16) = kreg[j]; }
#pragma unroll
        for (int j = 0; j < 8; ++j) { const int pi = j * 256 + tih; *(LAS v4u*)(Vl + (pi >> 3) * AT_KROW + (pi & 7) * 16) = vreg[j]; }
        if (h != htab) { htab = h; if (tih < 192) { const int o = tih - 96; tab[tih] = (o >= -64 && o <= 64) ? bias2g[h * 129 + o + 64] : NEGBIG; } }
        const size_t rowq = (size_t)b * SEQ + ((size_t)(t0 + r) << ldil) + rr;
        asm volatile("s_waitcnt lgkmcnt(0)" ::: "memory"); __builtin_amdgcn_s_barrier(); asm volatile("" ::: "memory");
        f32x16 S[5];
#pragma unroll
        for (int kb = 0; kb < 5; ++kb) {
            const LAS unsigned char* kp = Kl + (32 * wq + 32 * kb + r) * AT_KROW + 16 * hh;
#pragma unroll
            for (int i = 0; i < 16; ++i) S[kb][i] = 0.f;
#pragma unroll
            for (int ks = 0; ks < 4; ++ks) S[kb] = __builtin_amdgcn_mfma_f32_32x32x16_bf16(*(const LAS bf16x8s*)(kp + 32 * ks), qf[ks], S[kb], 0, 0, 0);
        }
        const int pnx = AT_P(it + 1); const bool more = it + 1 < npp && pnx < NP;
        __builtin_amdgcn_sched_barrier(0);
        if (more) { AT_FETCH_K(2 * pnx + hw); AT_FETCH_Q(2 * pnx + hw); AT_FETCH_V(2 * pnx + hw); }
        float lold = 0.f; v2u xo[2][4];
        if (!first) { lold = LSE[rowq * 16 + h];
#pragma unroll
            for (int db = 0; db < 2; ++db)
#pragma unroll
                for (int gq = 0; gq < 4; ++gq) xo[db][gq] = *(const v2u*)(OACC + rowq * D + h * 64 + 32 * db + 8 * gq + 4 * hh); }
        else {
#pragma unroll
            for (int db = 0; db < 2; ++db)
#pragma unroll
                for (int gq = 0; gq < 4; ++gq) xo[db][gq] = (v2u){0u, 0u}; }
        __builtin_amdgcn_sched_barrier(0);
        const LAS float* tb = tab + (32 + 4 * hh - r);
        float mx = NEGBIG;
        int kt0 = t0 - 64 + 4 * hh; asm volatile("" : "+v"(kt0));
#pragma unroll
        for (int kb = 0; kb < 5; ++kb)
#pragma unroll
            for (int i = 0; i < 16; ++i) { const int krel = 32 * kb + (i & 3) + 8 * (i >> 2);
                float s = S[kb][i] * SC + tb[krel]; s = ((unsigned)(kt0 + krel) >= (unsigned)Ls) ? NEGBIG : s; S[kb][i] = s; mx = fmaxf(mx, s); }
        mx = fmaxf(mx, get_xor32(mx, lane));
        float l = 0.f; unsigned pk[5][8];
#pragma unroll
        for (int kb = 0; kb < 5; ++kb)
#pragma unroll
            for (int i = 0; i < 8; ++i) { const float p0 = __builtin_amdgcn_exp2f(S[kb][2 * i] - mx), p1 = __builtin_amdgcn_exp2f(S[kb][2 * i + 1] - mx); l += p0 + p1; pk[kb][i] = cvtpk(p0, p1); }
        l += get_xor32(l, lane);
        f32x16 O[2];
#pragma unroll
        for (int db = 0; db < 2; ++db)
#pragma unroll
            for (int i = 0; i < 16; ++i) O[db][i] = 0.f;
#pragma unroll
        for (int kb = 0; kb < 5; ++kb) {
#pragma unroll
            for (int s2 = 0; s2 < 2; ++s2) {
                const v4u pw = (v4u){pk[kb][4 * s2 + 0], pk[kb][4 * s2 + 1], pk[kb][4 * s2 + 2], pk[kb][4 * s2 + 3]};
                const bf16x8s pf = __builtin_bit_cast(bf16x8s, pw);
                typedef short s16x4 __attribute__((ext_vector_type(4)));
                const LAS unsigned char* vb = Vl + (32 * wq + 32 * kb + 16 * s2 + 4 * hh + ((lane & 15) >> 2)) * AT_KROW + (16 * ((lane >> 4) & 1) + 4 * (lane & 3)) * 2;
#pragma unroll
                for (int db = 0; db < 2; ++db) {
                    const v2u lo = __builtin_bit_cast(v2u, __builtin_amdgcn_ds_read_tr16_b64_v4i16((LAS s16x4*)(vb + 64 * db))), hi = __builtin_bit_cast(v2u, __builtin_amdgcn_ds_read_tr16_b64_v4i16((LAS s16x4*)(vb + 64 * db + 8 * AT_KROW)));
                    const v4u vw = (v4u){lo.x, lo.y, hi.x, hi.y};
                    O[db] = __builtin_amdgcn_mfma_f32_32x32x16_bf16(__builtin_bit_cast(bf16x8s, vw), pf, O[db], 0, 0, 0); }
            }
        }
        const float il = __builtin_amdgcn_rcpf(l); float lse = mx + __builtin_amdgcn_logf(l);
        const size_t row = rowq;
        float wn = il, wo = 0.f;
        if (!first) { const float lo = lold; const float mm = fmaxf(lo, lse), eo = __builtin_amdgcn_exp2f(lo - mm), en = __builtin_amdgcn_exp2f(lse - mm), inv = __builtin_amdgcn_rcpf(eo + en); wn = en * inv * il; wo = eo * inv; lse = mm + __builtin_amdgcn_logf(eo + en); }
        if (hh == 0) LSE[row * 16 + h] = lse;
#pragma unroll
        for (int db = 0; db < 2; ++db)
#pragma unroll
            for (int gq = 0; gq < 4; ++gq) { v2u* op = (v2u*)(OACC + row * D + h * 64 + 32 * db + 8 * gq + 4 * hh);
                const v2u x = xo[db][gq];
                v2u y; y.x = cvtpk(wn * O[db][4 * gq + 0] + wo * bflo(x.x), wn * O[db][4 * gq + 1] + wo * bfhi(x.x)); y.y = cvtpk(wn * O[db][4 * gq + 2] + wo * bflo(x.y), wn * O[db][4 * gq + 3] + wo * bfhi(x.y));
                *op = y; }
    }
#undef AT_FETCH_Q
#undef AT_P
#undef AT_ROWQ
#undef AT_FETCH_K
#undef AT_FETCH_V
    __syncthreads();
}


struct Args { const float* in[11]; float* out; unsigned char* ws; int ph_lo, ph_hi; };
__global__ void __launch_bounds__(NTHREADS, 2) mk_fwd(Args args) {
    extern __shared__ __attribute__((aligned(16))) unsigned char lds_raw[];
    LAS unsigned char* lds = (LAS unsigned char*)lds_raw;
    volatile LAS unsigned* MISC = (volatile LAS unsigned*)(lds + MISC_OFF);
    const int wave0 = __builtin_amdgcn_readfirstlane(threadIdx.x >> 6);
    for (int u = threadIdx.x; u < (LDS_BYTES - LDSCTL_OFF) / 4; u += NTHREADS) ((LAS unsigned*)(lds + LDSCTL_OFF))[u] = 0u;
    __syncthreads();
    (void)xcd_barrier_post((unsigned*)(args.ws + WS_CTL) + CW_BAR, MISC + 8);
    bool again = false;
#if PROBE_TWICE
    for (int pass_ = 0; pass_ < 2; ++pass_)
#endif
    for (int ph = args.ph_lo; ph < args.ph_hi; ++ph) {
        size_t wsz = 0; asm volatile("" : "+s"(wsz)); unsigned char* ws = args.ws + wsz;
        int bid = blockIdx.x, G = gridDim.x; asm volatile("" : "+s"(bid), "+s"(G));
        const int gw = bid * NWAVES + wave0, NGW = G * NWAVES;
#define GET_TID() int tid; asm volatile("v_mbcnt_lo_u32_b32 %0, -1, 0\n\tv_mbcnt_hi_u32_b32 %0, -1, %0" : "=v"(tid)); const int lane = tid; tid += wave0 * 64; (void)lane;
        LAS float* scr = (LAS float*)(lds + RING_OFF + wave0 * CV_SCR);
        const float* gains = args.in[1]; float* out = args.out;
        float* RS = (float*)(ws + WS_RS);
        enum { T_P0, T_G1, T_FG, T_THIN, T_APROJ, T_ATT, T_RPROJ, T_RCORE, T_RGATE, T_RSTAT };
        int type, L = 0, kind = 0, aux = 0;
        if (ph == 0) type = T_P0;
        else { const int p = ph - 1, pp = p % 20, odd = pp >= 11, q = odd ? pp - 11 : pp, nmix = odd ? 5 : 7;
            L = 2 * (p / 20) + odd;
            if (q < 2) { kind = 0; type = q == 0 ? T_G1 : T_FG; }
            else if (q >= 2 + nmix) { kind = 2; type = q - 2 - nmix == 0 ? T_G1 : T_FG; }
            else { kind = 1; const int r = q - 2;
                if (r == nmix - 1) type = T_FG;
                else if (!odd) { aux = r >> 1; type = (r & 1) ? T_ATT : T_APROJ; }
                else type = r == 0 ? T_RPROJ : (r == 1 ? T_RCORE : (r == 2 ? T_RSTAT : T_RGATE)); } }
        const bool is_att = (L & 1) == 0; const int jj = L >> 1;
#if PROBE_TSEL
        volatile LAS unsigned long long* TS = (volatile LAS unsigned long long*)(lds + RING_BYTES + 512);
        if (wave0 == 0) TS[0] = __builtin_amdgcn_s_memrealtime();
#define TS_ACC() if (wave0 == 0 && ph >= PROBE_TLO && ph < PROBE_THI && ((PROBE_TMASK >> type) & 1)) TS[1] = TS[1] + (__builtin_amdgcn_s_memrealtime() - TS[0]);
#endif
#define P_BIAS ((float*)(ws + WS_BIAS))
#define P_WA   ((bf16*)(ws + WS_W))
#define P_XH   ((bf16*)(ws + WS_XH))
#define P_BIG  ((bf16*)(ws + WS_BIG))
#define P_F    ((bf16*)(ws + WS_F))
#define P_YC   ((bf16*)(ws + WS_YC))
#define P_OACC ((bf16*)(ws + WS_OACC))
#define P_LSE  ((float*)(ws + WS_LSE))
        if (type == T_P0) {
            GET_TID()
#if PROBE_TOUCH
            {
                const size_t tix = (size_t)(bid >> 3) * NTHREADS + tid, nthr = (size_t)(G >> 3) * NTHREADS; unsigned accw = 0;
                for (size_t o = tix * 65536; o < WS_END; o += nthr * 65536) accw += *(const volatile unsigned*)(ws + o);
                for (size_t o = tix * 65536; o < (size_t)M * D * 4; o += nthr * 65536) { accw += *(const volatile unsigned*)((const char*)args.in[0] + o); accw += *(const volatile unsigned*)((const char*)out + o); }
                for (size_t o = tix * 65536; o < (size_t)DEPTH * 2 * D * DFF * 4; o += nthr * 65536) { accw += *(const volatile unsigned*)((const char*)args.in[2] + o); accw += *(const volatile unsigned*)((const char*)args.in[3] + o); accw += *(const volatile unsigned*)((const char*)args.in[4] + o); }
                for (size_t o = tix * 65536; o < (size_t)2 * D * NGRP * ATT_COLS * 4; o += nthr * 65536) accw += *(const volatile unsigned*)((const char*)args.in[5] + o);
                for (size_t o = tix * 65536; o < (size_t)2 * D * RET_COLS * 4; o += nthr * 65536) accw += *(const volatile unsigned*)((const char*)args.in[8] + o);
                if (accw == 0x12345677u) P_BIAS[70000] = 1.f; }
#endif
            const float* rel_bias = args.in[7];
            for (int i = bid * NTHREADS + tid; i < 3 * 16 * 129; i += G * NTHREADS) { const int g = i / (16 * 129), h = (i / 129) % 16, kk = i % 129; P_BIAS[i] = rel_bias[(g * 16 + h) * 32 + T5_BUCKET[g][kk]] * 1.4426950409f; }
            conv_gateup(args.in[2], args.in[3], P_WA, gains, scr, gw, NGW, lane);
            conv_plain<DFF, D>(args.in[4], (bf16*)(ws + WS_W2A), nullptr, scr, gw, NGW, lane);
            p0_rows(args.in[0], P_XH, RS, gw, NGW, lane);
#if PROBE_MFMA
            {
                typedef short bx8 __attribute__((ext_vector_type(8)));
                bx8 a = {1, 2, 3, 4, 5, 6, 7, (short)lane}, b = {3, 1, 4, 1, 5, 9, 2, (short)(lane + 1)};
                f32x4 c0 = {0, 0, 0, 0}, c1 = c0, c2 = c0, c3 = c0, c4 = c0, c5 = c0, c6 = c0, c7 = c0;
                for (int it = 0; it < PROBE_MFMA; ++it) {
#pragma unroll
                    for (int r = 0; r < 4; ++r) {
                        c0 = __builtin_amdgcn_mfma_f32_16x16x32_bf16(a, b, c0, 0, 0, 0); c1 = __builtin_amdgcn_mfma_f32_16x16x32_bf16(a, b, c1, 0, 0, 0); c2 = __builtin_amdgcn_mfma_f32_16x16x32_bf16(a, b, c2, 0, 0, 0); c3 = __builtin_amdgcn_mfma_f32_16x16x32_bf16(a, b, c3, 0, 0, 0);
                        c4 = __builtin_amdgcn_mfma_f32_16x16x32_bf16(a, b, c4, 0, 0, 0); c5 = __builtin_amdgcn_mfma_f32_16x16x32_bf16(a, b, c5, 0, 0, 0); c6 = __builtin_amdgcn_mfma_f32_16x16x32_bf16(a, b, c6, 0, 0, 0); c7 = __builtin_amdgcn_mfma_f32_16x16x32_bf16(a, b, c7, 0, 0, 0); }
                    asm volatile("" : "+v"(a), "+v"(b)); }
                const f32x4 t = c0 + c1 + c2 + c3 + c4 + c5 + c6 + c7;
                if (t.x + t.y + t.z + t.w == 12345.678f) P_BIAS[60000 + tid] = t.x;
            }
#endif
        } else if (type == T_G1) {
            GET_TID()
            pg8::Gemm g{P_XH, P_WA, M, 2 * DFF, D, 0}; pg8::StaticOrder S; S.init(M, 2 * DFF, G, bid);
            pg8::stage_scales(lds + RING_OFF, S, RS, false, 0, tid);
            pg8::EpiSwiGLU E{P_BIG, DFF, (const LAS float*)(lds + RING_OFF + pg8::RS_TAB_OFF)};
            pg8::gemm_phase<pg8::EpiSwiGLU, pg8::StaticOrder, true, true>(lds + RING_OFF, g, S, E, tid);
#if PROBE_G1V >= 0
            { GET_TID() pg8::Gemm g2{P_XH, P_WA, M, 2 * DFF, D, 0}; pg8::StaticOrder S2; S2.init(M, 2 * DFF, G, bid);
              pg8::EpiSwiGLUT<PROBE_G1V> E2{PROBE_G1V ? P_F : P_BIG, PROBE_G1V ? D : DFF, (const LAS float*)(lds + RING_OFF + pg8::RS_TAB_OFF)};
              pg8::gemm_phase<pg8::EpiSwiGLUT<PROBE_G1V>, pg8::StaticOrder, true, true>(lds + RING_OFF, g2, S2, E2, tid); }
#endif
        } else if (type == T_FG) {
            GET_TID()
            const int sub = L * 3 + kind; const bool lastsub = sub + 1 >= 3 * DEPTH;
            if (!lastsub) {
                const int nk = (sub + 1) % 3, nL = (sub + 1) / 3, nj = nL >> 1;
                const float* gn = gains + ((size_t)nL * 6 + (nk == 0 ? 0 : (nk == 1 ? 2 : 4))) * D;
                bf16* w2n = (bf16*)(ws + (((sub + 1) & 1) ? WS_W2B : WS_W2A));
                if (nk != 1) { const size_t o = (size_t)(nL * 2 + (nk >> 1)) * D * DFF;
                    conv_gateup(args.in[2] + o, args.in[3] + o, P_WA, gn, scr, gw, NGW, lane); conv_plain<DFF, D>(args.in[4] + o, w2n, nullptr, scr, gw, NGW, lane); }
                else if ((nL & 1) == 0) { conv_plain<D, NGRP * ATT_COLS>(args.in[5] + (size_t)nj * D * NGRP * ATT_COLS, P_WA, gn, scr, gw, NGW, lane); conv_plain<D, D>(args.in[6] + (size_t)nj * D * D, w2n, nullptr, scr, gw, NGW, lane); }
                else { const float* rw = args.in[8] + (size_t)nj * D * RET_COLS;
                    conv_cols<D, RET_COLS, 2 * D + DV>(rw, 0, P_WA, 0, gn, scr, gw, NGW, lane); conv_gates<RET_COLS>(rw, 2 * D + DV, 2 * D + 2 * DV, P_WA, 2 * D + DV, gn, scr, gw, NGW, lane);
                    conv_plain<DV, D>(args.in[9] + (size_t)nj * DV * D, w2n, nullptr, scr, gw, NGW, lane); }
                asm volatile("" ::: "memory"); __syncthreads();
            }
            { GET_TID()
              const size_t fA = kind != 1 ? WS_BIG : (is_att ? WS_OACC : WS_YC), fB = (sub & 1) ? WS_W2B : WS_W2A; const int fK = kind != 1 ? DFF : (is_att ? D : DV);
              pg8::Gemm g{(const bf16*)(ws + fA), (const bf16*)(ws + fB), M, D, fK, 0}; pg8::PanelOrder S; S.init(M, D, G, bid);
              const float* gpost = gains + ((size_t)L * 6 + (kind == 0 ? 1 : (kind == 1 ? 3 : 5))) * D;
              unsigned* pf = (unsigned*)(ws + WS_PF);
              pg8::EpiThin E{P_XH, lastsub ? out : nullptr, gpost, kind == 1 ? 1.0f : 0.5f, pf + (size_t)(sub & 1) * M * 4, pf + (size_t)((sub + 1) & 1) * M * 4, RS, (LAS float*)(lds + RING_OFF + pg8::RS_TAB_OFF)};
              pg8::gemm_phase<pg8::EpiThin, pg8::PanelOrder, true, true>(lds + RING_OFF, g, S, E, tid); }
        } else if (type == T_APROJ) {
            GET_TID()
            { pg8::Gemm g{P_XH, P_WA + (size_t)aux * ATT_COLS * D, M, ATT_COLS, D, 0}; pg8::StaticOrder S; S.init(M, ATT_COLS, G, bid);
              pg8::stage_scales(lds + RING_OFF, S, RS, false, 0, tid);
              pg8::EpiPlain E{P_BIG, ATT_COLS, (const LAS float*)(lds + RING_OFF + pg8::RS_TAB_OFF)};
              pg8::gemm_phase<pg8::EpiPlain, pg8::StaticOrder, true, true>(lds + RING_OFF, g, S, E, tid); }
        } else if (type == T_ATT) {
            GET_TID()
            const int ldil = 2 * aux;
            attn_group_mfma2(P_BIG, P_BIAS + aux * 16 * 129, ldil, aux == 0, P_OACC, P_LSE, lds + RING_OFF, tid, bid, G);
        } else if (type == T_RPROJ) {
            GET_TID()
            { pg8::Gemm g{P_XH, P_WA, M, 2 * D, D, 0}; pg8::StaticOrder S; S.init(M, 2 * D, G, bid);
              pg8::stage_scales(lds + RING_OFF, S, RS, false, 0, tid);
              pg8::EpiRet E{P_BIG, 2 * D, (const LAS float*)(lds + RING_OFF + pg8::RS_TAB_OFF)};
              pg8::gemm_phase<pg8::EpiRet, pg8::StaticOrder, true, true>(lds + RING_OFF, g, S, E, tid); }
            { GET_TID()
              pg8::Gemm g{P_WA + (size_t)2 * D * D, P_XH, DV, M, D, 0}; pg8::StaticOrder S; S.init(DV, M, G, bid);
              pg8::stage_scales(lds + RING_OFF, S, RS, true, 0, tid);
              pg8::EpiVT E{(bf16*)(ws + WS_RVT), M, 0, (const LAS float*)(lds + RING_OFF + pg8::RS_TAB_OFF)};
              pg8::gemm_phase<pg8::EpiVT, pg8::StaticOrder, true, true>(lds + RING_OFF, g, S, E, tid); }
        } else if (type == T_RCORE) {
            GET_TID()
            static_assert(RC_LDS <= RING_BYTES, "retention core LDS tiles");
            ret_core_mfma<0>(P_BIG, (const bf16*)(ws + WS_RVT), args.in[10] + jj * 2 * HR, P_YC, (bf16*)out, (float*)(ws + WS_OACC), lds + RING_OFF, tid, bid, G);
        } else if (type == T_RSTAT) {
            GET_TID()
            ret_stats((const float*)(ws + WS_OACC), P_LSE, bid * NTHREADS + tid, G * NTHREADS);
        } else {
            GET_TID()
            pg8::Gemm g{P_XH, P_WA + (size_t)(2 * D + DV) * D, M, 2 * DV, D, 0}; pg8::StaticOrder S; S.init(M, 2 * DV, G, bid);
            pg8::stage_scales(lds + RING_OFF, S, RS, false, 0, tid);
            pg8::EpiGate E{P_YC, (const bf16*)out, P_LSE, (const LAS float*)(lds + RING_OFF + pg8::RS_TAB_OFF)};
            pg8::gemm_phase<pg8::EpiGate, pg8::StaticOrder, true, true>(lds + RING_OFF, g, S, E, tid);
        }
#if PROBE_TSEL && PROBE_TWORK
        TS_ACC()
#endif
        if (ph + 1 < args.ph_hi || PROBE_TWICE) { XcdBarrier b_; b_.bar = (unsigned*)(ws + WS_CTL) + CW_BAR; b_.x = xb_xcc_id(); b_.st = MISC + 8; xcd_barrier(b_);
#if PROBE_BAR2
            xcd_barrier(b_);
#endif
        }
#if PROBE_TSEL && !PROBE_TWORK
        TS_ACC()
#endif
        if (PROBE_REPEAT) {
            if (!again && ((PROBE_REPEAT >> type) & 1) && (type != T_ATT || aux == 0) && ph + 1 < args.ph_hi) { again = true; --ph; } else again = false; }
    }
#if PROBE_TSEL
    if (blockIdx.x == PROBE_TWG && wave0 == 0) {
        const unsigned long long tend = __builtin_amdgcn_s_memrealtime(), need = ((volatile LAS unsigned long long*)(lds + RING_BYTES + 512))[1] * PROBE_TAMP;
        while (__builtin_amdgcn_s_memrealtime() - tend < need) __builtin_amdgcn_s_sleep(8); }
#endif
}

extern "C" void kernel_launch(void* const* d_in, const int* in_sizes, int n_in, void* d_out, int out_size, void* d_ws, size_t ws_size, hipStream_t stream) {
    static int grid = 0;
    if (grid == 0) {
        if (n_in != 11 || in_sizes[0] != M * D || out_size != M * D || ws_size < WS_END) { fprintf(stderr, "kernel_launch: unexpected shapes / workspace (n_in %d, ws %zu, need %zu); nothing launched\n", n_in, ws_size, (size_t)WS_END); grid = -1; return; }
        int dev = 0, cus = 0, per_cu = 0;
        if (hipGetDevice(&dev) != hipSuccess || hipDeviceGetAttribute(&cus, hipDeviceAttributeMultiprocessorCount, dev) != hipSuccess) { grid = -1; return; }
        if (hipFuncSetAttribute((const void*)mk_fwd, hipFuncAttributeMaxDynamicSharedMemorySize, LDS_BYTES) != hipSuccess) { fprintf(stderr, "kernel_launch: hipFuncSetAttribute failed\n"); grid = -1; return; }
        if (hipOccupancyMaxActiveBlocksPerMultiprocessor(&per_cu, (const void*)mk_fwd, NTHREADS, LDS_BYTES) != hipSuccess || per_cu < 1) { fprintf(stderr, "kernel_launch: occupancy query reports %d workgroups per CU\n", per_cu); }
        (void)hipGetLastError();
        grid = cus;
    }
    if (grid < 0) return;
    if (hipMemsetAsync((char*)d_ws + WS_CTL, 0, CTL_ZERO_BYTES, stream) != hipSuccess) return;
    Args a{};
    for (int i = 0; i < 11; ++i) a.in[i] = (const float*)d_in[i];
    a.out = (float*)d_out; a.ws = (unsigned char*)d_ws;
#if MK_ONE_LAUNCH
    a.ph_lo = 0; a.ph_hi = NPHASES;
    hipLaunchKernelGGL(mk_fwd, dim3(grid), dim3(NTHREADS), LDS_BYTES, stream, a);
#else
    for (int p = 0; p < NPHASES; ++p) { a.ph_lo = p; a.ph_hi = p + 1; hipLaunchKernelGGL(mk_fwd, dim3(grid), dim3(NTHREADS), LDS_BYTES, stream, a); }
#endif
}
```

```cpp
#include <hip/hip_runtime.h>
#include <cstdio>
#include <cstdint>
#ifndef PROBE_REPEAT
#define PROBE_REPEAT 0
#endif
#ifndef PROBE_THIN2
#define PROBE_THIN2 0
#endif
#ifndef PROBE_ATT2
#define PROBE_ATT2 0
#endif
#ifndef PROBE_CONV2
#define PROBE_CONV2 0
#endif
#ifndef PROBE_FGM
#define PROBE_FGM 0
#endif
#ifndef PROBE_RC
#define PROBE_RC -1
#endif
#ifndef PROBE_G1V
#define PROBE_G1V -1
#endif
#ifndef PROBE_BAR2
#define PROBE_BAR2 0
#endif
#ifndef PROBE_MFMA
#define PROBE_MFMA 0
#endif
#ifndef PROBE_TWICE
#define PROBE_TWICE 0
#endif
#ifndef PROBE_TOUCH
#define PROBE_TOUCH 0
#endif
#ifndef PROBE_TSEL
#define PROBE_TSEL 0
#endif
#ifndef PROBE_TLO
#define PROBE_TLO 0
#endif
#ifndef PROBE_THI
#define PROBE_THI 1000
#endif
#ifndef PROBE_TMASK
#define PROBE_TMASK 0x3ff
#endif
#ifndef PROBE_TWORK
#define PROBE_TWORK 0
#endif
#ifndef PROBE_TWG
#define PROBE_TWG 0
#endif
#ifndef PROBE_TAMP
#define PROBE_TAMP 1
#endif
#ifndef MK_ONE_LAUNCH
#define MK_ONE_LAUNCH 1
#endif
namespace pg8 {
#define PG8_LAS __attribute__((address_space(3)))
typedef unsigned short bf16_t;
typedef short bf16x8 __attribute__((ext_vector_type(8)));
typedef float f32x4 __attribute__((ext_vector_type(4)));
typedef unsigned u32x4 __attribute__((ext_vector_type(4)));
constexpr int BM = 256, BK = 64, HALF = 128, HTB = HALF * BK * 2  , STAGE_BYTES = 8 * HTB, NXCD = 8, WGM = 8;

__host__ __device__ __forceinline__ int lds_byte(int r, int c) { const int st = (r >> 4) * 2 + (c >> 5), rr = r & 15, cc = c & 31, ob = rr * 64 + cc * 2; return st * 1024 + (ob ^ (((ob >> 9) & 1) << 5)); }
__host__ __device__ __forceinline__ void stage_rc(int b, int& R, int& C) { const int st = b / 1024, sb = b % 1024, swz = sb ^ (((sb >> 9) & 1) << 5); R = (st >> 1) * 16 + swz / 64; C = (st & 1) * 32 + (swz % 64) / 2; }
__host__ __device__ __forceinline__ int perm32(int rho) { const int n = rho >> 4, i = rho & 15; return 8 * (i >> 2) + 4 * n + (i & 3); }

struct Unit { int pm, pn, idx; };
struct Gemm { const bf16_t* A; const bf16_t* Bt; int M, N, K; int ldil; int ablk; };

struct StaticOrder {
    int nM, nN, nwg, G, c;
    __host__ __device__ void init(int M, int N, int G_, int c_) { nM = M / BM; nN = N / BM; nwg = nM * nN; G = G_; c = c_; }
    __host__ __device__ bool next(int i, Unit& u) const {
        const long L = (long)i * G + c; if (L >= nwg) return false;
        int wgid = (int)L; { const int q = nwg / NXCD, r = nwg % NXCD, xcd = wgid % NXCD, off = wgid / NXCD; wgid = (xcd < r ? xcd * (q + 1) : r * (q + 1) + (xcd - r) * q) + off; }
        const int nig = WGM * nN, gid = wgid / nig, fm = gid * WGM, gsz = (nM - fm) < WGM ? (nM - fm) : WGM;
        u.pm = fm + ((wgid % nig) % gsz); u.pn = (wgid % nig) / gsz; u.idx = i; return true;
    }
    __device__ __forceinline__ void a_ready(const Unit&) const {}
    __device__ __forceinline__ void done(const Unit&) const {}
};

__device__ __forceinline__ unsigned cvt_pk_bf16(float lo, float hi) { unsigned r; asm volatile("v_cvt_pk_bf16_f32 %0, %1, %2" : "=v"(r) : "v"(lo), "v"(hi)); return r; }
typedef float f32x2 __attribute__((ext_vector_type(2)));

__device__ __forceinline__ float fast_sigmoid(float g) { return __builtin_amdgcn_rcpf(1.0f + __builtin_amdgcn_exp2f(-1.4426950409f * g)); }
constexpr int RS_TAB_OFF = 131072;
template <class Sched> __device__ __forceinline__ void stage_scales(PG8_LAS unsigned char* lds, const Sched& S, const float* rs, bool cols, int ldil, int tid) {
    PG8_LAS float* tab = (PG8_LAS float*)(lds + RS_TAB_OFF); Unit u;
    if (tid < 256) { const int lper = 8 - ldil, c = tid, tm = ((c & ((1 << lper) - 1)) << ldil) + (c >> lper);
        float eps = 1e-6f; asm volatile("" : "+s"(eps));
        for (int i = 0; i < 16 && S.next(i, u); ++i) { const f32x4 a = *(const f32x4*)(rs + 4 * (size_t)(cols ? u.pn * BM + tm : u.pm * BM + tid));
            tab[i * 256 + tid] = __builtin_amdgcn_rsqf(((a[0] + a[1]) + (a[2] + a[3])) * (1.0f / 1024.0f) + eps); } }
    __syncthreads();
}
struct EpiPlain {
    static constexpr bool PERM = true, AFTER_DRAIN = false;
    bf16_t* O; int ldc; const PG8_LAS float* tab;
    __device__ __forceinline__ void operator()(const f32x4 (&acc)[2][2][4][2], const Unit& u, int wr, int wc, int fr, int fq) const {
        const int row0 = u.pm * BM + wr * 64 + fr, col0 = u.pn * BM + wc * 32 + 8 * fq;
#pragma unroll
        for (int ai = 0; ai < 2; ++ai)
#pragma unroll
            for (int m = 0; m < 4; ++m) { const int row = row0 + ai * HALF + m * 16; bf16_t* rowp = O + (size_t)row * ldc + col0; const float r = tab ? tab[u.idx * 256 + (row & 255)] : 1.0f;
#pragma unroll
                for (int bj = 0; bj < 2; ++bj) { const f32x4 v0 = acc[ai][bj][m][0] * r, v1 = acc[ai][bj][m][1] * r;
                    u32x4 w; w.x = cvt_pk_bf16(v0[0], v0[1]); w.y = cvt_pk_bf16(v0[2], v0[3]); w.z = cvt_pk_bf16(v1[0], v1[1]); w.w = cvt_pk_bf16(v1[2], v1[3]);
                    *(u32x4*)(rowp + bj * HALF) = w; } }
    }
};
template <int CHEAP = 0  > struct EpiSwiGLUT {
    static constexpr bool PERM = true, AFTER_DRAIN = false;
    bf16_t* O; int ldc; const PG8_LAS float* tab;
    __device__ __forceinline__ void operator()(const f32x4 (&acc)[2][2][4][2], const Unit& u, int wr, int wc, int fr, int fq) const {
        const int row0 = u.pm * BM + wr * 64 + fr, col0 = u.pn * HALF + wc * 32 + 8 * fq;
#pragma unroll
        for (int ai = 0; ai < 2; ++ai)
#pragma unroll
            for (int m = 0; m < 4; ++m) { const int row = row0 + ai * HALF + m * 16; bf16_t* rowp = O + ((size_t)u.pm * (ldc >> 6) + (col0 >> 6)) * 16384 + (row & 255) * 64 + (col0 & 63); const float r = tab[u.idx * 256 + (row & 255)];
                float o[8];
                const float kr = -1.4426950409f * r, r2 = r * r;
#pragma unroll
                for (int n = 0; n < 2; ++n)
#pragma unroll
                    for (int e = 0; e < 4; e += 2) { const f32x2 g2 = {acc[ai][0][m][n][e], acc[ai][0][m][n][e + 1]}, u2 = {acc[ai][1][m][n][e], acc[ai][1][m][n][e + 1]};
                        if (CHEAP) { const f32x2 p = g2 * u2 * r2; o[n * 4 + e] = p[0]; o[n * 4 + e + 1] = p[1]; }
                        else { const f32x2 x = g2 * kr; const f32x2 d = (f32x2){__builtin_amdgcn_exp2f(x[0]), __builtin_amdgcn_exp2f(x[1])} + 1.0f;
                            const f32x2 rc = (f32x2){__builtin_amdgcn_rcpf(d[0]), __builtin_amdgcn_rcpf(d[1])} * r2; const f32x2 p = (g2 * u2) * rc; o[n * 4 + e] = p[0]; o[n * 4 + e + 1] = p[1]; } }
                u32x4 w; w.x = cvt_pk_bf16(o[0], o[1]); w.y = cvt_pk_bf16(o[2], o[3]); w.z = cvt_pk_bf16(o[4], o[5]); w.w = cvt_pk_bf16(o[6], o[7]);
                if (CHEAP == 2) { if (w.x == 0x12345678u && w.y == w.z) *(u32x4*)rowp = w; } else *(u32x4*)rowp = w; }
    }
};
typedef EpiSwiGLUT<0> EpiSwiGLU;
struct EpiRet {
    static constexpr bool PERM = true, AFTER_DRAIN = false;
    bf16_t* O; int ldc; const PG8_LAS float* tab;
    __device__ __forceinline__ void operator()(const f32x4 (&acc)[2][2][4][2], const Unit& u, int wr, int wc, int fr, int fq) const {
        const int row0 = u.pm * BM + wr * 64 + fr, col0 = u.pn * BM + wc * 32 + 8 * fq;
        {
            const float osc = (u.pn >= 4) ? 0.0625f : 1.0f;
            float invf[8];
#pragma unroll
            for (int q = 0; q < 8; ++q) { const int j = wc * 32 + 8 * fq + q; invf[q] = __builtin_amdgcn_exp2f(-(float)j * (13.287712379549449f / 127.0f)) * 0.15915494309189535f; }
#pragma unroll
            for (int ai = 0; ai < 2; ++ai)
#pragma unroll
                for (int m = 0; m < 4; ++m) { const int row = row0 + ai * HALF + m * 16; const float pos = (float)(row & 2047), r = tab[u.idx * 256 + (row & 255)] * osc;
                    bf16_t* rowp = O + (size_t)row * ldc + col0;
                    float o1[8], o2[8];
#pragma unroll
                    for (int n = 0; n < 2; ++n)
#pragma unroll
                        for (int e = 0; e < 4; ++e) { const int q = n * 4 + e; float t = pos * invf[q]; t = __builtin_amdgcn_fractf(t);
                            const float sn = __builtin_amdgcn_sinf(t), cs = __builtin_amdgcn_cosf(t);
                            const float a = acc[ai][0][m][n][e], b = acc[ai][1][m][n][e];
                            o1[q] = (a * cs - b * sn) * r; o2[q] = (a * sn + b * cs) * r; }
                    u32x4 w; w.x = cvt_pk_bf16(o1[0], o1[1]); w.y = cvt_pk_bf16(o1[2], o1[3]); w.z = cvt_pk_bf16(o1[4], o1[5]); w.w = cvt_pk_bf16(o1[6], o1[7]);
                    *(u32x4*)rowp = w;
                    w.x = cvt_pk_bf16(o2[0], o2[1]); w.y = cvt_pk_bf16(o2[2], o2[3]); w.z = cvt_pk_bf16(o2[4], o2[5]); w.w = cvt_pk_bf16(o2[6], o2[7]);
                    *(u32x4*)(rowp + HALF) = w; }
        }
    }
};

struct EpiGate {
    static constexpr bool PERM = true, AFTER_DRAIN = false;
    bf16_t* Y; const bf16_t* YB; const float* ST; const PG8_LAS float* tab;
    __device__ __forceinline__ void operator()(const f32x4 (&acc)[2][2][4][2], const Unit& u, int wr, int wc, int fr, int fq) const {
        const int row0 = u.pm * BM + wr * 64 + fr, col0 = u.pn * HALF + wc * 32 + 8 * fq, head = u.pn >> 2;
#pragma unroll
        for (int ai = 0; ai < 2; ++ai) {
            f32x4 stv[4]; u32x4 yfv[4], ybv[4];
#pragma unroll
            for (int m = 0; m < 4; ++m) { const int row = row0 + ai * HALF + m * 16;
                stv[m] = *(const f32x4*)(ST + (size_t)row * 16 + head * 4); yfv[m] = *(const u32x4*)(Y + (size_t)row * 2048 + col0); ybv[m] = *(const u32x4*)(YB + (size_t)row * 2048 + col0); }
#pragma unroll
            for (int m = 0; m < 4; ++m) { const int row = row0 + ai * HALF + m * 16; const float r = tab[u.idx * 256 + (row & 255)];
                const f32x4 st = stv[m];
                const float muf = __builtin_amdgcn_ldexpf(st[0], -9), mub = __builtin_amdgcn_ldexpf(st[2], -9); float eps = 1e-6f; asm volatile("" : "+s"(eps));
                const float rf = __builtin_amdgcn_rsqf(fmaxf(__builtin_amdgcn_ldexpf(st[1], -9) - muf * muf, 0.f) + eps), rb = __builtin_amdgcn_rsqf(fmaxf(__builtin_amdgcn_ldexpf(st[3], -9) - mub * mub, 0.f) + eps);
                const float cf = rf * r, cb = rb * r, df = -muf * cf, db = -mub * cb, kr = -1.4426950409f * r;
                const u32x4 yfw = yfv[m], ybw = ybv[m];
                float o[8];
#pragma unroll
                for (int n = 0; n < 2; ++n)
#pragma unroll
                    for (int e = 0; e < 4; e += 2) { const int q = n * 4 + e; const unsigned wf = yfw[q >> 1], wb = ybw[q >> 1];
                        const f32x2 yf2 = {__builtin_bit_cast(float, wf << 16), __builtin_bit_cast(float, wf & 0xffff0000u)}, yb2 = {__builtin_bit_cast(float, wb << 16), __builtin_bit_cast(float, wb & 0xffff0000u)};
                        const f32x2 af = {acc[ai][0][m][n][e], acc[ai][0][m][n][e + 1]}, ab = {acc[ai][1][m][n][e], acc[ai][1][m][n][e + 1]};
                        const f32x2 nf = yf2 * cf + df, nb = yb2 * cb + db;
                        const f32x2 xf = __builtin_elementwise_min(af * kr, (f32x2){60.f, 60.f}), xb = __builtin_elementwise_min(ab * kr, (f32x2){60.f, 60.f});
                        const f32x2 pf = (f32x2){__builtin_amdgcn_exp2f(xf[0]), __builtin_amdgcn_exp2f(xf[1])} + 1.0f, pb = (f32x2){__builtin_amdgcn_exp2f(xb[0]), __builtin_amdgcn_exp2f(xb[1])} + 1.0f;
                        const f32x2 den = pf * pb, num = (af * nf) * pb + (ab * nb) * pf;
                        const f32x2 res = num * (f32x2){__builtin_amdgcn_rcpf(den[0]), __builtin_amdgcn_rcpf(den[1])};
                        o[q] = res[0]; o[q + 1] = res[1]; }
                u32x4 w; w.x = cvt_pk_bf16(o[0], o[1]); w.y = cvt_pk_bf16(o[2], o[3]); w.z = cvt_pk_bf16(o[4], o[5]); w.w = cvt_pk_bf16(o[6], o[7]);
                *(u32x4*)(Y + (size_t)row * 2048 + col0) = w; }
        }
    }
};

struct PanelOrder {
    int nM, G, c;
    __host__ __device__ void init(int M, int, int G_, int c_) { nM = M / BM; G = G_; c = c_; }
    __host__ __device__ bool next(int i, Unit& u) const {
        const int L = i * G + c; if (L >= 4 * nM) return false;
        if ((G & 31) == 0 && (4 * nM) % G == 0) { const int j = c >> 3, xcd = c & 7; u.pm = i * (G >> 2) + xcd * (G >> 5) + (j >> 2); u.pn = j & 3; } else { u.pm = L >> 2; u.pn = L & 3; }
        u.idx = i; return true;
    }
    __device__ __forceinline__ void a_ready(const Unit&) const {}
    __device__ __forceinline__ void done(const Unit&) const {}
};
__device__ __forceinline__ float epi_xor16(float v) { return __builtin_bit_cast(float, __builtin_amdgcn_ds_swizzle(__builtin_bit_cast(int, v), (16 << 10) | 0x1f)); }
__device__ __forceinline__ float epi_xor32(float v, int lane) { return __builtin_bit_cast(float, __builtin_amdgcn_ds_bpermute((lane ^ 32) << 2, __builtin_bit_cast(int, v))); }
struct EpiThin {
    static constexpr bool PERM = true, AFTER_DRAIN = false;
    bf16_t* XB; float* OUT; const float* gpost; float cpost; unsigned* PFc; unsigned* PFz; float* RS4; PG8_LAS float* scr;
    __device__ __forceinline__ void operator()(const f32x4 (&acc)[2][2][4][2], const Unit& u, int wr, int wc, int fr, int fq) const {
        const int lane = fr + 16 * fq, tid = (wr * 4 + wc) * 64 + lane;
        const int row0 = u.pm * BM + wr * 64 + fr, col0 = u.pn * BM + wc * 32 + 8 * fq;
        u32x4 xa[4][2];
#pragma unroll
        for (int m = 0; m < 4; ++m)
#pragma unroll
            for (int bj = 0; bj < 2; ++bj) xa[m][bj] = *(const u32x4*)(XB + (size_t)(row0 + m * 16) * 1024 + col0 + bj * HALF);
        float gp[2][8];
#pragma unroll
        for (int bj = 0; bj < 2; ++bj) { const f32x4 a = *(const f32x4*)(gpost + col0 + bj * HALF), b = *(const f32x4*)(gpost + col0 + bj * HALF + 4);
            gp[bj][0] = a[0]; gp[bj][1] = a[1]; gp[bj][2] = a[2]; gp[bj][3] = a[3]; gp[bj][4] = b[0]; gp[bj][5] = b[1]; gp[bj][6] = b[2]; gp[bj][7] = b[3]; }
#pragma unroll
        for (int ai = 0; ai < 2; ++ai)
#pragma unroll
            for (int m = 0; m < 4; ++m) { f32x2 s2v = {0.f, 0.f};
#pragma unroll
                for (int bj = 0; bj < 2; ++bj)
#pragma unroll
                    for (int n = 0; n < 2; ++n) { const f32x2 a0 = {acc[ai][bj][m][n][0], acc[ai][bj][m][n][1]}, a1 = {acc[ai][bj][m][n][2], acc[ai][bj][m][n][3]}; s2v += a0 * a0; s2v += a1 * a1; }
                float s = s2v[0] + s2v[1];
                s += epi_xor16(s); s += epi_xor32(s, lane);
                if (fq == 0) scr[wc * 256 + ai * HALF + wr * 64 + m * 16 + fr] = s; }
        asm volatile("s_waitcnt lgkmcnt(0)" ::: "memory"); __builtin_amdgcn_s_barrier(); asm volatile("" ::: "memory");
        if (tid < 256) {
            const float tot = (scr[tid] + scr[256 + tid]) + (scr[512 + tid] + scr[768 + tid]);
            const size_t gi = (size_t)(u.pm * BM + tid) * 4;
            __hip_atomic_store(PFc + gi + u.pn, __builtin_bit_cast(unsigned, tot) | 0x80000000u, __ATOMIC_RELAXED, __HIP_MEMORY_SCOPE_AGENT);
            __hip_atomic_store(PFz + gi + u.pn, 0u, __ATOMIC_RELAXED, __HIP_MEMORY_SCOPE_AGENT);
            unsigned w0, w1, w2, w3, sp = 0u;
            for (;;) {
                w0 = __hip_atomic_load(PFc + gi + 0, __ATOMIC_RELAXED, __HIP_MEMORY_SCOPE_AGENT); w1 = __hip_atomic_load(PFc + gi + 1, __ATOMIC_RELAXED, __HIP_MEMORY_SCOPE_AGENT);
                w2 = __hip_atomic_load(PFc + gi + 2, __ATOMIC_RELAXED, __HIP_MEMORY_SCOPE_AGENT); w3 = __hip_atomic_load(PFc + gi + 3, __ATOMIC_RELAXED, __HIP_MEMORY_SCOPE_AGENT);
                if ((w0 != 0u) & (w1 != 0u) & (w2 != 0u) & (w3 != 0u)) break;
                __builtin_amdgcn_s_sleep(2);
                if (++sp > (1u << 20)) break;
            }
            const float ssum = (__builtin_bit_cast(float, w0 & 0x7fffffffu) + __builtin_bit_cast(float, w1 & 0x7fffffffu)) + (__builtin_bit_cast(float, w2 & 0x7fffffffu) + __builtin_bit_cast(float, w3 & 0x7fffffffu));
            float eps = 1e-6f; asm volatile("" : "+s"(eps));
            scr[1024 + tid] = cpost * __builtin_amdgcn_rsqf(ssum * (1.0f / 1024.0f) + eps);
        }
        asm volatile("s_waitcnt lgkmcnt(0)" ::: "memory"); __builtin_amdgcn_s_barrier(); asm volatile("" ::: "memory");
#pragma unroll
        for (int ai = 0; ai < 2; ++ai) {
            if (ai == 1) {
#pragma unroll
                for (int m = 0; m < 4; ++m)
#pragma unroll
                    for (int bj = 0; bj < 2; ++bj) xa[m][bj] = *(const u32x4*)(XB + (size_t)(row0 + HALF + m * 16) * 1024 + col0 + bj * HALF); }
#pragma unroll
            for (int m = 0; m < 4; ++m) { const int row = row0 + ai * HALF + m * 16; const float rF = scr[1024 + (row & 255)]; f32x2 s2p = {0.f, 0.f};
#pragma unroll
                for (int bj = 0; bj < 2; ++bj) { const u32x4 xw = xa[m][bj]; float o[8];
#pragma unroll
                    for (int n = 0; n < 2; ++n)
#pragma unroll
                        for (int e = 0; e < 4; e += 2) { const int q = n * 4 + e; const unsigned w = xw[q >> 1];
                            const f32x2 xv = {__builtin_bit_cast(float, w << 16), __builtin_bit_cast(float, w & 0xffff0000u)}, av = {acc[ai][bj][m][n][e], acc[ai][bj][m][n][e + 1]}, gv = {gp[bj][q], gp[bj][q + 1]};
                            const f32x2 ov = xv + av * (gv * rF); s2p += ov * ov; o[q] = ov[0]; o[q + 1] = ov[1]; }
                    if (OUT) { float* op = OUT + (size_t)row * 1024 + col0 + bj * HALF;
                        __builtin_nontemporal_store((f32x4){o[0], o[1], o[2], o[3]}, (f32x4*)op); __builtin_nontemporal_store((f32x4){o[4], o[5], o[6], o[7]}, (f32x4*)(op + 4)); }
                    else { u32x4 w; w.x = cvt_pk_bf16(o[0], o[1]); w.y = cvt_pk_bf16(o[2], o[3]); w.z = cvt_pk_bf16(o[4], o[5]); w.w = cvt_pk_bf16(o[6], o[7]);
                        *(u32x4*)(XB + (size_t)row * 1024 + col0 + bj * HALF) = w; } }
                float s2 = s2p[0] + s2p[1];
                s2 += epi_xor16(s2); s2 += epi_xor32(s2, lane);
                if (fq == 0) scr[wc * 256 + (row & 255)] = s2; }
        }
        asm volatile("s_waitcnt lgkmcnt(0)" ::: "memory"); __builtin_amdgcn_s_barrier(); asm volatile("" ::: "memory");
        if (tid < 256) RS4[(size_t)(u.pm * BM + tid) * 4 + u.pn] = (scr[tid] + scr[256 + tid]) + (scr[512 + tid] + scr[768 + tid]);
    }
};

struct EpiVT {
    static constexpr bool PERM = true, AFTER_DRAIN = false;
    bf16_t* O; int ldc; int ldil; const PG8_LAS float* tab;
    __device__ __forceinline__ void operator()(const f32x4 (&acc)[2][2][4][2], const Unit& u, int wr, int wc, int fr, int fq) const {
        const int lper = 8 - ldil, per = 1 << lper, Ls = 2048 >> ldil, b = u.pn >> 3, pl = u.pn & 7;
        const int row0 = u.pm * BM + wr * 64 + fr;
        int colb[2]; float cs[2][8];
#pragma unroll
        for (int bj = 0; bj < 2; ++bj) { const int c0 = bj * HALF + wc * 32 + 8 * fq; colb[bj] = b * 2048 + (c0 >> lper) * Ls + pl * per + (c0 & (per - 1));
            const f32x4 a = *(const PG8_LAS f32x4*)(tab + u.idx * 256 + c0), b4 = *(const PG8_LAS f32x4*)(tab + u.idx * 256 + c0 + 4);
            cs[bj][0] = a[0]; cs[bj][1] = a[1]; cs[bj][2] = a[2]; cs[bj][3] = a[3]; cs[bj][4] = b4[0]; cs[bj][5] = b4[1]; cs[bj][6] = b4[2]; cs[bj][7] = b4[3]; }
#pragma unroll
        for (int ai = 0; ai < 2; ++ai)
#pragma unroll
            for (int m = 0; m < 4; ++m) { bf16_t* rowp = O + (size_t)(row0 + ai * HALF + m * 16) * ldc;
#pragma unroll
                for (int bj = 0; bj < 2; ++bj) { const f32x4 v0 = acc[ai][bj][m][0], v1 = acc[ai][bj][m][1];
                    u32x4 w; w.x = cvt_pk_bf16(v0[0] * cs[bj][0], v0[1] * cs[bj][1]); w.y = cvt_pk_bf16(v0[2] * cs[bj][2], v0[3] * cs[bj][3]); w.z = cvt_pk_bf16(v1[0] * cs[bj][4], v1[1] * cs[bj][5]); w.w = cvt_pk_bf16(v1[2] * cs[bj][6], v1[3] * cs[bj][7]);
                    *(u32x4*)(rowp + colb[bj]) = w; } }
    }
};
template <class Epi, class Sched, bool ALIGN_EPI = false, bool SP2 = false>
__device__ __forceinline__ void gemm_phase(PG8_LAS unsigned char* lds, const Gemm g, const Sched& S, const Epi& E, const int tid) {
    const int wid = __builtin_amdgcn_readfirstlane(tid >> 6), lane = tid & 63, wr = wid >> 2, wc = wid & 3, fr = lane & 15, fq = lane >> 4;
    const int K = g.K, nt = K / BK;
    unsigned voffA[2], voffB[2], voffB1[2];
#pragma unroll
    for (int i = 0; i < 2; ++i) { int R, C; stage_rc(tid * 16 + i * 8192, R, C); const int Rb = Epi::PERM ? ((R & ~31) + perm32(R & 31)) : R;
        voffA[i] = (unsigned)(R * (g.ablk ? BK : K) + C) * 2u; { const int ld = g.ldil, lper = 8 - ld, pm1 = (1 << lper) - 1; const int c0 = Rb, c1 = 128 + Rb; voffB[i] = (unsigned)((((c0 & pm1) << ld) + (c0 >> lper)) * K + C) * 2u; voffB1[i] = (unsigned)((((c1 & pm1) << ld) + (c1 >> lper)) * K + C) * 2u; } }
    const size_t kstep = (size_t)(BK * 2);
    const size_t hstep = (size_t)HALF * K * 2;
    const size_t tstep = 2 * hstep;
    const size_t kstepA = g.ablk ? (size_t)32768 : kstep, hstepA = g.ablk ? (size_t)16384 : hstep, tstepA = g.ablk ? (size_t)nt * 32768 : tstep;
    const unsigned ldsw = (unsigned)wid * 1024u;
    const int aoff = lds_byte(wr * 64 + fr, fq * 8), boff = lds_byte(wc * 32 + fr, fq * 8);
#define PG8_SA(b, h) (((b) * 2 + (h)) * HTB)
#define PG8_SB(b, h) ((4 + (b) * 2 + (h)) * HTB)
#define PG8_STAGE(bufoff, gbase, voff) do { _Pragma("unroll") for (int _i = 0; _i < 2; ++_i) \
        __builtin_amdgcn_global_load_lds((const unsigned*)((const char*)(gbase) + (voff)[_i]), (PG8_LAS unsigned*)(lds + (bufoff) + ldsw + _i * 8192), 16, 0, 0); } while (0)
#define PG8_LDA(dst, b, h) do { _Pragma("unroll") for (int m = 0; m < 4; ++m) _Pragma("unroll") for (int k = 0; k < 2; ++k) dst[m][k] = *(const PG8_LAS bf16x8*)(lds + PG8_SA(b, h) + aoff + m * 2048 + k * 1024); } while (0)
#define PG8_LDB(dst, b, h) do { _Pragma("unroll") for (int n = 0; n < 2; ++n) _Pragma("unroll") for (int k = 0; k < 2; ++k) dst[n][k] = *(const PG8_LAS bf16x8*)(lds + PG8_SB(b, h) + boff + n * 2048 + k * 1024); } while (0)
#define PG8_MMA(ai, bj, At, Bt) do { __builtin_amdgcn_s_setprio(1); _Pragma("unroll") for (int m = 0; m < 4; ++m) _Pragma("unroll") for (int n = 0; n < 2; ++n) _Pragma("unroll") for (int k = 0; k < 2; ++k) \
        acc[ai][bj][m][n] = __builtin_amdgcn_mfma_f32_16x16x32_bf16(Bt[n][k], At[m][k], acc[ai][bj][m][n], 0, 0, 0); __builtin_amdgcn_s_setprio(0); } while (0)
#define PG8_WAIT_V(n) asm volatile("s_waitcnt vmcnt(" #n ")" ::: "memory")
#define PG8_WAIT_L(n) asm volatile("s_waitcnt lgkmcnt(" #n ")" ::: "memory")
#define PG8_BAR __builtin_amdgcn_s_barrier()
#define PG8_SCHED __builtin_amdgcn_sched_barrier(0)
    Unit cur, nxt; int ui = 0;
    if (!S.next(0, cur)) return;
    f32x4 acc[2][2][4][2];
#pragma unroll
    for (int a = 0; a < 2; ++a)
#pragma unroll
        for (int b = 0; b < 2; ++b)
#pragma unroll
            for (int m = 0; m < 4; ++m)
#pragma unroll
                for (int n = 0; n < 2; ++n) acc[a][b][m][n] = (f32x4){0.f, 0.f, 0.f, 0.f};
    bf16x8 At[4][2], B0[2][2], B1[2][2];
    const char* cA = (const char*)g.A + (size_t)cur.pm * tstepA; const char* cB = (const char*)g.Bt + (size_t)cur.pn * tstep;
    S.a_ready(cur);
    if constexpr (SP2) {
        PG8_STAGE(PG8_SB(0, 0), cB, voffB); PG8_STAGE(PG8_SB(0, 1), cB, voffB1); PG8_STAGE(PG8_SA(0, 0), cA, voffA); PG8_STAGE(PG8_SA(0, 1), cA + hstepA, voffA);
        if (wr == 1) PG8_BAR;
        PG8_WAIT_V(2); PG8_BAR;
        PG8_STAGE(PG8_SB(1, 0), cB + kstep, voffB); PG8_STAGE(PG8_SA(1, 0), cA + kstepA, voffA); PG8_STAGE(PG8_SB(1, 1), cB + kstep, voffB1);
        PG8_WAIT_V(6); PG8_BAR;
    } else {
        PG8_STAGE(PG8_SB(0, 0), cB, voffB); PG8_STAGE(PG8_SA(0, 0), cA, voffA); PG8_STAGE(PG8_SB(0, 1), cB, voffB1); PG8_STAGE(PG8_SA(0, 1), cA + hstepA, voffA);
        if (wr == 1) PG8_BAR;
        PG8_WAIT_V(4); PG8_BAR;
        PG8_STAGE(PG8_SB(1, 0), cB + kstep, voffB); PG8_STAGE(PG8_SA(1, 0), cA + kstepA, voffA); PG8_STAGE(PG8_SB(1, 1), cB + kstep, voffB1);
        PG8_WAIT_V(6); PG8_BAR;
    }
    for (;;) {
        const bool has_next = S.next(ui + 1, nxt);
        const char* nA = has_next ? (const char*)g.A + (size_t)nxt.pm * tstepA : cA; const char* nB = has_next ? (const char*)g.Bt + (size_t)nxt.pn * tstep : cB;
        for (int t = 0; t < nt; t += 2) {
            const bool last = (t == nt - 2);
            const char* a1 = cA + (size_t)(t + 1) * kstepA;
            const char* a2 = last ? nA : cA + (size_t)(t + 2) * kstepA; const char* b2 = last ? nB : cB + (size_t)(t + 2) * kstep;
            const char* a3 = a2 + kstepA; const char* b3 = b2 + kstep;
            if (last && has_next) S.a_ready(nxt);
            if constexpr (SP2) {
            PG8_LDB(B0, 0, 0); PG8_LDB(B1, 0, 1); PG8_SCHED; PG8_LDA(At, 0, 0); PG8_STAGE(PG8_SA(1, 1), a1 + hstepA, voffA);
            PG8_WAIT_V(8); PG8_WAIT_L(0); PG8_BAR; PG8_MMA(0, 0, At, B0); PG8_MMA(0, 1, At, B1); PG8_BAR; PG8_SCHED;
            PG8_LDA(At, 0, 1); PG8_STAGE(PG8_SB(0, 0), b2, voffB); PG8_STAGE(PG8_SB(0, 1), b2, voffB1); PG8_STAGE(PG8_SA(0, 0), a2, voffA);
            PG8_WAIT_V(8); PG8_WAIT_L(0); PG8_BAR; PG8_MMA(1, 0, At, B0); PG8_MMA(1, 1, At, B1); PG8_BAR; PG8_SCHED;
            PG8_LDB(B0, 1, 0); PG8_LDB(B1, 1, 1); PG8_SCHED; PG8_LDA(At, 1, 0); PG8_STAGE(PG8_SA(0, 1), a2 + hstepA, voffA);
            PG8_WAIT_V(8); PG8_WAIT_L(0); PG8_BAR; PG8_MMA(0, 0, At, B0); PG8_MMA(0, 1, At, B1); PG8_BAR; PG8_SCHED;
            PG8_LDA(At, 1, 1); PG8_STAGE(PG8_SB(1, 0), b3, voffB); PG8_STAGE(PG8_SB(1, 1), b3, voffB1); PG8_STAGE(PG8_SA(1, 0), a3, voffA);
            PG8_WAIT_V(8); PG8_WAIT_L(0); PG8_BAR; PG8_MMA(1, 0, At, B0); PG8_MMA(1, 1, At, B1); PG8_BAR; PG8_SCHED;
            } else {
            PG8_LDB(B0, 0, 0); PG8_SCHED; PG8_LDA(At, 0, 0); PG8_STAGE(PG8_SA(1, 1), a1 + hstepA, voffA);
            PG8_WAIT_L(8); PG8_BAR; PG8_WAIT_L(0); PG8_MMA(0, 0, At, B0); PG8_BAR; PG8_SCHED;
            PG8_LDB(B1, 0, 1); PG8_STAGE(PG8_SB(0, 0), b2, voffB);
            PG8_BAR; PG8_WAIT_L(0); PG8_MMA(0, 1, At, B1); PG8_BAR;
            PG8_LDA(At, 0, 1); PG8_STAGE(PG8_SA(0, 0), a2, voffA);
            PG8_BAR; PG8_WAIT_L(0); PG8_MMA(1, 0, At, B0); PG8_BAR; PG8_SCHED;
            PG8_STAGE(PG8_SB(0, 1), b2, voffB1);
            PG8_WAIT_V(6); PG8_BAR; PG8_MMA(1, 1, At, B1); PG8_BAR;
            PG8_LDB(B0, 1, 0); PG8_SCHED; PG8_LDA(At, 1, 0); PG8_STAGE(PG8_SA(0, 1), a2 + hstepA, voffA);
            PG8_WAIT_L(8); PG8_BAR; PG8_WAIT_L(0); PG8_MMA(0, 0, At, B0); PG8_BAR; PG8_SCHED;
            PG8_LDB(B1, 1, 1); PG8_STAGE(PG8_SB(1, 0), b3, voffB);
            PG8_BAR; PG8_WAIT_L(0); PG8_MMA(0, 1, At, B1); PG8_BAR;
            PG8_LDA(At, 1, 1); PG8_STAGE(PG8_SA(1, 0), a3, voffA);
            PG8_BAR; PG8_WAIT_L(0); PG8_MMA(1, 0, At, B0); PG8_BAR; PG8_SCHED;
            PG8_STAGE(PG8_SB(1, 1), b3, voffB1);
            PG8_WAIT_V(6); PG8_BAR; PG8_MMA(1, 1, At, B1); PG8_BAR;
            }
        }
        if constexpr (ALIGN_EPI) { if (wr == 0) PG8_BAR; }
        if constexpr (!Epi::AFTER_DRAIN) { E(acc, cur, wr, wc, fr, fq); S.done(cur); }
        if (!has_next) break;
#pragma unroll
        for (int a = 0; a < 2; ++a)
#pragma unroll
            for (int b = 0; b < 2; ++b)
#pragma unroll
                for (int m = 0; m < 4; ++m)
#pragma unroll
                    for (int n = 0; n < 2; ++n) acc[a][b][m][n] = (f32x4){0.f, 0.f, 0.f, 0.f};
        cur = nxt; cA = nA; cB = nB; ++ui;
        if constexpr (ALIGN_EPI) { if (wr == 1) PG8_BAR; }
    }
    PG8_WAIT_V(0);
    if constexpr (!ALIGN_EPI) { if (wr == 0) PG8_BAR; }
    PG8_BAR;
    if constexpr (Epi::AFTER_DRAIN) { E.fused(acc, cur, wr, wc, fr, fq, lds, wid, lane); S.done(cur); }
#undef PG8_SA
#undef PG8_SB
#undef PG8_STAGE
#undef PG8_LDA
#undef PG8_LDB
#undef PG8_MMA
#undef PG8_WAIT_V
#undef PG8_WAIT_L
#undef PG8_BAR
#undef PG8_SCHED
}
}

constexpr int BATCH = 16, SEQ = 2048, D = 1024, M = BATCH * SEQ, DEPTH = 4, DFF = 2816;
constexpr int NGRP = 3, HA = 16, DHA = 64, ATT_COLS = 3 * D;
constexpr int HR = 4, DKR = 256, DVR = 512, DV = HR * DVR, RET_COLS = 2 * D + 3 * DV;
constexpr int MH = M / 2;
constexpr float NORM_EPS = 1e-6f;
constexpr int NWAVES = 8, NTHREADS = NWAVES * 64;
constexpr int NPHASES = 1 + (DEPTH / 2) * (11 + 9);

__device__ const unsigned char T5_BUCKET[3][129] = {
{11,11,11,11,11,11,11,11,11,11,11,11,11,11,11,10,10,10,10,10,10,10,10,10,10,10,10,10,10,10,10,10,10,10,10,10,10,10,9,9,9,9,9,9,9,9,9,9,9,9,8,8,8,8,8,8,8,7,6,5,4,3,2,1,0,17,18,19,20,21,22,23,24,24,24,24,24,24,24,25,25,25,25,25,25,25,25,25,25,25,25,26,26,26,26,26,26,26,26,26,26,26,26,26,26,26,26,26,26,26,26,26,26,26,27,27,27,27,27,27,27,27,27,27,27,27,27,27,27},
{13,13,13,13,13,13,13,13,13,13,13,13,13,13,13,13,13,13,13,13,13,13,13,12,12,12,12,12,12,12,12,12,12,12,12,12,12,12,12,12,12,12,11,11,11,11,11,11,11,11,11,11,10,10,10,10,10,10,9,9,9,8,8,4,0,20,24,24,25,25,25,26,26,26,26,26,26,27,27,27,27,27,27,27,27,27,27,28,28,28,28,28,28,28,28,28,28,28,28,28,28,28,28,28,28,28,29,29,29,29,29,29,29,29,29,29,29,29,29,29,29,29,29,29,29,29,29,29,29},
{15,15,15,15,15,15,15,15,15,15,15,15,15,15,15,15,15,15,15,15,15,15,15,15,15,15,15,15,15,15,14,14,14,14,14,14,14,14,14,14,14,14,14,14,14,13,13,13,13,13,13,13,13,13,12,12,12,12,12,11,11,10,10,9,0,25,26,26,27,27,28,28,28,28,28,29,29,29,29,29,29,29,29,29,30,30,30,30,30,30,30,30,30,30,30,30,30,30,30,31,31,31,31,31,31,31,31,31,31,31,31,31,31,31,31,31,31,31,31,31,31,31,31,31,31,31,31,31,31}};

constexpr size_t MiB = 1u << 20;
constexpr size_t WS_CTL = 0;
constexpr size_t WS_PF = 64 * 1024;
constexpr size_t CTL_ZERO_BYTES = WS_PF + (size_t)2 * M * 4 * 4;
constexpr size_t WS_BIAS = 1 * MiB + 256 * 1024;
constexpr size_t WS_RS = 1 * MiB + 512 * 1024;
constexpr size_t WS_W = 2 * MiB;
constexpr size_t WS_W2A = WS_W + 18 * MiB, WS_W2B = 540 * MiB;
static_assert(CTL_ZERO_BYTES <= WS_BIAS && WS_BIAS + 3 * 16 * 129 * 4 <= WS_RS && WS_RS + (size_t)M * 16 == WS_W, "low d_ws map");
constexpr size_t WS_XH = 26 * MiB;
constexpr size_t WS_YC = 90 * MiB;
constexpr size_t WS_BIG = 218 * MiB;
constexpr size_t WS_F = 410 * MiB;
constexpr size_t WS_RVT = 346 * MiB;
constexpr size_t WS_OACC = 474 * MiB;
constexpr size_t WS_LSE = 538 * MiB;
constexpr size_t WS_END = 546 * MiB;
static_assert((size_t)NGRP * ATT_COLS * D * 2 <= 18 * MiB && (size_t)RET_COLS * D * 2 <= 18 * MiB && (size_t)2 * DFF * D * 2 <= 18 * MiB && WS_W2A + (size_t)D * DFF * 2 <= WS_XH && WS_W2B + (size_t)D * DFF * 2 <= WS_END, "weight regions");
constexpr int RP_COLS = 2 * D + 2 * DV;
static_assert(WS_XH + (size_t)M * D * 2 == WS_YC && WS_YC + (size_t)M * DV * 2 == WS_BIG && WS_BIG + (size_t)MH * RP_COLS * 2 == WS_F && WS_BIG + (size_t)M * 2 * D * 2 == WS_RVT && WS_RVT + (size_t)DV * M * 2 == WS_OACC && WS_F + (size_t)M * D * 2 == WS_OACC && WS_OACC + (size_t)M * D * 2 == WS_LSE, "d_ws map");
static_assert((size_t)M * DFF * 2 <= 192 * MiB && (size_t)M * ATT_COLS * 2 <= 192 * MiB && WS_LSE + (size_t)M * 16 * 4 <= WS_END, "d_ws map");
constexpr int CW_BAR = 4096;

constexpr int RING_OFF = 0, RING_BYTES = 149504;
constexpr int LDSCTL_OFF = RING_BYTES, MISC_OFF = LDSCTL_OFF + 320;
constexpr int LDS_BYTES = RING_BYTES + 512 + (PROBE_TSEL ? 64 : 0);
static_assert(MISC_OFF + 128 <= LDS_BYTES, "LDS map");

#define LAS __attribute__((address_space(3)))
typedef unsigned short bf16;
typedef unsigned v4u __attribute__((ext_vector_type(4)));
typedef unsigned v2u __attribute__((ext_vector_type(2)));
typedef float f32x4 __attribute__((ext_vector_type(4)));
#define LDS_WAIT() asm volatile("s_waitcnt lgkmcnt(0)" ::: "memory")
__device__ __forceinline__ unsigned f2bf(float f) { unsigned u = __builtin_bit_cast(unsigned, f); return (u + 0x7fffu + ((u >> 16) & 1u)) >> 16; }
__device__ __forceinline__ unsigned pk2(float lo, float hi) { return f2bf(lo) | (f2bf(hi) << 16); }
__device__ __forceinline__ float bflo(unsigned w) { return __builtin_bit_cast(float, w << 16); }
__device__ __forceinline__ float bfhi(unsigned w) { return __builtin_bit_cast(float, w & 0xffff0000u); }
__device__ __forceinline__ float opaque_f(float c) { float v = c; asm volatile("" : "+s"(v)); return v; }
template <int O> __device__ __forceinline__ float swz_xor(float v) { return __builtin_bit_cast(float, __builtin_amdgcn_ds_swizzle(__builtin_bit_cast(int, v), (O << 10) | 0x1f)); }
__device__ __forceinline__ float wave_sum(float v) {
    v += swz_xor<1>(v); v += swz_xor<2>(v); v += swz_xor<4>(v); v += swz_xor<8>(v); v += swz_xor<16>(v);
    return __builtin_bit_cast(float, __builtin_amdgcn_readlane(__builtin_bit_cast(int, v), 0)) + __builtin_bit_cast(float, __builtin_amdgcn_readlane(__builtin_bit_cast(int, v), 32));
}
__device__ __forceinline__ float get_xor32(float v, int lane) { return __builtin_bit_cast(float, __builtin_amdgcn_ds_bpermute((lane ^ 32) << 2, __builtin_bit_cast(int, v))); }

#define XB_TMO      128
#define XB_XCNT(j)  (256  + 64 * (j))
#define XB_XSUB(j)  (1280 + 64 * (j))
#define XB_XGEN(j)  (2304 + 64 * (j))
#define XB_TOP      3328
#define XB_TOPGEN   3392
#define XCD_BAR_WORDS 3456
#define XB_SPIN_CAP (1u << 18)

__device__ __forceinline__ unsigned xb_ld(unsigned* p)              { return __hip_atomic_load(p, __ATOMIC_RELAXED, __HIP_MEMORY_SCOPE_AGENT); }
__device__ __forceinline__ unsigned xb_add(unsigned* p, unsigned v) { return __hip_atomic_fetch_add(p, v, __ATOMIC_RELAXED, __HIP_MEMORY_SCOPE_AGENT); }
__device__ __forceinline__ unsigned xb_xcc_id() { return (unsigned)__builtin_amdgcn_s_getreg((3 << 11) | 20) & 0xFu; }
#define XB_SPIN(cond, bar) do { unsigned _sp = 0; while (cond) { __builtin_amdgcn_s_sleep(1); \
    if ((++_sp & 255u) == 0u) { if (xb_ld(&(bar)[XB_TMO])) break; if (_sp > XB_SPIN_CAP) { atomicAdd(&(bar)[XB_TMO], 1u); break; } } } } while (0)

struct XcdBarrier {
    unsigned* bar; unsigned x;
    volatile LAS unsigned* st;
};

__device__ __forceinline__ XcdBarrier xcd_barrier_post(unsigned* bar, volatile LAS unsigned* st) {
    XcdBarrier b; b.bar = bar; b.x = xb_xcc_id(); b.st = st;
    if (threadIdx.x == 0) (void)xb_add(&bar[XB_XCNT(b.x)], 1u);
    return b;
}
__device__ __forceinline__ void xcd_barrier_complete(unsigned* bar, unsigned x, unsigned& nloc, unsigned& nx) {
    const unsigned G = gridDim.x * gridDim.y * gridDim.z;
    unsigned sum, cnt, mine, sp = 0u;
    for (;;) {
        sum = 0u; cnt = 0u; mine = 0u;
#pragma unroll
        for (unsigned j = 0; j < 16; ++j) { const unsigned c = xb_ld(&bar[XB_XCNT(j)]); sum += c; cnt += (c > 0u) ? 1u : 0u; mine = (j == x) ? c : mine; }
        if (sum == G) break;
        __builtin_amdgcn_s_sleep(1);
        if ((++sp & 255u) == 0u) { if (xb_ld(&bar[XB_TMO])) break; if (sp > XB_SPIN_CAP) { atomicAdd(&bar[XB_TMO], 1u); break; } }
    }
    nloc = mine > 0u ? mine : 1u; nx = cnt > 0u ? cnt : 1u;
}

__device__ __forceinline__ void xcd_barrier(const XcdBarrier& b) {
    asm volatile("s_waitcnt vmcnt(0)" ::: "memory");
    __syncthreads();
    if (threadIdx.x == 0) {
        unsigned* bar = b.bar;
        __builtin_amdgcn_s_waitcnt(0);
        unsigned nloc = b.st[0], nx = b.st[1];
        if (nloc == 0u) { xcd_barrier_complete(bar, b.x, nloc, nx); b.st[0] = nloc; b.st[1] = nx; }
        const unsigned old = xb_add(&bar[XB_XSUB(b.x)], 1u);
        const unsigned gen = old / nloc;
        if (old + 1u == (gen + 1u) * nloc) {
            __builtin_amdgcn_fence(__ATOMIC_RELEASE, "agent");
            asm volatile("s_waitcnt vmcnt(0)" ::: "memory");
            const unsigned og = xb_add(&bar[XB_TOP], 1u);
            const unsigned tg = og / nx;
            if (og + 1u == (tg + 1u) * nx) xb_add(&bar[XB_TOPGEN], 1u);
            else XB_SPIN(xb_ld(&bar[XB_TOPGEN]) == tg, bar);
            __builtin_amdgcn_fence(__ATOMIC_ACQUIRE, "agent");
            xb_add(&bar[XB_XGEN(b.x)], 1u);
            asm volatile("s_waitcnt vmcnt(0)" ::: "memory");
        } else {
            XB_SPIN(xb_ld(&bar[XB_XGEN(b.x)]) == gen, bar);
            __builtin_amdgcn_fence(__ATOMIC_ACQUIRE, "agent");
            asm volatile("s_waitcnt vmcnt(0)" ::: "memory");
        }
    }
    __syncthreads();
}


constexpr int CV_KR = 32, CV_SCR = 64 * 65 * 4;
struct CvItem { const float* src; int srcN, k0; bf16* dst; int dstK; };
__device__ __forceinline__ void conv_load(const CvItem& I, f32x4 (&v)[CV_KR / 4], int lane) {
    const float* src = I.src + (size_t)(lane >> 4) * I.srcN + (lane & 15) * 4;
#pragma unroll
    for (int i = 0; i < CV_KR / 4; ++i) v[i] = __builtin_nontemporal_load((const f32x4*)(src + (size_t)(4 * i) * I.srcN));
}
__device__ __forceinline__ void conv_store(const CvItem& I, const f32x4 (&v)[CV_KR / 4], const float* gain, LAS float* scr, int lane) {
    { LAS float* d = scr + (lane >> 4) * 65 + (lane & 15) * 4;
#pragma unroll
      for (int i = 0; i < CV_KR / 4; ++i) { d[4 * i * 65 + 0] = v[i].x; d[4 * i * 65 + 1] = v[i].y; d[4 * i * 65 + 2] = v[i].z; d[4 * i * 65 + 3] = v[i].w; } }
    LDS_WAIT(); asm volatile("" ::: "memory");
    constexpr int NPC = CV_KR / 8;
    const int c = lane & (NPC - 1);
    float gk[8];
#pragma unroll
    for (int i = 0; i < 8; ++i) gk[i] = gain ? gain[I.k0 + 8 * c + i] : 1.0f;
#pragma unroll
    for (int j = 0; j < NPC; ++j) { const int n = lane / NPC + (64 / NPC) * j; const LAS float* s = scr + (8 * c) * 65 + n;
        v4u o; o.x = pk2(s[0 * 65] * gk[0], s[1 * 65] * gk[1]); o.y = pk2(s[2 * 65] * gk[2], s[3 * 65] * gk[3]); o.z = pk2(s[4 * 65] * gk[4], s[5 * 65] * gk[5]); o.w = pk2(s[6 * 65] * gk[6], s[7 * 65] * gk[7]);
        *(v4u*)(I.dst + (size_t)n * I.dstK + I.k0 + 8 * c) = o; }
    LDS_WAIT(); asm volatile("" ::: "memory");
}
template <class Dec> __device__ __forceinline__ void conv_run(const Dec& dec, int nitems, const float* gain, LAS float* scr, int gw, int NGW, int lane) {
    int it = gw; if (it >= nitems) return;
    f32x4 va[CV_KR / 4], vb[CV_KR / 4];
    conv_load(dec.item(it), va, lane);
    for (;;) {
        const int it2 = it + NGW; const bool m2 = it2 < nitems;
        if (m2) conv_load(dec.item(it2), vb, lane);
        conv_store(dec.item(it), va, gain, scr, lane); if (!m2) break;
        const int it3 = it2 + NGW; const bool m3 = it3 < nitems;
        if (m3) conv_load(dec.item(it3), va, lane);
        conv_store(dec.item(it2), vb, gain, scr, lane); if (!m3) break;
        it = it3;
    }
}
template <int K, int N, int NC> struct CvCols { const float* W; int c0; bf16* WT; int r0;
    __device__ __forceinline__ CvItem item(int it) const { constexpr int nblk = NC / 64; const int kb = it / nblk, nb = it % nblk, k0 = CV_KR * kb;
        return CvItem{W + (size_t)k0 * N + c0 + 64 * nb, N, k0, WT + (size_t)(r0 + 64 * nb) * K, K}; } };
template <int K, int N, int NC> __device__ __forceinline__ void conv_cols(const float* W, int c0, bf16* WT, int r0, const float* gain, LAS float* scr, int gw, int NGW, int lane) {
    conv_run(CvCols<K, N, NC>{W, c0, WT, r0}, (K / CV_KR) * (NC / 64), gain, scr, gw, NGW, lane);
}
template <int K, int N> __device__ __forceinline__ void conv_plain(const float* W, bf16* WT, const float* gain, LAS float* scr, int gw, int NGW, int lane) { conv_cols<K, N, N>(W, 0, WT, 0, gain, scr, gw, NGW, lane); }
struct CvGateUp { const float* Wg; long dgu; bf16* WT;
    __device__ __forceinline__ CvItem item(int it) const { constexpr int nblk = 2 * DFF / 64; const int kb = it / nblk, nb = it % nblk, k0 = CV_KR * kb, n0 = 64 * nb, pn = n0 >> 8, bj = (n0 >> 7) & 1, c0 = n0 & 127;
        return CvItem{Wg + (bj ? dgu : 0l) + (size_t)k0 * DFF + 128 * pn + c0, DFF, k0, WT + (size_t)n0 * D, D}; } };
__device__ __forceinline__ void conv_gateup(const float* Wg, const float* Wu, bf16* WT, const float* gain, LAS float* scr, int gw, int NGW, int lane) {
    conv_run(CvGateUp{Wg, (long)(Wu - Wg), WT}, (D / CV_KR) * (2 * DFF / 64), gain, scr, gw, NGW, lane);
}

template <int N> struct CvGates { const float* W; int c_f, c_b; bf16* WT; int r0;
    __device__ __forceinline__ CvItem item(int it) const { constexpr int nblk = 2 * DV / 64; const int kb = it / nblk, nb = it % nblk, k0 = CV_KR * kb, n0 = 64 * nb, pn = n0 >> 8, bj = (n0 >> 7) & 1, c0 = n0 & 127;
        return CvItem{W + (size_t)k0 * N + (bj ? c_b : c_f) + 128 * pn + c0, N, k0, WT + (size_t)(r0 + n0) * D, D}; } };
template <int N> __device__ __forceinline__ void conv_gates(const float* W, int c_f, int c_b, bf16* WT, int r0, const float* gain, LAS float* scr, int gw, int NGW, int lane) {
    conv_run(CvGates<N>{W, c_f, c_b, WT, r0}, (D / CV_KR) * (2 * DV / 64), gain, scr, gw, NGW, lane);
}
__device__ __forceinline__ void unpack8(const v4u w, float (&f)[8]) { f[0] = bflo(w.x); f[1] = bfhi(w.x); f[2] = bflo(w.y); f[3] = bfhi(w.y); f[4] = bflo(w.z); f[5] = bfhi(w.z); f[6] = bflo(w.w); f[7] = bfhi(w.w); }
__device__ __forceinline__ void p0_rows(const float* xin, bf16* XB, float* RS, int gw, int NGW, int lane) {
    for (int m = gw; m < M; m += NGW) {
        float ss = 0.f;
#pragma unroll
        for (int j = 0; j < 2; ++j) { const float* p = xin + (size_t)m * D + 512 * j + 8 * lane; const f32x4 a = __builtin_nontemporal_load((const f32x4*)p), b = __builtin_nontemporal_load((const f32x4*)(p + 4));
            ss += (a.x * a.x + a.y * a.y) + (a.z * a.z + a.w * a.w) + (b.x * b.x + b.y * b.y) + (b.z * b.z + b.w * b.w);
            v4u w; w.x = pk2(a.x, a.y); w.y = pk2(a.z, a.w); w.z = pk2(b.x, b.y); w.w = pk2(b.z, b.w); *(v4u*)(XB + (size_t)m * D + 512 * j + 8 * lane) = w; }
        ss = wave_sum(ss);
        if (lane == 0) *(f32x4*)(RS + 4 * (size_t)m) = (f32x4){ss, 0.f, 0.f, 0.f};
    }
}

typedef float f32x16 __attribute__((ext_vector_type(16)));
typedef short bf16x8s __attribute__((ext_vector_type(8)));
typedef float f32x2_t __attribute__((ext_vector_type(2))); typedef __bf16 bf16x2_t __attribute__((ext_vector_type(2)));
__device__ __forceinline__ unsigned cvtpk(float lo, float hi) { f32x2_t v = {lo, hi}; bf16x2_t b = __builtin_convertvector(v, bf16x2_t); return __builtin_bit_cast(unsigned, b); }

constexpr int RQK = 2 * D;
constexpr int RC_ST = 0, RC_RG = 65536, RC_NSLOT = 5, RC_TB = RC_RG + RC_NSLOT * 16384, RC_LDS = RC_TB + 2048;
__device__ __forceinline__ int sl_swz(int ob) { return ob ^ (((ob >> 9) & 1) << 5); }
template <int VAR  >
__device__ __forceinline__ void ret_core_mfma(const bf16* P, const bf16* VT, const float* decay_logit  , bf16* YF, bf16* YB, float* PT, LAS unsigned char* lds, const int tid, const int bid, const int G) {
    typedef short bf16x8v __attribute__((ext_vector_type(8)));
    const int w = __builtin_amdgcn_readfirstlane(tid >> 6), lane = tid & 63, fr = lane & 15, fq = lane >> 4, wr = w >> 2, wc = w & 3;
#define RC_DMA(gptr, ldsoff) __builtin_amdgcn_global_load_lds((const unsigned*)(gptr), (LAS unsigned*)(lds + (ldsoff)), 16, 0, 0)
#define RC_WAITV(n) asm volatile("s_waitcnt vmcnt(" #n ")" ::: "memory")
#define RC_WAITL() asm volatile("s_waitcnt lgkmcnt(0)" ::: "memory")
#define RC_BAR() do { asm volatile("" ::: "memory"); __builtin_amdgcn_s_barrier(); asm volatile("" ::: "memory"); } while (0)
#define RC_MFMA(b, a, c) __builtin_amdgcn_mfma_f32_16x16x32_bf16((b), (a), (c), 0, 0, 0)
#define RC_NEXT(sl) ((sl) == RC_NSLOT - 1 ? 0 : (sl) + 1)
#define RC_PREV(sl) ((sl) == 0 ? RC_NSLOT - 1 : (sl) - 1)
    const int dob = sl_swz(lane * 16), drow = 16 * w + (dob >> 6), dcc = (dob & 63) >> 1;
    const int aoff = 4 * wr * 1024 + sl_swz(fr * 64 + fq * 16), boff = 2 * wc * 1024 + sl_swz(fr * 64 + fq * 16);
    for (int u = bid; u < 512; u += G) {
        const int xcd = u & 7, idx = u >> 3, es = idx & 3, cmb = (idx >> 2) * 8 + xcd, dir = cmb & 1, h = (cmb >> 1) & 3, bl = cmb >> 3;
        const float lg = __builtin_amdgcn_logf(1.0f - __builtin_amdgcn_exp2f(decay_logit[dir * HR + h] * 1.4426950409f));
        const float cdec = __builtin_amdgcn_exp2f(lg * 128.f);
        bf16* Y = dir ? YB : YF;
        const size_t rowbase = (size_t)bl * SEQ;
        const bf16* qsrc = P + (rowbase + drow) * RQK + h * DKR + dcc;
        const bf16* ksrc = qsrc + D;
        const int drowv = (drow & ~31) + 8 * ((drow & 15) >> 2) + 4 * ((drow >> 4) & 1) + (drow & 3);
        const bf16* vsrc = VT + (size_t)(h * DVR + es * 128 + drowv) * M + rowbase + dcc;
        const bf16* vown = VT + (size_t)(h * DVR + es * 128 + 16 * w + fr) * M + rowbase + 8 * fq;
        if (tid < 128) { LAS float* tb = (LAS float*)(lds + RC_TB); const float t = (float)tid;
            tb[tid] = __builtin_amdgcn_exp2f(lg * (dir ? t : 127.f - t)); tb[128 + tid] = __builtin_amdgcn_exp2f(lg * (dir ? -t : t));
            tb[256 + tid] = __builtin_amdgcn_exp2f(lg * (dir ? t : -t)); tb[384 + tid] = __builtin_amdgcn_exp2f(lg * (dir ? 128.f - t : t + 1.f)); }
        { const v4u z = (v4u){0u, 0u, 0u, 0u};
#pragma unroll
          for (int i = 0; i < 8; ++i) *(LAS v4u*)(lds + RC_ST + (i * NTHREADS + tid) * 16) = z; }
        f32x4 acc4[16];
#pragma unroll
        for (int n = 0; n < 16; ++n) acc4[n] = (f32x4){0.f, 0.f, 0.f, 0.f};
#define RC_ISSUE(st, tk, sl) do { if ((st) < 8) { const size_t to_ = (size_t)(tk) * RQK + 32 * (st); RC_DMA(qsrc + to_, RC_RG + (sl) * 16384 + w * 1024); RC_DMA(ksrc + to_, RC_RG + (sl) * 16384 + 8192 + w * 1024); } \
                                  else RC_DMA(vsrc + (tk) + 32 * ((st) - 8), RC_RG + (sl) * 16384 + w * 1024); } while (0)
        v4u vnx[4];
        { const int tok0 = dir ? 128 * 15 : 0;
#pragma unroll
          for (int js = 0; js < 4; ++js) vnx[js] = *(const v4u*)(vown + tok0 + 32 * js);
          RC_ISSUE(0, tok0, 0); RC_ISSUE(1, tok0, 1); RC_ISSUE(2, tok0, 2); RC_ISSUE(3, tok0, 3); }
        RC_WAITL(); RC_BAR();
        int slot = 0;
        for (int c = 0; c < 16; ++c) {
            const int tok0 = 128 * (dir ? 15 - c : c), tokn = 128 * (dir ? (c < 15 ? 14 - c : 0) : (c < 15 ? c + 1 : 15));
            float lgc = lg; int zo = 0; asm volatile("" : "+v"(lgc), "+v"(zo));
            int lc = lane; asm volatile("" : "+v"(lc)); const int frc = lc & 15, fqc = lc >> 4;
            bf16x8v Avs[4];
#pragma unroll
            for (int js = 0; js < 4; ++js) { const v4u kw = vnx[js]; float kd[8];
                { const LAS f32x4* kp = (const LAS f32x4*)(lds + RC_TB + (32 * js + 8 * fqc) * 4); const f32x4 k0 = kp[0], k1 = kp[1];
                  kd[0] = k0[0]; kd[1] = k0[1]; kd[2] = k0[2]; kd[3] = k0[3]; kd[4] = k1[0]; kd[5] = k1[1]; kd[6] = k1[2]; kd[7] = k1[3]; }
                v4u sw; sw.x = cvtpk(bflo(kw.x) * kd[0], bfhi(kw.x) * kd[1]); sw.y = cvtpk(bflo(kw.y) * kd[2], bfhi(kw.y) * kd[3]); sw.z = cvtpk(bflo(kw.z) * kd[4], bfhi(kw.z) * kd[5]); sw.w = cvtpk(bflo(kw.w) * kd[6], bfhi(kw.w) * kd[7]);
                Avs[js] = __builtin_bit_cast(bf16x8v, sw); }
#pragma unroll
            for (int n = 0; n < 16; ++n) acc4[n] = acc4[n] * cdec;
            const int jj = 8 * fqc + (frc >> 2);
            const unsigned trA = (unsigned)((jj >> 4) * 1024 + sl_swz((jj & 15) * 64 + 8 * (frc & 3))), trB = (unsigned)(((jj + 4) >> 4) * 1024 + sl_swz(((jj + 4) & 15) * 64 + 8 * (frc & 3)));
            f32x4 accA[4][2], accY[4][2];
#pragma unroll
            for (int m = 0; m < 4; ++m)
#pragma unroll
                for (int n = 0; n < 2; ++n) { accA[m][n] = (f32x4){0.f, 0.f, 0.f, 0.f}; accY[m][n] = (f32x4){0.f, 0.f, 0.f, 0.f}; }
#pragma unroll
            for (int ks = 0; ks < 8; ++ks) {
                if (ks < 4) { if (c == 0) RC_WAITV(6); else RC_WAITV(18); } else if (ks == 4) RC_WAITV(6); else if (ks == 5) RC_WAITV(5); else if (ks == 6) RC_WAITV(4); else RC_WAITV(3);
                RC_BAR();
                { const int s4 = RC_PREV(slot);
                  if (ks + 4 < 12) RC_ISSUE(ks + 4, tok0, s4); else RC_ISSUE(ks + 4 - 12, tokn, s4); }
                bf16x8v At[4], Bk[2], Bs[2];
                const LAS unsigned char* sq = lds + RC_RG + slot * 16384;
#pragma unroll
                for (int m = 0; m < 4; ++m) At[m] = *(const LAS bf16x8v*)(sq + aoff + m * 1024);
#pragma unroll
                for (int n = 0; n < 2; ++n) { Bk[n] = *(const LAS bf16x8v*)(sq + 8192 + boff + n * 1024); Bs[n] = *(const LAS bf16x8v*)(lds + RC_ST + ks * 8192 + boff + n * 1024); }
                RC_WAITL();
#pragma unroll
                for (int m = 0; m < 4; ++m)
#pragma unroll
                    for (int n = 0; n < 2; ++n) { accA[m][n] = RC_MFMA(Bk[n], At[m], accA[m][n]); accY[m][n] = RC_MFMA(Bs[n], At[m], accY[m][n]); }
                { const unsigned kb = (unsigned)(size_t)(sq + 8192);
#pragma unroll
                  for (int nl = 0; nl < 2; ++nl) { const unsigned a0 = kb + (trA ^ (nl << 5)), a1 = kb + (trB ^ (nl << 5));
                      v2u l0, h0, l1, h1, l2, h2, l3, h3;
                      asm volatile("ds_read_b64_tr_b16 %0, %8\n\tds_read_b64_tr_b16 %1, %9\n\tds_read_b64_tr_b16 %2, %8 offset:2048\n\tds_read_b64_tr_b16 %3, %9 offset:2048\n\t"
                                   "ds_read_b64_tr_b16 %4, %8 offset:4096\n\tds_read_b64_tr_b16 %5, %9 offset:4096\n\tds_read_b64_tr_b16 %6, %8 offset:6144\n\tds_read_b64_tr_b16 %7, %9 offset:6144\n\ts_waitcnt lgkmcnt(0)"
                                   : "=&v"(l0), "=&v"(h0), "=&v"(l1), "=&v"(h1), "=&v"(l2), "=&v"(h2), "=&v"(l3), "=&v"(h3) : "v"(a0), "v"(a1) : "memory");
                      acc4[2 * ks + nl] = RC_MFMA(__builtin_bit_cast(bf16x8v, ((v4u){l0.x, l0.y, h0.x, h0.y})), Avs[0], acc4[2 * ks + nl]);
                      acc4[2 * ks + nl] = RC_MFMA(__builtin_bit_cast(bf16x8v, ((v4u){l1.x, l1.y, h1.x, h1.y})), Avs[1], acc4[2 * ks + nl]);
                      acc4[2 * ks + nl] = RC_MFMA(__builtin_bit_cast(bf16x8v, ((v4u){l2.x, l2.y, h2.x, h2.y})), Avs[2], acc4[2 * ks + nl]);
                      acc4[2 * ks + nl] = RC_MFMA(__builtin_bit_cast(bf16x8v, ((v4u){l3.x, l3.y, h3.x, h3.y})), Avs[3], acc4[2 * ks + nl]); } }
                slot = RC_NEXT(slot);
            }
#pragma unroll
            for (int m = 0; m < 4; ++m)
#pragma unroll
                for (int n = 0; n < 2; ++n) { const int i = 64 * wr + 16 * m + frc;
                    const float qdf = *(const LAS float*)(lds + RC_TB + 1536 + i * 4), rwf = *(const LAS float*)(lds + RC_TB + 512 + i * 4);
                    const f32x4 clf = *(const LAS f32x4*)(lds + RC_TB + 1024 + (32 * wc + 16 * n + 4 * fqc) * 4);
                    accY[m][n] = accY[m][n] * qdf;
#pragma unroll
                    for (int ii = 0; ii < 4; ++ii) { const int j = 32 * wc + 16 * n + 4 * fqc + ii; const int dd = dir ? j - i : i - j;
                        accA[m][n][ii] = dd >= 0 ? accA[m][n][ii] * (rwf * clf[ii]) : 0.f; } }
            RC_BAR();
#pragma unroll
            for (int m = 0; m < 4; ++m)
#pragma unroll
                for (int n = 0; n < 2; ++n) { v2u pw; pw.x = cvtpk(accA[m][n][0], accA[m][n][1]); pw.y = cvtpk(accA[m][n][2], accA[m][n][3]);
                    *(LAS v2u*)(lds + RC_ST + wc * 8192 + (4 * wr + m) * 1024 + sl_swz(frc * 64 + (16 * n + 4 * fqc) * 2)) = pw; }
#pragma unroll
            for (int js = 0; js < 4; ++js) vnx[js] = *(const v4u*)(vown + tokn + 32 * js + zo);
            RC_WAITL();
#pragma unroll
            for (int js = 0; js < 4; ++js) {
                if (js == 0) RC_WAITV(7); else if (js == 1) RC_WAITV(8); else if (js == 2) RC_WAITV(9); else RC_WAITV(10);
                RC_BAR();
                { const int s4 = RC_PREV(slot); RC_ISSUE(js, tokn, s4); }
                bf16x8v At[4], Bv[2];
                const LAS unsigned char* sv = lds + RC_RG + slot * 16384;
#pragma unroll
                for (int m = 0; m < 4; ++m) At[m] = *(const LAS bf16x8v*)(lds + RC_ST + js * 8192 + aoff + m * 1024);
#pragma unroll
                for (int n = 0; n < 2; ++n) Bv[n] = *(const LAS bf16x8v*)(sv + boff + n * 1024);
                RC_WAITL();
#pragma unroll
                for (int m = 0; m < 4; ++m)
#pragma unroll
                    for (int n = 0; n < 2; ++n) accY[m][n] = RC_MFMA(Bv[n], At[m], accY[m][n]);
                slot = RC_NEXT(slot);
            }
#pragma unroll
            for (int m = 0; m < 4; ++m) { v4u pw; pw.x = cvtpk(accY[m][0][0], accY[m][0][1]); pw.y = cvtpk(accY[m][0][2], accY[m][0][3]); pw.z = cvtpk(accY[m][1][0], accY[m][1][1]); pw.w = cvtpk(accY[m][1][2], accY[m][1][3]);
                *(v4u*)(Y + (rowbase + tok0 + 64 * wr + 16 * m + frc + zo) * DV + h * DVR + es * 128 + 32 * wc + 8 * fqc) = pw; }
#pragma unroll
            for (int m = 0; m < 4; ++m) { float sv = 0.f, sq = 0.f;
#pragma unroll
                for (int n = 0; n < 2; ++n)
#pragma unroll
                    for (int ii = 0; ii < 4; ++ii) { const float yv = accY[m][n][ii]; sv += yv; sq += yv * yv; }
                sv += swz_xor<16>(sv); sq += swz_xor<16>(sq); sv += get_xor32(sv, lc); sq += get_xor32(sq, lc);
                float* sp = PT + (((size_t)((h * 2 + dir) * 16 + es * 4 + wc)) * M + (rowbase + tok0 + 64 * wr + 16 * m + frc + zo)) * 2;
                if (fqc == 0) *(f32x2_t*)sp = (f32x2_t){sv, sq}; }
            RC_BAR();
            const int srow = 4 * (2 * (w & 1) + (frc >> 3)) + (frc & 3), ssub = 2 * (w >> 1) + ((frc >> 2) & 1);
#pragma unroll
            for (int n = 0; n < 16; ++n) { v2u pw; pw.x = cvtpk(acc4[n][0], acc4[n][1]); pw.y = cvtpk(acc4[n][2], acc4[n][3]);
                *(LAS v2u*)(lds + RC_ST + (n >> 1) * 8192 + ssub * 1024 + sl_swz(srow * 64 + (16 * (n & 1) + 4 * fqc) * 2)) = pw; }
            RC_WAITL();
        }
        RC_WAITV(0); RC_BAR();
    }
#undef RC_DMA
#undef RC_WAITV
#undef RC_WAITL
#undef RC_BAR
#undef RC_MFMA
#undef RC_NEXT
#undef RC_PREV
#undef RC_ISSUE
}

__device__ __forceinline__ void ret_stats(const float* PT, float* ST, int gtid, int nthr) {
    for (int i = gtid; i < M * 8; i += nthr) { const int hd = i / M, row = i - hd * M; const f32x2_t* p = (const f32x2_t*)PT + (size_t)hd * 16 * M + row; float sv = 0.f, sq = 0.f;
#pragma unroll
        for (int k = 0; k < 16; ++k) { const f32x2_t v = p[(size_t)k * M]; sv += v.x; sq += v.y; }
        *(f32x2_t*)(ST + ((size_t)row * 8 + hd) * 2) = (f32x2_t){sv, sq}; }
}

constexpr int AT_KROW = 144, AT_KB = 256 * AT_KROW, AT_VB = AT_KB, AT_HALF = AT_KB + AT_VB + 768, AT_LD = 3 * D;
static_assert(2 * AT_HALF <= RING_BYTES, "attention tiles");
__device__ __forceinline__ void attn_group_mfma2(const bf16* QK, const float* bias2g, int ldil, int first, bf16* OACC, float* LSE, LAS unsigned char* lds, const int tid, const int bid, const int G) {
    const int wave = __builtin_amdgcn_readfirstlane(tid >> 6), lane = tid & 63, r = lane & 31, hh = lane >> 5, hw = wave >> 2, wq = wave & 3, tih0 = tid & 255;
    LAS unsigned char* Kl = lds + hw * AT_HALF; LAS unsigned char* Vl = Kl + AT_KB; LAS float* tab = (LAS float*)(Vl + AT_VB);
    const int Ls = SEQ >> ldil, lq4 = 4 - ldil, nq4m = (1 << lq4) - 1, dilm = (1 << ldil) - 1;
    constexpr float SC = 0.125f * 1.4426950409f;
    const float NEGBIG = opaque_f(-1e30f);
    constexpr int NP = BATCH * HA * 16 / 2;
    const int npp = (NP + G - 1) / G;
    v4u kreg[8], vreg[8];
#define AT_FETCH_K(su_) do { int tih = tih0; asm volatile("" : "+v"(tih)); const int su__ = (su_); const int q4_ = su__ & nq4m, rr_ = (su__ >> lq4) & dilm, h_ = (su__ >> 4) & 15, b_ = su__ >> 8, ks_ = q4_ * 128 - 64; \
        _Pragma("unroll") for (int j = 0; j < 8; ++j) { const int pi = j * 256 + tih, row = pi >> 3, ch = pi & 7; int kt = ks_ + row; kt = kt < 0 ? 0 : (kt > Ls - 1 ? Ls - 1 : kt); \
            kreg[j] = *(const v4u*)(QK + ((size_t)b_ * SEQ + ((size_t)kt << ldil) + rr_) * AT_LD + D + h_ * 64 + ch * 8); } } while (0)
#define AT_FETCH_V(su_) do { int tih = tih0; asm volatile("" : "+v"(tih)); const int su__ = (su_); const int q4_ = su__ & nq4m, rr_ = (su__ >> lq4) & dilm, h_ = (su__ >> 4) & 15, b_ = su__ >> 8, ks_ = q4_ * 128 - 64; \
        _Pragma("unroll") for (int j = 0; j < 8; ++j) { const int pi = j * 256 + tih, row = pi >> 3, ch = pi & 7; int kt = ks_ + row; kt = kt < 0 ? 0 : (kt > Ls - 1 ? Ls - 1 : kt); \
            vreg[j] = *(const v4u*)(QK + ((size_t)b_ * SEQ + ((size_t)kt << ldil) + rr_) * AT_LD + 2 * D + h_ * 64 + ch * 8); } } while (0)
#define AT_ROWQ(su_) ((size_t)((su_) >> 8) * SEQ + ((size_t)(((su_) & nq4m) * 128 + 32 * wq + r) << ldil) + (((su_) >> lq4) & dilm))
#define AT_FETCH_Q(su_) do { const int su__ = (su_); const bf16* qp_ = QK + AT_ROWQ(su__) * AT_LD + ((su__ >> 4) & 15) * 64 + 8 * hh; \
        _Pragma("unroll") for (int ks = 0; ks < 4; ++ks) qf[ks] = *(const bf16x8s*)(qp_ + 16 * ks); } while (0)
    bf16x8s qf[4]; int htab = -1;
    const bool remap = (G == 256);
#define AT_P(it_) (remap ? ((2 * ((bid * 4 + ((it_) & 3)) >> 7) + (((it_) >> 2) ? 0 : 1)) * 128 + ((bid * 4 + ((it_) & 3)) & 127)) : bid * npp + (it_))
    if (AT_P(0) < NP) { AT_FETCH_K(2 * AT_P(0) + hw); AT_FETCH_V(2 * AT_P(0) + hw); AT_FETCH_Q(2 * AT_P(0) + hw); }
    for (int it = 0; it < npp; ++it) {
        const int p = AT_P(it); if (p >= NP) break;
        const int su = 2 * p + hw, q4 = su & nq4m, rr = (su >> lq4) & dilm, h = (su >> 4) & 15, b = su >> 8, t0 = q4 * 128 + 32 * wq;
        asm volatile("" ::: "memory"); __builtin_amdgcn_s_barrier(); asm volatile("" ::: "memory");
        int tih = tih0; asm volatile("" : "+v"(tih));
#pragma unroll
        for (int j = 0; j < 8; ++j) { const int pi = j * 256 + tih; *(LAS v4u*)(Kl + (pi >> 3) * AT_KROW + (pi & 7) * 16) = kreg[j]; }
#pragma unroll
        for (int j = 0; j < 8; ++j) { const int pi = j * 256 + tih; *(LAS v4u*)(Vl + (pi >> 3) * AT_KROW + (pi & 7) * 16) = vreg[j]; }
        if (h != htab) { htab = h; if (tih < 192) { const int o = tih - 96; tab[tih] = (o >= -64 && o <= 64) ? bias2g[h * 129 + o + 64] : NEGBIG; } }
        const size_t rowq = (size_t)b * SEQ + ((size_t)(t0 + r) << ldil) + rr;
        asm volatile("s_waitcnt lgkmcnt(0)" ::: "memory"); __builtin_amdgcn_s_barrier(); asm volatile("" ::: "memory");
        f32x16 S[5];
#pragma unroll
        for (int kb = 0; kb < 5; ++kb) {
            const LAS unsigned char* kp = Kl + (32 * wq + 32 * kb + r) * AT_KROW + 16 * hh;
#pragma unroll
            for (int i = 0; i < 16; ++i) S[kb][i] = 0.f;
#pragma unroll
            for (int ks = 0; ks < 4; ++ks) S[kb] = __builtin_amdgcn_mfma_f32_32x32x16_bf16(*(const LAS bf16x8s*)(kp + 32 * ks), qf[ks], S[kb], 0, 0, 0);
        }
        const int pnx = AT_P(it + 1); const bool more = it + 1 < npp && pnx < NP;
        __builtin_amdgcn_sched_barrier(0);
        if (more) { AT_FETCH_K(2 * pnx + hw); AT_FETCH_Q(2 * pnx + hw); AT_FETCH_V(2 * pnx + hw); }
        float lold = 0.f; v2u xo[2][4];
        if (!first) { lold = LSE[rowq * 16 + h];
#pragma unroll
            for (int db = 0; db < 2; ++db)
#pragma unroll
                for (int gq = 0; gq < 4; ++gq) xo[db][gq] = *(const v2u*)(OACC + rowq * D + h * 64 + 32 * db + 8 * gq + 4 * hh); }
        else {
#pragma unroll
            for (int db = 0; db < 2; ++db)
#pragma unroll
                for (int gq = 0; gq < 4; ++gq) xo[db][gq] = (v2u){0u, 0u}; }
        __builtin_amdgcn_sched_barrier(0);
        const LAS float* tb = tab + (32 + 4 * hh - r);
        float mx = NEGBIG;
        int kt0 = t0 - 64 + 4 * hh; asm volatile("" : "+v"(kt0));
#pragma unroll
        for (int kb = 0; kb < 5; ++kb)
#pragma unroll
            for (int i = 0; i < 16; ++i) { const int krel = 32 * kb + (i & 3) + 8 * (i >> 2);
                float s = S[kb][i] * SC + tb[krel]; s = ((unsigned)(kt0 + krel) >= (unsigned)Ls) ? NEGBIG : s; S[kb][i] = s; mx = fmaxf(mx, s); }
        mx = fmaxf(mx, get_xor32(mx, lane));
        float l = 0.f; unsigned pk[5][8];
#pragma unroll
        for (int kb = 0; kb < 5; ++kb)
#pragma unroll
            for (int i = 0; i < 8; ++i) { const float p0 = __builtin_amdgcn_exp2f(S[kb][2 * i] - mx), p1 = __builtin_amdgcn_exp2f(S[kb][2 * i + 1] - mx); l += p0 + p1; pk[kb][i] = cvtpk(p0, p1); }
        l += get_xor32(l, lane);
        f32x16 O[2];
#pragma unroll
        for (int db = 0; db < 2; ++db)
#pragma unroll
            for (int i = 0; i < 16; ++i) O[db][i] = 0.f;
#pragma unroll
        for (int kb = 0; kb < 5; ++kb) {
#pragma unroll
            for (int s2 = 0; s2 < 2; ++s2) {
                const v4u pw = (v4u){pk[kb][4 * s2 + 0], pk[kb][4 * s2 + 1], pk[kb][4 * s2 + 2], pk[kb][4 * s2 + 3]};
                const bf16x8s pf = __builtin_bit_cast(bf16x8s, pw);
                typedef short s16x4 __attribute__((ext_vector_type(4)));
                const LAS unsigned char* vb = Vl + (32 * wq + 32 * kb + 16 * s2 + 4 * hh + ((lane & 15) >> 2)) * AT_KROW + (16 * ((lane >> 4) & 1) + 4 * (lane & 3)) * 2;
#pragma unroll
                for (int db = 0; db < 2; ++db) {
                    const v2u lo = __builtin_bit_cast(v2u, __builtin_amdgcn_ds_read_tr16_b64_v4i16((LAS s16x4*)(vb + 64 * db))), hi = __builtin_bit_cast(v2u, __builtin_amdgcn_ds_read_tr16_b64_v4i16((LAS s16x4*)(vb + 64 * db + 8 * AT_KROW)));
                    const v4u vw = (v4u){lo.x, lo.y, hi.x, hi.y};
                    O[db] = __builtin_amdgcn_mfma_f32_32x32x16_bf16(__builtin_bit_cast(bf16x8s, vw), pf, O[db], 0, 0, 0); }
            }
        }
        const float il = __builtin_amdgcn_rcpf(l); float lse = mx + __builtin_amdgcn_logf(l);
        const size_t row = rowq;
        float wn = il, wo = 0.f;
        if (!first) { const float lo = lold; const float mm = fmaxf(lo, lse), eo = __builtin_amdgcn_exp2f(lo - mm), en = __builtin_amdgcn_exp2f(lse - mm), inv = __builtin_amdgcn_rcpf(eo + en); wn = en * inv * il; wo = eo * inv; lse = mm + __builtin_amdgcn_logf(eo + en); }
        if (hh == 0) LSE[row * 16 + h] = lse;
#pragma unroll
        for (int db = 0; db < 2; ++db)
#pragma unroll
            for (int gq = 0; gq < 4; ++gq) { v2u* op = (v2u*)(OACC + row * D + h * 64 + 32 * db + 8 * gq + 4 * hh);
                const v2u x = xo[db][gq];
                v2u y; y.x = cvtpk(wn * O[db][4 * gq + 0] + wo * bflo(x.x), wn * O[db][4 * gq + 1] + wo * bfhi(x.x)); y.y = cvtpk(wn * O[db][4 * gq + 2] + wo * bflo(x.y), wn * O[db][4 * gq + 3] + wo * bfhi(x.y));
                *op = y; }
    }
#undef AT_FETCH_Q
#undef AT_P
#undef AT_ROWQ
#undef AT_FETCH_K
#undef AT_FETCH_V
    __syncthreads();
}


struct Args { const float* in[11]; float* out; unsigned char* ws; int ph_lo, ph_hi; };
__global__ void __launch_bounds__(NTHREADS, 2) mk_fwd(Args args) {
    extern __shared__ __attribute__((aligned(16))) unsigned char lds_raw[];
    LAS unsigned char* lds = (LAS unsigned char*)lds_raw;
    volatile LAS unsigned* MISC = (volatile LAS unsigned*)(lds + MISC_OFF);
    const int wave0 = __builtin_amdgcn_readfirstlane(threadIdx.x >> 6);
    for (int u = threadIdx.x; u < (LDS_BYTES - LDSCTL_OFF) / 4; u += NTHREADS) ((LAS unsigned*)(lds + LDSCTL_OFF))[u] = 0u;
    __syncthreads();
    (void)xcd_barrier_post((unsigned*)(args.ws + WS_CTL) + CW_BAR, MISC + 8);
    bool again = false;
#if PROBE_TWICE
    for (int pass_ = 0; pass_ < 2; ++pass_)
#endif
    for (int ph = args.ph_lo; ph < args.ph_hi; ++ph) {
        size_t wsz = 0; asm volatile("" : "+s"(wsz)); unsigned char* ws = args.ws + wsz;
        int bid = blockIdx.x, G = gridDim.x; asm volatile("" : "+s"(bid), "+s"(G));
        const int gw = bid * NWAVES + wave0, NGW = G * NWAVES;
#define GET_TID() int tid; asm volatile("v_mbcnt_lo_u32_b32 %0, -1, 0\n\tv_mbcnt_hi_u32_b32 %0, -1, %0" : "=v"(tid)); const int lane = tid; tid += wave0 * 64; (void)lane;
        LAS float* scr = (LAS float*)(lds + RING_OFF + wave0 * CV_SCR);
        const float* gains = args.in[1]; float* out = args.out;
        float* RS = (float*)(ws + WS_RS);
        enum { T_P0, T_G1, T_FG, T_THIN, T_APROJ, T_ATT, T_RPROJ, T_RCORE, T_RGATE, T_RSTAT };
        int type, L = 0, kind = 0, aux = 0;
        if (ph == 0) type = T_P0;
        else { const int p = ph - 1, pp = p % 20, odd = pp >= 11, q = odd ? pp - 11 : pp, nmix = odd ? 5 : 7;
            L = 2 * (p / 20) + odd;
            if (q < 2) { kind = 0; type = q == 0 ? T_G1 : T_FG; }
            else if (q >= 2 + nmix) { kind = 2; type = q - 2 - nmix == 0 ? T_G1 : T_FG; }
            else { kind = 1; const int r = q - 2;
                if (r == nmix - 1) type = T_FG;
                else if (!odd) { aux = r >> 1; type = (r & 1) ? T_ATT : T_APROJ; }
                else type = r == 0 ? T_RPROJ : (r == 1 ? T_RCORE : (r == 2 ? T_RSTAT : T_RGATE)); } }
        const bool is_att = (L & 1) == 0; const int jj = L >> 1;
#if PROBE_TSEL
        volatile LAS unsigned long long* TS = (volatile LAS unsigned long long*)(lds + RING_BYTES + 512);
        if (wave0 == 0) TS[0] = __builtin_amdgcn_s_memrealtime();
#define TS_ACC() if (wave0 == 0 && ph >= PROBE_TLO && ph < PROBE_THI && ((PROBE_TMASK >> type) & 1)) TS[1] = TS[1] + (__builtin_amdgcn_s_memrealtime() - TS[0]);
#endif
#define P_BIAS ((float*)(ws + WS_BIAS))
#define P_WA   ((bf16*)(ws + WS_W))
#define P_XH   ((bf16*)(ws + WS_XH))
#define P_BIG  ((bf16*)(ws + WS_BIG))
#define P_F    ((bf16*)(ws + WS_F))
#define P_YC   ((bf16*)(ws + WS_YC))
#define P_OACC ((bf16*)(ws + WS_OACC))
#define P_LSE  ((float*)(ws + WS_LSE))
        if (type == T_P0) {
            GET_TID()
#if PROBE_TOUCH
            {
                const size_t tix = (size_t)(bid >> 3) * NTHREADS + tid, nthr = (size_t)(G >> 3) * NTHREADS; unsigned accw = 0;
                for (size_t o = tix * 65536; o < WS_END; o += nthr * 65536) accw += *(const volatile unsigned*)(ws + o);
                for (size_t o = tix * 65536; o < (size_t)M * D * 4; o += nthr * 65536) { accw += *(const volatile unsigned*)((const char*)args.in[0] + o); accw += *(const volatile unsigned*)((const char*)out + o); }
                for (size_t o = tix * 65536; o < (size_t)DEPTH * 2 * D * DFF * 4; o += nthr * 65536) { accw += *(const volatile unsigned*)((const char*)args.in[2] + o); accw += *(const volatile unsigned*)((const char*)args.in[3] + o); accw += *(const volatile unsigned*)((const char*)args.in[4] + o); }
                for (size_t o = tix * 65536; o < (size_t)2 * D * NGRP * ATT_COLS * 4; o += nthr * 65536) accw += *(const volatile unsigned*)((const char*)args.in[5] + o);
                for (size_t o = tix * 65536; o < (size_t)2 * D * RET_COLS * 4; o += nthr * 65536) accw += *(const volatile unsigned*)((const char*)args.in[8] + o);
                if (accw == 0x12345677u) P_BIAS[70000] = 1.f; }
#endif
            const float* rel_bias = args.in[7];
            if (bid == 0) for (int i = tid; i < 3 * 16 * 129; i += NTHREADS) { const int g = i / (16 * 129), h = (i / 129) % 16, kk = i % 129; P_BIAS[i] = rel_bias[(g * 16 + h) * 32 + T5_BUCKET[g][kk]] * 1.4426950409f; }
            conv_gateup(args.in[2], args.in[3], P_WA, gains, scr, gw, NGW, lane);
            conv_plain<DFF, D>(args.in[4], (bf16*)(ws + WS_W2A), nullptr, scr, gw, NGW, lane);
            p0_rows(args.in[0], P_XH, RS, gw, NGW, lane);
#if PROBE_MFMA
            {
                typedef short bx8 __attribute__((ext_vector_type(8)));
                bx8 a = {1, 2, 3, 4, 5, 6, 7, (short)lane}, b = {3, 1, 4, 1, 5, 9, 2, (short)(lane + 1)};
                f32x4 c0 = {0, 0, 0, 0}, c1 = c0, c2 = c0, c3 = c0, c4 = c0, c5 = c0, c6 = c0, c7 = c0;
                for (int it = 0; it < PROBE_MFMA; ++it) {
#pragma unroll
                    for (int r = 0; r < 4; ++r) {
                        c0 = __builtin_amdgcn_mfma_f32_16x16x32_bf16(a, b, c0, 0, 0, 0); c1 = __builtin_amdgcn_mfma_f32_16x16x32_bf16(a, b, c1, 0, 0, 0); c2 = __builtin_amdgcn_mfma_f32_16x16x32_bf16(a, b, c2, 0, 0, 0); c3 = __builtin_amdgcn_mfma_f32_16x16x32_bf16(a, b, c3, 0, 0, 0);
                        c4 = __builtin_amdgcn_mfma_f32_16x16x32_bf16(a, b, c4, 0, 0, 0); c5 = __builtin_amdgcn_mfma_f32_16x16x32_bf16(a, b, c5, 0, 0, 0); c6 = __builtin_amdgcn_mfma_f32_16x16x32_bf16(a, b, c6, 0, 0, 0); c7 = __builtin_amdgcn_mfma_f32_16x16x32_bf16(a, b, c7, 0, 0, 0); }
                    asm volatile("" : "+v"(a), "+v"(b)); }
                const f32x4 t = c0 + c1 + c2 + c3 + c4 + c5 + c6 + c7;
                if (t.x + t.y + t.z + t.w == 12345.678f) P_BIAS[60000 + tid] = t.x;
            }
#endif
        } else if (type == T_G1) {
            GET_TID()
            pg8::Gemm g{P_XH, P_WA, M, 2 * DFF, D, 0, 0}; pg8::StaticOrder S; S.init(M, 2 * DFF, G, bid);
            pg8::stage_scales(lds + RING_OFF, S, RS, false, 0, tid);
            pg8::EpiSwiGLU E{P_BIG, DFF, (const LAS float*)(lds + RING_OFF + pg8::RS_TAB_OFF)};
            pg8::gemm_phase<pg8::EpiSwiGLU, pg8::StaticOrder, true, true>(lds + RING_OFF, g, S, E, tid);
#if PROBE_G1V >= 0
            { GET_TID() pg8::Gemm g2{P_XH, P_WA, M, 2 * DFF, D, 0, 0}; pg8::StaticOrder S2; S2.init(M, 2 * DFF, G, bid);
              pg8::EpiSwiGLUT<PROBE_G1V> E2{PROBE_G1V ? P_F : P_BIG, PROBE_G1V ? D : DFF, (const LAS float*)(lds + RING_OFF + pg8::RS_TAB_OFF)};
              pg8::gemm_phase<pg8::EpiSwiGLUT<PROBE_G1V>, pg8::StaticOrder, true, true>(lds + RING_OFF, g2, S2, E2, tid); }
#endif
        } else if (type == T_FG) {
            GET_TID()
            const int sub = L * 3 + kind; const bool lastsub = sub + 1 >= 3 * DEPTH;
            if (!lastsub) {
                const int nk = (sub + 1) % 3, nL = (sub + 1) / 3, nj = nL >> 1;
                const float* gn = gains + ((size_t)nL * 6 + (nk == 0 ? 0 : (nk == 1 ? 2 : 4))) * D;
                bf16* w2n = (bf16*)(ws + (((sub + 1) & 1) ? WS_W2B : WS_W2A));
                if (nk != 1) { const size_t o = (size_t)(nL * 2 + (nk >> 1)) * D * DFF;
                    conv_gateup(args.in[2] + o, args.in[3] + o, P_WA, gn, scr, gw, NGW, lane); conv_plain<DFF, D>(args.in[4] + o, w2n, nullptr, scr, gw, NGW, lane); }
                else if ((nL & 1) == 0) { conv_plain<D, NGRP * ATT_COLS>(args.in[5] + (size_t)nj * D * NGRP * ATT_COLS, P_WA, gn, scr, gw, NGW, lane); conv_plain<D, D>(args.in[6] + (size_t)nj * D * D, w2n, nullptr, scr, gw, NGW, lane); }
                else { const float* rw = args.in[8] + (size_t)nj * D * RET_COLS;
                    conv_cols<D, RET_COLS, 2 * D + DV>(rw, 0, P_WA, 0, gn, scr, gw, NGW, lane); conv_gates<RET_COLS>(rw, 2 * D + DV, 2 * D + 2 * DV, P_WA, 2 * D + DV, gn, scr, gw, NGW, lane);
                    conv_plain<DV, D>(args.in[9] + (size_t)nj * DV * D, w2n, nullptr, scr, gw, NGW, lane); }
                asm volatile("" ::: "memory"); __syncthreads();
            }
            { GET_TID()
              const size_t fA = kind != 1 ? WS_BIG : (is_att ? WS_OACC : WS_YC), fB = (sub & 1) ? WS_W2B : WS_W2A; const int fK = kind != 1 ? DFF : (is_att ? D : DV);
              pg8::Gemm g{(const bf16*)(ws + fA), (const bf16*)(ws + fB), M, D, fK, 0, kind != 1 ? 1 : 0  }; pg8::PanelOrder S; S.init(M, D, G, bid);
              const float* gpost = gains + ((size_t)L * 6 + (kind == 0 ? 1 : (kind == 1 ? 3 : 5))) * D;
              unsigned* pf = (unsigned*)(ws + WS_PF);
              pg8::EpiThin E{P_XH, lastsub ? out : nullptr, gpost, kind == 1 ? 1.0f : 0.5f, pf + (size_t)(sub & 1) * M * 4, pf + (size_t)((sub + 1) & 1) * M * 4, RS, (LAS float*)(lds + RING_OFF + pg8::RS_TAB_OFF)};
              pg8::gemm_phase<pg8::EpiThin, pg8::PanelOrder, true, true>(lds + RING_OFF, g, S, E, tid); }
        } else if (type == T_APROJ) {
            GET_TID()
            { pg8::Gemm g{P_XH, P_WA + (size_t)aux * ATT_COLS * D, M, ATT_COLS, D, 0, 0}; pg8::StaticOrder S; S.init(M, ATT_COLS, G, bid);
              pg8::stage_scales(lds + RING_OFF, S, RS, false, 0, tid);
              pg8::EpiPlain E{P_BIG, ATT_COLS, (const LAS float*)(lds + RING_OFF + pg8::RS_TAB_OFF)};
              pg8::gemm_phase<pg8::EpiPlain, pg8::StaticOrder, true, true>(lds + RING_OFF, g, S, E, tid); }
        } else if (type == T_ATT) {
            GET_TID()
            const int ldil = 2 * aux;
            attn_group_mfma2(P_BIG, P_BIAS + aux * 16 * 129, ldil, aux == 0, P_OACC, P_LSE, lds + RING_OFF, tid, bid, G);
        } else if (type == T_RPROJ) {
            GET_TID()
            { pg8::Gemm g{P_XH, P_WA, M, 2 * D, D, 0, 0}; pg8::StaticOrder S; S.init(M, 2 * D, G, bid);
              pg8::stage_scales(lds + RING_OFF, S, RS, false, 0, tid);
              pg8::EpiRet E{P_BIG, 2 * D, (const LAS float*)(lds + RING_OFF + pg8::RS_TAB_OFF)};
              pg8::gemm_phase<pg8::EpiRet, pg8::StaticOrder, true, true>(lds + RING_OFF, g, S, E, tid); }
            { GET_TID()
              pg8::Gemm g{P_WA + (size_t)2 * D * D, P_XH, DV, M, D, 0, 0}; pg8::StaticOrder S; S.init(DV, M, G, bid);
              pg8::stage_scales(lds + RING_OFF, S, RS, true, 0, tid);
              pg8::EpiVT E{(bf16*)(ws + WS_RVT), M, 0, (const LAS float*)(lds + RING_OFF + pg8::RS_TAB_OFF)};
              pg8::gemm_phase<pg8::EpiVT, pg8::StaticOrder, true, true>(lds + RING_OFF, g, S, E, tid); }
        } else if (type == T_RCORE) {
            GET_TID()
            static_assert(RC_LDS <= RING_BYTES, "retention core LDS tiles");
            ret_core_mfma<0>(P_BIG, (const bf16*)(ws + WS_RVT), args.in[10] + jj * 2 * HR, P_YC, (bf16*)out, (float*)(ws + WS_OACC), lds + RING_OFF, tid, bid, G);
        } else if (type == T_RSTAT) {
            GET_TID()
            ret_stats((const float*)(ws + WS_OACC), P_LSE, bid * NTHREADS + tid, G * NTHREADS);
        } else {
            GET_TID()
            pg8::Gemm g{P_XH, P_WA + (size_t)(2 * D + DV) * D, M, 2 * DV, D, 0, 0}; pg8::StaticOrder S; S.init(M, 2 * DV, G, bid);
            pg8::stage_scales(lds + RING_OFF, S, RS, false, 0, tid);
            pg8::EpiGate E{P_YC, (const bf16*)out, P_LSE, (const LAS float*)(lds + RING_OFF + pg8::RS_TAB_OFF)};
            pg8::gemm_phase<pg8::EpiGate, pg8::StaticOrder, true, true>(lds + RING_OFF, g, S, E, tid);
        }
#if PROBE_TSEL && PROBE_TWORK
        TS_ACC()
#endif
        if (ph + 1 < args.ph_hi || PROBE_TWICE) { XcdBarrier b_; b_.bar = (unsigned*)(ws + WS_CTL) + CW_BAR; b_.x = xb_xcc_id(); b_.st = MISC + 8; xcd_barrier(b_);
#if PROBE_BAR2
            xcd_barrier(b_);
#endif
        }
#if PROBE_TSEL && !PROBE_TWORK
        TS_ACC()
#endif
        if (PROBE_REPEAT) {
            if (!again && ((PROBE_REPEAT >> type) & 1) && (type != T_ATT || aux == 0) && ph + 1 < args.ph_hi) { again = true; --ph; } else again = false; }
    }
#if PROBE_TSEL
    if (blockIdx.x == PROBE_TWG && wave0 == 0) {
        const unsigned long long tend = __builtin_amdgcn_s_memrealtime(), need = ((volatile LAS unsigned long long*)(lds + RING_BYTES + 512))[1] * PROBE_TAMP;
        while (__builtin_amdgcn_s_memrealtime() - tend < need) __builtin_amdgcn_s_sleep(8); }
#endif
}

extern "C" void kernel_launch(void* const* d_in, const int* in_sizes, int n_in, void* d_out, int out_size, void* d_ws, size_t ws_size, hipStream_t stream) {
    static int grid = 0;
    if (grid == 0) {
        if (n_in != 11 || in_sizes[0] != M * D || out_size != M * D || ws_size < WS_END) { fprintf(stderr, "kernel_launch: unexpected shapes / workspace (n_in %d, ws %zu, need %zu); nothing launched\n", n_in, ws_size, (size_t)WS_END); grid = -1; return; }
        int dev = 0, cus = 0, per_cu = 0;
        if (hipGetDevice(&dev) != hipSuccess || hipDeviceGetAttribute(&cus, hipDeviceAttributeMultiprocessorCount, dev) != hipSuccess) { grid = -1; return; }
        if (hipFuncSetAttribute((const void*)mk_fwd, hipFuncAttributeMaxDynamicSharedMemorySize, LDS_BYTES) != hipSuccess) { fprintf(stderr, "kernel_launch: hipFuncSetAttribute failed\n"); grid = -1; return; }
        if (hipOccupancyMaxActiveBlocksPerMultiprocessor(&per_cu, (const void*)mk_fwd, NTHREADS, LDS_BYTES) != hipSuccess || per_cu < 1) { fprintf(stderr, "kernel_launch: occupancy query reports %d workgroups per CU\n", per_cu); }
        (void)hipGetLastError();
        grid = cus;
    }
    if (grid < 0) return;
    if (hipMemsetAsync((char*)d_ws + WS_CTL, 0, CTL_ZERO_BYTES, stream) != hipSuccess) return;
    Args a{};
    for (int i = 0; i < 11; ++i) a.in[i] = (const float*)d_in[i];
    a.out = (float*)d_out; a.ws = (unsigned char*)d_ws;
#if MK_ONE_LAUNCH
    a.ph_lo = 0; a.ph_hi = NPHASES;
    hipLaunchKernelGGL(mk_fwd, dim3(grid), dim3(NTHREADS), LDS_BYTES, stream, a);
#else
    for (int p = 0; p < NPHASES; ++p) { a.ph_lo = p; a.ph_hi = p + 1; hipLaunchKernelGGL(mk_fwd, dim3(grid), dim3(NTHREADS), LDS_BYTES, stream, a); }
#endif
}
```

```cpp
#include <hip/hip_runtime.h>
#include <cstdio>
#include <cstdint>
#ifndef PROBE_REPEAT
#define PROBE_REPEAT 0
#endif
#ifndef PROBE_THIN2
#define PROBE_THIN2 0
#endif
#ifndef PROBE_ATT2
#define PROBE_ATT2 0
#endif
#ifndef PROBE_CONV2
#define PROBE_CONV2 0
#endif
#ifndef PROBE_FGM
#define PROBE_FGM 0
#endif
#ifndef PROBE_RC
#define PROBE_RC -1
#endif
#ifndef PROBE_G1V
#define PROBE_G1V -1
#endif
#ifndef PROBE_BAR2
#define PROBE_BAR2 0
#endif
#ifndef PROBE_MFMA
#define PROBE_MFMA 0
#endif
#ifndef PROBE_TWICE
#define PROBE_TWICE 0
#endif
#ifndef PROBE_TOUCH
#define PROBE_TOUCH 0
#endif
#ifndef PROBE_TSEL
#define PROBE_TSEL 0
#endif
#ifndef PROBE_TLO
#define PROBE_TLO 0
#endif
#ifndef PROBE_THI
#define PROBE_THI 1000
#endif
#ifndef PROBE_TMASK
#define PROBE_TMASK 0x3ff
#endif
#ifndef PROBE_TWORK
#define PROBE_TWORK 0
#endif
#ifndef PROBE_TWG
#define PROBE_TWG 0
#endif
#ifndef PROBE_TAMP
#define PROBE_TAMP 1
#endif
#ifndef MK_ONE_LAUNCH
#define MK_ONE_LAUNCH 1
#endif
namespace pg8 {
#define PG8_LAS __attribute__((address_space(3)))
typedef unsigned short bf16_t;
typedef short bf16x8 __attribute__((ext_vector_type(8)));
typedef float f32x4 __attribute__((ext_vector_type(4)));
typedef unsigned u32x4 __attribute__((ext_vector_type(4)));
constexpr int BM = 256, BK = 64, HALF = 128, HTB = HALF * BK * 2  , STAGE_BYTES = 8 * HTB, NXCD = 8, WGM = 8;

__host__ __device__ __forceinline__ int lds_byte(int r, int c) { const int st = (r >> 4) * 2 + (c >> 5), rr = r & 15, cc = c & 31, ob = rr * 64 + cc * 2; return st * 1024 + (ob ^ (((ob >> 9) & 1) << 5)); }
__host__ __device__ __forceinline__ void stage_rc(int b, int& R, int& C) { const int st = b / 1024, sb = b % 1024, swz = sb ^ (((sb >> 9) & 1) << 5); R = (st >> 1) * 16 + swz / 64; C = (st & 1) * 32 + (swz % 64) / 2; }
__host__ __device__ __forceinline__ int perm32(int rho) { const int n = rho >> 4, i = rho & 15; return 8 * (i >> 2) + 4 * n + (i & 3); }

struct Unit { int pm, pn, idx; };
struct Gemm { const bf16_t* A; const bf16_t* Bt; int M, N, K; int ldil; };

struct StaticOrder {
    int nM, nN, nwg, G, c;
    __host__ __device__ void init(int M, int N, int G_, int c_) { nM = M / BM; nN = N / BM; nwg = nM * nN; G = G_; c = c_; }
    __host__ __device__ bool next(int i, Unit& u) const {
        const long L = (long)i * G + c; if (L >= nwg) return false;
        int wgid = (int)L; { const int q = nwg / NXCD, r = nwg % NXCD, xcd = wgid % NXCD, off = wgid / NXCD; wgid = (xcd < r ? xcd * (q + 1) : r * (q + 1) + (xcd - r) * q) + off; }
        const int nig = WGM * nN, gid = wgid / nig, fm = gid * WGM, gsz = (nM - fm) < WGM ? (nM - fm) : WGM;
        u.pm = fm + ((wgid % nig) % gsz); u.pn = (wgid % nig) / gsz; u.idx = i; return true;
    }
    __device__ __forceinline__ void a_ready(const Unit&) const {}
    __device__ __forceinline__ void done(const Unit&) const {}
};

__device__ __forceinline__ unsigned cvt_pk_bf16(float lo, float hi) { unsigned r; asm volatile("v_cvt_pk_bf16_f32 %0, %1, %2" : "=v"(r) : "v"(lo), "v"(hi)); return r; }
typedef float f32x2 __attribute__((ext_vector_type(2)));

__device__ __forceinline__ float fast_sigmoid(float g) { return __builtin_amdgcn_rcpf(1.0f + __builtin_amdgcn_exp2f(-1.4426950409f * g)); }
constexpr int RS_TAB_OFF = 131072;
template <class Sched> __device__ __forceinline__ void stage_scales(PG8_LAS unsigned char* lds, const Sched& S, const float* rs, bool cols, int ldil, int tid) {
    PG8_LAS float* tab = (PG8_LAS float*)(lds + RS_TAB_OFF); Unit u;
    if (tid < 256) { const int lper = 8 - ldil, c = tid, tm = ((c & ((1 << lper) - 1)) << ldil) + (c >> lper);
        float eps = 1e-6f; asm volatile("" : "+s"(eps));
        for (int i = 0; i < 16 && S.next(i, u); ++i) { const f32x4 a = *(const f32x4*)(rs + 4 * (size_t)(cols ? u.pn * BM + tm : u.pm * BM + tid));
            tab[i * 256 + tid] = __builtin_amdgcn_rsqf(((a[0] + a[1]) + (a[2] + a[3])) * (1.0f / 1024.0f) + eps); } }
    __syncthreads();
}
struct EpiPlain {
    static constexpr bool PERM = true, AFTER_DRAIN = false;
    bf16_t* O; int ldc; const PG8_LAS float* tab;
    __device__ __forceinline__ void operator()(const f32x4 (&acc)[2][2][4][2], const Unit& u, int wr, int wc, int fr, int fq) const {
        const int row0 = u.pm * BM + wr * 64 + fr, col0 = u.pn * BM + wc * 32 + 8 * fq;
#pragma unroll
        for (int ai = 0; ai < 2; ++ai)
#pragma unroll
            for (int m = 0; m < 4; ++m) { const int row = row0 + ai * HALF + m * 16; bf16_t* rowp = O + (size_t)row * ldc + col0; const float r = tab ? tab[u.idx * 256 + (row & 255)] : 1.0f;
#pragma unroll
                for (int bj = 0; bj < 2; ++bj) { const f32x4 v0 = acc[ai][bj][m][0] * r, v1 = acc[ai][bj][m][1] * r;
                    u32x4 w; w.x = cvt_pk_bf16(v0[0], v0[1]); w.y = cvt_pk_bf16(v0[2], v0[3]); w.z = cvt_pk_bf16(v1[0], v1[1]); w.w = cvt_pk_bf16(v1[2], v1[3]);
                    *(u32x4*)(rowp + bj * HALF) = w; } }
    }
};
struct EpiQKV {
    static constexpr bool PERM = true, AFTER_DRAIN = false;
    bf16_t* O; int ldil; const PG8_LAS float* tab;
    __device__ __forceinline__ void operator()(const f32x4 (&acc)[2][2][4][2], const Unit& u, int wr, int wc, int fr, int fq) const {
        const int row0 = u.pm * BM + wr * 64 + fr, col0 = u.pn * BM + wc * 32 + 8 * fq, dilm = (1 << ldil) - 1, lLs = 11 - ldil;
#pragma unroll
        for (int ai = 0; ai < 2; ++ai)
#pragma unroll
            for (int m = 0; m < 4; ++m) { const int row = row0 + ai * HALF + m * 16; const float r = tab[u.idx * 256 + (row & 255)];
                const int b = row >> 11, pos = row & 2047, rr = pos & dilm, t = pos >> ldil;
#pragma unroll
                for (int bj = 0; bj < 2; ++bj) { const int c = col0 + bj * HALF, which = c >> 10, head = (c >> 6) & 15, d = c & 63;
                    bf16_t* dst = O + (size_t)which * 32768 * 1024 + ((((size_t)(b * 16 + head) << ldil) | rr) << lLs | t) * 64 + d;
                    const f32x4 v0 = acc[ai][bj][m][0] * r, v1 = acc[ai][bj][m][1] * r;
                    u32x4 w; w.x = cvt_pk_bf16(v0[0], v0[1]); w.y = cvt_pk_bf16(v0[2], v0[3]); w.z = cvt_pk_bf16(v1[0], v1[1]); w.w = cvt_pk_bf16(v1[2], v1[3]);
                    *(u32x4*)dst = w; } }
    }
};
template <int CHEAP = 0  > struct EpiSwiGLUT {
    static constexpr bool PERM = true, AFTER_DRAIN = false;
    bf16_t* O; int ldc; const PG8_LAS float* tab;
    __device__ __forceinline__ void operator()(const f32x4 (&acc)[2][2][4][2], const Unit& u, int wr, int wc, int fr, int fq) const {
        const int row0 = u.pm * BM + wr * 64 + fr, col0 = CHEAP ? ((u.pn * HALF + wc * 32 + 8 * fq) & 1023) : (u.pn * HALF + wc * 32 + 8 * fq);
#pragma unroll
        for (int ai = 0; ai < 2; ++ai)
#pragma unroll
            for (int m = 0; m < 4; ++m) { const int row = row0 + ai * HALF + m * 16; bf16_t* rowp = O + (size_t)row * ldc + col0; const float r = tab[u.idx * 256 + (row & 255)];
                float o[8];
                const float kr = -1.4426950409f * r, r2 = r * r;
#pragma unroll
                for (int n = 0; n < 2; ++n)
#pragma unroll
                    for (int e = 0; e < 4; e += 2) { const f32x2 g2 = {acc[ai][0][m][n][e], acc[ai][0][m][n][e + 1]}, u2 = {acc[ai][1][m][n][e], acc[ai][1][m][n][e + 1]};
                        if (CHEAP) { const f32x2 p = g2 * u2 * r2; o[n * 4 + e] = p[0]; o[n * 4 + e + 1] = p[1]; }
                        else { const f32x2 x = g2 * kr; const f32x2 d = (f32x2){__builtin_amdgcn_exp2f(x[0]), __builtin_amdgcn_exp2f(x[1])} + 1.0f;
                            const f32x2 rc = (f32x2){__builtin_amdgcn_rcpf(d[0]), __builtin_amdgcn_rcpf(d[1])} * r2; const f32x2 p = (g2 * u2) * rc; o[n * 4 + e] = p[0]; o[n * 4 + e + 1] = p[1]; } }
                u32x4 w; w.x = cvt_pk_bf16(o[0], o[1]); w.y = cvt_pk_bf16(o[2], o[3]); w.z = cvt_pk_bf16(o[4], o[5]); w.w = cvt_pk_bf16(o[6], o[7]);
                if (CHEAP == 2) { if (w.x == 0x12345678u && w.y == w.z) *(u32x4*)rowp = w; } else *(u32x4*)rowp = w; }
    }
};
typedef EpiSwiGLUT<0> EpiSwiGLU;
struct EpiRet {
    static constexpr bool PERM = true, AFTER_DRAIN = false;
    bf16_t* O; int ldc; const PG8_LAS float* tab;
    __device__ __forceinline__ void operator()(const f32x4 (&acc)[2][2][4][2], const Unit& u, int wr, int wc, int fr, int fq) const {
        const int row0 = u.pm * BM + wr * 64 + fr, col0 = u.pn * BM + wc * 32 + 8 * fq;
        {
            const float osc = (u.pn >= 4) ? 0.0625f : 1.0f;
            float invf[8];
#pragma unroll
            for (int q = 0; q < 8; ++q) { const int j = wc * 32 + 8 * fq + q; invf[q] = __builtin_amdgcn_exp2f(-(float)j * (13.287712379549449f / 127.0f)) * 0.15915494309189535f; }
#pragma unroll
            for (int ai = 0; ai < 2; ++ai)
#pragma unroll
                for (int m = 0; m < 4; ++m) { const int row = row0 + ai * HALF + m * 16; const float pos = (float)(row & 2047), r = tab[u.idx * 256 + (row & 255)] * osc;
                    bf16_t* rowp = O + (size_t)row * ldc + col0;
                    float o1[8], o2[8];
#pragma unroll
                    for (int n = 0; n < 2; ++n)
#pragma unroll
                        for (int e = 0; e < 4; ++e) { const int q = n * 4 + e; float t = pos * invf[q]; t = __builtin_amdgcn_fractf(t);
                            const float sn = __builtin_amdgcn_sinf(t), cs = __builtin_amdgcn_cosf(t);
                            const float a = acc[ai][0][m][n][e], b = acc[ai][1][m][n][e];
                            o1[q] = (a * cs - b * sn) * r; o2[q] = (a * sn + b * cs) * r; }
                    u32x4 w; w.x = cvt_pk_bf16(o1[0], o1[1]); w.y = cvt_pk_bf16(o1[2], o1[3]); w.z = cvt_pk_bf16(o1[4], o1[5]); w.w = cvt_pk_bf16(o1[6], o1[7]);
                    *(u32x4*)rowp = w;
                    w.x = cvt_pk_bf16(o2[0], o2[1]); w.y = cvt_pk_bf16(o2[2], o2[3]); w.z = cvt_pk_bf16(o2[4], o2[5]); w.w = cvt_pk_bf16(o2[6], o2[7]);
                    *(u32x4*)(rowp + HALF) = w; }
        }
    }
};

struct EpiGate {
    static constexpr bool PERM = true, AFTER_DRAIN = false;
    bf16_t* Y; const bf16_t* YB; const float* ST; const PG8_LAS float* tab;
    __device__ __forceinline__ void operator()(const f32x4 (&acc)[2][2][4][2], const Unit& u, int wr, int wc, int fr, int fq) const {
        const int row0 = u.pm * BM + wr * 64 + fr, col0 = u.pn * HALF + wc * 32 + 8 * fq, head = u.pn >> 2;
#pragma unroll
        for (int ai = 0; ai < 2; ++ai) {
            f32x4 stv[4]; u32x4 yfv[4], ybv[4];
#pragma unroll
            for (int m = 0; m < 4; ++m) { const int row = row0 + ai * HALF + m * 16;
                stv[m] = *(const f32x4*)(ST + (size_t)row * 16 + head * 4); yfv[m] = *(const u32x4*)(Y + (size_t)row * 2048 + col0); ybv[m] = *(const u32x4*)(YB + (size_t)row * 2048 + col0); }
#pragma unroll
            for (int m = 0; m < 4; ++m) { const int row = row0 + ai * HALF + m * 16; const float r = tab[u.idx * 256 + (row & 255)];
                const f32x4 st = stv[m];
                const float muf = __builtin_amdgcn_ldexpf(st[0], -9), mub = __builtin_amdgcn_ldexpf(st[2], -9); float eps = 1e-6f; asm volatile("" : "+s"(eps));
                const float rf = __builtin_amdgcn_rsqf(fmaxf(__builtin_amdgcn_ldexpf(st[1], -9) - muf * muf, 0.f) + eps), rb = __builtin_amdgcn_rsqf(fmaxf(__builtin_amdgcn_ldexpf(st[3], -9) - mub * mub, 0.f) + eps);
                const float cf = rf * r, cb = rb * r, df = -muf * cf, db = -mub * cb, kr = -1.4426950409f * r;
                const u32x4 yfw = yfv[m], ybw = ybv[m];
                float o[8];
#pragma unroll
                for (int n = 0; n < 2; ++n)
#pragma unroll
                    for (int e = 0; e < 4; e += 2) { const int q = n * 4 + e; const unsigned wf = yfw[q >> 1], wb = ybw[q >> 1];
                        const f32x2 yf2 = {__builtin_bit_cast(float, wf << 16), __builtin_bit_cast(float, wf & 0xffff0000u)}, yb2 = {__builtin_bit_cast(float, wb << 16), __builtin_bit_cast(float, wb & 0xffff0000u)};
                        const f32x2 af = {acc[ai][0][m][n][e], acc[ai][0][m][n][e + 1]}, ab = {acc[ai][1][m][n][e], acc[ai][1][m][n][e + 1]};
                        const f32x2 nf = yf2 * cf + df, nb = yb2 * cb + db;
                        const f32x2 xf = __builtin_elementwise_min(af * kr, (f32x2){60.f, 60.f}), xb = __builtin_elementwise_min(ab * kr, (f32x2){60.f, 60.f});
                        const f32x2 pf = (f32x2){__builtin_amdgcn_exp2f(xf[0]), __builtin_amdgcn_exp2f(xf[1])} + 1.0f, pb = (f32x2){__builtin_amdgcn_exp2f(xb[0]), __builtin_amdgcn_exp2f(xb[1])} + 1.0f;
                        const f32x2 den = pf * pb, num = (af * nf) * pb + (ab * nb) * pf;
                        const f32x2 res = num * (f32x2){__builtin_amdgcn_rcpf(den[0]), __builtin_amdgcn_rcpf(den[1])};
                        o[q] = res[0]; o[q + 1] = res[1]; }
                u32x4 w; w.x = cvt_pk_bf16(o[0], o[1]); w.y = cvt_pk_bf16(o[2], o[3]); w.z = cvt_pk_bf16(o[4], o[5]); w.w = cvt_pk_bf16(o[6], o[7]);
                *(u32x4*)(Y + (size_t)row * 2048 + col0) = w; }
        }
    }
};

struct PanelOrder {
    int nM, G, c;
    __host__ __device__ void init(int M, int, int G_, int c_) { nM = M / BM; G = G_; c = c_; }
    __host__ __device__ bool next(int i, Unit& u) const {
        const int L = i * G + c; if (L >= 4 * nM) return false;
        if ((G & 31) == 0 && (4 * nM) % G == 0) { const int j = c >> 3, xcd = c & 7; u.pm = i * (G >> 2) + xcd * (G >> 5) + (j >> 2); u.pn = j & 3; } else { u.pm = L >> 2; u.pn = L & 3; }
        u.idx = i; return true;
    }
    __device__ __forceinline__ void a_ready(const Unit&) const {}
    __device__ __forceinline__ void done(const Unit&) const {}
};
__device__ __forceinline__ float epi_xor16(float v) { return __builtin_bit_cast(float, __builtin_amdgcn_ds_swizzle(__builtin_bit_cast(int, v), (16 << 10) | 0x1f)); }
__device__ __forceinline__ float epi_xor32(float v, int lane) { return __builtin_bit_cast(float, __builtin_amdgcn_ds_bpermute((lane ^ 32) << 2, __builtin_bit_cast(int, v))); }
struct EpiThin {
    static constexpr bool PERM = true, AFTER_DRAIN = false;
    bf16_t* XB; float* OUT; const float* gpost; float cpost; unsigned* PFc; unsigned* PFz; float* RS4; PG8_LAS float* scr;
    __device__ __forceinline__ void operator()(const f32x4 (&acc)[2][2][4][2], const Unit& u, int wr, int wc, int fr, int fq) const {
        const int lane = fr + 16 * fq, tid = (wr * 4 + wc) * 64 + lane;
        const int row0 = u.pm * BM + wr * 64 + fr, col0 = u.pn * BM + wc * 32 + 8 * fq;
        u32x4 xa[4][2];
#pragma unroll
        for (int m = 0; m < 4; ++m)
#pragma unroll
            for (int bj = 0; bj < 2; ++bj) xa[m][bj] = *(const u32x4*)(XB + (size_t)(row0 + m * 16) * 1024 + col0 + bj * HALF);
        float gp[2][8];
#pragma unroll
        for (int bj = 0; bj < 2; ++bj) { const f32x4 a = *(const f32x4*)(gpost + col0 + bj * HALF), b = *(const f32x4*)(gpost + col0 + bj * HALF + 4);
            gp[bj][0] = a[0]; gp[bj][1] = a[1]; gp[bj][2] = a[2]; gp[bj][3] = a[3]; gp[bj][4] = b[0]; gp[bj][5] = b[1]; gp[bj][6] = b[2]; gp[bj][7] = b[3]; }
#pragma unroll
        for (int ai = 0; ai < 2; ++ai)
#pragma unroll
            for (int m = 0; m < 4; ++m) { f32x2 s2v = {0.f, 0.f};
#pragma unroll
                for (int bj = 0; bj < 2; ++bj)
#pragma unroll
                    for (int n = 0; n < 2; ++n) { const f32x2 a0 = {acc[ai][bj][m][n][0], acc[ai][bj][m][n][1]}, a1 = {acc[ai][bj][m][n][2], acc[ai][bj][m][n][3]}; s2v += a0 * a0; s2v += a1 * a1; }
                float s = s2v[0] + s2v[1];
                s += epi_xor16(s); s += epi_xor32(s, lane);
                if (fq == 0) scr[wc * 256 + ai * HALF + wr * 64 + m * 16 + fr] = s; }
        asm volatile("s_waitcnt lgkmcnt(0)" ::: "memory"); __builtin_amdgcn_s_barrier(); asm volatile("" ::: "memory");
        if (tid < 256) {
            const float tot = (scr[tid] + scr[256 + tid]) + (scr[512 + tid] + scr[768 + tid]);
            const size_t gi = (size_t)(u.pm * BM + tid) * 4;
            __hip_atomic_store(PFc + gi + u.pn, __builtin_bit_cast(unsigned, tot) | 0x80000000u, __ATOMIC_RELAXED, __HIP_MEMORY_SCOPE_AGENT);
            __hip_atomic_store(PFz + gi + u.pn, 0u, __ATOMIC_RELAXED, __HIP_MEMORY_SCOPE_AGENT);
            unsigned w0, w1, w2, w3, sp = 0u;
            for (;;) {
                w0 = __hip_atomic_load(PFc + gi + 0, __ATOMIC_RELAXED, __HIP_MEMORY_SCOPE_AGENT); w1 = __hip_atomic_load(PFc + gi + 1, __ATOMIC_RELAXED, __HIP_MEMORY_SCOPE_AGENT);
                w2 = __hip_atomic_load(PFc + gi + 2, __ATOMIC_RELAXED, __HIP_MEMORY_SCOPE_AGENT); w3 = __hip_atomic_load(PFc + gi + 3, __ATOMIC_RELAXED, __HIP_MEMORY_SCOPE_AGENT);
                if ((w0 != 0u) & (w1 != 0u) & (w2 != 0u) & (w3 != 0u)) break;
                __builtin_amdgcn_s_sleep(2);
                if (++sp > (1u << 20)) break;
            }
            const float ssum = (__builtin_bit_cast(float, w0 & 0x7fffffffu) + __builtin_bit_cast(float, w1 & 0x7fffffffu)) + (__builtin_bit_cast(float, w2 & 0x7fffffffu) + __builtin_bit_cast(float, w3 & 0x7fffffffu));
            float eps = 1e-6f; asm volatile("" : "+s"(eps));
            scr[1024 + tid] = cpost * __builtin_amdgcn_rsqf(ssum * (1.0f / 1024.0f) + eps);
        }
        asm volatile("s_waitcnt lgkmcnt(0)" ::: "memory"); __builtin_amdgcn_s_barrier(); asm volatile("" ::: "memory");
#pragma unroll
        for (int ai = 0; ai < 2; ++ai) {
            if (ai == 1) {
#pragma unroll
                for (int m = 0; m < 4; ++m)
#pragma unroll
                    for (int bj = 0; bj < 2; ++bj) xa[m][bj] = *(const u32x4*)(XB + (size_t)(row0 + HALF + m * 16) * 1024 + col0 + bj * HALF); }
#pragma unroll
            for (int m = 0; m < 4; ++m) { const int row = row0 + ai * HALF + m * 16; const float rF = scr[1024 + (row & 255)]; f32x2 s2p = {0.f, 0.f};
#pragma unroll
                for (int bj = 0; bj < 2; ++bj) { const u32x4 xw = xa[m][bj]; float o[8];
#pragma unroll
                    for (int n = 0; n < 2; ++n)
#pragma unroll
                        for (int e = 0; e < 4; e += 2) { const int q = n * 4 + e; const unsigned w = xw[q >> 1];
                            const f32x2 xv = {__builtin_bit_cast(float, w << 16), __builtin_bit_cast(float, w & 0xffff0000u)}, av = {acc[ai][bj][m][n][e], acc[ai][bj][m][n][e + 1]}, gv = {gp[bj][q], gp[bj][q + 1]};
                            const f32x2 ov = xv + av * (gv * rF); s2p += ov * ov; o[q] = ov[0]; o[q + 1] = ov[1]; }
                    if (OUT) { float* op = OUT + (size_t)row * 1024 + col0 + bj * HALF;
                        __builtin_nontemporal_store((f32x4){o[0], o[1], o[2], o[3]}, (f32x4*)op); __builtin_nontemporal_store((f32x4){o[4], o[5], o[6], o[7]}, (f32x4*)(op + 4)); }
                    else { u32x4 w; w.x = cvt_pk_bf16(o[0], o[1]); w.y = cvt_pk_bf16(o[2], o[3]); w.z = cvt_pk_bf16(o[4], o[5]); w.w = cvt_pk_bf16(o[6], o[7]);
                        *(u32x4*)(XB + (size_t)row * 1024 + col0 + bj * HALF) = w; } }
                float s2 = s2p[0] + s2p[1];
                s2 += epi_xor16(s2); s2 += epi_xor32(s2, lane);
                if (fq == 0) scr[wc * 256 + (row & 255)] = s2; }
        }
        asm volatile("s_waitcnt lgkmcnt(0)" ::: "memory"); __builtin_amdgcn_s_barrier(); asm volatile("" ::: "memory");
        if (tid < 256) RS4[(size_t)(u.pm * BM + tid) * 4 + u.pn] = (scr[tid] + scr[256 + tid]) + (scr[512 + tid] + scr[768 + tid]);
    }
};

struct EpiVT {
    static constexpr bool PERM = true, AFTER_DRAIN = false;
    bf16_t* O; int ldc; int ldil; const PG8_LAS float* tab;
    __device__ __forceinline__ void operator()(const f32x4 (&acc)[2][2][4][2], const Unit& u, int wr, int wc, int fr, int fq) const {
        const int lper = 8 - ldil, per = 1 << lper, Ls = 2048 >> ldil, b = u.pn >> 3, pl = u.pn & 7;
        const int row0 = u.pm * BM + wr * 64 + fr;
        int colb[2]; float cs[2][8];
#pragma unroll
        for (int bj = 0; bj < 2; ++bj) { const int c0 = bj * HALF + wc * 32 + 8 * fq; colb[bj] = b * 2048 + (c0 >> lper) * Ls + pl * per + (c0 & (per - 1));
            const f32x4 a = *(const PG8_LAS f32x4*)(tab + u.idx * 256 + c0), b4 = *(const PG8_LAS f32x4*)(tab + u.idx * 256 + c0 + 4);
            cs[bj][0] = a[0]; cs[bj][1] = a[1]; cs[bj][2] = a[2]; cs[bj][3] = a[3]; cs[bj][4] = b4[0]; cs[bj][5] = b4[1]; cs[bj][6] = b4[2]; cs[bj][7] = b4[3]; }
#pragma unroll
        for (int ai = 0; ai < 2; ++ai)
#pragma unroll
            for (int m = 0; m < 4; ++m) { bf16_t* rowp = O + (size_t)(row0 + ai * HALF + m * 16) * ldc;
#pragma unroll
                for (int bj = 0; bj < 2; ++bj) { const f32x4 v0 = acc[ai][bj][m][0], v1 = acc[ai][bj][m][1];
                    u32x4 w; w.x = cvt_pk_bf16(v0[0] * cs[bj][0], v0[1] * cs[bj][1]); w.y = cvt_pk_bf16(v0[2] * cs[bj][2], v0[3] * cs[bj][3]); w.z = cvt_pk_bf16(v1[0] * cs[bj][4], v1[1] * cs[bj][5]); w.w = cvt_pk_bf16(v1[2] * cs[bj][6], v1[3] * cs[bj][7]);
                    *(u32x4*)(rowp + colb[bj]) = w; } }
    }
};
template <class Epi, class Sched, bool ALIGN_EPI = false, bool SP2 = false>
__device__ __forceinline__ void gemm_phase(PG8_LAS unsigned char* lds, const Gemm g, const Sched& S, const Epi& E, const int tid) {
    const int wid = __builtin_amdgcn_readfirstlane(tid >> 6), lane = tid & 63, wr = wid >> 2, wc = wid & 3, fr = lane & 15, fq = lane >> 4;
    const int K = g.K, nt = K / BK;
    unsigned voffA[2], voffB[2], voffB1[2];
#pragma unroll
    for (int i = 0; i < 2; ++i) { int R, C; stage_rc(tid * 16 + i * 8192, R, C); const int Rb = Epi::PERM ? ((R & ~31) + perm32(R & 31)) : R;
        voffA[i] = (unsigned)(R * K + C) * 2u; { const int ld = g.ldil, lper = 8 - ld, pm1 = (1 << lper) - 1; const int c0 = Rb, c1 = 128 + Rb; voffB[i] = (unsigned)((((c0 & pm1) << ld) + (c0 >> lper)) * K + C) * 2u; voffB1[i] = (unsigned)((((c1 & pm1) << ld) + (c1 >> lper)) * K + C) * 2u; } }
    const size_t kstep = (size_t)(BK * 2);
    const size_t hstep = (size_t)HALF * K * 2;
    const size_t tstep = 2 * hstep;
    const unsigned ldsw = (unsigned)wid * 1024u;
    const int aoff = lds_byte(wr * 64 + fr, fq * 8), boff = lds_byte(wc * 32 + fr, fq * 8);
#define PG8_SA(b, h) (((b) * 2 + (h)) * HTB)
#define PG8_SB(b, h) ((4 + (b) * 2 + (h)) * HTB)
#define PG8_STAGE(bufoff, gbase, voff) do { _Pragma("unroll") for (int _i = 0; _i < 2; ++_i) \
        __builtin_amdgcn_global_load_lds((const unsigned*)((const char*)(gbase) + (voff)[_i]), (PG8_LAS unsigned*)(lds + (bufoff) + ldsw + _i * 8192), 16, 0, 0); } while (0)
#define PG8_LDA(dst, b, h) do { _Pragma("unroll") for (int m = 0; m < 4; ++m) _Pragma("unroll") for (int k = 0; k < 2; ++k) dst[m][k] = *(const PG8_LAS bf16x8*)(lds + PG8_SA(b, h) + aoff + m * 2048 + k * 1024); } while (0)
#define PG8_LDB(dst, b, h) do { _Pragma("unroll") for (int n = 0; n < 2; ++n) _Pragma("unroll") for (int k = 0; k < 2; ++k) dst[n][k] = *(const PG8_LAS bf16x8*)(lds + PG8_SB(b, h) + boff + n * 2048 + k * 1024); } while (0)
#define PG8_MMA(ai, bj, At, Bt) do { __builtin_amdgcn_s_setprio(1); _Pragma("unroll") for (int m = 0; m < 4; ++m) _Pragma("unroll") for (int n = 0; n < 2; ++n) _Pragma("unroll") for (int k = 0; k < 2; ++k) \
        acc[ai][bj][m][n] = __builtin_amdgcn_mfma_f32_16x16x32_bf16(Bt[n][k], At[m][k], acc[ai][bj][m][n], 0, 0, 0); __builtin_amdgcn_s_setprio(0); } while (0)
#define PG8_WAIT_V(n) asm volatile("s_waitcnt vmcnt(" #n ")" ::: "memory")
#define PG8_WAIT_L(n) asm volatile("s_waitcnt lgkmcnt(" #n ")" ::: "memory")
#define PG8_BAR __builtin_amdgcn_s_barrier()
#define PG8_SCHED __builtin_amdgcn_sched_barrier(0)
    Unit cur, nxt; int ui = 0;
    if (!S.next(0, cur)) return;
    f32x4 acc[2][2][4][2];
#pragma unroll
    for (int a = 0; a < 2; ++a)
#pragma unroll
        for (int b = 0; b < 2; ++b)
#pragma unroll
            for (int m = 0; m < 4; ++m)
#pragma unroll
                for (int n = 0; n < 2; ++n) acc[a][b][m][n] = (f32x4){0.f, 0.f, 0.f, 0.f};
    bf16x8 At[4][2], B0[2][2], B1[2][2];
    const char* cA = (const char*)g.A + (size_t)cur.pm * tstep; const char* cB = (const char*)g.Bt + (size_t)cur.pn * tstep;
    S.a_ready(cur);
    if constexpr (SP2) {
        PG8_STAGE(PG8_SB(0, 0), cB, voffB); PG8_STAGE(PG8_SB(0, 1), cB, voffB1); PG8_STAGE(PG8_SA(0, 0), cA, voffA); PG8_STAGE(PG8_SA(0, 1), cA + hstep, voffA);
        if (wr == 1) PG8_BAR;
        PG8_WAIT_V(2); PG8_BAR;
        PG8_STAGE(PG8_SB(1, 0), cB + kstep, voffB); PG8_STAGE(PG8_SA(1, 0), cA + kstep, voffA); PG8_STAGE(PG8_SB(1, 1), cB + kstep, voffB1);
        PG8_WAIT_V(6); PG8_BAR;
    } else {
        PG8_STAGE(PG8_SB(0, 0), cB, voffB); PG8_STAGE(PG8_SA(0, 0), cA, voffA); PG8_STAGE(PG8_SB(0, 1), cB, voffB1); PG8_STAGE(PG8_SA(0, 1), cA + hstep, voffA);
        if (wr == 1) PG8_BAR;
        PG8_WAIT_V(4); PG8_BAR;
        PG8_STAGE(PG8_SB(1, 0), cB + kstep, voffB); PG8_STAGE(PG8_SA(1, 0), cA + kstep, voffA); PG8_STAGE(PG8_SB(1, 1), cB + kstep, voffB1);
        PG8_WAIT_V(6); PG8_BAR;
    }
    for (;;) {
        const bool has_next = S.next(ui + 1, nxt);
        const char* nA = has_next ? (const char*)g.A + (size_t)nxt.pm * tstep : cA; const char* nB = has_next ? (const char*)g.Bt + (size_t)nxt.pn * tstep : cB;
        for (int t = 0; t < nt; t += 2) {
            const bool last = (t == nt - 2);
            const char* a1 = cA + (size_t)(t + 1) * kstep;
            const char* a2 = last ? nA : cA + (size_t)(t + 2) * kstep; const char* b2 = last ? nB : cB + (size_t)(t + 2) * kstep;
            const char* a3 = a2 + kstep; const char* b3 = b2 + kstep;
            if (last && has_next) S.a_ready(nxt);
            if constexpr (SP2) {
            PG8_LDB(B0, 0, 0); PG8_LDB(B1, 0, 1); PG8_SCHED; PG8_LDA(At, 0, 0); PG8_STAGE(PG8_SA(1, 1), a1 + hstep, voffA);
            PG8_WAIT_V(8); PG8_WAIT_L(0); PG8_BAR; PG8_MMA(0, 0, At, B0); PG8_MMA(0, 1, At, B1); PG8_BAR; PG8_SCHED;
            PG8_LDA(At, 0, 1); PG8_STAGE(PG8_SB(0, 0), b2, voffB); PG8_STAGE(PG8_SB(0, 1), b2, voffB1); PG8_STAGE(PG8_SA(0, 0), a2, voffA);
            PG8_WAIT_V(8); PG8_WAIT_L(0); PG8_BAR; PG8_MMA(1, 0, At, B0); PG8_MMA(1, 1, At, B1); PG8_BAR; PG8_SCHED;
            PG8_LDB(B0, 1, 0); PG8_LDB(B1, 1, 1); PG8_SCHED; PG8_LDA(At, 1, 0); PG8_STAGE(PG8_SA(0, 1), a2 + hstep, voffA);
            PG8_WAIT_V(8); PG8_WAIT_L(0); PG8_BAR; PG8_MMA(0, 0, At, B0); PG8_MMA(0, 1, At, B1); PG8_BAR; PG8_SCHED;
            PG8_LDA(At, 1, 1); PG8_STAGE(PG8_SB(1, 0), b3, voffB); PG8_STAGE(PG8_SB(1, 1), b3, voffB1); PG8_STAGE(PG8_SA(1, 0), a3, voffA);
            PG8_WAIT_V(8); PG8_WAIT_L(0); PG8_BAR; PG8_MMA(1, 0, At, B0); PG8_MMA(1, 1, At, B1); PG8_BAR; PG8_SCHED;
            } else {
            PG8_LDB(B0, 0, 0); PG8_SCHED; PG8_LDA(At, 0, 0); PG8_STAGE(PG8_SA(1, 1), a1 + hstep, voffA);
            PG8_WAIT_L(8); PG8_BAR; PG8_WAIT_L(0); PG8_MMA(0, 0, At, B0); PG8_BAR; PG8_SCHED;
            PG8_LDB(B1, 0, 1); PG8_STAGE(PG8_SB(0, 0), b2, voffB);
            PG8_BAR; PG8_WAIT_L(0); PG8_MMA(0, 1, At, B1); PG8_BAR;
            PG8_LDA(At, 0, 1); PG8_STAGE(PG8_SA(0, 0), a2, voffA);
            PG8_BAR; PG8_WAIT_L(0); PG8_MMA(1, 0, At, B0); PG8_BAR; PG8_SCHED;
            PG8_STAGE(PG8_SB(0, 1), b2, voffB1);
            PG8_WAIT_V(6); PG8_BAR; PG8_MMA(1, 1, At, B1); PG8_BAR;
            PG8_LDB(B0, 1, 0); PG8_SCHED; PG8_LDA(At, 1, 0); PG8_STAGE(PG8_SA(0, 1), a2 + hstep, voffA);
            PG8_WAIT_L(8); PG8_BAR; PG8_WAIT_L(0); PG8_MMA(0, 0, At, B0); PG8_BAR; PG8_SCHED;
            PG8_LDB(B1, 1, 1); PG8_STAGE(PG8_SB(1, 0), b3, voffB);
            PG8_BAR; PG8_WAIT_L(0); PG8_MMA(0, 1, At, B1); PG8_BAR;
            PG8_LDA(At, 1, 1); PG8_STAGE(PG8_SA(1, 0), a3, voffA);
            PG8_BAR; PG8_WAIT_L(0); PG8_MMA(1, 0, At, B0); PG8_BAR; PG8_SCHED;
            PG8_STAGE(PG8_SB(1, 1), b3, voffB1);
            PG8_WAIT_V(6); PG8_BAR; PG8_MMA(1, 1, At, B1); PG8_BAR;
            }
        }
        if constexpr (ALIGN_EPI) { if (wr == 0) PG8_BAR; }
        if constexpr (!Epi::AFTER_DRAIN) { E(acc, cur, wr, wc, fr, fq); S.done(cur); }
        if (!has_next) break;
#pragma unroll
        for (int a = 0; a < 2; ++a)
#pragma unroll
            for (int b = 0; b < 2; ++b)
#pragma unroll
                for (int m = 0; m < 4; ++m)
#pragma unroll
                    for (int n = 0; n < 2; ++n) acc[a][b][m][n] = (f32x4){0.f, 0.f, 0.f, 0.f};
        cur = nxt; cA = nA; cB = nB; ++ui;
        if constexpr (ALIGN_EPI) { if (wr == 1) PG8_BAR; }
    }
    PG8_WAIT_V(0);
    if constexpr (!ALIGN_EPI) { if (wr == 0) PG8_BAR; }
    PG8_BAR;
    if constexpr (Epi::AFTER_DRAIN) { E.fused(acc, cur, wr, wc, fr, fq, lds, wid, lane); S.done(cur); }
#undef PG8_SA
#undef PG8_SB
#undef PG8_STAGE
#undef PG8_LDA
#undef PG8_LDB
#undef PG8_MMA
#undef PG8_WAIT_V
#undef PG8_WAIT_L
#undef PG8_BAR
#undef PG8_SCHED
}
}

constexpr int BATCH = 16, SEQ = 2048, D = 1024, M = BATCH * SEQ, DEPTH = 4, DFF = 2816;
constexpr int NGRP = 3, HA = 16, DHA = 64, ATT_COLS = 3 * D;
constexpr int HR = 4, DKR = 256, DVR = 512, DV = HR * DVR, RET_COLS = 2 * D + 3 * DV;
constexpr int MH = M / 2;
constexpr float NORM_EPS = 1e-6f;
constexpr int NWAVES = 8, NTHREADS = NWAVES * 64;
constexpr int NPHASES = 1 + (DEPTH / 2) * (11 + 9);

__device__ const unsigned char T5_BUCKET[3][129] = {
{11,11,11,11,11,11,11,11,11,11,11,11,11,11,11,10,10,10,10,10,10,10,10,10,10,10,10,10,10,10,10,10,10,10,10,10,10,10,9,9,9,9,9,9,9,9,9,9,9,9,8,8,8,8,8,8,8,7,6,5,4,3,2,1,0,17,18,19,20,21,22,23,24,24,24,24,24,24,24,25,25,25,25,25,25,25,25,25,25,25,25,26,26,26,26,26,26,26,26,26,26,26,26,26,26,26,26,26,26,26,26,26,26,26,27,27,27,27,27,27,27,27,27,27,27,27,27,27,27},
{13,13,13,13,13,13,13,13,13,13,13,13,13,13,13,13,13,13,13,13,13,13,13,12,12,12,12,12,12,12,12,12,12,12,12,12,12,12,12,12,12,12,11,11,11,11,11,11,11,11,11,11,10,10,10,10,10,10,9,9,9,8,8,4,0,20,24,24,25,25,25,26,26,26,26,26,26,27,27,27,27,27,27,27,27,27,27,28,28,28,28,28,28,28,28,28,28,28,28,28,28,28,28,28,28,28,29,29,29,29,29,29,29,29,29,29,29,29,29,29,29,29,29,29,29,29,29,29,29},
{15,15,15,15,15,15,15,15,15,15,15,15,15,15,15,15,15,15,15,15,15,15,15,15,15,15,15,15,15,15,14,14,14,14,14,14,14,14,14,14,14,14,14,14,14,13,13,13,13,13,13,13,13,13,12,12,12,12,12,11,11,10,10,9,0,25,26,26,27,27,28,28,28,28,28,29,29,29,29,29,29,29,29,29,30,30,30,30,30,30,30,30,30,30,30,30,30,30,30,31,31,31,31,31,31,31,31,31,31,31,31,31,31,31,31,31,31,31,31,31,31,31,31,31,31,31,31,31,31}};

constexpr size_t MiB = 1u << 20;
constexpr size_t WS_CTL = 0;
constexpr size_t WS_PF = 64 * 1024;
constexpr size_t CTL_ZERO_BYTES = WS_PF + (size_t)2 * M * 4 * 4;
constexpr size_t WS_BIAS = 1 * MiB + 256 * 1024;
constexpr size_t WS_RS = 1 * MiB + 512 * 1024;
constexpr size_t WS_W = 2 * MiB;
constexpr size_t WS_W2A = WS_W + 18 * MiB, WS_W2B = 540 * MiB;
static_assert(CTL_ZERO_BYTES <= WS_BIAS && WS_BIAS + 3 * 16 * 129 * 4 <= WS_RS && WS_RS + (size_t)M * 16 == WS_W, "low d_ws map");
constexpr size_t WS_XH = 26 * MiB;
constexpr size_t WS_YC = 90 * MiB;
constexpr size_t WS_BIG = 218 * MiB;
constexpr size_t WS_F = 410 * MiB;
constexpr size_t WS_RVT = 346 * MiB;
constexpr size_t WS_OACC = 474 * MiB;
constexpr size_t WS_LSE = 538 * MiB;
constexpr size_t WS_END = 546 * MiB;
static_assert((size_t)NGRP * ATT_COLS * D * 2 <= 18 * MiB && (size_t)RET_COLS * D * 2 <= 18 * MiB && (size_t)2 * DFF * D * 2 <= 18 * MiB && WS_W2A + (size_t)D * DFF * 2 <= WS_XH && WS_W2B + (size_t)D * DFF * 2 <= WS_END, "weight regions");
constexpr int RP_COLS = 2 * D + 2 * DV;
static_assert(WS_XH + (size_t)M * D * 2 == WS_YC && WS_YC + (size_t)M * DV * 2 == WS_BIG && WS_BIG + (size_t)MH * RP_COLS * 2 == WS_F && WS_BIG + (size_t)M * 2 * D * 2 == WS_RVT && WS_RVT + (size_t)DV * M * 2 == WS_OACC && WS_F + (size_t)M * D * 2 == WS_OACC && WS_OACC + (size_t)M * D * 2 == WS_LSE, "d_ws map");
static_assert((size_t)M * DFF * 2 <= 192 * MiB && (size_t)M * ATT_COLS * 2 <= 192 * MiB && WS_LSE + (size_t)M * 16 * 4 <= WS_END, "d_ws map");
constexpr int CW_BAR = 4096;

constexpr int RING_OFF = 0, RING_BYTES = 149504;
constexpr int LDSCTL_OFF = RING_BYTES, MISC_OFF = LDSCTL_OFF + 320;
constexpr int LDS_BYTES = RING_BYTES + 512 + (PROBE_TSEL ? 64 : 0);
static_assert(MISC_OFF + 128 <= LDS_BYTES, "LDS map");

#define LAS __attribute__((address_space(3)))
typedef unsigned short bf16;
typedef unsigned v4u __attribute__((ext_vector_type(4)));
typedef unsigned v2u __attribute__((ext_vector_type(2)));
typedef float f32x4 __attribute__((ext_vector_type(4)));
#define LDS_WAIT() asm volatile("s_waitcnt lgkmcnt(0)" ::: "memory")
__device__ __forceinline__ unsigned f2bf(float f) { unsigned u = __builtin_bit_cast(unsigned, f); return (u + 0x7fffu + ((u >> 16) & 1u)) >> 16; }
__device__ __forceinline__ unsigned pk2(float lo, float hi) { return f2bf(lo) | (f2bf(hi) << 16); }
__device__ __forceinline__ float bflo(unsigned w) { return __builtin_bit_cast(float, w << 16); }
__device__ __forceinline__ float bfhi(unsigned w) { return __builtin_bit_cast(float, w & 0xffff0000u); }
__device__ __forceinline__ float opaque_f(float c) { float v = c; asm volatile("" : "+s"(v)); return v; }
template <int O> __device__ __forceinline__ float swz_xor(float v) { return __builtin_bit_cast(float, __builtin_amdgcn_ds_swizzle(__builtin_bit_cast(int, v), (O << 10) | 0x1f)); }
__device__ __forceinline__ float wave_sum(float v) {
    v += swz_xor<1>(v); v += swz_xor<2>(v); v += swz_xor<4>(v); v += swz_xor<8>(v); v += swz_xor<16>(v);
    return __builtin_bit_cast(float, __builtin_amdgcn_readlane(__builtin_bit_cast(int, v), 0)) + __builtin_bit_cast(float, __builtin_amdgcn_readlane(__builtin_bit_cast(int, v), 32));
}
__device__ __forceinline__ float get_xor32(float v, int lane) { return __builtin_bit_cast(float, __builtin_amdgcn_ds_bpermute((lane ^ 32) << 2, __builtin_bit_cast(int, v))); }

#define XB_TMO      128
#define XB_XCNT(j)  (256  + 64 * (j))
#define XB_XSUB(j)  (1280 + 64 * (j))
#define XB_XGEN(j)  (2304 + 64 * (j))
#define XB_TOP      3328
#define XB_TOPGEN   3392
#define XCD_BAR_WORDS 3456
#define XB_SPIN_CAP (1u << 18)

__device__ __forceinline__ unsigned xb_ld(unsigned* p)              { return __hip_atomic_load(p, __ATOMIC_RELAXED, __HIP_MEMORY_SCOPE_AGENT); }
__device__ __forceinline__ unsigned xb_add(unsigned* p, unsigned v) { return __hip_atomic_fetch_add(p, v, __ATOMIC_RELAXED, __HIP_MEMORY_SCOPE_AGENT); }
__device__ __forceinline__ unsigned xb_xcc_id() { return (unsigned)__builtin_amdgcn_s_getreg((3 << 11) | 20) & 0xFu; }
#define XB_SPIN(cond, bar) do { unsigned _sp = 0; while (cond) { __builtin_amdgcn_s_sleep(1); \
    if ((++_sp & 255u) == 0u) { if (xb_ld(&(bar)[XB_TMO])) break; if (_sp > XB_SPIN_CAP) { atomicAdd(&(bar)[XB_TMO], 1u); break; } } } } while (0)

struct XcdBarrier {
    unsigned* bar; unsigned x;
    volatile LAS unsigned* st;
};

__device__ __forceinline__ XcdBarrier xcd_barrier_post(unsigned* bar, volatile LAS unsigned* st) {
    XcdBarrier b; b.bar = bar; b.x = xb_xcc_id(); b.st = st;
    if (threadIdx.x == 0) (void)xb_add(&bar[XB_XCNT(b.x)], 1u);
    return b;
}
__device__ __forceinline__ void xcd_barrier_complete(unsigned* bar, unsigned x, unsigned& nloc, unsigned& nx) {
    const unsigned G = gridDim.x * gridDim.y * gridDim.z;
    unsigned sum, cnt, mine, sp = 0u;
    for (;;) {
        sum = 0u; cnt = 0u; mine = 0u;
#pragma unroll
        for (unsigned j = 0; j < 16; ++j) { const unsigned c = xb_ld(&bar[XB_XCNT(j)]); sum += c; cnt += (c > 0u) ? 1u : 0u; mine = (j == x) ? c : mine; }
        if (sum == G) break;
        __builtin_amdgcn_s_sleep(1);
        if ((++sp & 255u) == 0u) { if (xb_ld(&bar[XB_TMO])) break; if (sp > XB_SPIN_CAP) { atomicAdd(&bar[XB_TMO], 1u); break; } }
    }
    nloc = mine > 0u ? mine : 1u; nx = cnt > 0u ? cnt : 1u;
}

__device__ __forceinline__ void xcd_barrier(const XcdBarrier& b) {
    asm volatile("s_waitcnt vmcnt(0)" ::: "memory");
    __syncthreads();
    if (threadIdx.x == 0) {
        unsigned* bar = b.bar;
        __builtin_amdgcn_s_waitcnt(0);
        unsigned nloc = b.st[0], nx = b.st[1];
        if (nloc == 0u) { xcd_barrier_complete(bar, b.x, nloc, nx); b.st[0] = nloc; b.st[1] = nx; }
        const unsigned old = xb_add(&bar[XB_XSUB(b.x)], 1u);
        const unsigned gen = old / nloc;
        if (old + 1u == (gen + 1u) * nloc) {
            __builtin_amdgcn_fence(__ATOMIC_RELEASE, "agent");
            asm volatile("s_waitcnt vmcnt(0)" ::: "memory");
            const unsigned og = xb_add(&bar[XB_TOP], 1u);
            const unsigned tg = og / nx;
            if (og + 1u == (tg + 1u) * nx) xb_add(&bar[XB_TOPGEN], 1u);
            else XB_SPIN(xb_ld(&bar[XB_TOPGEN]) == tg, bar);
            __builtin_amdgcn_fence(__ATOMIC_ACQUIRE, "agent");
            xb_add(&bar[XB_XGEN(b.x)], 1u);
            asm volatile("s_waitcnt vmcnt(0)" ::: "memory");
        } else {
            XB_SPIN(xb_ld(&bar[XB_XGEN(b.x)]) == gen, bar);
            __builtin_amdgcn_fence(__ATOMIC_ACQUIRE, "agent");
            asm volatile("s_waitcnt vmcnt(0)" ::: "memory");
        }
    }
    __syncthreads();
}


constexpr int CV_KR = 32, CV_SCR = 64 * 65 * 4;
struct CvItem { const float* src; int srcN, k0; bf16* dst; int dstK; };
__device__ __forceinline__ void conv_load(const CvItem& I, f32x4 (&v)[CV_KR / 4], int lane) {
    const float* src = I.src + (size_t)(lane >> 4) * I.srcN + (lane & 15) * 4;
#pragma unroll
    for (int i = 0; i < CV_KR / 4; ++i) v[i] = __builtin_nontemporal_load((const f32x4*)(src + (size_t)(4 * i) * I.srcN));
}
__device__ __forceinline__ void conv_store(const CvItem& I, const f32x4 (&v)[CV_KR / 4], const float* gain, LAS float* scr, int lane) {
    { LAS float* d = scr + (lane >> 4) * 65 + (lane & 15) * 4;
#pragma unroll
      for (int i = 0; i < CV_KR / 4; ++i) { d[4 * i * 65 + 0] = v[i].x; d[4 * i * 65 + 1] = v[i].y; d[4 * i * 65 + 2] = v[i].z; d[4 * i * 65 + 3] = v[i].w; } }
    LDS_WAIT(); asm volatile("" ::: "memory");
    constexpr int NPC = CV_KR / 8;
    const int c = lane & (NPC - 1);
    float gk[8];
#pragma unroll
    for (int i = 0; i < 8; ++i) gk[i] = gain ? gain[I.k0 + 8 * c + i] : 1.0f;
#pragma unroll
    for (int j = 0; j < NPC; ++j) { const int n = lane / NPC + (64 / NPC) * j; const LAS float* s = scr + (8 * c) * 65 + n;
        v4u o; o.x = pk2(s[0 * 65] * gk[0], s[1 * 65] * gk[1]); o.y = pk2(s[2 * 65] * gk[2], s[3 * 65] * gk[3]); o.z = pk2(s[4 * 65] * gk[4], s[5 * 65] * gk[5]); o.w = pk2(s[6 * 65] * gk[6], s[7 * 65] * gk[7]);
        *(v4u*)(I.dst + (size_t)n * I.dstK + I.k0 + 8 * c) = o; }
    LDS_WAIT(); asm volatile("" ::: "memory");
}
template <class Dec> __device__ __forceinline__ void conv_run(const Dec& dec, int nitems, const float* gain, LAS float* scr, int gw, int NGW, int lane) {
    int it = gw; if (it >= nitems) return;
    f32x4 va[CV_KR / 4], vb[CV_KR / 4];
    conv_load(dec.item(it), va, lane);
    for (;;) {
        const int it2 = it + NGW; const bool m2 = it2 < nitems;
        if (m2) conv_load(dec.item(it2), vb, lane);
        conv_store(dec.item(it), va, gain, scr, lane); if (!m2) break;
        const int it3 = it2 + NGW; const bool m3 = it3 < nitems;
        if (m3) conv_load(dec.item(it3), va, lane);
        conv_store(dec.item(it2), vb, gain, scr, lane); if (!m3) break;
        it = it3;
    }
}
template <int K, int N, int NC> struct CvCols { const float* W; int c0; bf16* WT; int r0;
    __device__ __forceinline__ CvItem item(int it) const { constexpr int nblk = NC / 64; const int kb = it / nblk, nb = it % nblk, k0 = CV_KR * kb;
        return CvItem{W + (size_t)k0 * N + c0 + 64 * nb, N, k0, WT + (size_t)(r0 + 64 * nb) * K, K}; } };
template <int K, int N, int NC> __device__ __forceinline__ void conv_cols(const float* W, int c0, bf16* WT, int r0, const float* gain, LAS float* scr, int gw, int NGW, int lane) {
    conv_run(CvCols<K, N, NC>{W, c0, WT, r0}, (K / CV_KR) * (NC / 64), gain, scr, gw, NGW, lane);
}
template <int K, int N> __device__ __forceinline__ void conv_plain(const float* W, bf16* WT, const float* gain, LAS float* scr, int gw, int NGW, int lane) { conv_cols<K, N, N>(W, 0, WT, 0, gain, scr, gw, NGW, lane); }
struct CvGateUp { const float* Wg; long dgu; bf16* WT;
    __device__ __forceinline__ CvItem item(int it) const { constexpr int nblk = 2 * DFF / 64; const int kb = it / nblk, nb = it % nblk, k0 = CV_KR * kb, n0 = 64 * nb, pn = n0 >> 8, bj = (n0 >> 7) & 1, c0 = n0 & 127;
        return CvItem{Wg + (bj ? dgu : 0l) + (size_t)k0 * DFF + 128 * pn + c0, DFF, k0, WT + (size_t)n0 * D, D}; } };
__device__ __forceinline__ void conv_gateup(const float* Wg, const float* Wu, bf16* WT, const float* gain, LAS float* scr, int gw, int NGW, int lane) {
    conv_run(CvGateUp{Wg, (long)(Wu - Wg), WT}, (D / CV_KR) * (2 * DFF / 64), gain, scr, gw, NGW, lane);
}

template <int N> struct CvGates { const float* W; int c_f, c_b; bf16* WT; int r0;
    __device__ __forceinline__ CvItem item(int it) const { constexpr int nblk = 2 * DV / 64; const int kb = it / nblk, nb = it % nblk, k0 = CV_KR * kb, n0 = 64 * nb, pn = n0 >> 8, bj = (n0 >> 7) & 1, c0 = n0 & 127;
        return CvItem{W + (size_t)k0 * N + (bj ? c_b : c_f) + 128 * pn + c0, N, k0, WT + (size_t)(r0 + n0) * D, D}; } };
template <int N> __device__ __forceinline__ void conv_gates(const float* W, int c_f, int c_b, bf16* WT, int r0, const float* gain, LAS float* scr, int gw, int NGW, int lane) {
    conv_run(CvGates<N>{W, c_f, c_b, WT, r0}, (D / CV_KR) * (2 * DV / 64), gain, scr, gw, NGW, lane);
}
__device__ __forceinline__ void unpack8(const v4u w, float (&f)[8]) { f[0] = bflo(w.x); f[1] = bfhi(w.x); f[2] = bflo(w.y); f[3] = bfhi(w.y); f[4] = bflo(w.z); f[5] = bfhi(w.z); f[6] = bflo(w.w); f[7] = bfhi(w.w); }
__device__ __forceinline__ void p0_rows(const float* xin, bf16* XB, float* RS, int gw, int NGW, int lane) {
    for (int m = gw; m < M; m += NGW) {
        float ss = 0.f;
#pragma unroll
        for (int j = 0; j < 2; ++j) { const float* p = xin + (size_t)m * D + 512 * j + 8 * lane; const f32x4 a = __builtin_nontemporal_load((const f32x4*)p), b = __builtin_nontemporal_load((const f32x4*)(p + 4));
            ss += (a.x * a.x + a.y * a.y) + (a.z * a.z + a.w * a.w) + (b.x * b.x + b.y * b.y) + (b.z * b.z + b.w * b.w);
            v4u w; w.x = pk2(a.x, a.y); w.y = pk2(a.z, a.w); w.z = pk2(b.x, b.y); w.w = pk2(b.z, b.w); *(v4u*)(XB + (size_t)m * D + 512 * j + 8 * lane) = w; }
        ss = wave_sum(ss);
        if (lane == 0) *(f32x4*)(RS + 4 * (size_t)m) = (f32x4){ss, 0.f, 0.f, 0.f};
    }
}

typedef float f32x16 __attribute__((ext_vector_type(16)));
typedef short bf16x8s __attribute__((ext_vector_type(8)));
typedef float f32x2_t __attribute__((ext_vector_type(2))); typedef __bf16 bf16x2_t __attribute__((ext_vector_type(2)));
__device__ __forceinline__ unsigned cvtpk(float lo, float hi) { f32x2_t v = {lo, hi}; bf16x2_t b = __builtin_convertvector(v, bf16x2_t); return __builtin_bit_cast(unsigned, b); }

constexpr int RQK = 2 * D;
constexpr int RC_ST = 0, RC_RG = 65536, RC_NSLOT = 5, RC_TB = RC_RG + RC_NSLOT * 16384, RC_LDS = RC_TB + 2048;
__device__ __forceinline__ int sl_swz(int ob) { return ob ^ (((ob >> 9) & 1) << 5); }
template <int VAR  >
__device__ __forceinline__ void ret_core_mfma(const bf16* P, const bf16* VT, const float* decay_logit  , bf16* YF, bf16* YB, float* PT, LAS unsigned char* lds, const int tid, const int bid, const int G) {
    typedef short bf16x8v __attribute__((ext_vector_type(8)));
    const int w = __builtin_amdgcn_readfirstlane(tid >> 6), lane = tid & 63, fr = lane & 15, fq = lane >> 4, wr = w >> 2, wc = w & 3;
#define RC_DMA(gptr, ldsoff) __builtin_amdgcn_global_load_lds((const unsigned*)(gptr), (LAS unsigned*)(lds + (ldsoff)), 16, 0, 0)
#define RC_WAITV(n) asm volatile("s_waitcnt vmcnt(" #n ")" ::: "memory")
#define RC_WAITL() asm volatile("s_waitcnt lgkmcnt(0)" ::: "memory")
#define RC_BAR() do { asm volatile("" ::: "memory"); __builtin_amdgcn_s_barrier(); asm volatile("" ::: "memory"); } while (0)
#define RC_MFMA(b, a, c) __builtin_amdgcn_mfma_f32_16x16x32_bf16((b), (a), (c), 0, 0, 0)
#define RC_NEXT(sl) ((sl) == RC_NSLOT - 1 ? 0 : (sl) + 1)
#define RC_PREV(sl) ((sl) == 0 ? RC_NSLOT - 1 : (sl) - 1)
    const int dob = sl_swz(lane * 16), drow = 16 * w + (dob >> 6), dcc = (dob & 63) >> 1;
    const int aoff = 4 * wr * 1024 + sl_swz(fr * 64 + fq * 16), boff = 2 * wc * 1024 + sl_swz(fr * 64 + fq * 16);
    for (int u = bid; u < 512; u += G) {
        const int xcd = u & 7, idx = u >> 3, es = idx & 3, cmb = (idx >> 2) * 8 + xcd, dir = cmb & 1, h = (cmb >> 1) & 3, bl = cmb >> 3;
        const float lg = __builtin_amdgcn_logf(1.0f - __builtin_amdgcn_exp2f(decay_logit[dir * HR + h] * 1.4426950409f));
        const float cdec = __builtin_amdgcn_exp2f(lg * 128.f);
        bf16* Y = dir ? YB : YF;
        const size_t rowbase = (size_t)bl * SEQ;
        const bf16* qsrc = P + (rowbase + drow) * RQK + h * DKR + dcc;
        const bf16* ksrc = qsrc + D;
        const int drowv = (drow & ~31) + 8 * ((drow & 15) >> 2) + 4 * ((drow >> 4) & 1) + (drow & 3);
        const bf16* vsrc = VT + (size_t)(h * DVR + es * 128 + drowv) * M + rowbase + dcc;
        const bf16* vown = VT + (size_t)(h * DVR + es * 128 + 16 * w + fr) * M + rowbase + 8 * fq;
        if (tid < 128) { LAS float* tb = (LAS float*)(lds + RC_TB); const float t = (float)tid;
            tb[tid] = __builtin_amdgcn_exp2f(lg * (dir ? t : 127.f - t)); tb[128 + tid] = __builtin_amdgcn_exp2f(lg * (dir ? -t : t));
            tb[256 + tid] = __builtin_amdgcn_exp2f(lg * (dir ? t : -t)); tb[384 + tid] = __builtin_amdgcn_exp2f(lg * (dir ? 128.f - t : t + 1.f)); }
        { const v4u z = (v4u){0u, 0u, 0u, 0u};
#pragma unroll
          for (int i = 0; i < 8; ++i) *(LAS v4u*)(lds + RC_ST + (i * NTHREADS + tid) * 16) = z; }
        f32x4 acc4[16];
#pragma unroll
        for (int n = 0; n < 16; ++n) acc4[n] = (f32x4){0.f, 0.f, 0.f, 0.f};
#define RC_ISSUE(st, tk, sl) do { if ((st) < 8) { const size_t to_ = (size_t)(tk) * RQK + 32 * (st); RC_DMA(qsrc + to_, RC_RG + (sl) * 16384 + w * 1024); RC_DMA(ksrc + to_, RC_RG + (sl) * 16384 + 8192 + w * 1024); } \
                                  else RC_DMA(vsrc + (tk) + 32 * ((st) - 8), RC_RG + (sl) * 16384 + w * 1024); } while (0)
        v4u vnx[4];
        { const int tok0 = dir ? 128 * 15 : 0;
#pragma unroll
          for (int js = 0; js < 4; ++js) vnx[js] = *(const v4u*)(vown + tok0 + 32 * js);
          RC_ISSUE(0, tok0, 0); RC_ISSUE(1, tok0, 1); RC_ISSUE(2, tok0, 2); RC_ISSUE(3, tok0, 3); }
        RC_WAITL(); RC_BAR();
        int slot = 0;
        for (int c = 0; c < 16; ++c) {
            const int tok0 = 128 * (dir ? 15 - c : c), tokn = 128 * (dir ? (c < 15 ? 14 - c : 0) : (c < 15 ? c + 1 : 15));
            float lgc = lg; int zo = 0; asm volatile("" : "+v"(lgc), "+v"(zo));
            int lc = lane; asm volatile("" : "+v"(lc)); const int frc = lc & 15, fqc = lc >> 4;
            bf16x8v Avs[4];
#pragma unroll
            for (int js = 0; js < 4; ++js) { const v4u kw = vnx[js]; float kd[8];
                { const LAS f32x4* kp = (const LAS f32x4*)(lds + RC_TB + (32 * js + 8 * fqc) * 4); const f32x4 k0 = kp[0], k1 = kp[1];
                  kd[0] = k0[0]; kd[1] = k0[1]; kd[2] = k0[2]; kd[3] = k0[3]; kd[4] = k1[0]; kd[5] = k1[1]; kd[6] = k1[2]; kd[7] = k1[3]; }
                v4u sw; sw.x = cvtpk(bflo(kw.x) * kd[0], bfhi(kw.x) * kd[1]); sw.y = cvtpk(bflo(kw.y) * kd[2], bfhi(kw.y) * kd[3]); sw.z = cvtpk(bflo(kw.z) * kd[4], bfhi(kw.z) * kd[5]); sw.w = cvtpk(bflo(kw.w) * kd[6], bfhi(kw.w) * kd[7]);
                Avs[js] = __builtin_bit_cast(bf16x8v, sw); }
#pragma unroll
            for (int n = 0; n < 16; ++n) acc4[n] = acc4[n] * cdec;
            const int jj = 8 * fqc + (frc >> 2);
            const unsigned trA = (unsigned)((jj >> 4) * 1024 + sl_swz((jj & 15) * 64 + 8 * (frc & 3))), trB = (unsigned)(((jj + 4) >> 4) * 1024 + sl_swz(((jj + 4) & 15) * 64 + 8 * (frc & 3)));
            f32x4 accA[4][2], accY[4][2];
#pragma unroll
            for (int m = 0; m < 4; ++m)
#pragma unroll
                for (int n = 0; n < 2; ++n) { accA[m][n] = (f32x4){0.f, 0.f, 0.f, 0.f}; accY[m][n] = (f32x4){0.f, 0.f, 0.f, 0.f}; }
#pragma unroll
            for (int ks = 0; ks < 8; ++ks) {
                if (ks < 4) { if (c == 0) RC_WAITV(6); else RC_WAITV(14); } else if (ks == 4) RC_WAITV(6); else if (ks == 5) RC_WAITV(5); else if (ks == 6) RC_WAITV(4); else RC_WAITV(3);
                RC_BAR();
                { const int s4 = RC_PREV(slot);
                  if (ks + 4 < 12) RC_ISSUE(ks + 4, tok0, s4); else RC_ISSUE(ks + 4 - 12, tokn, s4); }
                bf16x8v At[4], Bk[2], Bs[2];
                const LAS unsigned char* sq = lds + RC_RG + slot * 16384;
#pragma unroll
                for (int m = 0; m < 4; ++m) At[m] = *(const LAS bf16x8v*)(sq + aoff + m * 1024);
#pragma unroll
                for (int n = 0; n < 2; ++n) { Bk[n] = *(const LAS bf16x8v*)(sq + 8192 + boff + n * 1024); Bs[n] = *(const LAS bf16x8v*)(lds + RC_ST + ks * 8192 + boff + n * 1024); }
#pragma unroll
                for (int m = 0; m < 4; ++m)
#pragma unroll
                    for (int n = 0; n < 2; ++n) { accA[m][n] = RC_MFMA(Bk[n], At[m], accA[m][n]); accY[m][n] = RC_MFMA(Bs[n], At[m], accY[m][n]); }
                { const unsigned kb = (unsigned)(size_t)(sq + 8192);
                  const unsigned a0 = kb + trA, a1 = kb + trB, b0 = kb + (trA ^ 32u), b1 = kb + (trB ^ 32u);
                  v2u l0, h0, l1, h1, l2, h2, l3, h3, p0, q0, p1, q1, p2, q2, p3, q3;
                  asm volatile("ds_read_b64_tr_b16 %0, %16\n\tds_read_b64_tr_b16 %1, %17\n\tds_read_b64_tr_b16 %8, %18\n\tds_read_b64_tr_b16 %9, %19\n\t"
                               "ds_read_b64_tr_b16 %2, %16 offset:2048\n\tds_read_b64_tr_b16 %3, %17 offset:2048\n\tds_read_b64_tr_b16 %10, %18 offset:2048\n\tds_read_b64_tr_b16 %11, %19 offset:2048\n\t"
                               "ds_read_b64_tr_b16 %4, %16 offset:4096\n\tds_read_b64_tr_b16 %5, %17 offset:4096\n\tds_read_b64_tr_b16 %12, %18 offset:4096\n\tds_read_b64_tr_b16 %13, %19 offset:4096\n\t"
                               "ds_read_b64_tr_b16 %6, %16 offset:6144\n\tds_read_b64_tr_b16 %7, %17 offset:6144\n\tds_read_b64_tr_b16 %14, %18 offset:6144\n\tds_read_b64_tr_b16 %15, %19 offset:6144\n\ts_waitcnt lgkmcnt(0)"
                               : "=&v"(l0), "=&v"(h0), "=&v"(l1), "=&v"(h1), "=&v"(l2), "=&v"(h2), "=&v"(l3), "=&v"(h3), "=&v"(p0), "=&v"(q0), "=&v"(p1), "=&v"(q1), "=&v"(p2), "=&v"(q2), "=&v"(p3), "=&v"(q3)
                               : "v"(a0), "v"(a1), "v"(b0), "v"(b1) : "memory");
                  acc4[2 * ks] = RC_MFMA(__builtin_bit_cast(bf16x8v, ((v4u){l0.x, l0.y, h0.x, h0.y})), Avs[0], acc4[2 * ks]); acc4[2 * ks + 1] = RC_MFMA(__builtin_bit_cast(bf16x8v, ((v4u){p0.x, p0.y, q0.x, q0.y})), Avs[0], acc4[2 * ks + 1]);
                  acc4[2 * ks] = RC_MFMA(__builtin_bit_cast(bf16x8v, ((v4u){l1.x, l1.y, h1.x, h1.y})), Avs[1], acc4[2 * ks]); acc4[2 * ks + 1] = RC_MFMA(__builtin_bit_cast(bf16x8v, ((v4u){p1.x, p1.y, q1.x, q1.y})), Avs[1], acc4[2 * ks + 1]);
                  acc4[2 * ks] = RC_MFMA(__builtin_bit_cast(bf16x8v, ((v4u){l2.x, l2.y, h2.x, h2.y})), Avs[2], acc4[2 * ks]); acc4[2 * ks + 1] = RC_MFMA(__builtin_bit_cast(bf16x8v, ((v4u){p2.x, p2.y, q2.x, q2.y})), Avs[2], acc4[2 * ks + 1]);
                  acc4[2 * ks] = RC_MFMA(__builtin_bit_cast(bf16x8v, ((v4u){l3.x, l3.y, h3.x, h3.y})), Avs[3], acc4[2 * ks]); acc4[2 * ks + 1] = RC_MFMA(__builtin_bit_cast(bf16x8v, ((v4u){p3.x, p3.y, q3.x, q3.y})), Avs[3], acc4[2 * ks + 1]); }
                slot = RC_NEXT(slot);
            }
#pragma unroll
            for (int m = 0; m < 4; ++m)
#pragma unroll
                for (int n = 0; n < 2; ++n) { const int i = 64 * wr + 16 * m + frc;
                    const float qdf = *(const LAS float*)(lds + RC_TB + 1536 + i * 4), rwf = *(const LAS float*)(lds + RC_TB + 512 + i * 4);
                    const f32x4 clf = *(const LAS f32x4*)(lds + RC_TB + 1024 + (32 * wc + 16 * n + 4 * fqc) * 4);
                    accY[m][n] = accY[m][n] * qdf;
#pragma unroll
                    for (int ii = 0; ii < 4; ++ii) { const int j = 32 * wc + 16 * n + 4 * fqc + ii; const int dd = dir ? j - i : i - j;
                        accA[m][n][ii] = dd >= 0 ? accA[m][n][ii] * (rwf * clf[ii]) : 0.f; } }
            RC_BAR();
#pragma unroll
            for (int m = 0; m < 4; ++m)
#pragma unroll
                for (int n = 0; n < 2; ++n) { v2u pw; pw.x = cvtpk(accA[m][n][0], accA[m][n][1]); pw.y = cvtpk(accA[m][n][2], accA[m][n][3]);
                    *(LAS v2u*)(lds + RC_ST + wc * 8192 + (4 * wr + m) * 1024 + sl_swz(frc * 64 + (16 * n + 4 * fqc) * 2)) = pw; }
#pragma unroll
            for (int js = 0; js < 4; ++js) vnx[js] = *(const v4u*)(vown + tokn + 32 * js + zo);
            RC_WAITL();
#pragma unroll
            for (int js = 0; js < 4; ++js) {
                if (js == 0) RC_WAITV(7); else if (js == 1) RC_WAITV(8); else if (js == 2) RC_WAITV(9); else RC_WAITV(10);
                RC_BAR();
                { const int s4 = RC_PREV(slot); RC_ISSUE(js, tokn, s4); }
                bf16x8v At[4], Bv[2];
                const LAS unsigned char* sv = lds + RC_RG + slot * 16384;
#pragma unroll
                for (int m = 0; m < 4; ++m) At[m] = *(const LAS bf16x8v*)(lds + RC_ST + js * 8192 + aoff + m * 1024);
#pragma unroll
                for (int n = 0; n < 2; ++n) Bv[n] = *(const LAS bf16x8v*)(sv + boff + n * 1024);
                RC_WAITL();
#pragma unroll
                for (int m = 0; m < 4; ++m)
#pragma unroll
                    for (int n = 0; n < 2; ++n) accY[m][n] = RC_MFMA(Bv[n], At[m], accY[m][n]);
                slot = RC_NEXT(slot);
            }
#pragma unroll
            for (int m = 0; m < 4; ++m) { v4u pw; pw.x = cvtpk(accY[m][0][0], accY[m][0][1]); pw.y = cvtpk(accY[m][0][2], accY[m][0][3]); pw.z = cvtpk(accY[m][1][0], accY[m][1][1]); pw.w = cvtpk(accY[m][1][2], accY[m][1][3]);
                *(v4u*)(Y + (rowbase + tok0 + 64 * wr + 16 * m + frc + zo) * DV + h * DVR + es * 128 + 32 * wc + 8 * fqc) = pw; }
#pragma unroll
            for (int m = 0; m < 4; ++m) { float sv = 0.f, sq = 0.f;
#pragma unroll
                for (int n = 0; n < 2; ++n)
#pragma unroll
                    for (int ii = 0; ii < 4; ++ii) { const float yv = accY[m][n][ii]; sv += yv; sq += yv * yv; }
                sv += swz_xor<16>(sv); sq += swz_xor<16>(sq); sv += get_xor32(sv, lc); sq += get_xor32(sq, lc);
                float* sp = PT + (((size_t)((h * 2 + dir) * 16 + es * 4 + wc)) * M + (rowbase + tok0 + 64 * wr + 16 * m + frc + zo)) * 2;
                if (fqc == 0) *(f32x2_t*)sp = (f32x2_t){sv, sq}; }
            RC_BAR();
            const int srow = 4 * (2 * (w & 1) + (frc >> 3)) + (frc & 3), ssub = 2 * (w >> 1) + ((frc >> 2) & 1);
#pragma unroll
            for (int n = 0; n < 16; ++n) { v2u pw; pw.x = cvtpk(acc4[n][0], acc4[n][1]); pw.y = cvtpk(acc4[n][2], acc4[n][3]);
                *(LAS v2u*)(lds + RC_ST + (n >> 1) * 8192 + ssub * 1024 + sl_swz(srow * 64 + (16 * (n & 1) + 4 * fqc) * 2)) = pw; }
            RC_WAITL();
        }
        RC_WAITV(0); RC_BAR();
    }
#undef RC_DMA
#undef RC_WAITV
#undef RC_WAITL
#undef RC_BAR
#undef RC_MFMA
#undef RC_NEXT
#undef RC_PREV
#undef RC_ISSUE
}

__device__ __forceinline__ void ret_stats(const float* PT, float* ST, int gtid, int nthr) {
    for (int i = gtid; i < M * 8; i += nthr) { const int hd = i / M, row = i - hd * M; const f32x2_t* p = (const f32x2_t*)PT + (size_t)hd * 16 * M + row; float sv = 0.f, sq = 0.f;
#pragma unroll
        for (int k = 0; k < 16; ++k) { const f32x2_t v = p[(size_t)k * M]; sv += v.x; sq += v.y; }
        *(f32x2_t*)(ST + ((size_t)row * 8 + hd) * 2) = (f32x2_t){sv, sq}; }
}

__device__ __forceinline__ void attn_group_mfma5(const bf16* QK, const float* bias2g, int ldil, int first, bf16* OACC, float* LSE, LAS unsigned char* lds, const int tid, const int bid, const int G) {
    typedef short s16x4 __attribute__((ext_vector_type(4)));
    const int wq = __builtin_amdgcn_readfirstlane(tid >> 6), lane = tid & 63, n = lane & 15, kq = lane >> 4;
    const int Ls = SEQ >> ldil, lq4 = 4 - ldil, nq4m = (1 << lq4) - 1, dilm = (1 << ldil) - 1;
    constexpr float SC = 0.125f * 1.4426950409f;
    const float NEGBIG = opaque_f(-1e30f);
    constexpr int NP = BATCH * HA * 16 / 2;
    const int npp = (NP + G - 1) / G, ns = 2 * npp;
    const bool remap = (G == 256);
    constexpr int AT5_BUF = 2 * 32768 + 768;
    static_assert(2 * AT5_BUF <= RING_BYTES, "attention v5 tiles");
#define AT_P(it_) (remap ? ((2 * ((bid * 4 + ((it_) & 3)) >> 7) + (((it_) >> 2) ? 0 : 1)) * 128 + ((bid * 4 + ((it_) & 3)) & 127)) : bid * npp + (it_))
#define AT_SU(s_) (2 * AT_P((s_) >> 1) + ((s_) & 1))
#define AT_OK(s_) ((s_) < ns && AT_P((s_) >> 1) < NP)
#define AT_DMA(su_, buf_) do { const int su__ = (su_); const int q4_ = su__ & nq4m, rr_ = (su__ >> lq4) & dilm, h_ = (su__ >> 4) & 15, b_ = su__ >> 8, ks_ = q4_ * 128 - 64; \
        int ln_ = lane; asm volatile("" : "+v"(ln_)); const bf16* vs_[4]; \
        _Pragma("unroll") for (int j = 0; j < 4; ++j) { const int rb = wq * 4 + j, row = 8 * rb + (ln_ >> 3); int kt = ks_ + row; kt = kt < 0 ? 0 : (kt > Ls - 1 ? Ls - 1 : kt); \
            const bf16* rp_ = QK + ((((size_t)(b_ * 16 + h_) << ldil) | rr_) * Ls + kt) * 64 + (((ln_ & 7) ^ ((row >> 1) & 7)) * 8); vs_[j] = rp_ + 2 * (size_t)M * D; \
            __builtin_amdgcn_global_load_lds((const unsigned*)(rp_ + (size_t)M * D), (LAS unsigned*)(lds + (buf_) * AT5_BUF + rb * 1024), 16, 0, 0); } \
        _Pragma("unroll") for (int j = 0; j < 4; ++j) __builtin_amdgcn_global_load_lds((const unsigned*)vs_[j], (LAS unsigned*)(lds + (buf_) * AT5_BUF + 32768 + (wq * 4 + j) * 1024), 16, 0, 0); } while (0)
#define AT_BIAS(su_) ((tid < 192 && tid - 96 >= -64 && tid - 96 <= 64) ? bias2g[(((su_) >> 4) & 15) * 129 + tid - 96 + 64] : NEGBIG)
#define AT_ROWQ(su_) ((size_t)((su_) >> 8) * SEQ + ((size_t)(((su_) & nq4m) * 128 + 16 * wq + n) << ldil) + (((su_) >> lq4) & dilm))
#define AT_FETCH_Q(su_) do { const int su__ = (su_); const bf16* qp_ = QK + ((((size_t)((su__ >> 8) * 16 + ((su__ >> 4) & 15)) << ldil) | ((su__ >> lq4) & dilm)) * Ls + ((su__ & nq4m) * 128 + 16 * wq + n)) * 64 + 8 * kq; \
        qf[0] = *(const bf16x8s*)qp_; qf[1] = *(const bf16x8s*)(qp_ + 32); } while (0)
    bf16x8s qf[2]; float bv = 0.f;
    if (AT_OK(0)) { bv = AT_BIAS(AT_SU(0)); AT_DMA(AT_SU(0), 0); AT_FETCH_Q(AT_SU(0)); if (tid < 192) ((LAS float*)(lds + 65536))[tid] = bv; }
    asm volatile("s_waitcnt vmcnt(0) lgkmcnt(0)" ::: "memory"); __builtin_amdgcn_s_barrier(); asm volatile("" ::: "memory");
    const int fl = (n >> 1) & 7;
    for (int s = 0; s < ns; ++s) {
        if (!AT_OK(s)) break;
        const bool more = AT_OK(s + 1);
        if (more) { bv = AT_BIAS(AT_SU(s + 1)); AT_DMA(AT_SU(s + 1), (s + 1) & 1); }
        const int su = AT_SU(s), q4 = su & nq4m, rr = (su >> lq4) & dilm, h = (su >> 4) & 15, b = su >> 8;
        const LAS unsigned char* Kl = lds + (s & 1) * AT5_BUF; const LAS unsigned char* Vl = Kl + 32768; const LAS float* tab = (const LAS float*)(Kl + 65536);
        const size_t rowq = (size_t)b * SEQ + ((size_t)(q4 * 128 + 16 * wq + n) << ldil) + rr;
        f32x4 S[9];
#pragma unroll
        for (int kb = 0; kb < 9; ++kb) S[kb] = (f32x4){0.f, 0.f, 0.f, 0.f};
        { const LAS unsigned char* kp0 = Kl + (16 * wq + n) * 128;
#pragma unroll
          for (int ks = 0; ks < 2; ++ks)
#pragma unroll
            for (int kb = 0; kb < 9; ++kb) S[kb] = __builtin_amdgcn_mfma_f32_16x16x32_bf16(*(const LAS bf16x8s*)(kp0 + 16 * kb * 128 + (((4 * ks + kq) ^ fl) * 16)), qf[ks], S[kb], 0, 0, 0); }
        __builtin_amdgcn_sched_barrier(0);
        if (more) AT_FETCH_Q(AT_SU(s + 1));
        float lold = 0.f; v2u xo[4];
        if (!first) { lold = LSE[rowq * 16 + h];
#pragma unroll
            for (int db = 0; db < 4; ++db) xo[db] = *(const v2u*)(OACC + rowq * D + h * 64 + 16 * db + 4 * kq); }
        else {
#pragma unroll
            for (int db = 0; db < 4; ++db) xo[db] = (v2u){0u, 0u}; }
        __builtin_amdgcn_sched_barrier(0);
        const LAS float* tb = tab + (32 + 4 * kq - n);
        int kt0 = q4 * 128 - 64 + 16 * wq + 4 * kq; asm volatile("" : "+v"(kt0));
        float mx = NEGBIG;
#pragma unroll
        for (int kb = 0; kb < 9; ++kb)
#pragma unroll
            for (int e = 0; e < 4; ++e) { const int krel = 16 * kb + e;
                float sv = S[kb][e] * SC + tb[krel]; sv = ((unsigned)(kt0 + krel) >= (unsigned)Ls) ? NEGBIG : sv; S[kb][e] = sv; mx = fmaxf(mx, sv); }
        mx = fmaxf(mx, swz_xor<16>(mx)); mx = fmaxf(mx, get_xor32(mx, lane));
        float l = 0.f; v4u pb[5];
#pragma unroll
        for (int kb = 0; kb < 9; ++kb) {
            const float p0 = __builtin_amdgcn_exp2f(S[kb][0] - mx), p1 = __builtin_amdgcn_exp2f(S[kb][1] - mx), p2 = __builtin_amdgcn_exp2f(S[kb][2] - mx), p3 = __builtin_amdgcn_exp2f(S[kb][3] - mx);
            l += (p0 + p1) + (p2 + p3);
            if (kb & 1) { pb[kb >> 1].z = cvtpk(p0, p1); pb[kb >> 1].w = cvtpk(p2, p3); } else { pb[kb >> 1].x = cvtpk(p0, p1); pb[kb >> 1].y = cvtpk(p2, p3); } }
        pb[4].z = 0u; pb[4].w = 0u;
        l += swz_xor<16>(l); l += get_xor32(l, lane);
        f32x4 O[4];
#pragma unroll
        for (int db = 0; db < 4; ++db) O[db] = (f32x4){0.f, 0.f, 0.f, 0.f};
        { const int vf = (2 * kq + (n >> 3)) & 7;
          const unsigned vb0 = (unsigned)(size_t)(Vl + (16 * wq + 4 * kq + (n >> 2)) * 128 + 8 * (n & 1));
          unsigned ad[4];
#pragma unroll
          for (int db = 0; db < 4; ++db) ad[db] = vb0 + (unsigned)(((2 * db + ((n & 3) >> 1)) ^ vf) * 16);
#pragma unroll
          for (int t = 0; t < 5; ++t) {
              v2u l0, l1, l2, l3, h0 = (v2u){0u, 0u}, h1 = h0, h2 = h0, h3 = h0;
              if (t < 4) asm volatile("ds_read_b64_tr_b16 %0, %8 offset:%12\n\tds_read_b64_tr_b16 %1, %9 offset:%12\n\tds_read_b64_tr_b16 %2, %10 offset:%12\n\tds_read_b64_tr_b16 %3, %11 offset:%12\n\t"
                                      "ds_read_b64_tr_b16 %4, %8 offset:%13\n\tds_read_b64_tr_b16 %5, %9 offset:%13\n\tds_read_b64_tr_b16 %6, %10 offset:%13\n\tds_read_b64_tr_b16 %7, %11 offset:%13\n\ts_waitcnt lgkmcnt(0)"
                                      : "=&v"(l0), "=&v"(l1), "=&v"(l2), "=&v"(l3), "=&v"(h0), "=&v"(h1), "=&v"(h2), "=&v"(h3) : "v"(ad[0]), "v"(ad[1]), "v"(ad[2]), "v"(ad[3]), "n"(t * 4096), "n"(t * 4096 + 2048) : "memory");
              else asm volatile("ds_read_b64_tr_b16 %0, %4 offset:%8\n\tds_read_b64_tr_b16 %1, %5 offset:%8\n\tds_read_b64_tr_b16 %2, %6 offset:%8\n\tds_read_b64_tr_b16 %3, %7 offset:%8\n\ts_waitcnt lgkmcnt(0)"
                                : "=&v"(l0), "=&v"(l1), "=&v"(l2), "=&v"(l3) : "v"(ad[0]), "v"(ad[1]), "v"(ad[2]), "v"(ad[3]), "n"(t * 4096) : "memory");
              const bf16x8s pf = __builtin_bit_cast(bf16x8s, pb[t]);
              O[0] = __builtin_amdgcn_mfma_f32_16x16x32_bf16(__builtin_bit_cast(bf16x8s, ((v4u){l0.x, l0.y, h0.x, h0.y})), pf, O[0], 0, 0, 0);
              O[1] = __builtin_amdgcn_mfma_f32_16x16x32_bf16(__builtin_bit_cast(bf16x8s, ((v4u){l1.x, l1.y, h1.x, h1.y})), pf, O[1], 0, 0, 0);
              O[2] = __builtin_amdgcn_mfma_f32_16x16x32_bf16(__builtin_bit_cast(bf16x8s, ((v4u){l2.x, l2.y, h2.x, h2.y})), pf, O[2], 0, 0, 0);
              O[3] = __builtin_amdgcn_mfma_f32_16x16x32_bf16(__builtin_bit_cast(bf16x8s, ((v4u){l3.x, l3.y, h3.x, h3.y})), pf, O[3], 0, 0, 0); } }
        const float il = __builtin_amdgcn_rcpf(l); float lse = mx + __builtin_amdgcn_logf(l);
        float wn = il, wo = 0.f;
        if (!first) { const float mm = fmaxf(lold, lse), eo = __builtin_amdgcn_exp2f(lold - mm), en = __builtin_amdgcn_exp2f(lse - mm), inv = __builtin_amdgcn_rcpf(eo + en); wn = en * inv * il; wo = eo * inv; lse = mm + __builtin_amdgcn_logf(eo + en); }
        if (kq == 0) LSE[rowq * 16 + h] = lse;
#pragma unroll
        for (int db = 0; db < 4; ++db) { const v2u x = xo[db]; v2u y;
            y.x = cvtpk(wn * O[db][0] + wo * bflo(x.x), wn * O[db][1] + wo * bfhi(x.x)); y.y = cvtpk(wn * O[db][2] + wo * bflo(x.y), wn * O[db][3] + wo * bfhi(x.y));
            *(v2u*)(OACC + rowq * D + h * 64 + 16 * db + 4 * kq) = y; }
        if (more && tid < 192) ((LAS float*)(lds + ((s + 1) & 1) * AT5_BUF + 65536))[tid] = bv;
        asm volatile("s_waitcnt vmcnt(7)" ::: "memory");
        asm volatile("s_waitcnt lgkmcnt(0)" ::: "memory"); __builtin_amdgcn_s_barrier(); asm volatile("" ::: "memory");
    }
#undef AT_FETCH_Q
#undef AT_ROWQ
#undef AT_BIAS
#undef AT_DMA
#undef AT_OK
#undef AT_SU
#undef AT_P
    __syncthreads();
}

__device__ __forceinline__ void attn_group_ring(const bf16* QK, const float* bias2g, int ldil, int first, bf16* OACC, float* LSE, LAS unsigned char* lds, const int tid, const int bid, const int G) {
    const int wq = __builtin_amdgcn_readfirstlane(tid >> 6), lane = tid & 63, n = lane & 15, kq = lane >> 4;
    const int Ls = SEQ >> ldil, lq4 = 4 - ldil, nq4m = (1 << lq4) - 1, dilm = (1 << ldil) - 1;
    constexpr float SC = 0.125f * 1.4426950409f;
    const float NEGBIG = opaque_f(-1e30f);
    constexpr int NP = BATCH * HA * 16 / 2;
    const int npp = (NP + G - 1) / G, ns = 2 * npp;
    const bool remap = (G == 256);
    const int R = ldil == 0 ? 8 : 4, RH = R + 1, NH = (ns / R) * RH;
#define AT_P(it_) (remap ? ((2 * ((bid * 4 + ((it_) & 3)) >> 7) + (((it_) >> 2) ? 0 : 1)) * 128 + ((bid * 4 + ((it_) & 3)) & 127)) : bid * npp + (it_))
#define AT_SU(s_) (2 * AT_P((s_) >> 1) + ((s_) & 1))
#define AT_DMAH(i_) do { const int i__ = (i_); const int r_ = i__ / RH, k_ = i__ - r_ * RH, up_ = (k_ == R) ? 1 : 0, su__ = AT_SU(r_ * R + (up_ ? R - 1 : k_)); \
        const int q4_ = su__ & nq4m, rr_ = (su__ >> lq4) & dilm, h_ = (su__ >> 4) & 15, b_ = su__ >> 8, ks_ = q4_ * 128 - 64 + 128 * up_; \
        int ln_ = lane; asm volatile("" : "+v"(ln_)); const bf16* vs_[2]; LAS unsigned char* sl_ = lds + (i__ & 3) * 32768; \
        _Pragma("unroll") for (int j = 0; j < 2; ++j) { const int rb = wq * 2 + j, row = 8 * rb + (ln_ >> 3); int kt = ks_ + row; kt = kt < 0 ? 0 : (kt > Ls - 1 ? Ls - 1 : kt); \
            const bf16* rp_ = QK + ((((size_t)(b_ * 16 + h_) << ldil) | rr_) * Ls + kt) * 64 + (((ln_ & 7) ^ ((row >> 1) & 7)) * 8); vs_[j] = rp_ + 2 * (size_t)M * D; \
            __builtin_amdgcn_global_load_lds((const unsigned*)(rp_ + (size_t)M * D), (LAS unsigned*)(sl_ + rb * 1024), 16, 0, 0); } \
        _Pragma("unroll") for (int j = 0; j < 2; ++j) __builtin_amdgcn_global_load_lds((const unsigned*)vs_[j], (LAS unsigned*)(sl_ + 16384 + (wq * 2 + j) * 1024), 16, 0, 0); \
        tick += 4; tkat[i__ & 3] = tick; } while (0)
#define AT_FETCH_Q(su_) do { const int su__ = (su_); const bf16* qp_ = QK + ((((size_t)((su__ >> 8) * 16 + ((su__ >> 4) & 15)) << ldil) | ((su__ >> lq4) & dilm)) * Ls + ((su__ & nq4m) * 128 + 16 * wq + n)) * 64 + 8 * kq; \
        qf[0] = *(const bf16x8s*)qp_; qf[1] = *(const bf16x8s*)(qp_ + 32); tick += 2; } while (0)
#define AT_WAITH(i_) do { const int nl_ = (tick - tkat[(i_) & 3]) >> 2; \
        if (nl_ <= 0) asm volatile("s_waitcnt vmcnt(0)" ::: "memory"); else if (nl_ == 1) asm volatile("s_waitcnt vmcnt(4)" ::: "memory"); else if (nl_ == 2) asm volatile("s_waitcnt vmcnt(8)" ::: "memory"); \
        else if (nl_ == 3) asm volatile("s_waitcnt vmcnt(12)" ::: "memory"); else if (nl_ == 4) asm volatile("s_waitcnt vmcnt(16)" ::: "memory"); else asm volatile("s_waitcnt vmcnt(20)" ::: "memory"); } while (0)
    int tick = 0; int tkat[4] = {0, 0, 0, 0};
    bf16x8s qf[2];
    LAS float* const tab = (LAS float*)(lds + 131072);
    static_assert(131072 + 768 <= RING_BYTES, "attention ring");
    { const float bv = (tid < 192 && tid - 96 >= -64 && tid - 96 <= 64) ? bias2g[((AT_SU(0) >> 4) & 15) * 129 + tid - 96 + 64] : NEGBIG;
      int iss0 = 0; for (; iss0 < 4 && iss0 < NH; ++iss0) AT_DMAH(iss0);
      AT_FETCH_Q(AT_SU(0)); if (tid < 192) tab[tid] = bv; }
    int iss = NH < 4 ? NH : 4;
    AT_WAITH(1);
    asm volatile("s_waitcnt lgkmcnt(0)" ::: "memory"); __builtin_amdgcn_s_barrier(); asm volatile("" ::: "memory");
    const int fl = (n >> 1) & 7;
    for (int s = 0; s < ns; ++s) {
        const int rn = s / R, jn = s - rn * R, a = rn * RH + jn;
        if (iss <= a + 3 && iss < NH) { AT_DMAH(iss); ++iss; }
        if (iss <= a + 3 && iss < NH) { AT_DMAH(iss); ++iss; }
        const bool more = s + 1 < ns;
        const int su = AT_SU(s), q4 = su & nq4m, rr = (su >> lq4) & dilm, h = (su >> 4) & 15, b = su >> 8;
        const size_t rowq = (size_t)b * SEQ + ((size_t)(q4 * 128 + 16 * wq + n) << ldil) + rr;
        f32x4 S[9];
#pragma unroll
        for (int kb = 0; kb < 9; ++kb) S[kb] = (f32x4){0.f, 0.f, 0.f, 0.f};
#pragma unroll
        for (int ks = 0; ks < 2; ++ks)
#pragma unroll
            for (int kb = 0; kb < 9; ++kb) { const int wrow = 16 * (wq + kb);
                const LAS unsigned char* kp = lds + ((a + (wrow >> 7)) & 3) * 32768 + ((wrow & 127) + n) * 128 + (((4 * ks + kq) ^ fl) * 16);
                S[kb] = __builtin_amdgcn_mfma_f32_16x16x32_bf16(*(const LAS bf16x8s*)kp, qf[ks], S[kb], 0, 0, 0); }
        __builtin_amdgcn_sched_barrier(0);
        if (more) AT_FETCH_Q(AT_SU(s + 1));
        float lold = 0.f; v2u xo[4];
        if (!first) { lold = LSE[rowq * 16 + h];
#pragma unroll
            for (int db = 0; db < 4; ++db) xo[db] = *(const v2u*)(OACC + rowq * D + h * 64 + 16 * db + 4 * kq); }
        else {
#pragma unroll
            for (int db = 0; db < 4; ++db) xo[db] = (v2u){0u, 0u}; }
        __builtin_amdgcn_sched_barrier(0);
        const LAS float* tb = tab + (32 + 4 * kq - n);
        int kt0 = q4 * 128 - 64 + 16 * wq + 4 * kq; asm volatile("" : "+v"(kt0));
        float mx = NEGBIG;
#pragma unroll
        for (int kb = 0; kb < 9; ++kb)
#pragma unroll
            for (int e = 0; e < 4; ++e) { const int krel = 16 * kb + e;
                float sv = S[kb][e] * SC + tb[krel]; sv = ((unsigned)(kt0 + krel) >= (unsigned)Ls) ? NEGBIG : sv; S[kb][e] = sv; mx = fmaxf(mx, sv); }
        mx = fmaxf(mx, swz_xor<16>(mx)); mx = fmaxf(mx, get_xor32(mx, lane));
        float l = 0.f; v4u pb[5];
#pragma unroll
        for (int kb = 0; kb < 9; ++kb) {
            const float p0 = __builtin_amdgcn_exp2f(S[kb][0] - mx), p1 = __builtin_amdgcn_exp2f(S[kb][1] - mx), p2 = __builtin_amdgcn_exp2f(S[kb][2] - mx), p3 = __builtin_amdgcn_exp2f(S[kb][3] - mx);
            l += (p0 + p1) + (p2 + p3);
            if (kb & 1) { pb[kb >> 1].z = cvtpk(p0, p1); pb[kb >> 1].w = cvtpk(p2, p3); } else { pb[kb >> 1].x = cvtpk(p0, p1); pb[kb >> 1].y = cvtpk(p2, p3); } }
        pb[4].z = 0u; pb[4].w = 0u;
        l += swz_xor<16>(l); l += get_xor32(l, lane);
        f32x4 O[4];
#pragma unroll
        for (int db = 0; db < 4; ++db) O[db] = (f32x4){0.f, 0.f, 0.f, 0.f};
        { const int vf = (2 * kq + (n >> 3)) & 7;
          unsigned pcs[4];
#pragma unroll
          for (int db = 0; db < 4; ++db) pcs[db] = (unsigned)((4 * kq + (n >> 2)) * 128 + 8 * (n & 1) + (((2 * db + ((n & 3) >> 1)) ^ vf) * 16));
#pragma unroll
          for (int t = 0; t < 5; ++t) {
              const int wlo = 16 * wq + 32 * t, whi = wlo + 16;
              const unsigned blo = (unsigned)(size_t)(lds + ((a + (wlo >> 7)) & 3) * 32768 + 16384 + (wlo & 127) * 128), bhi = (unsigned)(size_t)(lds + ((a + (whi >> 7)) & 3) * 32768 + 16384 + (whi & 127) * 128);
              v2u l0, l1, l2, l3, h0 = (v2u){0u, 0u}, h1 = h0, h2 = h0, h3 = h0;
              const unsigned a0 = blo + pcs[0], a1 = blo + pcs[1], a2 = blo + pcs[2], a3 = blo + pcs[3];
              if (t < 4) { const unsigned c0 = bhi + pcs[0], c1 = bhi + pcs[1], c2 = bhi + pcs[2], c3 = bhi + pcs[3];
                  asm volatile("ds_read_b64_tr_b16 %0, %8\n\tds_read_b64_tr_b16 %1, %9\n\tds_read_b64_tr_b16 %2, %10\n\tds_read_b64_tr_b16 %3, %11\n\t"
                               "ds_read_b64_tr_b16 %4, %12\n\tds_read_b64_tr_b16 %5, %13\n\tds_read_b64_tr_b16 %6, %14\n\tds_read_b64_tr_b16 %7, %15\n\ts_waitcnt lgkmcnt(0)"
                               : "=&v"(l0), "=&v"(l1), "=&v"(l2), "=&v"(l3), "=&v"(h0), "=&v"(h1), "=&v"(h2), "=&v"(h3) : "v"(a0), "v"(a1), "v"(a2), "v"(a3), "v"(c0), "v"(c1), "v"(c2), "v"(c3) : "memory"); }
              else asm volatile("ds_read_b64_tr_b16 %0, %4\n\tds_read_b64_tr_b16 %1, %5\n\tds_read_b64_tr_b16 %2, %6\n\tds_read_b64_tr_b16 %3, %7\n\ts_waitcnt lgkmcnt(0)"
                                : "=&v"(l0), "=&v"(l1), "=&v"(l2), "=&v"(l3) : "v"(a0), "v"(a1), "v"(a2), "v"(a3) : "memory");
              const bf16x8s pf = __builtin_bit_cast(bf16x8s, pb[t]);
              O[0] = __builtin_amdgcn_mfma_f32_16x16x32_bf16(__builtin_bit_cast(bf16x8s, ((v4u){l0.x, l0.y, h0.x, h0.y})), pf, O[0], 0, 0, 0);
              O[1] = __builtin_amdgcn_mfma_f32_16x16x32_bf16(__builtin_bit_cast(bf16x8s, ((v4u){l1.x, l1.y, h1.x, h1.y})), pf, O[1], 0, 0, 0);
              O[2] = __builtin_amdgcn_mfma_f32_16x16x32_bf16(__builtin_bit_cast(bf16x8s, ((v4u){l2.x, l2.y, h2.x, h2.y})), pf, O[2], 0, 0, 0);
              O[3] = __builtin_amdgcn_mfma_f32_16x16x32_bf16(__builtin_bit_cast(bf16x8s, ((v4u){l3.x, l3.y, h3.x, h3.y})), pf, O[3], 0, 0, 0); } }
        const float il = __builtin_amdgcn_rcpf(l); float lse = mx + __builtin_amdgcn_logf(l);
        float wn = il, wo = 0.f;
        if (!first) { const float mm = fmaxf(lold, lse), eo = __builtin_amdgcn_exp2f(lold - mm), en = __builtin_amdgcn_exp2f(lse - mm), inv = __builtin_amdgcn_rcpf(eo + en); wn = en * inv * il; wo = eo * inv; lse = mm + __builtin_amdgcn_logf(eo + en); }
        if (kq == 0) LSE[rowq * 16 + h] = lse;
#pragma unroll
        for (int db = 0; db < 4; ++db) { const v2u x = xo[db]; v2u y;
            y.x = cvtpk(wn * O[db][0] + wo * bflo(x.x), wn * O[db][1] + wo * bfhi(x.x)); y.y = cvtpk(wn * O[db][2] + wo * bflo(x.y), wn * O[db][3] + wo * bfhi(x.y));
            *(v2u*)(OACC + rowq * D + h * 64 + 16 * db + 4 * kq) = y; }
        tick += 5;
        if (more) { const int an = ((s + 1) / R) * RH + ((s + 1) % R); AT_WAITH(an + 1); }
        asm volatile("s_waitcnt lgkmcnt(0)" ::: "memory"); __builtin_amdgcn_s_barrier(); asm volatile("" ::: "memory");
    }
#undef AT_WAITH
#undef AT_FETCH_Q
#undef AT_DMAH
#undef AT_SU
#undef AT_P
    __syncthreads();
}

struct Args { const float* in[11]; float* out; unsigned char* ws; int ph_lo, ph_hi; };
__global__ void __launch_bounds__(NTHREADS, 2) mk_fwd(Args args) {
    extern __shared__ __attribute__((aligned(16))) unsigned char lds_raw[];
    LAS unsigned char* lds = (LAS unsigned char*)lds_raw;
    volatile LAS unsigned* MISC = (volatile LAS unsigned*)(lds + MISC_OFF);
    const int wave0 = __builtin_amdgcn_readfirstlane(threadIdx.x >> 6);
    for (int u = threadIdx.x; u < (LDS_BYTES - LDSCTL_OFF) / 4; u += NTHREADS) ((LAS unsigned*)(lds + LDSCTL_OFF))[u] = 0u;
    __syncthreads();
    (void)xcd_barrier_post((unsigned*)(args.ws + WS_CTL) + CW_BAR, MISC + 8);
    bool again = false;
#if PROBE_TWICE
    for (int pass_ = 0; pass_ < 2; ++pass_)
#endif
    for (int ph = args.ph_lo; ph < args.ph_hi; ++ph) {
        size_t wsz = 0; asm volatile("" : "+s"(wsz)); unsigned char* ws = args.ws + wsz;
        int bid = blockIdx.x, G = gridDim.x; asm volatile("" : "+s"(bid), "+s"(G));
        const int gw = bid * NWAVES + wave0, NGW = G * NWAVES;
#define GET_TID() int tid; asm volatile("v_mbcnt_lo_u32_b32 %0, -1, 0\n\tv_mbcnt_hi_u32_b32 %0, -1, %0" : "=v"(tid)); const int lane = tid; tid += wave0 * 64; (void)lane;
        LAS float* scr = (LAS float*)(lds + RING_OFF + wave0 * CV_SCR);
        const float* gains = args.in[1]; float* out = args.out;
        float* RS = (float*)(ws + WS_RS);
        enum { T_P0, T_G1, T_FG, T_THIN, T_APROJ, T_ATT, T_RPROJ, T_RCORE, T_RGATE, T_RSTAT };
        int type, L = 0, kind = 0, aux = 0;
        if (ph == 0) type = T_P0;
        else { const int p = ph - 1, pp = p % 20, odd = pp >= 11, q = odd ? pp - 11 : pp, nmix = odd ? 5 : 7;
            L = 2 * (p / 20) + odd;
            if (q < 2) { kind = 0; type = q == 0 ? T_G1 : T_FG; }
            else if (q >= 2 + nmix) { kind = 2; type = q - 2 - nmix == 0 ? T_G1 : T_FG; }
            else { kind = 1; const int r = q - 2;
                if (r == nmix - 1) type = T_FG;
                else if (!odd) { aux = r >> 1; type = (r & 1) ? T_ATT : T_APROJ; }
                else type = r == 0 ? T_RPROJ : (r == 1 ? T_RCORE : (r == 2 ? T_RSTAT : T_RGATE)); } }
        const bool is_att = (L & 1) == 0; const int jj = L >> 1;
#if PROBE_TSEL
        volatile LAS unsigned long long* TS = (volatile LAS unsigned long long*)(lds + RING_BYTES + 512);
        if (wave0 == 0) TS[0] = __builtin_amdgcn_s_memrealtime();
#define TS_ACC() if (wave0 == 0 && ph >= PROBE_TLO && ph < PROBE_THI && ((PROBE_TMASK >> type) & 1)) TS[1] = TS[1] + (__builtin_amdgcn_s_memrealtime() - TS[0]);
#endif
#define P_BIAS ((float*)(ws + WS_BIAS))
#define P_WA   ((bf16*)(ws + WS_W))
#define P_XH   ((bf16*)(ws + WS_XH))
#define P_BIG  ((bf16*)(ws + WS_BIG))
#define P_F    ((bf16*)(ws + WS_F))
#define P_YC   ((bf16*)(ws + WS_YC))
#define P_OACC ((bf16*)(ws + WS_OACC))
#define P_LSE  ((float*)(ws + WS_LSE))
        if (type == T_P0) {
            GET_TID()
#if PROBE_TOUCH
            {
                const size_t tix = (size_t)(bid >> 3) * NTHREADS + tid, nthr = (size_t)(G >> 3) * NTHREADS; unsigned accw = 0;
                for (size_t o = tix * 65536; o < WS_END; o += nthr * 65536) accw += *(const volatile unsigned*)(ws + o);
                for (size_t o = tix * 65536; o < (size_t)M * D * 4; o += nthr * 65536) { accw += *(const volatile unsigned*)((const char*)args.in[0] + o); accw += *(const volatile unsigned*)((const char*)out + o); }
                for (size_t o = tix * 65536; o < (size_t)DEPTH * 2 * D * DFF * 4; o += nthr * 65536) { accw += *(const volatile unsigned*)((const char*)args.in[2] + o); accw += *(const volatile unsigned*)((const char*)args.in[3] + o); accw += *(const volatile unsigned*)((const char*)args.in[4] + o); }
                for (size_t o = tix * 65536; o < (size_t)2 * D * NGRP * ATT_COLS * 4; o += nthr * 65536) accw += *(const volatile unsigned*)((const char*)args.in[5] + o);
                for (size_t o = tix * 65536; o < (size_t)2 * D * RET_COLS * 4; o += nthr * 65536) accw += *(const volatile unsigned*)((const char*)args.in[8] + o);
                if (accw == 0x12345677u) P_BIAS[70000] = 1.f; }
#endif
            const float* rel_bias = args.in[7];
            if (bid == 0) for (int i = tid; i < 3 * 16 * 129; i += NTHREADS) { const int g = i / (16 * 129), h = (i / 129) % 16, kk = i % 129; P_BIAS[i] = rel_bias[(g * 16 + h) * 32 + T5_BUCKET[g][kk]] * 1.4426950409f; }
            conv_gateup(args.in[2], args.in[3], P_WA, gains, scr, gw, NGW, lane);
            conv_plain<DFF, D>(args.in[4], (bf16*)(ws + WS_W2A), nullptr, scr, gw, NGW, lane);
            p0_rows(args.in[0], P_XH, RS, gw, NGW, lane);
#if PROBE_MFMA
            {
                typedef short bx8 __attribute__((ext_vector_type(8)));
                bx8 a = {1, 2, 3, 4, 5, 6, 7, (short)lane}, b = {3, 1, 4, 1, 5, 9, 2, (short)(lane + 1)};
                f32x4 c0 = {0, 0, 0, 0}, c1 = c0, c2 = c0, c3 = c0, c4 = c0, c5 = c0, c6 = c0, c7 = c0;
                for (int it = 0; it < PROBE_MFMA; ++it) {
#pragma unroll
                    for (int r = 0; r < 4; ++r) {
                        c0 = __builtin_amdgcn_mfma_f32_16x16x32_bf16(a, b, c0, 0, 0, 0); c1 = __builtin_amdgcn_mfma_f32_16x16x32_bf16(a, b, c1, 0, 0, 0); c2 = __builtin_amdgcn_mfma_f32_16x16x32_bf16(a, b, c2, 0, 0, 0); c3 = __builtin_amdgcn_mfma_f32_16x16x32_bf16(a, b, c3, 0, 0, 0);
                        c4 = __builtin_amdgcn_mfma_f32_16x16x32_bf16(a, b, c4, 0, 0, 0); c5 = __builtin_amdgcn_mfma_f32_16x16x32_bf16(a, b, c5, 0, 0, 0); c6 = __builtin_amdgcn_mfma_f32_16x16x32_bf16(a, b, c6, 0, 0, 0); c7 = __builtin_amdgcn_mfma_f32_16x16x32_bf16(a, b, c7, 0, 0, 0); }
                    asm volatile("" : "+v"(a), "+v"(b)); }
                const f32x4 t = c0 + c1 + c2 + c3 + c4 + c5 + c6 + c7;
                if (t.x + t.y + t.z + t.w == 12345.678f) P_BIAS[60000 + tid] = t.x;
            }
#endif
        } else if (type == T_G1) {
            GET_TID()
            pg8::Gemm g{P_XH, P_WA, M, 2 * DFF, D, 0}; pg8::StaticOrder S; S.init(M, 2 * DFF, G, bid);
            pg8::stage_scales(lds + RING_OFF, S, RS, false, 0, tid);
            pg8::EpiSwiGLU E{P_BIG, DFF, (const LAS float*)(lds + RING_OFF + pg8::RS_TAB_OFF)};
            pg8::gemm_phase<pg8::EpiSwiGLU, pg8::StaticOrder, true, true>(lds + RING_OFF, g, S, E, tid);
#if PROBE_G1V >= 0
            { GET_TID() pg8::Gemm g2{P_XH, P_WA, M, 2 * DFF, D, 0}; pg8::StaticOrder S2; S2.init(M, 2 * DFF, G, bid);
              pg8::EpiSwiGLUT<PROBE_G1V> E2{PROBE_G1V ? P_F : P_BIG, PROBE_G1V ? D : DFF, (const LAS float*)(lds + RING_OFF + pg8::RS_TAB_OFF)};
              pg8::gemm_phase<pg8::EpiSwiGLUT<PROBE_G1V>, pg8::StaticOrder, true, true>(lds + RING_OFF, g2, S2, E2, tid); }
#endif
        } else if (type == T_FG) {
            GET_TID()
            const int sub = L * 3 + kind; const bool lastsub = sub + 1 >= 3 * DEPTH;
            if (!lastsub) {
                const int nk = (sub + 1) % 3, nL = (sub + 1) / 3, nj = nL >> 1;
                const float* gn = gains + ((size_t)nL * 6 + (nk == 0 ? 0 : (nk == 1 ? 2 : 4))) * D;
                bf16* w2n = (bf16*)(ws + (((sub + 1) & 1) ? WS_W2B : WS_W2A));
                if (nk != 1) { const size_t o = (size_t)(nL * 2 + (nk >> 1)) * D * DFF;
                    conv_gateup(args.in[2] + o, args.in[3] + o, P_WA, gn, scr, gw, NGW, lane); conv_plain<DFF, D>(args.in[4] + o, w2n, nullptr, scr, gw, NGW, lane); }
                else if ((nL & 1) == 0) { conv_plain<D, NGRP * ATT_COLS>(args.in[5] + (size_t)nj * D * NGRP * ATT_COLS, P_WA, gn, scr, gw, NGW, lane); conv_plain<D, D>(args.in[6] + (size_t)nj * D * D, w2n, nullptr, scr, gw, NGW, lane); }
                else { const float* rw = args.in[8] + (size_t)nj * D * RET_COLS;
                    conv_cols<D, RET_COLS, 2 * D + DV>(rw, 0, P_WA, 0, gn, scr, gw, NGW, lane); conv_gates<RET_COLS>(rw, 2 * D + DV, 2 * D + 2 * DV, P_WA, 2 * D + DV, gn, scr, gw, NGW, lane);
                    conv_plain<DV, D>(args.in[9] + (size_t)nj * DV * D, w2n, nullptr, scr, gw, NGW, lane); }
                asm volatile("" ::: "memory"); __syncthreads();
            }
            { GET_TID()
              const size_t fA = kind != 1 ? WS_BIG : (is_att ? WS_OACC : WS_YC), fB = (sub & 1) ? WS_W2B : WS_W2A; const int fK = kind != 1 ? DFF : (is_att ? D : DV);
              pg8::Gemm g{(const bf16*)(ws + fA), (const bf16*)(ws + fB), M, D, fK, 0}; pg8::PanelOrder S; S.init(M, D, G, bid);
              const float* gpost = gains + ((size_t)L * 6 + (kind == 0 ? 1 : (kind == 1 ? 3 : 5))) * D;
              unsigned* pf = (unsigned*)(ws + WS_PF);
              pg8::EpiThin E{P_XH, lastsub ? out : nullptr, gpost, kind == 1 ? 1.0f : 0.5f, pf + (size_t)(sub & 1) * M * 4, pf + (size_t)((sub + 1) & 1) * M * 4, RS, (LAS float*)(lds + RING_OFF + pg8::RS_TAB_OFF)};
              pg8::gemm_phase<pg8::EpiThin, pg8::PanelOrder, true, true>(lds + RING_OFF, g, S, E, tid); }
        } else if (type == T_APROJ) {
            GET_TID()
            { pg8::Gemm g{P_XH, P_WA + (size_t)aux * ATT_COLS * D, M, ATT_COLS, D, 0}; pg8::StaticOrder S; S.init(M, ATT_COLS, G, bid);
              pg8::stage_scales(lds + RING_OFF, S, RS, false, 0, tid);
              pg8::EpiQKV E{P_BIG, 2 * aux, (const LAS float*)(lds + RING_OFF + pg8::RS_TAB_OFF)};
              pg8::gemm_phase<pg8::EpiQKV, pg8::StaticOrder, true, true>(lds + RING_OFF, g, S, E, tid); }
        } else if (type == T_ATT) {
            GET_TID()
            const int ldil = 2 * aux;
            if (ldil < 4 && G * 8 == BATCH * HA * 16 / 2) attn_group_ring(P_BIG, P_BIAS + aux * 16 * 129, ldil, aux == 0, P_OACC, P_LSE, lds + RING_OFF, tid, bid, G);
            else attn_group_mfma5(P_BIG, P_BIAS + aux * 16 * 129, ldil, aux == 0, P_OACC, P_LSE, lds + RING_OFF, tid, bid, G);
        } else if (type == T_RPROJ) {
            GET_TID()
            { pg8::Gemm g{P_XH, P_WA, M, 2 * D, D, 0}; pg8::StaticOrder S; S.init(M, 2 * D, G, bid);
              pg8::stage_scales(lds + RING_OFF, S, RS, false, 0, tid);
              pg8::EpiRet E{P_BIG, 2 * D, (const LAS float*)(lds + RING_OFF + pg8::RS_TAB_OFF)};
              pg8::gemm_phase<pg8::EpiRet, pg8::StaticOrder, true, true>(lds + RING_OFF, g, S, E, tid); }
            { GET_TID()
              pg8::Gemm g{P_WA + (size_t)2 * D * D, P_XH, DV, M, D, 0}; pg8::StaticOrder S; S.init(DV, M, G, bid);
              pg8::stage_scales(lds + RING_OFF, S, RS, true, 0, tid);
              pg8::EpiVT E{(bf16*)(ws + WS_RVT), M, 0, (const LAS float*)(lds + RING_OFF + pg8::RS_TAB_OFF)};
              pg8::gemm_phase<pg8::EpiVT, pg8::StaticOrder, true, true>(lds + RING_OFF, g, S, E, tid); }
        } else if (type == T_RCORE) {
            GET_TID()
            static_assert(RC_LDS <= RING_BYTES, "retention core LDS tiles");
            ret_core_mfma<0>(P_BIG, (const bf16*)(ws + WS_RVT), args.in[10] + jj * 2 * HR, P_YC, (bf16*)out, (float*)(ws + WS_OACC), lds + RING_OFF, tid, bid, G);
        } else if (type == T_RSTAT) {
            GET_TID()
            ret_stats((const float*)(ws + WS_OACC), P_LSE, bid * NTHREADS + tid, G * NTHREADS);
        } else {
            GET_TID()
            pg8::Gemm g{P_XH, P_WA + (size_t)(2 * D + DV) * D, M, 2 * DV, D, 0}; pg8::StaticOrder S; S.init(M, 2 * DV, G, bid);
            pg8::stage_scales(lds + RING_OFF, S, RS, false, 0, tid);
            pg8::EpiGate E{P_YC, (const bf16*)out, P_LSE, (const LAS float*)(lds + RING_OFF + pg8::RS_TAB_OFF)};
            pg8::gemm_phase<pg8::EpiGate, pg8::StaticOrder, true, true>(lds + RING_OFF, g, S, E, tid);
        }
#if PROBE_TSEL && PROBE_TWORK
        TS_ACC()
#endif
        if (ph + 1 < args.ph_hi || PROBE_TWICE) { XcdBarrier b_; b_.bar = (unsigned*)(ws + WS_CTL) + CW_BAR; b_.x = xb_xcc_id(); b_.st = MISC + 8; xcd_barrier(b_);
#if PROBE_BAR2
            xcd_barrier(b_);
#endif
        }
#if PROBE_TSEL && !PROBE_TWORK
        TS_ACC()
#endif
        if (PROBE_REPEAT) {
            if (!again && ((PROBE_REPEAT >> type) & 1) && (type != T_ATT || aux == 0) && ph + 1 < args.ph_hi) { again = true; --ph; } else again = false; }
    }
#if PROBE_TSEL
    if (blockIdx.x == PROBE_TWG && wave0 == 0) {
        const unsigned long long tend = __builtin_amdgcn_s_memrealtime(), need = ((volatile LAS unsigned long long*)(lds + RING_BYTES + 512))[1] * PROBE_TAMP;
        while (__builtin_amdgcn_s_memrealtime() - tend < need) __builtin_amdgcn_s_sleep(8); }
#endif
}

extern "C" void kernel_launch(void* const* d_in, const int* in_sizes, int n_in, void* d_out, int out_size, void* d_ws, size_t ws_size, hipStream_t stream) {
    static int grid = 0;
    if (grid == 0) {
        if (n_in != 11 || in_sizes[0] != M * D || out_size != M * D || ws_size < WS_END) { fprintf(stderr, "kernel_launch: unexpected shapes / workspace (n_in %d, ws %zu, need %zu); nothing launched\n", n_in, ws_size, (size_t)WS_END); grid = -1; return; }
        int dev = 0, cus = 0, per_cu = 0;
        if (hipGetDevice(&dev) != hipSuccess || hipDeviceGetAttribute(&cus, hipDeviceAttributeMultiprocessorCount, dev) != hipSuccess) { grid = -1; return; }
        if (hipFuncSetAttribute((const void*)mk_fwd, hipFuncAttributeMaxDynamicSharedMemorySize, LDS_BYTES) != hipSuccess) { fprintf(stderr, "kernel_launch: hipFuncSetAttribute failed\n"); grid = -1; return; }
        if (hipOccupancyMaxActiveBlocksPerMultiprocessor(&per_cu, (const void*)mk_fwd, NTHREADS, LDS_BYTES) != hipSuccess || per_cu < 1) { fprintf(stderr, "kernel_launch: occupancy query reports %d workgroups per CU\n", per_cu); }
        (void)hipGetLastError();
        grid = cus;
    }
    if (grid < 0) return;
    if (hipMemsetAsync((char*)d_ws + WS_CTL, 0, CTL_ZERO_BYTES, stream) != hipSuccess) return;
    Args a{};
    for (int i = 0; i < 11; ++i) a.in[i] = (const float*)d_in[i];
    a.out = (float*)d_out; a.ws = (unsigned char*)d_ws;
#if MK_ONE_LAUNCH
    a.ph_lo = 0; a.ph_hi = NPHASES;
    hipLaunchKernelGGL(mk_fwd, dim3(grid), dim3(NTHREADS), LDS_BYTES, stream, a);
#else
    for (int p = 0; p < NPHASES; ++p) { a.ph_lo = p; a.ph_hi = p + 1; hipLaunchKernelGGL(mk_fwd, dim3(grid), dim3(NTHREADS), LDS_BYTES, stream, a); }
#endif
}
```
